# Optimizing an MI355X kernel written in HIP

```python
import jax, jax.numpy as jnp
from jax import lax
import numpy as np


D_MODEL = 1024
BATCH = 4
SEQ = 8192
DEPTH = 2

GRID_W = 64
CTX_LEN = 256
N_MIXERS = 2
NORM_EPS = 1e-6
ATTN_HEADS = 16
ATTN_KV_HEADS = 4
HEAD_DIM = D_MODEL // ATTN_HEADS
ATTN_GROUP = ATTN_HEADS // ATTN_KV_HEADS
Q_WIDTH = ATTN_HEADS * HEAD_DIM
KV_WIDTH = ATTN_KV_HEADS * HEAD_DIM
QKV_WIDTH = Q_WIDTH + 2 * KV_WIDTH
AXIS_DIM = HEAD_DIM // 2
ROPE_THETA = 10000.0
Q_BLOCK = 128
HGRN_WIDTH = D_MODEL
HGRN_EXPAND = 128
HGRN_HEADS = HGRN_WIDTH // HGRN_EXPAND
HGRN_DK = HGRN_EXPAND
HGRN_DV = HGRN_WIDTH // HGRN_HEADS
HGRN_CHUNK = 64
FFN_HIDDEN = ((8 * D_MODEL // 3 + 255) // 256) * 256
N_ATTN_LAYERS = (DEPTH + 1) // 2
N_HGRN_LAYERS = DEPTH // 2

kernel_name = 'hybrid_gqa_hgrn2_adaln_prefix_dit'


def rms_norm(x, w):
    xf = x.astype(jnp.float32)
    y = xf * lax.rsqrt(jnp.mean(xf * xf, axis=-1, keepdims=True) + NORM_EPS)
    return (y * w.astype(jnp.float32)).astype(x.dtype)


def modulate(h, shift, scale):
    return h * (1.0 + scale) + shift


def axial_rope_tables(n_tokens):
    rows = n_tokens // GRID_W
    row_pos = jnp.repeat(jnp.arange(rows), GRID_W).astype(jnp.float32)
    col_pos = jnp.tile(jnp.arange(GRID_W), rows).astype(jnp.float32)
    inv_freq = ROPE_THETA ** (-(jnp.arange(AXIS_DIM // 2, dtype=jnp.float32) * 2.0 / AXIS_DIM))
    ang_r = row_pos[:, None] * inv_freq
    ang_c = col_pos[:, None] * inv_freq
    return (jnp.cos(ang_r), jnp.sin(ang_r), jnp.cos(ang_c), jnp.sin(ang_c))


def rotate_half(x, cos, sin):
    x1, x2 = jnp.split(x, 2, axis=-1)
    return jnp.concatenate([x1 * cos - x2 * sin, x2 * cos + x1 * sin], axis=-1)


def apply_axial_rope(x, rope):
    cos_r, sin_r, cos_c, sin_c = rope
    xf = x.astype(jnp.float32)
    xr, xc = jnp.split(xf, 2, axis=-1)
    out = jnp.concatenate([rotate_half(xr, cos_r, sin_r), rotate_half(xc, cos_c, sin_c)], axis=-1)
    return out.astype(x.dtype)


def gqa_attend(q, k, v):
    s = jnp.einsum('bkgqd,bksd->bkgqs', q, k, preferred_element_type=jnp.float32) * (HEAD_DIM ** -0.5)
    p = jax.nn.softmax(s, axis=-1).astype(v.dtype)
    return jnp.einsum('bkgqs,bksd->bkgqd', p, v)


def attention_mixer(h_lat, h_ctx, w_qkv, q_norm, k_norm, w_o, rope, with_ctx_out):
    b, n, _ = h_lat.shape
    m = h_ctx.shape[1]
    w_q, w_kv = w_qkv[:, :Q_WIDTH], w_qkv[:, Q_WIDTH:]

    def queries(h):
        t = h.shape[1]
        q = (h @ w_q).reshape(b, t, ATTN_KV_HEADS, ATTN_GROUP, HEAD_DIM).transpose(0, 2, 3, 1, 4)
        return rms_norm(q, q_norm)

    def keys_values(h):
        t = h.shape[1]
        k, v = jnp.split(h @ w_kv, 2, axis=-1)
        k = k.reshape(b, t, ATTN_KV_HEADS, HEAD_DIM).transpose(0, 2, 1, 3)
        v = v.reshape(b, t, ATTN_KV_HEADS, HEAD_DIM).transpose(0, 2, 1, 3)
        return rms_norm(k, k_norm), v

    q_l = apply_axial_rope(queries(h_lat), rope)
    k_l, v_l = keys_values(h_lat)
    k_l = apply_axial_rope(k_l, rope)
    k_c, v_c = keys_values(h_ctx)
    k_all = jnp.concatenate([k_c, k_l], axis=2)
    v_all = jnp.concatenate([v_c, v_l], axis=2)

    nb = n // Q_BLOCK
    q_blocks = q_l.reshape(b, ATTN_KV_HEADS, ATTN_GROUP, nb, Q_BLOCK, HEAD_DIM).transpose(3, 0, 1, 2, 4, 5)
    o_blocks = lax.map(lambda qb: gqa_attend(qb, k_all, v_all), q_blocks)
    o_l = o_blocks.transpose(1, 0, 4, 2, 3, 5).reshape(b, n, Q_WIDTH)
    y_l = o_l @ w_o
    if not with_ctx_out:
        return y_l, None
    o_c = gqa_attend(queries(h_ctx), k_c, v_c)
    y_c = o_c.transpose(0, 3, 1, 2, 4).reshape(b, m, Q_WIDTH) @ w_o
    return y_l, y_c


def hgrn2_chunk_scan(q, k, log_f, v, s0):
    b, h, n, dk = q.shape
    dv = v.shape[-1]
    nc = n // HGRN_CHUNK

    def to_chunks(a):
        return a.reshape(b, h, nc, HGRN_CHUNK, a.shape[-1]).transpose(2, 0, 1, 3, 4)

    mask = jnp.tril(jnp.ones((HGRN_CHUNK, HGRN_CHUNK), dtype=bool))[None, None, :, :, None]

    def step(state, inp):
        qc, kc, gc, vc = inp
        L = jnp.cumsum(gc, axis=2)
        o_inter = jnp.einsum('bhtk,bhkv->bhtv', qc * jnp.exp(L), state)
        diff = L[:, :, :, None, :] - L[:, :, None, :, :]
        decay = jnp.where(mask, jnp.exp(jnp.where(mask, diff, 0.0)), 0.0)
        a = jnp.einsum('bhtk,bhtsk,bhsk->bhts', qc, decay, kc)
        o_intra = jnp.einsum('bhts,bhsv->bhtv', a, vc)
        L_end = L[:, :, -1:, :]
        new_state = jnp.exp(L_end[:, :, 0, :])[..., None] * state + jnp.einsum(
            'bhsk,bhsv->bhkv', kc * jnp.exp(L_end - L), vc)
        return new_state, o_inter + o_intra

    s_final, o = lax.scan(step, s0, (to_chunks(q), to_chunks(k), to_chunks(log_f), to_chunks(v)))
    return o.transpose(1, 2, 0, 3, 4).reshape(b, h, n, dv), s_final


def hgrn2_final_state(k, log_f, v):
    L = jnp.cumsum(log_f, axis=2)
    return jnp.einsum('bhsk,bhsv->bhkv', k * jnp.exp(L[:, :, -1:, :] - L), v)


def hgrn2_mixer(h_lat, h_ctx, w_in, lb, out_norm, w_o, with_ctx_out):
    b = h_lat.shape[0]

    def heads(a):
        return a.reshape(b, a.shape[1], HGRN_HEADS, -1).transpose(0, 2, 1, 3).astype(jnp.float32)

    def gates(z):
        f = lb + (1.0 - lb) * jax.nn.sigmoid(z.astype(jnp.float32))
        return heads(jnp.log(f)), heads(1.0 - f)

    def recurrent_inputs(h):
        z_fw, z_bw, v = jnp.split(h @ w_in[:, 2 * HGRN_WIDTH:], 3, axis=-1)
        g_fw, k_fw = gates(z_fw)
        g_bw, k_bw = gates(z_bw)
        return g_fw, k_fw, g_bw, k_bw, heads(v)

    def query_gate(h):
        q, g = jnp.split(h @ w_in[:, :2 * HGRN_WIDTH], 2, axis=-1)
        return heads(q), g

    def flip(a):
        return jnp.flip(a, axis=2)

    def readout(o, g):
        t = o.shape[2]
        o = rms_norm(o.transpose(0, 2, 1, 3), out_norm.reshape(HGRN_HEADS, HGRN_DV))
        o = o * jax.nn.sigmoid(g.astype(jnp.float32)).reshape(b, t, HGRN_HEADS, HGRN_DV)
        return o.reshape(b, t, HGRN_WIDTH).astype(h_lat.dtype) @ w_o

    zeros = jnp.zeros((b, HGRN_HEADS, HGRN_DK, HGRN_DV), jnp.float32)
    gc_fw, kc_fw, gc_bw, kc_bw, vc = recurrent_inputs(h_ctx)
    y_c = None
    if with_ctx_out:
        qc, gate_c = query_gate(h_ctx)
        oc_fw, s_fw = hgrn2_chunk_scan(qc, kc_fw, gc_fw, vc, zeros)
        oc_bw, s_bw = hgrn2_chunk_scan(flip(qc), flip(kc_bw), flip(gc_bw), flip(vc), zeros)
        y_c = readout(oc_fw + flip(oc_bw), gate_c)
    else:
        s_fw = hgrn2_final_state(kc_fw, gc_fw, vc)
        s_bw = hgrn2_final_state(flip(kc_bw), flip(gc_bw), flip(vc))

    q, gate = query_gate(h_lat)
    g_fw, k_fw, g_bw, k_bw, v = recurrent_inputs(h_lat)
    o_fw, _ = hgrn2_chunk_scan(q, k_fw, g_fw, v, s_fw)
    o_bw, _ = hgrn2_chunk_scan(flip(q), flip(k_bw), flip(g_bw), flip(v), s_bw)
    return readout(o_fw + flip(o_bw), gate), y_c


def swiglu(h, w_in, w_out):
    a, u = jnp.split(h @ w_in, 2, axis=-1)
    return (jax.nn.silu(a) * u) @ w_out


def setup_inputs(seed: int = 0) -> dict:
    key = jax.random.key(seed)
    ks = jax.random.split(key, 19)
    D = D_MODEL

    def nrm(k, shape, scale):
        return jax.random.normal(k, shape, jnp.float32) * scale

    return {
        'x': nrm(ks[0], (BATCH, SEQ, D), 1.0),
        'c': nrm(ks[1], (BATCH, D), 1.0),
        'ctx': nrm(ks[2], (BATCH, CTX_LEN, D), 1.0),
        'c_ctx': nrm(ks[3], (D,), 1.0),
        'ada_w': nrm(ks[4], (DEPTH, D, 6 * D), 0.5 * D ** -0.5),
        'ada_b': nrm(ks[5], (DEPTH, 6 * D), 0.02),
        'norm_mix_w': 1.0 + nrm(ks[6], (DEPTH, D), 0.05),
        'norm_ffn_w': 1.0 + nrm(ks[7], (DEPTH, D), 0.05),
        'attn_w_qkv': nrm(ks[8], (N_ATTN_LAYERS, D, QKV_WIDTH), D ** -0.5),
        'attn_q_norm': 1.0 + nrm(ks[9], (N_ATTN_LAYERS, HEAD_DIM), 0.05),
        'attn_k_norm': 1.0 + nrm(ks[10], (N_ATTN_LAYERS, HEAD_DIM), 0.05),
        'attn_w_o': nrm(ks[11], (N_ATTN_LAYERS, Q_WIDTH, D), Q_WIDTH ** -0.5),
        'hgrn_w_in': nrm(ks[12], (N_HGRN_LAYERS, D, 5 * HGRN_WIDTH), D ** -0.5),
        'hgrn_lb_logits': nrm(ks[13], (DEPTH, HGRN_WIDTH), 0.5),
        'hgrn_out_norm': 1.0 + nrm(ks[14], (N_HGRN_LAYERS, HGRN_WIDTH), 0.05),
        'hgrn_w_o': nrm(ks[15], (N_HGRN_LAYERS, HGRN_WIDTH, D), HGRN_WIDTH ** -0.5),
        'ffn_w_in': nrm(ks[16], (DEPTH, D, 2 * FFN_HIDDEN), D ** -0.5),
        'ffn_w_out': nrm(ks[17], (DEPTH, FFN_HIDDEN, D), FFN_HIDDEN ** -0.5),
        'final_norm_w': 1.0 + nrm(ks[18], (D,), 0.05),
    }


def reference(x, c, ctx, c_ctx, ada_w, ada_b, norm_mix_w, norm_ffn_w, attn_w_qkv, attn_q_norm,
              attn_k_norm, attn_w_o, hgrn_w_in, hgrn_lb_logits, hgrn_out_norm, hgrn_w_o,
              ffn_w_in, ffn_w_out, final_norm_w):
    n = x.shape[1]
    rope = axial_rope_tables(n)
    p = jax.nn.softmax(hgrn_lb_logits.astype(jnp.float32), axis=0)
    lower_bounds = jnp.cumsum(p, axis=0) - p[0:1]

    h, hc = x, ctx
    for i in range(DEPTH):
        last = i == DEPTH - 1
        mod_l = (jax.nn.silu(c) @ ada_w[i] + ada_b[i])[:, None, :]
        mod_c = (jax.nn.silu(c_ctx) @ ada_w[i] + ada_b[i])[None, None, :]
        sh1_l, sc1_l, gt1_l, sh2_l, sc2_l, gt2_l = jnp.split(mod_l, 6, axis=-1)
        sh1_c, sc1_c, gt1_c, sh2_c, sc2_c, gt2_c = jnp.split(mod_c, 6, axis=-1)

        hn_l = modulate(rms_norm(h, norm_mix_w[i]), sh1_l, sc1_l)
        hn_c = modulate(rms_norm(hc, norm_mix_w[i]), sh1_c, sc1_c)
        if i % N_MIXERS == 0:
            j = i // N_MIXERS
            y_l, y_c = attention_mixer(hn_l, hn_c, attn_w_qkv[j], attn_q_norm[j], attn_k_norm[j],
                                       attn_w_o[j], rope, not last)
        else:
            j = i // N_MIXERS
            y_l, y_c = hgrn2_mixer(hn_l, hn_c, hgrn_w_in[j], lower_bounds[i], hgrn_out_norm[j],
                                   hgrn_w_o[j], not last)

        h = h + gt1_l * y_l
        h = h + gt2_l * swiglu(modulate(rms_norm(h, norm_ffn_w[i]), sh2_l, sc2_l), ffn_w_in[i], ffn_w_out[i])
        if not last:
            hc = hc + gt1_c * y_c
            hc = hc + gt2_c * swiglu(modulate(rms_norm(hc, norm_ffn_w[i]), sh2_c, sc2_c),
                                     ffn_w_in[i], ffn_w_out[i])
    return rms_norm(h, final_norm_w)
```

```cpp
#include <hip/hip_cooperative_groups.h>
namespace cg = cooperative_groups;
#include <hip/hip_runtime.h>
#include <cstdio>
#include <cstdint>
namespace pg8 {
#define PG8_LAS __attribute__((address_space(3)))
typedef unsigned short bf16_t;
typedef short bf16x8 __attribute__((ext_vector_type(8)));
typedef float f32x4 __attribute__((ext_vector_type(4)));
typedef unsigned u32x4 __attribute__((ext_vector_type(4)));
constexpr int BM = 256, BK = 64, HALF = 128, HTB = HALF * BK * 2  , STAGE_BYTES = 8 * HTB, NXCD = 8, WGM = 8;

__host__ __device__ __forceinline__ int lds_byte(int r, int c) { const int st = (r >> 4) * 2 + (c >> 5), rr = r & 15, cc = c & 31, ob = rr * 64 + cc * 2; return st * 1024 + (ob ^ (((ob >> 9) & 1) << 5)); }
__host__ __device__ __forceinline__ void stage_rc(int b, int& R, int& C) { const int st = b / 1024, sb = b % 1024, swz = sb ^ (((sb >> 9) & 1) << 5); R = (st >> 1) * 16 + swz / 64; C = (st & 1) * 32 + (swz % 64) / 2; }
__host__ __device__ __forceinline__ int perm32(int rho) { const int n = rho >> 4, i = rho & 15; return 8 * (i >> 2) + 4 * n + (i & 3); }

struct Unit { int pm, pn; };
struct Gemm { const bf16_t* A; const bf16_t* Bt; int M, N, K; };

struct StaticOrder {
    int nM, nN, nwg, G, c;
    __host__ __device__ void init(int M, int N, int G_, int c_) { nM = M / BM; nN = N / BM; nwg = nM * nN; G = G_; c = c_; }
    __host__ __device__ bool next(int i, Unit& u) const {
        const long L = (long)i * G + c; if (L >= nwg) return false;
        int wgid = (int)L; { const int q = nwg / NXCD, r = nwg % NXCD, xcd = wgid % NXCD, off = wgid / NXCD; wgid = (xcd < r ? xcd * (q + 1) : r * (q + 1) + (xcd - r) * q) + off; }
        const int nig = WGM * nN, gid = wgid / nig, fm = gid * WGM, gsz = (nM - fm) < WGM ? (nM - fm) : WGM;
        u.pm = fm + ((wgid % nig) % gsz); u.pn = (wgid % nig) / gsz; return true;
    }
    __device__ __forceinline__ void a_ready(const Unit&) const {}
    __device__ __forceinline__ void done(const Unit&) const {}
};

__device__ __forceinline__ unsigned cvt_pk_bf16(float lo, float hi) { unsigned r; asm volatile("v_cvt_pk_bf16_f32 %0, %1, %2" : "=v"(r) : "v"(lo), "v"(hi)); return r; }
typedef unsigned u32x2 __attribute__((ext_vector_type(2)));
constexpr int NLAT = 32768, KVROWS = 8448;

struct EpiQKV {
    static constexpr bool PERM = false, AFTER_DRAIN = false;
    bf16_t* Q; bf16_t* Kall; bf16_t* Vall; const float* qn; const float* kn; const float* ropec; const float* ropes; float qscale;
    __device__ __forceinline__ void operator()(const f32x4 (&acc)[2][2][4][2], const Unit& u, int wr, int wc, int fr, int fq) const {
        const int pn = u.pn; const bool isv = (pn == 5), isk = (pn == 4);
        const float* nw = isk ? kn : qn;
        f32x4 w[2][2];
#pragma unroll
        for (int bj = 0; bj < 2; ++bj)
#pragma unroll
            for (int n = 0; n < 2; ++n) w[bj][n] = *(const f32x4*)(nw + 32 * bj + 16 * n + 4 * fq);
        const float osc = (pn < 4) ? qscale : 1.f;
#pragma unroll
        for (int ai = 0; ai < 2; ++ai)
#pragma unroll
            for (int m = 0; m < 4; ++m) {
                const int r = u.pm * BM + ai * HALF + wr * 64 + m * 16 + fr;
                const bool lat = r < NLAT; int b, t;
                if (lat) { b = r >> 13; t = r & 8191; } else { const int rc = r - NLAT; b = rc >> 8; t = rc & 255; }
                f32x4 x[2][2];
#pragma unroll
                for (int bj = 0; bj < 2; ++bj)
#pragma unroll
                    for (int n = 0; n < 2; ++n) x[bj][n] = acc[ai][bj][m][n];
                if (!isv) {
                    float ss = 0.f;
#pragma unroll
                    for (int bj = 0; bj < 2; ++bj)
#pragma unroll
                        for (int n = 0; n < 2; ++n) { const f32x4 v = x[bj][n]; ss += (v[0] * v[0] + v[1] * v[1]) + (v[2] * v[2] + v[3] * v[3]); }
                    ss += __shfl_xor(ss, 16); ss += __shfl_xor(ss, 32);
                    const float rs = rsqrtf(ss * (1.0f / 64.0f) + 1e-6f);
#pragma unroll
                    for (int bj = 0; bj < 2; ++bj)
#pragma unroll
                        for (int n = 0; n < 2; ++n) x[bj][n] = x[bj][n] * rs * w[bj][n];
                    if (lat) {
#pragma unroll
                        for (int bj = 0; bj < 2; ++bj) {
                            const int pos = bj == 0 ? (t >> 6) : (t & 63);
                            const f32x4 c = *(const f32x4*)(ropec + pos * 16 + 4 * fq), s = *(const f32x4*)(ropes + pos * 16 + 4 * fq);
                            const f32x4 x1 = x[bj][0], x2 = x[bj][1];
                            x[bj][0] = x1 * c - x2 * s; x[bj][1] = x2 * c + x1 * s;
                        }
                    }
#pragma unroll
                    for (int bj = 0; bj < 2; ++bj)
#pragma unroll
                        for (int n = 0; n < 2; ++n) x[bj][n] = x[bj][n] * osc;
                }
                bf16_t* dst;
                if (pn < 4) dst = Q + (size_t)r * 1024 + pn * 256 + 64 * wc;
                else { const size_t kr = (size_t)b * KVROWS + (lat ? 256 + t : t); dst = (isk ? Kall : Vall) + kr * 256 + 64 * wc; }
#pragma unroll
                for (int bj = 0; bj < 2; ++bj)
#pragma unroll
                    for (int n = 0; n < 2; ++n) { u32x2 p; p.x = cvt_pk_bf16(x[bj][n][0], x[bj][n][1]); p.y = cvt_pk_bf16(x[bj][n][2], x[bj][n][3]); *(u32x2*)(dst + 32 * bj + 16 * n + 4 * fq) = p; }
            }
    }
};

struct EpiResid {
    static constexpr bool PERM = true, AFTER_DRAIN = false;
    const float* base_lat; const float* base_ctx; float* out_lat; float* out_ctx; const float* gate;
    __device__ __forceinline__ void operator()(const f32x4 (&acc)[2][2][4][2], const Unit& u, int wr, int wc, int fr, int fq) const {
        const int rowt = u.pm * BM; const bool lat = rowt < NLAT; const int vec = lat ? (rowt >> 13) : 4;
        const float* bp = lat ? base_lat + (size_t)rowt * 1024 : base_ctx + (size_t)(rowt - NLAT) * 1024;
        float* op = lat ? out_lat + (size_t)rowt * 1024 : out_ctx + (size_t)(rowt - NLAT) * 1024;
        const int col0 = u.pn * BM + wc * 32 + 8 * fq;
#pragma unroll
        for (int bj = 0; bj < 2; ++bj) {
            const int cc = col0 + bj * HALF;
            const f32x4 g0 = *(const f32x4*)(gate + vec * 6144 + cc), g1 = *(const f32x4*)(gate + vec * 6144 + cc + 4);
#pragma unroll
            for (int ai = 0; ai < 2; ++ai)
#pragma unroll
                for (int m = 0; m < 4; ++m) { const size_t off = (size_t)(ai * HALF + wr * 64 + m * 16 + fr) * 1024 + cc;
                    const f32x4 hn0 = *(const f32x4*)(bp + off) + g0 * acc[ai][bj][m][0], hn1 = *(const f32x4*)(bp + off + 4) + g1 * acc[ai][bj][m][1];
                    *(f32x4*)(op + off) = hn0; *(f32x4*)(op + off + 4) = hn1; }
            asm volatile("" ::: "memory");
        }
    }
};

struct EpiResidFinal {
    static constexpr bool PERM = true, AFTER_DRAIN = false;
    const float* base; float* out; const float* gate; float* SS; unsigned* cnt; const float* fw; PG8_LAS float* red;
    __device__ __forceinline__ void operator()(const f32x4 (&acc)[2][2][4][2], const Unit& u, int wr, int wc, int fr, int fq) const {
        const int rowt = u.pm * BM, vec = rowt >> 13;
        const float* bp = base + (size_t)rowt * 1024; float* op = out + (size_t)rowt * 1024;
        const int col0 = u.pn * BM + wc * 32 + 8 * fq;
        float ss[8];
#pragma unroll
        for (int q = 0; q < 8; ++q) ss[q] = 0.f;
#pragma unroll
        for (int bj = 0; bj < 2; ++bj) {
            const int cc = col0 + bj * HALF;
            const f32x4 g0 = *(const f32x4*)(gate + vec * 6144 + cc), g1 = *(const f32x4*)(gate + vec * 6144 + cc + 4);
#pragma unroll
            for (int ai = 0; ai < 2; ++ai)
#pragma unroll
                for (int m = 0; m < 4; ++m) { const size_t off = (size_t)(ai * HALF + wr * 64 + m * 16 + fr) * 1024 + cc;
                    const f32x4 hn0 = *(const f32x4*)(bp + off) + g0 * acc[ai][bj][m][0], hn1 = *(const f32x4*)(bp + off + 4) + g1 * acc[ai][bj][m][1];
                    *(f32x4*)(op + off) = hn0; *(f32x4*)(op + off + 4) = hn1;
                    ss[ai * 4 + m] += ((hn0[0] * hn0[0] + hn0[1] * hn0[1]) + (hn0[2] * hn0[2] + hn0[3] * hn0[3])) + ((hn1[0] * hn1[0] + hn1[1] * hn1[1]) + (hn1[2] * hn1[2] + hn1[3] * hn1[3])); }
            asm volatile("" ::: "memory");
        }
#pragma unroll
        for (int q = 0; q < 8; ++q) { float s = ss[q]; s += __shfl_xor(s, 16); s += __shfl_xor(s, 32);
            if (fq == 0) red[((q >> 2) * HALF + wr * 64 + (q & 3) * 16 + fr) * 4 + wc] = s; }
        asm volatile("s_waitcnt lgkmcnt(0)" ::: "memory"); __builtin_amdgcn_s_barrier(); asm volatile("" ::: "memory");
        const int lane = fq * 16 + fr;
        if (lane < 32) { const int row = (wr * 4 + wc) * 32 + lane; const f32x4 p = *(const PG8_LAS f32x4*)(red + row * 4); atomicAdd(SS + rowt + row, (p[0] + p[1]) + (p[2] + p[3])); }
        asm volatile("s_waitcnt vmcnt(0)" ::: "memory"); __builtin_amdgcn_s_barrier(); asm volatile("" ::: "memory");
        if (threadIdx.x == 0) __hip_atomic_fetch_add(cnt + u.pm, 1u, __ATOMIC_RELAXED, __HIP_MEMORY_SCOPE_AGENT);
        { unsigned sp = 0; while ((unsigned)__builtin_amdgcn_readfirstlane(__hip_atomic_load(cnt + u.pm, __ATOMIC_RELAXED, __HIP_MEMORY_SCOPE_AGENT)) < 4u) { __builtin_amdgcn_s_sleep(2); if (++sp > (1u << 22)) break; } }
        asm volatile("" ::: "memory");
#pragma unroll
        for (int q = 0; q < 8; ++q) { const unsigned b = __hip_atomic_load((const unsigned*)SS + rowt + (q >> 2) * HALF + wr * 64 + (q & 3) * 16 + fr, __ATOMIC_RELAXED, __HIP_MEMORY_SCOPE_AGENT);
            ss[q] = rsqrtf(__builtin_bit_cast(float, b) * (1.0f / 1024.0f) + 1e-6f); }
#pragma unroll
        for (int bj = 0; bj < 2; ++bj) {
            const int cc = col0 + bj * HALF;
            const f32x4 w0 = *(const f32x4*)(fw + cc), w1 = *(const f32x4*)(fw + cc + 4);
#pragma unroll
            for (int ai = 0; ai < 2; ++ai)
#pragma unroll
                for (int m = 0; m < 4; ++m) { const size_t off = (size_t)(ai * HALF + wr * 64 + m * 16 + fr) * 1024 + cc;
                    const f32x4 hn0 = *(const f32x4*)(op + off), hn1 = *(const f32x4*)(op + off + 4);
                    *(f32x4*)(op + off) = hn0 * ss[ai * 4 + m] * w0; *(f32x4*)(op + off + 4) = hn1 * ss[ai * 4 + m] * w1; }
            asm volatile("" ::: "memory");
        }
    }
};

struct EpiResidN {
    static constexpr bool PERM = true, AFTER_DRAIN = false;
    const float* base_lat; const float* base_ctx; float* out_lat; float* out_ctx; const float* gate;
    bf16_t* XNr; float* SS; const float* nw; const float* sc;
    PG8_LAS float* red;
    __device__ __forceinline__ void operator()(const f32x4 (&acc)[2][2][4][2], const Unit& u, int wr, int wc, int fr, int fq) const {
        const int rowt = u.pm * BM; const bool lat = rowt < NLAT; const int vec = lat ? (rowt >> 13) : 4;
        const float* bp = lat ? base_lat + (size_t)rowt * 1024 : base_ctx + (size_t)(rowt - NLAT) * 1024;
        float* op = lat ? out_lat + (size_t)rowt * 1024 : out_ctx + (size_t)(rowt - NLAT) * 1024;
        const int col0 = u.pn * BM + wc * 32 + 8 * fq;
        float ss[8];
#pragma unroll
        for (int q = 0; q < 8; ++q) ss[q] = 0.f;
#pragma unroll
        for (int bj = 0; bj < 2; ++bj) {
            const int cc = col0 + bj * HALF;
            const f32x4 g0 = *(const f32x4*)(gate + vec * 6144 + cc), g1 = *(const f32x4*)(gate + vec * 6144 + cc + 4);
            const f32x4 gm0 = *(const f32x4*)(nw + cc) * (*(const f32x4*)(sc + vec * 6144 + cc) + 1.0f), gm1 = *(const f32x4*)(nw + cc + 4) * (*(const f32x4*)(sc + vec * 6144 + cc + 4) + 1.0f);
#pragma unroll
            for (int ai = 0; ai < 2; ++ai)
#pragma unroll
                for (int m = 0; m < 4; ++m) { const int rl = ai * HALF + wr * 64 + m * 16 + fr; const size_t off = (size_t)rl * 1024 + cc;
                    const f32x4 hn0 = *(const f32x4*)(bp + off) + g0 * acc[ai][bj][m][0], hn1 = *(const f32x4*)(bp + off + 4) + g1 * acc[ai][bj][m][1];
                    *(f32x4*)(op + off) = hn0; *(f32x4*)(op + off + 4) = hn1;
                    ss[ai * 4 + m] += ((hn0[0] * hn0[0] + hn0[1] * hn0[1]) + (hn0[2] * hn0[2] + hn0[3] * hn0[3])) + ((hn1[0] * hn1[0] + hn1[1] * hn1[1]) + (hn1[2] * hn1[2] + hn1[3] * hn1[3]));
                    const f32x4 y0 = hn0 * gm0, y1 = hn1 * gm1; u32x4 p; p.x = cvt_pk_bf16(y0[0], y0[1]); p.y = cvt_pk_bf16(y0[2], y0[3]); p.z = cvt_pk_bf16(y1[0], y1[1]); p.w = cvt_pk_bf16(y1[2], y1[3]);
                    *(u32x4*)(XNr + (size_t)rowt * 1024 + off) = p; }
            asm volatile("" ::: "memory");
        }
#pragma unroll
        for (int q = 0; q < 8; ++q) { float s = ss[q]; s += __shfl_xor(s, 16); s += __shfl_xor(s, 32);
            if (fq == 0) red[((q >> 2) * HALF + wr * 64 + (q & 3) * 16 + fr) * 4 + wc] = s; }
        asm volatile("s_waitcnt lgkmcnt(0)" ::: "memory"); __builtin_amdgcn_s_barrier(); asm volatile("" ::: "memory");
        const int lane = fq * 16 + fr;
        if (lane < 32) { const int row = (wr * 4 + wc) * 32 + lane; const f32x4 p = *(const PG8_LAS f32x4*)(red + row * 4); atomicAdd(SS + rowt + row, (p[0] + p[1]) + (p[2] + p[3])); }
    }
};

__device__ __forceinline__ float silu_f(float a) { return a * __builtin_amdgcn_rcpf(1.0f + __expf(-a)); }
struct EpiSwiGLU {
    static constexpr bool PERM = true, AFTER_DRAIN = false;
    bf16_t* O; const float* SS; const float* shw;
    __device__ __forceinline__ void operator()(const f32x4 (&acc)[2][2][4][2], const Unit& u, int wr, int wc, int fr, int fq) const {
        const int row0 = u.pm * BM + wr * 64 + fr, hc0 = u.pn * HALF + wc * 32 + 8 * fq;
        const int vec = (u.pm * BM < NLAT) ? ((u.pm * BM) >> 13) : 4;
        f32x4 sa0 = {0.f, 0.f, 0.f, 0.f}, sa1 = sa0, su0 = sa0, su1 = sa0;
        if (SS) { const float* sp = shw + vec * 5632 + u.pn * BM + wc * 32 + 8 * fq; sa0 = *(const f32x4*)sp; sa1 = *(const f32x4*)(sp + 4); su0 = *(const f32x4*)(sp + HALF); su1 = *(const f32x4*)(sp + HALF + 4); }
#pragma unroll
        for (int ai = 0; ai < 2; ++ai)
#pragma unroll
            for (int m = 0; m < 4; ++m) { const int r = row0 + ai * HALF + m * 16; bf16_t* rowp = O + (size_t)r * 2816 + hc0;
                const float rs = SS ? rsqrtf(SS[r] * (1.0f / 1024.0f) + 1e-6f) : 1.0f;
                const f32x4 a0 = acc[ai][0][m][0] * rs + sa0, a1 = acc[ai][0][m][1] * rs + sa1, u0 = acc[ai][1][m][0] * rs + su0, u1 = acc[ai][1][m][1] * rs + su1;
                u32x4 wv; wv.x = cvt_pk_bf16(silu_f(a0[0]) * u0[0], silu_f(a0[1]) * u0[1]); wv.y = cvt_pk_bf16(silu_f(a0[2]) * u0[2], silu_f(a0[3]) * u0[3]);
                wv.z = cvt_pk_bf16(silu_f(a1[0]) * u1[0], silu_f(a1[1]) * u1[1]); wv.w = cvt_pk_bf16(silu_f(a1[2]) * u1[2], silu_f(a1[3]) * u1[3]);
                *(u32x4*)rowp = wv; }
    }
};

__device__ __forceinline__ unsigned pk_f16(float lo, float hi) { const _Float16 a = (_Float16)lo, b = (_Float16)hi; return (unsigned)__builtin_bit_cast(unsigned short, a) | ((unsigned)__builtin_bit_cast(unsigned short, b) << 16); }
constexpr size_t OFF_MiB = 1u << 20, OFF_HQ = 122 * OFF_MiB, OFF_HG = 186 * OFF_MiB, OFF_HV = 250 * OFF_MiB, OFF_LFW = 314 * OFF_MiB, OFF_LBW = 378 * OFF_MiB, OFF_HVC = 506 * OFF_MiB, OFF_LFWC = 508 * OFF_MiB, OFF_LBWC = 510 * OFF_MiB;
struct EpiHgrnIn {
    static constexpr bool PERM = true, AFTER_DRAIN = false;
    unsigned char* ws; const float* lbl; const float* SS; const float* shw;
    __device__ __forceinline__ void operator()(const f32x4 (&acc)[2][2][4][2], const Unit& u, int wr, int wc, int fr, int fq) const {
        const int type = u.pn >> 2; const bool lat = u.pm < (NLAT / BM);
        if (type < 2 && !lat) return;
        const size_t doff = lat ? (type == 0 ? OFF_HQ : type == 1 ? OFF_HG : type == 2 ? OFF_LFW : type == 3 ? OFF_LBW : OFF_HV)
                                : (type == 2 ? OFF_LFWC : type == 3 ? OFF_LBWC : OFF_HVC) - (size_t)NLAT * 2048;
        bf16_t* dstb = (bf16_t*)(ws + doff);
        const int row0 = u.pm * BM + wr * 64 + fr; const int vec = lat ? ((u.pm * BM) >> 13) : 4;
#pragma unroll
        for (int bj = 0; bj < 2; ++bj) {
            const int ch = (u.pn & 3) * 256 + bj * HALF + wc * 32 + 8 * fq;
            const float* sp = shw + vec * 5120 + u.pn * BM + bj * HALF + wc * 32 + 8 * fq; const f32x4 sw0 = *(const f32x4*)sp, sw1 = *(const f32x4*)(sp + 4);
            float lb[8];
            if (type == 2 || type == 3) {
#pragma unroll
                for (int e = 0; e < 8; ++e) { const float l0 = lbl[ch + e], l1 = lbl[1024 + ch + e]; lb[e] = 1.0f / (1.0f + __expf(l0 - l1)); }
            } else {
#pragma unroll
                for (int e = 0; e < 8; ++e) lb[e] = 0.f;
            }
#pragma unroll
            for (int ai = 0; ai < 2; ++ai)
#pragma unroll
                for (int m = 0; m < 4; ++m) { const int r = row0 + ai * HALF + m * 16; bf16_t* p = dstb + (size_t)r * 1024 + ch;
                    const float rs = rsqrtf(SS[r] * (1.0f / 1024.0f) + 1e-6f);
                    float v[8];
#pragma unroll
                    for (int e = 0; e < 8; ++e) v[e] = acc[ai][bj][m][e >> 2][e & 3] * rs + (e < 4 ? sw0[e & 3] : sw1[e & 3]);
                    u32x4 wv;
                    if (type == 2 || type == 3) {
#pragma unroll
                        for (int e = 0; e < 8; ++e) { const float sg = __builtin_amdgcn_rcpf(1.0f + __expf(-v[e])); v[e] = __logf(lb[e] + (1.0f - lb[e]) * sg); }
                        wv.x = pk_f16(v[0], v[1]); wv.y = pk_f16(v[2], v[3]); wv.z = pk_f16(v[4], v[5]); wv.w = pk_f16(v[6], v[7]);
                    } else { wv.x = cvt_pk_bf16(v[0], v[1]); wv.y = cvt_pk_bf16(v[2], v[3]); wv.z = cvt_pk_bf16(v[4], v[5]); wv.w = cvt_pk_bf16(v[6], v[7]); }
                    *(u32x4*)p = wv; if (m & 1) asm volatile("" ::: "memory"); }
        }
    }
};

__device__ __forceinline__ void publish_unit(unsigned* cnt) {
    asm volatile("s_waitcnt vmcnt(0)" ::: "memory"); __builtin_amdgcn_s_barrier(); asm volatile("" ::: "memory");
    if (threadIdx.x == 0) { __builtin_amdgcn_fence(__ATOMIC_RELEASE, "agent"); asm volatile("s_waitcnt vmcnt(0)" ::: "memory"); __hip_atomic_fetch_add(cnt, 1u, __ATOMIC_RELAXED, __HIP_MEMORY_SCOPE_AGENT); }
}
__device__ __forceinline__ void wave_wait_count(unsigned* cnt, unsigned want) {
    unsigned sp = 0;
    while ((unsigned)__builtin_amdgcn_readfirstlane(__hip_atomic_load(cnt, __ATOMIC_RELAXED, __HIP_MEMORY_SCOPE_AGENT)) < want) { __builtin_amdgcn_s_sleep(4); if (++sp > (1u << 22)) break; }
    __builtin_amdgcn_fence(__ATOMIC_ACQUIRE, "agent"); asm volatile("s_waitcnt vmcnt(0)" ::: "memory");
}
__device__ __forceinline__ void latent_up_unit(int q, Unit& u) { const int nN = 22, nM = 128, nig = WGM * nN, gid = q / nig, fm = gid * WGM, gsz = (nM - fm) < WGM ? (nM - fm) : WGM; u.pm = fm + ((q % nig) % gsz); u.pn = (q % nig) / gsz; }
__device__ __forceinline__ int up_pos_type(int x, int j, int& idx) {
    if (x == 0 && j < 16) { idx = j; return 1; }
    if (j >= 30 && j < 60 && x < 3) { const int uu = x * 30 + (j - 30); if (uu < 88) { idx = uu; return 2; } }
    if (j >= 330 && j < 336) { idx = x * 6 + (j - 330); return 3; }
    int sp = 0;
    if (x == 0) sp += 16;
    if (x < 3) { const int lim = x < 2 ? 30 : 28; int t = j - 30; t = t < 0 ? 0 : (t > lim ? lim : t); sp += t; }
    { int t = j - 330; t = t < 0 ? 0 : (t > 6 ? 6 : t); sp += t; }
    const int prev = x == 0 ? 0 : x == 1 ? 52 : x == 2 ? 88 : 122 + (x - 3) * 6;
    idx = x * 360 + j - sp - prev; return 0;
}
struct UpOrder {
    int c, i0, i1; unsigned* cntW; unsigned* cntU;
    __device__ __forceinline__ bool next(int k, Unit& u) const {
        const int i = i0 + k; if (i >= i1) return false;
        int idx; const int t = up_pos_type(c & 7, i * 30 + (c >> 3), idx);
        if (t == 2) { u.pm = 128 + idx / 22; u.pn = idx % 22; } else latent_up_unit(idx, u);
        return true;
    }
    __device__ __forceinline__ void a_ready(const Unit& u) const { if (u.pm >= 128) wave_wait_count(cntW, 16u); }
    __device__ __forceinline__ void done(const Unit& u) const { if (u.pm >= 128) publish_unit(cntU); }
};
struct UpOrderD {
    int d, i0, i1;
    __device__ __forceinline__ bool next(int k, Unit& u) const { const int i = i0 + k; if (i >= i1) return false; const int q = 2728 + i * 16 + d; if (q >= 2816) return false; latent_up_unit(q, u); return true; }
    __device__ __forceinline__ void a_ready(const Unit&) const {}
    __device__ __forceinline__ void done(const Unit&) const {}
};
struct OneUnit {
    int pm, pn; unsigned* cnt;
    __device__ __forceinline__ bool next(int i, Unit& u) const { if (i > 0) return false; u.pm = pm; u.pn = pn; return true; }
    __device__ __forceinline__ void a_ready(const Unit&) const {}
    __device__ __forceinline__ void done(const Unit&) const { if (cnt) publish_unit(cnt); }
};
template <class Epi, class Sched, bool ALIGN_EPI = false, bool SP2 = false>
__device__ __forceinline__ void gemm_phase(PG8_LAS unsigned char* lds, const Gemm g, const Sched& S, const Epi& E) {
    int tid_ = threadIdx.x; asm volatile("" : "+v"(tid_));
    const int tid = tid_, wid = __builtin_amdgcn_readfirstlane(tid >> 6), lane = tid & 63, wr = wid >> 2, wc = wid & 3, fr = lane & 15, fq = lane >> 4;
    const int K = g.K, nt = K / BK;
    unsigned voffA[2], voffB[2];
#pragma unroll
    for (int i = 0; i < 2; ++i) { int R, C; stage_rc(tid * 16 + i * 8192, R, C); const int Rb = Epi::PERM ? ((R & ~31) + perm32(R & 31)) : R;
        voffA[i] = (unsigned)(R * K + C) * 2u; voffB[i] = (unsigned)(Rb * K + C) * 2u; }
    const size_t kstep = (size_t)(BK * 2);
    const size_t hstep = (size_t)HALF * K * 2;
    const size_t tstep = 2 * hstep;
    const unsigned ldsw = (unsigned)wid * 1024u;
    const int aoff = lds_byte(wr * 64 + fr, fq * 8), boff = lds_byte(wc * 32 + fr, fq * 8);
#define PG8_SA(b, h) (((b) * 2 + (h)) * HTB)
#define PG8_SB(b, h) ((4 + (b) * 2 + (h)) * HTB)
#define PG8_STAGE(bufoff, gbase, voff) do { _Pragma("unroll") for (int _i = 0; _i < 2; ++_i) \
        __builtin_amdgcn_global_load_lds((const unsigned*)((const char*)(gbase) + (voff)[_i]), (PG8_LAS unsigned*)(lds + (bufoff) + ldsw + _i * 8192), 16, 0, 0); } while (0)
#define PG8_LDA(dst, b, h) do { _Pragma("unroll") for (int m = 0; m < 4; ++m) _Pragma("unroll") for (int k = 0; k < 2; ++k) dst[m][k] = *(const PG8_LAS bf16x8*)(lds + PG8_SA(b, h) + aoff + m * 2048 + k * 1024); } while (0)
#define PG8_LDB(dst, b, h) do { _Pragma("unroll") for (int n = 0; n < 2; ++n) _Pragma("unroll") for (int k = 0; k < 2; ++k) dst[n][k] = *(const PG8_LAS bf16x8*)(lds + PG8_SB(b, h) + boff + n * 2048 + k * 1024); } while (0)
#define PG8_MMA(ai, bj, At, Bt) do { __builtin_amdgcn_s_setprio(1); _Pragma("unroll") for (int m = 0; m < 4; ++m) _Pragma("unroll") for (int n = 0; n < 2; ++n) _Pragma("unroll") for (int k = 0; k < 2; ++k) \
        acc[ai][bj][m][n] = __builtin_amdgcn_mfma_f32_16x16x32_bf16(Bt[n][k], At[m][k], acc[ai][bj][m][n], 0, 0, 0); __builtin_amdgcn_s_setprio(0); } while (0)
#define PG8_WAIT_V(n) asm volatile("s_waitcnt vmcnt(" #n ")" ::: "memory")
#define PG8_WAIT_L(n) asm volatile("s_waitcnt lgkmcnt(" #n ")" ::: "memory")
#define PG8_BAR __builtin_amdgcn_s_barrier()
#define PG8_SCHED __builtin_amdgcn_sched_barrier(0)
    Unit cur, nxt; int ui = 0;
    if (!S.next(0, cur)) return;
    f32x4 acc[2][2][4][2];
#pragma unroll
    for (int a = 0; a < 2; ++a)
#pragma unroll
        for (int b = 0; b < 2; ++b)
#pragma unroll
            for (int m = 0; m < 4; ++m)
#pragma unroll
                for (int n = 0; n < 2; ++n) acc[a][b][m][n] = (f32x4){0.f, 0.f, 0.f, 0.f};
    bf16x8 At[4][2], B0[2][2], B1[2][2];
    const char* cA = (const char*)g.A + (size_t)cur.pm * tstep; const char* cB = (const char*)g.Bt + (size_t)cur.pn * tstep;
    S.a_ready(cur);
    if constexpr (SP2) {
        PG8_STAGE(PG8_SB(0, 0), cB, voffB); PG8_STAGE(PG8_SB(0, 1), cB + hstep, voffB); PG8_STAGE(PG8_SA(0, 0), cA, voffA); PG8_STAGE(PG8_SA(0, 1), cA + hstep, voffA);
        if (wr == 1) PG8_BAR;
        PG8_WAIT_V(2); PG8_BAR;
        PG8_STAGE(PG8_SB(1, 0), cB + kstep, voffB); PG8_STAGE(PG8_SA(1, 0), cA + kstep, voffA); PG8_STAGE(PG8_SB(1, 1), cB + hstep + kstep, voffB);
        PG8_WAIT_V(6); PG8_BAR;
    } else {
        PG8_STAGE(PG8_SB(0, 0), cB, voffB); PG8_STAGE(PG8_SA(0, 0), cA, voffA); PG8_STAGE(PG8_SB(0, 1), cB + hstep, voffB); PG8_STAGE(PG8_SA(0, 1), cA + hstep, voffA);
        if (wr == 1) PG8_BAR;
        PG8_WAIT_V(4); PG8_BAR;
        PG8_STAGE(PG8_SB(1, 0), cB + kstep, voffB); PG8_STAGE(PG8_SA(1, 0), cA + kstep, voffA); PG8_STAGE(PG8_SB(1, 1), cB + hstep + kstep, voffB);
        PG8_WAIT_V(6); PG8_BAR;
    }
    for (;;) {
        const bool has_next = S.next(ui + 1, nxt);
        const char* nA = has_next ? (const char*)g.A + (size_t)nxt.pm * tstep : cA; const char* nB = has_next ? (const char*)g.Bt + (size_t)nxt.pn * tstep : cB;
        for (int t = 0; t < nt; t += 2) {
            const bool last = (t == nt - 2);
            const char* a1 = cA + (size_t)(t + 1) * kstep;
            const char* a2 = last ? nA : cA + (size_t)(t + 2) * kstep; const char* b2 = last ? nB : cB + (size_t)(t + 2) * kstep;
            const char* a3 = a2 + kstep; const char* b3 = b2 + kstep;
            if (last && has_next) S.a_ready(nxt);
            if constexpr (SP2) {
            PG8_LDB(B0, 0, 0); PG8_LDB(B1, 0, 1); PG8_SCHED; PG8_LDA(At, 0, 0); PG8_STAGE(PG8_SA(1, 1), a1 + hstep, voffA);
            PG8_WAIT_V(8); PG8_WAIT_L(0); PG8_BAR; PG8_MMA(0, 0, At, B0); PG8_MMA(0, 1, At, B1); PG8_BAR; PG8_SCHED;
            PG8_LDA(At, 0, 1); PG8_STAGE(PG8_SB(0, 0), b2, voffB); PG8_STAGE(PG8_SB(0, 1), b2 + hstep, voffB); PG8_STAGE(PG8_SA(0, 0), a2, voffA);
            PG8_WAIT_V(8); PG8_WAIT_L(0); PG8_BAR; PG8_MMA(1, 0, At, B0); PG8_MMA(1, 1, At, B1); PG8_BAR; PG8_SCHED;
            PG8_LDB(B0, 1, 0); PG8_LDB(B1, 1, 1); PG8_SCHED; PG8_LDA(At, 1, 0); PG8_STAGE(PG8_SA(0, 1), a2 + hstep, voffA);
            PG8_WAIT_V(8); PG8_WAIT_L(0); PG8_BAR; PG8_MMA(0, 0, At, B0); PG8_MMA(0, 1, At, B1); PG8_BAR; PG8_SCHED;
            PG8_LDA(At, 1, 1); PG8_STAGE(PG8_SB(1, 0), b3, voffB); PG8_STAGE(PG8_SB(1, 1), b3 + hstep, voffB); PG8_STAGE(PG8_SA(1, 0), a3, voffA);
            PG8_WAIT_V(8); PG8_WAIT_L(0); PG8_BAR; PG8_MMA(1, 0, At, B0); PG8_MMA(1, 1, At, B1); PG8_BAR; PG8_SCHED;
            } else {
            PG8_LDB(B0, 0, 0); PG8_SCHED; PG8_LDA(At, 0, 0); PG8_STAGE(PG8_SA(1, 1), a1 + hstep, voffA);
            PG8_WAIT_L(8); PG8_BAR; PG8_WAIT_L(0); PG8_MMA(0, 0, At, B0); PG8_BAR; PG8_SCHED;
            PG8_LDB(B1, 0, 1); PG8_STAGE(PG8_SB(0, 0), b2, voffB);
            PG8_BAR; PG8_WAIT_L(0); PG8_MMA(0, 1, At, B1); PG8_BAR;
            PG8_LDA(At, 0, 1); PG8_STAGE(PG8_SA(0, 0), a2, voffA);
            PG8_BAR; PG8_WAIT_L(0); PG8_MMA(1, 0, At, B0); PG8_BAR; PG8_SCHED;
            PG8_STAGE(PG8_SB(0, 1), b2 + hstep, voffB);
            PG8_WAIT_V(6); PG8_BAR; PG8_MMA(1, 1, At, B1); PG8_BAR;
            PG8_LDB(B0, 1, 0); PG8_SCHED; PG8_LDA(At, 1, 0); PG8_STAGE(PG8_SA(0, 1), a2 + hstep, voffA);
            PG8_WAIT_L(8); PG8_BAR; PG8_WAIT_L(0); PG8_MMA(0, 0, At, B0); PG8_BAR; PG8_SCHED;
            PG8_LDB(B1, 1, 1); PG8_STAGE(PG8_SB(1, 0), b3, voffB);
            PG8_BAR; PG8_WAIT_L(0); PG8_MMA(0, 1, At, B1); PG8_BAR;
            PG8_LDA(At, 1, 1); PG8_STAGE(PG8_SA(1, 0), a3, voffA);
            PG8_BAR; PG8_WAIT_L(0); PG8_MMA(1, 0, At, B0); PG8_BAR; PG8_SCHED;
            PG8_STAGE(PG8_SB(1, 1), b3 + hstep, voffB);
            PG8_WAIT_V(6); PG8_BAR; PG8_MMA(1, 1, At, B1); PG8_BAR;
            }
        }
        if constexpr (ALIGN_EPI) { if (wr == 0) PG8_BAR; }
        if constexpr (!Epi::AFTER_DRAIN) { E(acc, cur, wr, wc, fr, fq); S.done(cur); }
        if (!has_next) break;
#pragma unroll
        for (int a = 0; a < 2; ++a)
#pragma unroll
            for (int b = 0; b < 2; ++b)
#pragma unroll
                for (int m = 0; m < 4; ++m)
#pragma unroll
                    for (int n = 0; n < 2; ++n) acc[a][b][m][n] = (f32x4){0.f, 0.f, 0.f, 0.f};
        cur = nxt; cA = nA; cB = nB; ++ui;
        if constexpr (ALIGN_EPI) { if (wr == 1) PG8_BAR; }
    }
    PG8_WAIT_V(0);
    if constexpr (!ALIGN_EPI) { if (wr == 0) PG8_BAR; }
    PG8_BAR;
    if constexpr (Epi::AFTER_DRAIN) { E.fused(acc, cur, wr, wc, fr, fq, lds, wid, lane); S.done(cur); }
#undef PG8_SA
#undef PG8_SB
#undef PG8_STAGE
#undef PG8_LDA
#undef PG8_LDB
#undef PG8_MMA
#undef PG8_WAIT_V
#undef PG8_WAIT_L
#undef PG8_BAR
#undef PG8_SCHED
}
}

#ifndef PG8_SP2
#define PG8_SP2 true
#endif
#ifndef PG8_ALIGN
#define PG8_ALIGN true
#endif
#include <hip/hip_bf16.h>
#include <cmath>
namespace attn_body {
using bf16=__hip_bfloat16;
using bf16x8=__attribute__((ext_vector_type(8)))short;
using s16x4=__attribute__((ext_vector_type(4)))short;
using f32x16=__attribute__((ext_vector_type(16)))float;
using u32x4=__attribute__((ext_vector_type(4)))unsigned;
constexpr int D=64,QP=1024,KVP=256;
constexpr int NW=8,QBLK=32,QB=QBLK*NW,KVBLK=64;
__device__ __forceinline__ int crow(int r,int hi){return (r&3)+8*(r>>2)+4*hi;}
#define SBAR() __builtin_amdgcn_sched_barrier(0)
constexpr int NSLOT=3, SLOTB=8192;
constexpr int LDS_K=0, LDS_V=NSLOT*SLOTB, LDS_WS=2*NSLOT*SLOTB, LDS_OST=LDS_WS+NW*64*4, LDS_BYTES=LDS_OST+NW*4096;
constexpr float C2=0.125f*1.4426950408889634f;
__device__ __forceinline__ void glds16(const void*gsrc,unsigned lds_dst){unsigned keep;
  asm volatile("s_mov_b32 %0, m0\n\ts_mov_b32 m0, %2\n\ts_nop 0\n\tglobal_load_lds_dwordx4 %1, off\n\ts_mov_b32 m0, %0":"=&s"(keep):"v"(gsrc),"s"(lds_dst):"memory");}
__device__ __forceinline__ float max3f(float a,float b,float c){float r;asm("v_max3_f32 %0, %1, %2, %3":"=v"(r):"v"(a),"v"(b),"v"(c));return r;}
__device__ __forceinline__ float max2f(float a,float b){float r;asm("v_max_f32_e32 %0, %1, %2":"=v"(r):"v"(a),"v"(b));return r;}
__device__ __forceinline__ float fadd_s(float a,float b){float r;asm("v_add_f32_e32 %0, %1, %2":"=v"(r):"v"(a),"v"(b));return r;}
__device__ __forceinline__ float fsub_s(float a,float b){float r;asm("v_sub_f32_e32 %0, %1, %2":"=v"(r):"v"(a),"v"(b));return r;}
typedef float f32x2_t __attribute__((ext_vector_type(2))); typedef __bf16 bf16x2_t __attribute__((ext_vector_type(2)));
__device__ __forceinline__ unsigned cvtpk_s(float lo,float hi){f32x2_t v={lo,hi};bf16x2_t b=__builtin_convertvector(v,bf16x2_t);return __builtin_bit_cast(unsigned,b);}
#define WAIT_BAR(N) asm volatile("s_waitcnt vmcnt(" #N ") lgkmcnt(0)\n\ts_barrier":::"memory")

__device__ __forceinline__ void qkt(f32x16&p0,f32x16&p1,const char*Kslot,const bf16x8*qr,const f32x16&negm,int r32,int hi){
  const char*kb=Kslot+hi*1024+r32*16;
  #pragma unroll
  for(int d0=0;d0<4;++d0){
    const bf16x8 b0=*reinterpret_cast<const bf16x8*>(kb+d0*2048);
    const bf16x8 b1=*reinterpret_cast<const bf16x8*>(kb+d0*2048+512);
    if(d0==0){p0=__builtin_amdgcn_mfma_f32_32x32x16_bf16(b0,qr[0],negm,0,0,0);p1=__builtin_amdgcn_mfma_f32_32x32x16_bf16(b1,qr[0],negm,0,0,0);}
    else{p0=__builtin_amdgcn_mfma_f32_32x32x16_bf16(b0,qr[d0],p0,0,0,0);p1=__builtin_amdgcn_mfma_f32_32x32x16_bf16(b1,qr[d0],p1,0,0,0);}}
}
typedef __attribute__((address_space(3))) const char* lds_cptr;
typedef short v4i16_t __attribute__((ext_vector_type(4)));
__device__ __forceinline__ void kload8(bf16x8*kf,lds_cptr kp){
  kf[0]=*(const __attribute__((address_space(3))) bf16x8*)(kp);      kf[1]=*(const __attribute__((address_space(3))) bf16x8*)(kp+512);
  kf[2]=*(const __attribute__((address_space(3))) bf16x8*)(kp+2048); kf[3]=*(const __attribute__((address_space(3))) bf16x8*)(kp+2560);
  kf[4]=*(const __attribute__((address_space(3))) bf16x8*)(kp+4096); kf[5]=*(const __attribute__((address_space(3))) bf16x8*)(kp+4608);
  kf[6]=*(const __attribute__((address_space(3))) bf16x8*)(kp+6144); kf[7]=*(const __attribute__((address_space(3))) bf16x8*)(kp+6656);
}
__device__ __forceinline__ void kload2(bf16x8*kf,lds_cptr kp,int j){ kf[2*j]=*(const __attribute__((address_space(3))) bf16x8*)(kp+j*2048); kf[2*j+1]=*(const __attribute__((address_space(3))) bf16x8*)(kp+j*2048+512); }
__device__ __forceinline__ s16x4 vtr(lds_cptr p){ return __builtin_bit_cast(s16x4,__builtin_amdgcn_ds_read_tr16_b64_v4i16((__attribute__((address_space(3))) v4i16_t*)p)); }
__device__ __forceinline__ float rowmax(const f32x16&p0,const f32x16&p1){
  float a=max3f(p0[0],p0[1],p1[0]),b=max3f(p0[2],p0[3],p1[1]);a=max3f(a,p1[2],p1[3]);
  #pragma unroll
  for(int r=4;r<16;r+=4){a=max3f(a,p0[r],p0[r+1]);b=max3f(b,p0[r+2],p0[r+3]);a=max3f(a,p1[r],p1[r+1]);b=max3f(b,p1[r+2],p1[r+3]);}
  const float m=max2f(a,b);
  auto rr=__builtin_amdgcn_permlane32_swap(__float_as_uint(m),__float_as_uint(m),false,false);
  return max2f(__uint_as_float(rr[0]),__uint_as_float(rr[1]));
}
__device__ __forceinline__ void pv(f32x16*o,int vb,bf16x8 pa0,bf16x8 pa1,bf16x8 pa2,bf16x8 pa3){
  #pragma unroll
  for(int d0=0;d0<2;++d0){s16x4 lo[4],hi[4];
    #pragma unroll
    for(int ks=0;ks<4;++ks){
      asm volatile("ds_read_b64_tr_b16 %0,%1 offset:%c2":"=&v"(lo[ks]):"v"(vb),"i"(d0*4096+ks*1024):"memory");
      asm volatile("ds_read_b64_tr_b16 %0,%1 offset:%c2":"=&v"(hi[ks]):"v"(vb),"i"(d0*4096+ks*1024+512):"memory");}
    asm volatile("s_waitcnt lgkmcnt(0)":::"memory");SBAR();
    #define PK(k) (bf16x8){lo[k][0],lo[k][1],lo[k][2],lo[k][3],hi[k][0],hi[k][1],hi[k][2],hi[k][3]}
    o[d0]=__builtin_amdgcn_mfma_f32_32x32x16_bf16(pa0,PK(0),o[d0],0,0,0);
    o[d0]=__builtin_amdgcn_mfma_f32_32x32x16_bf16(pa1,PK(1),o[d0],0,0,0);
    o[d0]=__builtin_amdgcn_mfma_f32_32x32x16_bf16(pa2,PK(2),o[d0],0,0,0);
    o[d0]=__builtin_amdgcn_mfma_f32_32x32x16_bf16(pa3,PK(3),o[d0],0,0,0);
    #undef PK
  }
}

#ifndef ATTN_STORE16
#define ATTN_STORE16(p,v) (*(u32x4*)(p)=(v))
#endif
template<int THRL> __device__ __forceinline__ void attn_unit(const bf16*Qu,const bf16*__restrict__ Kh,const bf16*__restrict__ Vh,bf16*Ou,const int NT,char*shm){
  int tid_=threadIdx.x; asm volatile("":"+v"(tid_)); const int tid=tid_,lane=tid&63,r32=lane&31,hi=lane>>5; const int wid=__builtin_amdgcn_readfirstlane(tid>>6);
  const bf16*Qw=Qu+(long)(wid*QBLK)*QP;
  const unsigned lds0=(unsigned)(uintptr_t)shm;
  float*wsf=(float*)(shm+LDS_WS)+wid*64;
  const bf16*ksrc=Kh+(long)lane*KVP+wid*8;
  const bf16*vsrc=Vh+(long)(16*(wid&3)+(lane>>2))*KVP+(wid>>2)*32+(lane&3)*8;
  const unsigned kdst=lds0+LDS_K+wid*1024, vdst=lds0+LDS_V+wid*1024;
  #define DMA_K(t,slot) glds16(ksrc+(long)(t)*KVBLK*KVP,(unsigned)__builtin_amdgcn_readfirstlane(kdst+(slot)))
  #define DMA_V(t,slot) glds16(vsrc+(long)(t)*KVBLK*KVP,(unsigned)__builtin_amdgcn_readfirstlane(vdst+(slot)))
  const int vb0=(int)(lds0+LDS_V)+((lane>>4)&1)*32+(lane&3)*8+(4*hi+((lane&15)>>2))*64;
  const char*Kbase=shm+LDS_K; bf16x8 kf[8];
  const lds_cptr shm3=(lds_cptr)shm; const lds_cptr kp0=shm3+LDS_K+hi*1024+r32*16; const lds_cptr vp0=shm3+LDS_V+((lane>>4)&1)*32+(lane&3)*8+(4*hi+((lane&15)>>2))*64;
  DMA_K(0,0);DMA_V(0,0);DMA_K(1,SLOTB);
  bf16x8 qr[4];
  #pragma unroll
  for(int d0=0;d0<4;++d0)qr[d0]=*reinterpret_cast<const bf16x8*>(&Qw[(long)r32*QP+d0*16+hi*8]);
  float mhat=0.f,l_reg=0.f;f32x16 o[2];o[0]=f32x16{};o[1]=f32x16{};f32x16 negm=f32x16{};asm volatile("":"+v"(negm));
  #define CMASK(P0,P1,t) do{}while(0)
  bool resc=false;
  #define START(P0,P1) do{ const float rm=rowmax(P0,P1); resc=false; \
    { const float dl=rm; mhat=fadd_s(mhat,dl); \
      _Pragma("unroll") for(int r=0;r<16;++r){P0[r]=fsub_s(P0[r],dl);P1[r]=fsub_s(P1[r],dl);} \
      _Pragma("unroll") for(int r=0;r<16;++r)negm[r]=-mhat; asm volatile("":"+v"(negm)); } \
    _Pragma("unroll") for(int r=0;r<16;++r)P0[r]=__builtin_amdgcn_exp2f(P0[r]); }while(0)
  #define RESC() do{ if(resc){ asm volatile("s_waitcnt lgkmcnt(0)":::"memory"); \
      _Pragma("unroll") for(int d_=0;d_<2;++d_) _Pragma("unroll") for(int r=0;r<16;++r)o[d_][r]*=wsf[crow(r,hi)]; } }while(0)
  f32x16 pA0,pA1,pB0,pB1;
  int sl_prev=0,sl_cur=0,sl_next=SLOTB;
  #define ROT() do{sl_prev=sl_cur;sl_cur=sl_next;sl_next=(sl_next==(NSLOT-1)*SLOTB)?0:sl_next+SLOTB;}while(0)
  DMA_K(2,2*SLOTB);
  WAIT_BAR(3);
  qkt(pA0,pA1,Kbase,qr,negm,r32,hi);asm volatile("s_nop 15\n\ts_nop 7":"+v"(pA0),"+v"(pA1));CMASK(pA0,pA1,0);
  START(pA0,pA1);
  _Pragma("unroll") for(int r=0;r<16;++r)pA1[r]=__builtin_amdgcn_exp2f(pA1[r]);
  WAIT_BAR(0);
  DMA_K(3,0);DMA_V(1,SLOTB);
  ROT();
  kload8(kf,kp0+sl_cur);
  WAIT_BAR(2);
  s16x4 vlo[8],vhi[8]; u32x4 pw0,pw1,pw2,pw3;
  #define PKW(P,B) cvtpk_s(P[B],P[B+1])
  #define PAF(k) __builtin_bit_cast(bf16x8,pw##k)
  #define VFR(i) (bf16x8){vlo[i][0],vlo[i][1],vlo[i][2],vlo[i][3],vhi[i][0],vhi[i][1],vhi[i][2],vhi[i][3]}
  #define PIN(x) asm volatile("":"+v"(x))
  #define MX3(a,b,c) __builtin_fmaxf(__builtin_fmaxf((a),(b)),(c))
  #define GAPA(MF,A0,A1,A2,A3,W0,W1,PW) do{ MF; sacc+=A0; sacc+=A1; sacc+=A2; sacc+=A3; PIN(sacc); W0; W1; PIN(PW); SBAR(); }while(0)
  #define EX(v) __builtin_amdgcn_exp2f(v)
  #define GAPB(MF,X,B) do{ MF; X[B]=EX(X[B]); X[B+1]=EX(X[B+1]); X[B+2]=EX(X[B+2]); X[B+3]=EX(X[B+3]); PIN(X); SBAR(); }while(0)
  #define VRD(i) do{ vlo[i]=vtr(vp_+(((i)>>2)*4096+((i)&3)*1024)); vhi[i]=vtr(vp_+(((i)>>2)*4096+((i)&3)*1024+512)); }while(0)
  #define KRD(G,j) do{ if(G){ kload2(kf,kp0+sl_next,j); SBAR(); } }while(0)
  #define STEP(C0,C1,P0,P1,t,GK,GV,GL) do{ SBAR(); \
    const lds_cptr vp_=vp0+sl_prev; \
    VRD(0); SBAR(); float sacc=(P0[0]+P0[1]); \
    GAPA(C0=__builtin_amdgcn_mfma_f32_32x32x16_bf16(kf[0],qr[0],negm,0,0,0), P0[2],P0[3],P0[4],P0[5],     pw0[0]=PKW(P0,0), pw0[1]=PKW(P0,2), pw0); \
    VRD(4); SBAR(); GAPA(C1=__builtin_amdgcn_mfma_f32_32x32x16_bf16(kf[1],qr[0],negm,0,0,0), P0[6],P0[7],P0[8],P0[9],     pw0[2]=PKW(P0,4), pw0[3]=PKW(P0,6), pw0); \
    VRD(1); SBAR(); GAPA(C0=__builtin_amdgcn_mfma_f32_32x32x16_bf16(kf[2],qr[1],C0,0,0,0),   P0[10],P0[11],P0[12],P0[13], pw1[0]=PKW(P0,8), pw1[1]=PKW(P0,10), pw1); \
    VRD(5); SBAR(); GAPA(C1=__builtin_amdgcn_mfma_f32_32x32x16_bf16(kf[3],qr[1],C1,0,0,0),   P0[14],P0[15],P1[0],P1[1],   pw1[2]=PKW(P0,12),pw1[3]=PKW(P0,14), pw1); \
    VRD(2); SBAR(); GAPA(C0=__builtin_amdgcn_mfma_f32_32x32x16_bf16(kf[4],qr[2],C0,0,0,0),   P1[2],P1[3],P1[4],P1[5],     pw2[0]=PKW(P1,0), pw2[1]=PKW(P1,2), pw2); \
    VRD(6); SBAR(); GAPA(C1=__builtin_amdgcn_mfma_f32_32x32x16_bf16(kf[5],qr[2],C1,0,0,0),   P1[6],P1[7],P1[8],P1[9],     pw2[2]=PKW(P1,4), pw2[3]=PKW(P1,6), pw2); \
    VRD(3); SBAR(); GAPA(C0=__builtin_amdgcn_mfma_f32_32x32x16_bf16(kf[6],qr[3],C0,0,0,0),   P1[10],P1[11],P1[12],P1[13], pw3[0]=PKW(P1,8), pw3[1]=PKW(P1,10), pw3); \
    VRD(7); SBAR(); GAPA(C1=__builtin_amdgcn_mfma_f32_32x32x16_bf16(kf[7],qr[3],C1,0,0,0),   P1[14],P1[15],0.f,0.f,       pw3[2]=PKW(P1,12),pw3[3]=PKW(P1,14), pw3); \
    l_reg+=sacc; \
    if(GK){DMA_K((t)+3,sl_cur);} if(GV){DMA_V((t)+1,sl_next);} \
    CMASK(C0,C1,t); \
    { float a=MX3(C0[0],C0[1],C1[0]),b=MX3(C0[2],C0[3],C1[1]); a=MX3(a,C1[2],C1[3]); \
      _Pragma("unroll") for(int r=4;r<16;r+=4){a=MX3(a,C0[r],C0[r+1]);b=MX3(b,C0[r+2],C0[r+3]);a=MX3(a,C1[r],C1[r+1]);b=MX3(b,C1[r+2],C1[r+3]);} \
      float rm=__builtin_fmaxf(a,b); { auto rr=__builtin_amdgcn_permlane32_swap(__float_as_uint(rm),__float_as_uint(rm),false,false); rm=__builtin_fmaxf(__uint_as_float(rr[0]),__uint_as_float(rr[1])); } \
      resc=false; \
      if(__builtin_expect(__any(rm>(float)THRL),0)){ const float dl=__builtin_fmaxf(rm,0.f); mhat+=dl; \
        _Pragma("unroll") for(int r=0;r<16;++r){C0[r]-=dl;C1[r]-=dl;} \
        _Pragma("unroll") for(int r=0;r<16;++r)negm[r]=-mhat; asm volatile("":"+v"(negm)); \
        const float f=__builtin_amdgcn_exp2f(-dl); l_reg*=f; if(hi==0)wsf[r32]=f; resc=true; } } \
    SBAR(); \
    GAPB(o[0]=__builtin_amdgcn_mfma_f32_32x32x16_bf16(PAF(0),VFR(0),o[0],0,0,0), C0,0); \
    GAPB(o[1]=__builtin_amdgcn_mfma_f32_32x32x16_bf16(PAF(0),VFR(4),o[1],0,0,0), C0,4); \
    KRD(GL,0); GAPB(o[0]=__builtin_amdgcn_mfma_f32_32x32x16_bf16(PAF(1),VFR(1),o[0],0,0,0), C0,8); \
    KRD(GL,1); GAPB(o[1]=__builtin_amdgcn_mfma_f32_32x32x16_bf16(PAF(1),VFR(5),o[1],0,0,0), C0,12); \
    KRD(GL,2); GAPB(o[0]=__builtin_amdgcn_mfma_f32_32x32x16_bf16(PAF(2),VFR(2),o[0],0,0,0), C1,0); \
    KRD(GL,3); GAPB(o[1]=__builtin_amdgcn_mfma_f32_32x32x16_bf16(PAF(2),VFR(6),o[1],0,0,0), C1,4); \
    GAPB(o[0]=__builtin_amdgcn_mfma_f32_32x32x16_bf16(PAF(3),VFR(3),o[0],0,0,0), C1,8); \
    GAPB(o[1]=__builtin_amdgcn_mfma_f32_32x32x16_bf16(PAF(3),VFR(7),o[1],0,0,0), C1,12); \
    }while(0)
  int t=1;
  #undef CMASK
  #define CMASK(P0,P1,t) do{}while(0)
  for(;t+5<NT;t+=2){
    STEP(pB0,pB1,pA0,pA1,t,true,true,true);     WAIT_BAR(2); RESC(); ROT();
    STEP(pA0,pA1,pB0,pB1,t+1,true,true,true);   WAIT_BAR(2); RESC(); ROT();
  }
  #undef CMASK
  #define CMASK(P0,P1,t) do{}while(0)
  #define ENDW(tt) do{ if((tt)+3<NT){WAIT_BAR(2);} else if((tt)+2<NT){WAIT_BAR(1);} else {WAIT_BAR(0);} }while(0)
  for(;t+1<NT;t+=2){
    STEP(pB0,pB1,pA0,pA1,t,(t+3<NT),(t+1<NT),(t+1<NT));       ENDW(t);   RESC(); ROT();
    STEP(pA0,pA1,pB0,pB1,t+1,(t+4<NT),(t+2<NT),(t+2<NT));     ENDW(t+1); RESC(); ROT();
  }
  STEP(pB0,pB1,pA0,pA1,NT-1,false,false,false); RESC();
  { float sacc=pB0[0]+pB0[1]; _Pragma("unroll") for(int r=2;r<16;++r)sacc+=pB0[r]; _Pragma("unroll") for(int r=0;r<16;++r)sacc+=pB1[r]; l_reg+=sacc;
    pw0=(u32x4){PKW(pB0,0),PKW(pB0,2),PKW(pB0,4),PKW(pB0,6)};pw1=(u32x4){PKW(pB0,8),PKW(pB0,10),PKW(pB0,12),PKW(pB0,14)};pw2=(u32x4){PKW(pB1,0),PKW(pB1,2),PKW(pB1,4),PKW(pB1,6)};pw3=(u32x4){PKW(pB1,8),PKW(pB1,10),PKW(pB1,12),PKW(pB1,14)};
    SBAR(); pv(o,vb0+sl_cur,PAF(0),PAF(1),PAF(2),PAF(3)); }
  #undef PKW
  #undef PAF
  #undef VFR
  #undef PIN
  #undef MX3
  #undef GAPA
  #undef GAPB
  #undef EX
  #undef VRD
  #undef KRD
  #undef STEP
  #undef ENDW
  {auto rr=__builtin_amdgcn_permlane32_swap(__float_as_uint(l_reg),__float_as_uint(l_reg),false,false);l_reg=__uint_as_float(rr[0])+__uint_as_float(rr[1]);}
  if(hi==0)wsf[32+r32]=l_reg;asm volatile("s_waitcnt lgkmcnt(0)":::"memory");
  float rli[16];
  #pragma unroll
  for(int r=0;r<16;++r)rli[r]=__builtin_amdgcn_rcpf(wsf[32+crow(r,hi)]);
  bf16*Ow=Ou+(long)(wid*QBLK)*QP;
  { bf16*stg=(bf16*)(shm+LDS_OST)+wid*2048;
    #pragma unroll
    for(int r=0;r<16;++r){const int orow=crow(r,hi);
      #pragma unroll
      for(int d0=0;d0<2;++d0)stg[orow*64+d0*32+r32]=__float2bfloat16(o[d0][r]*rli[r]);}
    asm volatile("s_waitcnt lgkmcnt(0)":::"memory");
    #pragma unroll
    for(int i=0;i<4;++i){const int row=i*8+(lane>>3),ch=lane&7; const u32x4 v=*(const u32x4*)(stg+row*64+ch*8); ATTN_STORE16(Ow+(long)row*QP+ch*8,v);} }
  asm volatile("s_waitcnt lgkmcnt(0)\n\ts_barrier":::"memory");
  #undef DMA_K
  #undef DMA_V
  #undef CMASK
  #undef START
  #undef RESC
  #undef ROT
}
constexpr int ATTN_LDS_BYTES=LDS_BYTES;
#undef SBAR
#undef WAIT_BAR
}
constexpr int NWAVES = 8;
constexpr int NLAT = 32768, NCTX = 1024, MALL = NLAT + NCTX, DM = 1024, SEQ = 8192, CTXL = 256, KVROWS = 8448, FFH = 2816;
constexpr size_t MiB = 1u << 20;
constexpr size_t WS_MOD = 0, WS_ROPE = 256 * 1024, WS_BAR = 280 * 1024, WS_SS = 296 * 1024, WS_SHW = 51 * MiB + 512 * 1024;
constexpr size_t WS_XN2 = 304 * MiB;
constexpr size_t WS_WQKV = 1 * MiB, WS_WO = 4 * MiB, WS_F1A = 6 * MiB, WS_F2A = 17 * MiB, WS_HIN = 23 * MiB, WS_HO = 33 * MiB, WS_F1B = 35 * MiB, WS_F2B = 46 * MiB, WS_HCTX = 52 * MiB, WS_XN = 56 * MiB;
constexpr size_t WS_U = 1 * MiB, WS_D = 18 * MiB;
constexpr size_t WS_QO = 122 * MiB, WS_K = 188 * MiB, WS_V = 205 * MiB, WS_HID0 = 122 * MiB;
constexpr size_t WS_HQ = 122 * MiB, WS_HG = 186 * MiB, WS_HV = 250 * MiB, WS_LFW = 314 * MiB, WS_LBW = 378 * MiB, WS_OFW = 442 * MiB, WS_OBW = 56 * MiB, WS_OG = 122 * MiB, WS_HID1 = 186 * MiB;
constexpr size_t WS_HVC = 506 * MiB, WS_LFWC = 508 * MiB, WS_LBWC = 510 * MiB;
constexpr size_t WS_END = 512 * MiB;
static_assert(WS_HQ == pg8::OFF_HQ && WS_HG == pg8::OFF_HG && WS_HV == pg8::OFF_HV && WS_LFW == pg8::OFF_LFW && WS_LBW == pg8::OFF_LBW && WS_HVC == pg8::OFF_HVC && WS_LFWC == pg8::OFF_LFWC && WS_LBWC == pg8::OFF_LBWC, "EpiHgrnIn offsets");
constexpr size_t F1_ELEMS = (size_t)2 * FFH * DM, F2_ELEMS = (size_t)DM * FFH;
constexpr int RING_BYTES = 131072, LDS_BYTES = 147456;

#define LAS __attribute__((address_space(3)))
typedef unsigned short bf16;
typedef unsigned v4u __attribute__((ext_vector_type(4)));
typedef unsigned v2u __attribute__((ext_vector_type(2)));
typedef float f32x4 __attribute__((ext_vector_type(4)));
typedef float f32x16 __attribute__((ext_vector_type(16)));
typedef short bf16x8 __attribute__((ext_vector_type(8)));
typedef float f32x2_t __attribute__((ext_vector_type(2)));
typedef __bf16 bf16x2_t __attribute__((ext_vector_type(2)));
__device__ __forceinline__ unsigned pk2(float lo, float hi) { f32x2_t v = {lo, hi}; bf16x2_t b = __builtin_convertvector(v, bf16x2_t); return __builtin_bit_cast(unsigned, b); }
__device__ __forceinline__ unsigned short f2bf(float f) { return (unsigned short)(pk2(f, 0.f) & 0xffffu); }
__device__ __forceinline__ float bf2f(unsigned short h) { return __builtin_bit_cast(float, (unsigned)h << 16); }
__device__ __forceinline__ float h2f(unsigned short h) { return (float)__builtin_bit_cast(_Float16, h); }
__device__ __forceinline__ float wave_sum(float v) {
#pragma unroll
    for (int o = 1; o < 64; o <<= 1) v += __shfl_xor(v, o);
    return v;
}
#define LDS_WAIT() asm volatile("s_waitcnt lgkmcnt(0)" ::: "memory")

template <int MODE> __device__ __forceinline__ int wmap(int o) {
    if (MODE == 1) { const int tile = o >> 8, w = o & 255, wc = w >> 6, bj = (w >> 5) & 1, e = w & 31; return tile * 256 + 128 * bj + 32 * wc + e; }
    if (MODE == 2) { const int half = o >= FFH ? 1 : 0, idx = o - half * FFH, pn = idx >> 7, q = idx & 127; return 256 * pn + 128 * half + q; }
    return o;
}
template <int MODE> __device__ __forceinline__ void p0_transpose_item(const float* W, int K, int N, bf16* WT, LAS float* scr, int item, int lane) {
    const int nblk = N / 32, kb = item / nblk, nb = item % nblk, k0 = 64 * kb, n0 = 32 * nb;
#pragma unroll 8
    for (int i = 0; i < 32; ++i) { const int kk = 2 * i + (lane >> 5); scr[kk * 33 + (lane & 31)] = W[(size_t)(k0 + kk) * N + n0 + (lane & 31)]; }
    LDS_WAIT(); asm volatile("" ::: "memory");
    const int c = lane & 7;
#pragma unroll
    for (int j = 0; j < 4; ++j) { const int n = (lane >> 3) + 8 * j; const LAS float* s = scr + (8 * c) * 33 + n;
        v4u o; o.x = pk2(s[0 * 33], s[1 * 33]); o.y = pk2(s[2 * 33], s[3 * 33]); o.z = pk2(s[4 * 33], s[5 * 33]); o.w = pk2(s[6 * 33], s[7 * 33]);
        *(v4u*)(WT + (size_t)wmap<MODE>(n0 + n) * K + k0 + 8 * c) = o; }
    LDS_WAIT(); asm volatile("" ::: "memory");
}

__device__ __forceinline__ void norm_rows(int gw, int NGW, int lane, const float* src_lat, const float* src_ctx, int nrows, const float* w, const float* modl, int shi, int sci, bf16* XN) {
    for (int r = gw; r < nrows; r += NGW) {
        const bool lat = r < NLAT; const float* src = lat ? src_lat + (size_t)r * DM : src_ctx + (size_t)(r - NLAT) * DM; const int vec = lat ? (r >> 13) : 4;
        const f32x4* xr = (const f32x4*)src + lane;
        f32x4 v[4]; float s = 0.f;
#pragma unroll
        for (int j = 0; j < 4; ++j) { v[j] = xr[64 * j]; s += (v[j].x * v[j].x + v[j].y * v[j].y) + (v[j].z * v[j].z + v[j].w * v[j].w); }
        const float rstd = rsqrtf(wave_sum(s) * (1.f / DM) + 1e-6f);
        const f32x4* wp = (const f32x4*)w + lane; const f32x4* shp = (const f32x4*)(modl + vec * 6144 + shi * 1024) + lane; const f32x4* scp = (const f32x4*)(modl + vec * 6144 + sci * 1024) + lane;
        unsigned long long* o8 = (unsigned long long*)(XN + (size_t)r * DM) + lane;
#pragma unroll
        for (int j = 0; j < 4; ++j) { const f32x4 ww = wp[64 * j], sh = shp[64 * j], sc = scp[64 * j]; const f32x4 y = v[j] * rstd * ww * (sc + 1.0f) + sh;
            o8[64 * j] = (unsigned long long)pk2(y.x, y.y) | ((unsigned long long)pk2(y.z, y.w) << 32); }
    }
}
__device__ __forceinline__ void final_norm_rows(int gw, int NGW, int lane, float* h, const float* w) {
    for (int r = gw; r < NLAT; r += NGW) {
        f32x4* xr = (f32x4*)(h + (size_t)r * DM) + lane;
        f32x4 v[4]; float s = 0.f;
#pragma unroll
        for (int j = 0; j < 4; ++j) { v[j] = xr[64 * j]; s += (v[j].x * v[j].x + v[j].y * v[j].y) + (v[j].z * v[j].z + v[j].w * v[j].w); }
        const float rstd = rsqrtf(wave_sum(s) * (1.f / DM) + 1e-6f);
        const f32x4* wp = (const f32x4*)w + lane;
#pragma unroll
        for (int j = 0; j < 4; ++j) xr[64 * j] = v[j] * rstd * wp[64 * j];
    }
}

constexpr int SC_Q0 = 0, SC_QM = 17408, SC_KE = 34816, SC_KT = 52224, SC_VT = 70656, SC_ST = 89088, SC_AT = 123904, SC_PS = 133120, SC_EL = 137216;
constexpr int NSTR = 272, TSTR = 144;
static_assert(SC_EL + 512 <= LDS_BYTES, "scan LDS map");
__device__ __forceinline__ int crow(int r, int hi) { return (r & 3) + 8 * (r >> 2) + 4 * hi; }
__device__ __forceinline__ int scan_row(int c, int s, int b, int dir) {
    if (c < 4) { const int idx = 64 * c + s; return NLAT + b * CTXL + (dir ? (CTXL - 1 - idx) : idx); }
    const int idx = 64 * (c - 4) + s; return b * SEQ + (dir ? (SEQ - 1 - idx) : idx);
}
#define MFMA32(a, b, c) __builtin_amdgcn_mfma_f32_32x32x16_bf16((a), (b), (c), 0, 0, 0)
template <int MODE> __device__ __forceinline__ void hgrn_scan_item(LAS unsigned char* lds, int item, const bf16* HQ, const bf16* HV, const bf16* LFW, const bf16* LBW, const bf16* HVc, const bf16* LFWc, const bf16* LBWc, bf16* OFW, bf16* OBW, float* UB, float* DB) {
    int tid_ = threadIdx.x; asm volatile("" : "+v"(tid_));
    const int tid = tid_, lane = tid & 63, wid = __builtin_amdgcn_readfirstlane(tid >> 6), r32 = lane & 31, hi = lane >> 5;
    const int seg = item & 3, stream = item >> 2, dir = stream & 1, h = (stream >> 1) & 7, b = stream >> 4;
    if (MODE == 0 && seg == 3) return;
    const bf16* LF = dir ? LBW : LFW; bf16* OX = dir ? OBW : OFW;
    const bf16* LFc = (dir ? LBWc : LFWc) - (size_t)NLAT * DM; const bf16* HVcb = HVc - (size_t)NLAT * DM;
    const int kp = lane, g = wid;
    const unsigned voff2 = (unsigned)(h * 128 + 2 * kp) * 2u;
    const int vt = wid & 3, th = wid >> 2;
    unsigned lfrA[8], qrA[8], vrA[8], lfrB[8], qrB[8], vrB[8];
#define SCAN_LOAD(LFR, QR, VR, c) do { const bf16* lfb_ = (c) < 4 ? LFc : LF; const bf16* hvb_ = (c) < 4 ? HVcb : HV; \
        _Pragma("unroll") for (int i = 0; i < 8; ++i) { const size_t r_ = (size_t)__builtin_amdgcn_readfirstlane(scan_row((c), 8 * g + i, b, dir)) * (DM * 2);     \
            LFR[i] = *(const unsigned*)((const char*)lfb_ + r_ + voff2); VR[i] = *(const unsigned*)((const char*)hvb_ + r_ + voff2); \
            if (MODE == 1) QR[i] = *(const unsigned*)((const char*)HQ + r_ + voff2);     } } while (0)
    f32x16 S[2];
#pragma unroll
    for (int j = 0; j < 2; ++j)
#pragma unroll
        for (int i = 0; i < 16; ++i) S[j][i] = 0.f;
    if (MODE == 1) {
        for (int js = 0; js < seg; ++js) { const int it = stream * 4 + js;
#pragma unroll
            for (int j = 0; j < 2; ++j)
#pragma unroll
                for (int i = 0; i < 16; ++i) S[j][i] = S[j][i] * DB[it * 128 + 32 * (2 * th + j) + crow(i, hi)] + UB[((size_t)it * 32 + j * 16 + i) * 512 + tid]; }
        *(LAS unsigned*)(lds + SC_AT + (tid >> 4) * TSTR + 64 + 4 * (tid & 15)) = 0u;
    }
    float dacc0 = 1.f, dacc1 = 1.f;
    const int c0 = 33 * seg;
    SCAN_LOAD(lfrA, qrA, vrA, c0); SCAN_LOAD(lfrB, qrB, vrB, c0 + 1);
    for (int cc = c0; cc < c0 + 33; cc += 2) {
      { const int c = cc;
        const bool has_out = (MODE == 1) && c >= 4;
        f32x2_t lf[8]; f32x2_t ps = {0.f, 0.f};
#pragma unroll
        for (int i = 0; i < 8; ++i) { lf[i] = (f32x2_t){h2f((unsigned short)(lfrA[i] & 0xffffu)), h2f((unsigned short)(lfrA[i] >> 16))}; ps += lf[i]; }
        *(LAS f32x2_t*)(lds + SC_PS + (g * 128 + 2 * kp) * 4) = ps;
        LDS_WAIT(); __builtin_amdgcn_s_barrier(); asm volatile("" ::: "memory");
        {
            f32x2_t pre = {0.f, 0.f}, Lmid = {0.f, 0.f}, Lend = {0.f, 0.f};
#pragma unroll
            for (int gg = 0; gg < 8; ++gg) { const f32x2_t p = *(const LAS f32x2_t*)(lds + SC_PS + (gg * 128 + 2 * kp) * 4); if (gg < g) pre += p; if (gg < 4) Lmid += p; Lend += p; }
            const f32x2_t eLmid = {__expf(Lmid.x), __expf(Lmid.y)}, eEndMid = {__expf(Lend.x - Lmid.x), __expf(Lend.y - Lmid.y)};
            if (g == 0) { const f32x2_t el = {__expf(Lend.x), __expf(Lend.y)}; *(LAS f32x2_t*)(lds + SC_EL + 2 * kp * 4) = el; dacc0 *= el.x; dacc1 *= el.y; }
            f32x2_t E = {__expf(pre.x - Lmid.x), __expf(pre.y - Lmid.y)};
            unsigned kt0[4], kt1[4];
#pragma unroll
            for (int i = 0; i < 8; ++i) {
                const f32x2_t f = {__expf(lf[i].x), __expf(lf[i].y)};
                E = E * f;
                const f32x2_t re = {__builtin_amdgcn_rcpf(E.x), __builtin_amdgcn_rcpf(E.y)};
                const f32x2_t ke = (1.0f - f) * re, kend = ke * eEndMid;
                const int s = 8 * g + i;
                if (has_out) {
                    const f32x2_t q = {bf2f((unsigned short)(qrA[i] & 0xffffu)), bf2f((unsigned short)(qrA[i] >> 16))};
                    const f32x2_t qm = q * E, q0 = qm * eLmid;
                    *(LAS unsigned*)(lds + SC_Q0 + s * NSTR + 4 * kp) = pk2(q0.x, q0.y);
                    *(LAS unsigned*)(lds + SC_QM + s * NSTR + 4 * kp) = pk2(qm.x, qm.y);
                    *(LAS unsigned*)(lds + SC_KE + s * NSTR + 4 * kp) = pk2(ke.x, ke.y);
                }
                const unsigned kd = pk2(kend.x, kend.y);
                if (i & 1) { kt0[i >> 1] |= kd << 16; kt1[i >> 1] |= kd & 0xffff0000u; } else { kt0[i >> 1] = kd & 0xffffu; kt1[i >> 1] = kd >> 16; }
            }
            *(LAS v4u*)(lds + SC_KT + (2 * kp) * TSTR + 16 * g) = (v4u){kt0[0], kt0[1], kt0[2], kt0[3]};
            *(LAS v4u*)(lds + SC_KT + (2 * kp + 1) * TSTR + 16 * g) = (v4u){kt1[0], kt1[1], kt1[2], kt1[3]};
            v4u v0, v1;
#pragma unroll
            for (int i2 = 0; i2 < 4; ++i2) { v0[i2] = (vrA[2 * i2] & 0xffffu) | (vrA[2 * i2 + 1] << 16); v1[i2] = (vrA[2 * i2] >> 16) | (vrA[2 * i2 + 1] & 0xffff0000u); }
            *(LAS v4u*)(lds + SC_VT + (2 * kp) * TSTR + 16 * g) = v0;
            *(LAS v4u*)(lds + SC_VT + (2 * kp + 1) * TSTR + 16 * g) = v1;
            if (has_out) {
#pragma unroll
                for (int j = 0; j < 2; ++j)
#pragma unroll
                    for (int g4 = 0; g4 < 4; ++g4)
                        *(LAS v2u*)(lds + SC_ST + (32 * vt + r32) * NSTR + (32 * (2 * th + j) + 8 * g4 + 4 * hi) * 2) = (v2u){pk2(S[j][4 * g4], S[j][4 * g4 + 1]), pk2(S[j][4 * g4 + 2], S[j][4 * g4 + 3])};
            }
        }
        if (c + 2 < c0 + 33) SCAN_LOAD(lfrA, qrA, vrA, c + 2);
        LDS_WAIT(); __builtin_amdgcn_s_barrier(); asm volatile("" ::: "memory");
        f32x16 o;
#pragma unroll
        for (int i = 0; i < 16; ++i) o[i] = 0.f;
        if (has_out && wid < 3) {
            const int si = wid >> 1, ti = (wid + 1) >> 1;
            f32x16 a;
#pragma unroll
            for (int i = 0; i < 16; ++i) a[i] = 0.f;
#pragma unroll
            for (int kk = 0; kk < 8; ++kk) {
                const bf16x8 A = *(const LAS bf16x8*)(lds + SC_KE + (32 * si + r32) * NSTR + (16 * kk + 8 * hi) * 2);
                const bf16x8 B = *(const LAS bf16x8*)(lds + SC_QM + (32 * ti + r32) * NSTR + (16 * kk + 8 * hi) * 2);
                a = MFMA32(A, B, a);
            }
            const int t = 32 * ti + r32;
#pragma unroll
            for (int g4 = 0; g4 < 4; ++g4) {
                const int s0 = 32 * si + 8 * g4 + 4 * hi;
                const float a0 = (s0 + 0 <= t) ? a[4 * g4 + 0] : 0.f, a1 = (s0 + 1 <= t) ? a[4 * g4 + 1] : 0.f, a2 = (s0 + 2 <= t) ? a[4 * g4 + 2] : 0.f, a3 = (s0 + 3 <= t) ? a[4 * g4 + 3] : 0.f;
                *(LAS v2u*)(lds + SC_AT + t * TSTR + s0 * 2) = (v2u){pk2(a0, a1), pk2(a2, a3)};
            }
        }
        {
            const LAS float* EL = (const LAS float*)(lds + SC_EL);
#pragma unroll
            for (int j = 0; j < 2; ++j) {
                const int kq = 2 * th + j;
#pragma unroll
                for (int i = 0; i < 16; ++i) S[j][i] *= EL[32 * kq + crow(i, hi)];
#pragma unroll
                for (int kk = 0; kk < 4; ++kk) {
                    const bf16x8 A = *(const LAS bf16x8*)(lds + SC_KT + (32 * kq + r32) * TSTR + (16 * kk + 8 * hi) * 2);
                    const bf16x8 B = *(const LAS bf16x8*)(lds + SC_VT + (32 * vt + r32) * TSTR + (16 * kk + 8 * hi) * 2);
                    S[j] = MFMA32(A, B, S[j]);
                }
            }
            if (has_out) {
#pragma unroll
                for (int kk = 0; kk < 8; ++kk) {
                    const bf16x8 A = *(const LAS bf16x8*)(lds + SC_Q0 + (32 * th + r32) * NSTR + (16 * kk + 8 * hi) * 2);
                    const bf16x8 B = *(const LAS bf16x8*)(lds + SC_ST + (32 * vt + r32) * NSTR + (16 * kk + 8 * hi) * 2);
                    o = MFMA32(A, B, o);
                }
            }
        }
        LDS_WAIT(); __builtin_amdgcn_s_barrier(); asm volatile("" ::: "memory");
        if (has_out) {
#pragma unroll
            for (int kk = 0; kk < 4; ++kk) {
                const bf16x8 A = *(const LAS bf16x8*)(lds + SC_AT + (32 * th + r32) * TSTR + (16 * kk + 8 * hi) * 2);
                const bf16x8 B = *(const LAS bf16x8*)(lds + SC_VT + (32 * vt + r32) * TSTR + (16 * kk + 8 * hi) * 2);
                o = MFMA32(A, B, o);
            }
#pragma unroll
            for (int i = 0; i < 16; ++i) *(LAS unsigned short*)(lds + SC_Q0 + wid * 2560 + crow(i, hi) * 80 + 2 * r32) = f2bf(o[i]);
            LDS_WAIT(); asm volatile("" ::: "memory");
#pragma unroll
            for (int j2 = 0; j2 < 2; ++j2) { const int tl = j2 * 16 + (lane >> 2), pc = lane & 3; const v4u pv = *(const LAS v4u*)(lds + SC_Q0 + wid * 2560 + tl * 80 + 16 * pc);
                const size_t r_ = (size_t)scan_row(c, 32 * th + tl, b, dir); *(v4u*)(OX + r_ * DM + h * 128 + 32 * vt + 8 * pc) = pv; }
        }
          }
      if (cc + 1 < c0 + 33) { const int c = cc + 1;
        const bool has_out = (MODE == 1) && c >= 4;
        f32x2_t lf[8]; f32x2_t ps = {0.f, 0.f};
#pragma unroll
        for (int i = 0; i < 8; ++i) { lf[i] = (f32x2_t){h2f((unsigned short)(lfrB[i] & 0xffffu)), h2f((unsigned short)(lfrB[i] >> 16))}; ps += lf[i]; }
        *(LAS f32x2_t*)(lds + SC_PS + (g * 128 + 2 * kp) * 4) = ps;
        LDS_WAIT(); __builtin_amdgcn_s_barrier(); asm volatile("" ::: "memory");
        {
            f32x2_t pre = {0.f, 0.f}, Lmid = {0.f, 0.f}, Lend = {0.f, 0.f};
#pragma unroll
            for (int gg = 0; gg < 8; ++gg) { const f32x2_t p = *(const LAS f32x2_t*)(lds + SC_PS + (gg * 128 + 2 * kp) * 4); if (gg < g) pre += p; if (gg < 4) Lmid += p; Lend += p; }
            const f32x2_t eLmid = {__expf(Lmid.x), __expf(Lmid.y)}, eEndMid = {__expf(Lend.x - Lmid.x), __expf(Lend.y - Lmid.y)};
            if (g == 0) { const f32x2_t el = {__expf(Lend.x), __expf(Lend.y)}; *(LAS f32x2_t*)(lds + SC_EL + 2 * kp * 4) = el; dacc0 *= el.x; dacc1 *= el.y; }
            f32x2_t E = {__expf(pre.x - Lmid.x), __expf(pre.y - Lmid.y)};
            unsigned kt0[4], kt1[4];
#pragma unroll
            for (int i = 0; i < 8; ++i) {
                const f32x2_t f = {__expf(lf[i].x), __expf(lf[i].y)};
                E = E * f;
                const f32x2_t re = {__builtin_amdgcn_rcpf(E.x), __builtin_amdgcn_rcpf(E.y)};
                const f32x2_t ke = (1.0f - f) * re, kend = ke * eEndMid;
                const int s = 8 * g + i;
                if (has_out) {
                    const f32x2_t q = {bf2f((unsigned short)(qrB[i] & 0xffffu)), bf2f((unsigned short)(qrB[i] >> 16))};
                    const f32x2_t qm = q * E, q0 = qm * eLmid;
                    *(LAS unsigned*)(lds + SC_Q0 + s * NSTR + 4 * kp) = pk2(q0.x, q0.y);
                    *(LAS unsigned*)(lds + SC_QM + s * NSTR + 4 * kp) = pk2(qm.x, qm.y);
                    *(LAS unsigned*)(lds + SC_KE + s * NSTR + 4 * kp) = pk2(ke.x, ke.y);
                }
                const unsigned kd = pk2(kend.x, kend.y);
                if (i & 1) { kt0[i >> 1] |= kd << 16; kt1[i >> 1] |= kd & 0xffff0000u; } else { kt0[i >> 1] = kd & 0xffffu; kt1[i >> 1] = kd >> 16; }
            }
            *(LAS v4u*)(lds + SC_KT + (2 * kp) * TSTR + 16 * g) = (v4u){kt0[0], kt0[1], kt0[2], kt0[3]};
            *(LAS v4u*)(lds + SC_KT + (2 * kp + 1) * TSTR + 16 * g) = (v4u){kt1[0], kt1[1], kt1[2], kt1[3]};
            v4u v0, v1;
#pragma unroll
            for (int i2 = 0; i2 < 4; ++i2) { v0[i2] = (vrB[2 * i2] & 0xffffu) | (vrB[2 * i2 + 1] << 16); v1[i2] = (vrB[2 * i2] >> 16) | (vrB[2 * i2 + 1] & 0xffff0000u); }
            *(LAS v4u*)(lds + SC_VT + (2 * kp) * TSTR + 16 * g) = v0;
            *(LAS v4u*)(lds + SC_VT + (2 * kp + 1) * TSTR + 16 * g) = v1;
            if (has_out) {
#pragma unroll
                for (int j = 0; j < 2; ++j)
#pragma unroll
                    for (int g4 = 0; g4 < 4; ++g4)
                        *(LAS v2u*)(lds + SC_ST + (32 * vt + r32) * NSTR + (32 * (2 * th + j) + 8 * g4 + 4 * hi) * 2) = (v2u){pk2(S[j][4 * g4], S[j][4 * g4 + 1]), pk2(S[j][4 * g4 + 2], S[j][4 * g4 + 3])};
            }
        }
        if (c + 2 < c0 + 33) SCAN_LOAD(lfrB, qrB, vrB, c + 2);
        LDS_WAIT(); __builtin_amdgcn_s_barrier(); asm volatile("" ::: "memory");
        f32x16 o;
#pragma unroll
        for (int i = 0; i < 16; ++i) o[i] = 0.f;
        if (has_out && wid < 3) {
            const int si = wid >> 1, ti = (wid + 1) >> 1;
            f32x16 a;
#pragma unroll
            for (int i = 0; i < 16; ++i) a[i] = 0.f;
#pragma unroll
            for (int kk = 0; kk < 8; ++kk) {
                const bf16x8 A = *(const LAS bf16x8*)(lds + SC_KE + (32 * si + r32) * NSTR + (16 * kk + 8 * hi) * 2);
                const bf16x8 B = *(const LAS bf16x8*)(lds + SC_QM + (32 * ti + r32) * NSTR + (16 * kk + 8 * hi) * 2);
                a = MFMA32(A, B, a);
            }
            const int t = 32 * ti + r32;
#pragma unroll
            for (int g4 = 0; g4 < 4; ++g4) {
                const int s0 = 32 * si + 8 * g4 + 4 * hi;
                const float a0 = (s0 + 0 <= t) ? a[4 * g4 + 0] : 0.f, a1 = (s0 + 1 <= t) ? a[4 * g4 + 1] : 0.f, a2 = (s0 + 2 <= t) ? a[4 * g4 + 2] : 0.f, a3 = (s0 + 3 <= t) ? a[4 * g4 + 3] : 0.f;
                *(LAS v2u*)(lds + SC_AT + t * TSTR + s0 * 2) = (v2u){pk2(a0, a1), pk2(a2, a3)};
            }
        }
        {
            const LAS float* EL = (const LAS float*)(lds + SC_EL);
#pragma unroll
            for (int j = 0; j < 2; ++j) {
                const int kq = 2 * th + j;
#pragma unroll
                for (int i = 0; i < 16; ++i) S[j][i] *= EL[32 * kq + crow(i, hi)];
#pragma unroll
                for (int kk = 0; kk < 4; ++kk) {
                    const bf16x8 A = *(const LAS bf16x8*)(lds + SC_KT + (32 * kq + r32) * TSTR + (16 * kk + 8 * hi) * 2);
                    const bf16x8 B = *(const LAS bf16x8*)(lds + SC_VT + (32 * vt + r32) * TSTR + (16 * kk + 8 * hi) * 2);
                    S[j] = MFMA32(A, B, S[j]);
                }
            }
            if (has_out) {
#pragma unroll
                for (int kk = 0; kk < 8; ++kk) {
                    const bf16x8 A = *(const LAS bf16x8*)(lds + SC_Q0 + (32 * th + r32) * NSTR + (16 * kk + 8 * hi) * 2);
                    const bf16x8 B = *(const LAS bf16x8*)(lds + SC_ST + (32 * vt + r32) * NSTR + (16 * kk + 8 * hi) * 2);
                    o = MFMA32(A, B, o);
                }
            }
        }
        LDS_WAIT(); __builtin_amdgcn_s_barrier(); asm volatile("" ::: "memory");
        if (has_out) {
#pragma unroll
            for (int kk = 0; kk < 4; ++kk) {
                const bf16x8 A = *(const LAS bf16x8*)(lds + SC_AT + (32 * th + r32) * TSTR + (16 * kk + 8 * hi) * 2);
                const bf16x8 B = *(const LAS bf16x8*)(lds + SC_VT + (32 * vt + r32) * TSTR + (16 * kk + 8 * hi) * 2);
                o = MFMA32(A, B, o);
            }
#pragma unroll
            for (int i = 0; i < 16; ++i) *(LAS unsigned short*)(lds + SC_Q0 + wid * 2560 + crow(i, hi) * 80 + 2 * r32) = f2bf(o[i]);
            LDS_WAIT(); asm volatile("" ::: "memory");
#pragma unroll
            for (int j2 = 0; j2 < 2; ++j2) { const int tl = j2 * 16 + (lane >> 2), pc = lane & 3; const v4u pv = *(const LAS v4u*)(lds + SC_Q0 + wid * 2560 + tl * 80 + 16 * pc);
                const size_t r_ = (size_t)scan_row(c, 32 * th + tl, b, dir); *(v4u*)(OX + r_ * DM + h * 128 + 32 * vt + 8 * pc) = pv; }
        }
          }
    }
#undef SCAN_LOAD
    if (MODE == 0) {
#pragma unroll
        for (int j = 0; j < 2; ++j)
#pragma unroll
            for (int i = 0; i < 16; ++i) UB[((size_t)item * 32 + j * 16 + i) * 512 + tid] = S[j][i];
        if (g == 0) { DB[item * 128 + 2 * kp] = dacc0; DB[item * 128 + 2 * kp + 1] = dacc1; }
    }
    LDS_WAIT(); __builtin_amdgcn_s_barrier(); asm volatile("" ::: "memory");
}
__device__ __forceinline__ void hgrn_combine(int gw, int NGW, int lane, const bf16* OFW, const bf16* OBW, const bf16* HG, const float* onorm, bf16* OG) {
    for (int r = gw; r < NLAT; r += NGW) {
        const size_t off = (size_t)r * DM + lane * 16;
        float o[16], gt[16];
#pragma unroll
        for (int j = 0; j < 2; ++j) { const v4u a = *(const v4u*)(OFW + off + 8 * j), bq = *(const v4u*)(OBW + off + 8 * j), gg = *(const v4u*)(HG + off + 8 * j);
#pragma unroll
            for (int e = 0; e < 4; ++e) { o[8 * j + 2 * e] = bf2f((unsigned short)(a[e] & 0xffffu)) + bf2f((unsigned short)(bq[e] & 0xffffu)); o[8 * j + 2 * e + 1] = bf2f((unsigned short)(a[e] >> 16)) + bf2f((unsigned short)(bq[e] >> 16));
                gt[8 * j + 2 * e] = bf2f((unsigned short)(gg[e] & 0xffffu)); gt[8 * j + 2 * e + 1] = bf2f((unsigned short)(gg[e] >> 16)); } }
        float ss = 0.f;
#pragma unroll
        for (int e = 0; e < 16; ++e) ss += o[e] * o[e];
        ss += __shfl_xor(ss, 1); ss += __shfl_xor(ss, 2); ss += __shfl_xor(ss, 4);
        const float rstd = rsqrtf(ss * (1.f / 128.f) + 1e-6f);
        unsigned pk[8];
#pragma unroll
        for (int e = 0; e < 8; ++e) { const float w0 = onorm[lane * 16 + 2 * e], w1 = onorm[lane * 16 + 2 * e + 1];
            const float y0 = o[2 * e] * rstd * w0 * __builtin_amdgcn_rcpf(1.0f + __expf(-gt[2 * e])), y1 = o[2 * e + 1] * rstd * w1 * __builtin_amdgcn_rcpf(1.0f + __expf(-gt[2 * e + 1])); pk[e] = pk2(y0, y1); }
        *(v4u*)(OG + off) = (v4u){pk[0], pk[1], pk[2], pk[3]}; *(v4u*)(OG + off + 8) = (v4u){pk[4], pk[5], pk[6], pk[7]};
    }
}

#define XB_TMO      128
#define XB_XCNT(j)  (256  + 64 * (j))
#define XB_XSUB(j)  (1280 + 64 * (j))
#define XB_XGEN(j)  (2304 + 64 * (j))
#define XB_TOP      3328
#define XB_TOPGEN   3392
#define XCD_BAR_WORDS 3456
#define XB_SPIN_CAP (1u << 18)

__device__ __forceinline__ unsigned xb_ld(unsigned* p)              { return __hip_atomic_load(p, __ATOMIC_RELAXED, __HIP_MEMORY_SCOPE_AGENT); }
__device__ __forceinline__ unsigned xb_add(unsigned* p, unsigned v) { return __hip_atomic_fetch_add(p, v, __ATOMIC_RELAXED, __HIP_MEMORY_SCOPE_AGENT); }
__device__ __forceinline__ unsigned xb_xcc_id() { return (unsigned)__builtin_amdgcn_s_getreg((3 << 11) | 20) & 0xFu; }
#define XB_SPIN(cond, bar) do { unsigned _sp = 0; while (cond) { __builtin_amdgcn_s_sleep(1); \
    if ((++_sp & 255u) == 0u) { if (xb_ld(&(bar)[XB_TMO])) break; if (_sp > XB_SPIN_CAP) { atomicAdd(&(bar)[XB_TMO], 1u); break; } } } } while (0)

struct XcdBarrier {
    unsigned* bar; unsigned x;
    volatile LAS unsigned* st;
};

__device__ __forceinline__ XcdBarrier xcd_barrier_post(unsigned* bar, volatile LAS unsigned* st) {
    XcdBarrier b; b.bar = bar; b.x = xb_xcc_id(); b.st = st;
    if (threadIdx.x == 0) (void)xb_add(&bar[XB_XCNT(b.x)], 1u);
    return b;
}
__device__ __forceinline__ void xcd_barrier_complete(unsigned* bar, unsigned x, unsigned& nloc, unsigned& nx) {
    const unsigned G = gridDim.x * gridDim.y * gridDim.z;
    unsigned sum, cnt, mine, sp = 0u;
    for (;;) {
        sum = 0u; cnt = 0u; mine = 0u;
#pragma unroll
        for (unsigned j = 0; j < 16; ++j) { const unsigned c = xb_ld(&bar[XB_XCNT(j)]); sum += c; cnt += (c > 0u) ? 1u : 0u; mine = (j == x) ? c : mine; }
        if (sum == G) break;
        __builtin_amdgcn_s_sleep(1);
        if ((++sp & 255u) == 0u) { if (xb_ld(&bar[XB_TMO])) break; if (sp > XB_SPIN_CAP) { atomicAdd(&bar[XB_TMO], 1u); break; } }
    }
    nloc = mine > 0u ? mine : 1u; nx = cnt > 0u ? cnt : 1u;
}

__device__ __forceinline__ void xcd_barrier(const XcdBarrier& b) {
    asm volatile("s_waitcnt vmcnt(0)" ::: "memory");
    __syncthreads();
    if (threadIdx.x == 0) {
        unsigned* bar = b.bar;
        __builtin_amdgcn_s_waitcnt(0);
        unsigned nloc = b.st[0], nx = b.st[1];
        if (nloc == 0u) { xcd_barrier_complete(bar, b.x, nloc, nx); b.st[0] = nloc; b.st[1] = nx; }
        const unsigned old = xb_add(&bar[XB_XSUB(b.x)], 1u);
        const unsigned gen = old / nloc;
        if (old + 1u == (gen + 1u) * nloc) {
            __builtin_amdgcn_fence(__ATOMIC_RELEASE, "agent");
            asm volatile("s_waitcnt vmcnt(0)" ::: "memory");
            const unsigned og = xb_add(&bar[XB_TOP], 1u);
            const unsigned tg = og / nx;
            if (og + 1u == (tg + 1u) * nx) xb_add(&bar[XB_TOPGEN], 1u);
            else XB_SPIN(xb_ld(&bar[XB_TOPGEN]) == tg, bar);
            __builtin_amdgcn_fence(__ATOMIC_ACQUIRE, "agent");
            xb_add(&bar[XB_XGEN(b.x)], 1u);
            asm volatile("s_waitcnt vmcnt(0)" ::: "memory");
        } else {
            XB_SPIN(xb_ld(&bar[XB_XGEN(b.x)]) == gen, bar);
            __builtin_amdgcn_fence(__ATOMIC_ACQUIRE, "agent");
            asm volatile("s_waitcnt vmcnt(0)" ::: "memory");
        }
    }
    __syncthreads();
}

struct Args { const float* in[19]; float* out; unsigned char* ws; };
typedef __attribute__((address_space(4))) Args KArgs;
__device__ __forceinline__ int fresh_v(int t) { asm volatile("" : "+v"(t)); return t; }
__device__ __forceinline__ int fresh_s(int t) { asm volatile("" : "+s"(t)); return t; }
__global__ void __launch_bounds__(NWAVES * 64, 2) mk_fwd(Args args) {
    extern __shared__ __attribute__((aligned(16))) unsigned char lds_raw[];
    LAS unsigned char* lds = (LAS unsigned char*)lds_raw;
    cg::grid_group grid = cg::this_grid();
#define PHASE_IDS() const int tid = fresh_v((int)threadIdx.x), lane = tid & 63, wave = __builtin_amdgcn_readfirstlane(tid >> 6); (void)lane; (void)wave; \
    const int G = fresh_s((int)gridDim.x), bx = fresh_s((int)blockIdx.x); const int vcu = (G % 8 == 0) ? (bx % 8) * (G / 8) + bx / 8 : bx; (void)vcu; \
    const int gw = vcu * NWAVES + wave, NGW = G * NWAVES; (void)gw; (void)NGW; \
    const KArgs* ap = (const KArgs*)__builtin_amdgcn_kernarg_segment_ptr(); asm volatile("" : "+s"(ap)); unsigned char* ws = ap->ws; (void)ws
#define IN(k) (ap->in[k])
#define MOD ((float*)(ws + WS_MOD))
#define ROPEC ((float*)(ws + WS_ROPE))
#define ROPES (ROPEC + 128 * 16)
#define Wqkv_t ((bf16*)(ws + WS_WQKV))
#define Wo_t ((bf16*)(ws + WS_WO))
#define Hin_t ((bf16*)(ws + WS_HIN))
#define Ho_t ((bf16*)(ws + WS_HO))
#define F1A_t ((bf16*)(ws + WS_F1A))
#define F2A_t ((bf16*)(ws + WS_F2A))
#define F1B_t ((bf16*)(ws + WS_F1B))
#define F2B_t ((bf16*)(ws + WS_F2B))
#define HCTX ((float*)(ws + WS_HCTX))
#define XN ((bf16*)(ws + WS_XN))
#define QO ((bf16*)(ws + WS_QO))
#define KB ((bf16*)(ws + WS_K))
#define VB ((bf16*)(ws + WS_V))
#define MOD1 (MOD + 5 * 6144)
#define SS0 ((float*)(ws + WS_SS))
#define SS1 (SS0 + MALL)
#define SS2 (SS1 + MALL)
#define SS3 (SS2 + MALL)
#define SHW0 ((float*)(ws + WS_SHW))
#define SHW1 (SHW0 + 5 * 5632)
#define SHW2 (SHW1 + 5 * 5120)
    if (args.ws == nullptr) grid.sync();
    volatile LAS unsigned* bst = (volatile LAS unsigned*)(lds + LDS_BYTES - 16);
    if (threadIdx.x == 0) { bst[0] = 0u; bst[1] = 0u; }
    __syncthreads();
    const XcdBarrier bar = xcd_barrier_post((unsigned*)(args.ws + WS_BAR), bst);
    {
        PHASE_IDS();
        for (int i = (bx * NWAVES * 64) + tid; i < 4 * MALL; i += G * NWAVES * 64) SS0[i] = 0.f;
        LAS float* sl = (LAS float*)lds;
        for (int i = tid; i < 5 * 1024; i += NWAVES * 64) { const float v = i < 4096 ? (ap->in[1])[i] : (ap->in[3])[i - 4096]; sl[i] = v / (1.0f + __expf(-v)); }
        __syncthreads();
        for (int it = gw; it < 768; it += NGW) {
            const int l = it / 384, n0 = (it % 384) * 16, cg4 = lane & 3, ks = lane >> 2;
            const float* W = (ap->in[4]) + (size_t)l * 1024 * 6144 + n0 + 4 * cg4;
            f32x4 acc[5];
#pragma unroll
            for (int v = 0; v < 5; ++v) acc[v] = (f32x4){0.f, 0.f, 0.f, 0.f};
#pragma unroll 8
            for (int i = 0; i < 64; ++i) { const int kk = i * 16 + ks; const f32x4 w4 = *(const f32x4*)(W + (size_t)kk * 6144);
#pragma unroll
                for (int v = 0; v < 5; ++v) acc[v] += w4 * sl[v * 1024 + kk]; }
#pragma unroll
            for (int v = 0; v < 5; ++v)
#pragma unroll
                for (int e = 0; e < 4; ++e) { float a = acc[v][e]; a += __shfl_xor(a, 4); a += __shfl_xor(a, 8); a += __shfl_xor(a, 16); a += __shfl_xor(a, 32); acc[v][e] = a; }
            if (ks == 0) { const f32x4 bb = *(const f32x4*)((ap->in[5]) + l * 6144 + n0 + 4 * cg4);
#pragma unroll
                for (int v = 0; v < 5; ++v) *(f32x4*)(MOD + (size_t)(l * 5 + v) * 6144 + n0 + 4 * cg4) = acc[v] + bb; }
        }
        __syncthreads();
        for (int idx = bx * (NWAVES * 64) + tid; idx < 2048; idx += G * NWAVES * 64) {
            const int pos = idx >> 4, f = idx & 15;
            double inv = 1.0; for (int j = 0; j < f; ++j) inv *= 0.56234132519034908;
            const double ang = (double)pos * inv, TWO_PI = 6.283185307179586476925;
            const double kq = __builtin_rint(ang / TWO_PI); const double rr = ang - kq * TWO_PI, r2 = rr * rr;
            double cs = 1.0, sn = rr, tc = 1.0, tsn = rr;
            for (int n = 1; n <= 14; ++n) { tc *= -r2 / (double)((2 * n - 1) * (2 * n)); tsn *= -r2 / (double)((2 * n) * (2 * n + 1)); cs += tc; sn += tsn; }
            ROPEC[idx] = (float)cs; ROPES[idx] = (float)sn;
        }
        LAS float* scr = (LAS float*)(lds + wave * 16384);
        constexpr int I_QKV = 16 * 48, I_O = 16 * 32, I_HIN = 16 * 160, I_HO = 16 * 32, I_F1 = 16 * 176, I_F2 = 44 * 32;
        constexpr int NITEMS = I_QKV + I_O + I_HIN + I_HO + 2 * I_F1 + 2 * I_F2;
        for (int it = gw; it < NITEMS; it += NGW) {
            int r = it;
            if (r < I_QKV) { p0_transpose_item<1>((ap->in[8]), 1024, 1536, Wqkv_t, scr, r, lane); continue; } r -= I_QKV;
            if (r < I_O) { p0_transpose_item<0>((ap->in[11]), 1024, 1024, Wo_t, scr, r, lane); continue; } r -= I_O;
            if (r < I_HIN) { p0_transpose_item<0>((ap->in[12]), 1024, 5120, Hin_t, scr, r, lane); continue; } r -= I_HIN;
            if (r < I_HO) { p0_transpose_item<0>((ap->in[15]), 1024, 1024, Ho_t, scr, r, lane); continue; } r -= I_HO;
            if (r < I_F1) { p0_transpose_item<2>((ap->in[16]), 1024, 5632, F1A_t, scr, r, lane); continue; } r -= I_F1;
            if (r < I_F1) { p0_transpose_item<2>((ap->in[16]) + (size_t)1024 * 5632, 1024, 5632, F1B_t, scr, r, lane); continue; } r -= I_F1;
            if (r < I_F2) { p0_transpose_item<0>((ap->in[17]), 2816, 1024, F2A_t, scr, r, lane); continue; } r -= I_F2;
            p0_transpose_item<0>((ap->in[17]) + (size_t)2816 * 1024, 2816, 1024, F2B_t, scr, r, lane);
        }
    }
    xcd_barrier(bar);
    { PHASE_IDS(); norm_rows(gw, NGW, lane, (ap->in[0]), (ap->in[2]), MALL, (ap->in[6]), MOD, 0, 1, XN);
      for (int site = 0; site < 3; ++site) {
          const bf16* Bt = site == 0 ? F1A_t : site == 1 ? Hin_t : F1B_t; const int N = site == 1 ? 5120 : 5632;
          const float* shv = (site == 0 ? MOD : MOD1) + (site == 1 ? 0 : 3) * 1024; float* dst = site == 0 ? SHW0 : site == 1 ? SHW1 : SHW2;
          for (int n = gw; n < N; n += NGW) {
              const v4u w0 = *(const v4u*)(Bt + (size_t)n * 1024 + lane * 16), w1 = *(const v4u*)(Bt + (size_t)n * 1024 + lane * 16 + 8);
              float wf[16];
#pragma unroll
              for (int e = 0; e < 4; ++e) { wf[2 * e] = bf2f((unsigned short)(w0[e] & 0xffffu)); wf[2 * e + 1] = bf2f((unsigned short)(w0[e] >> 16)); wf[8 + 2 * e] = bf2f((unsigned short)(w1[e] & 0xffffu)); wf[8 + 2 * e + 1] = bf2f((unsigned short)(w1[e] >> 16)); }
#pragma unroll
              for (int v = 0; v < 5; ++v) { const float* sp = shv + v * 6144 + lane * 16; float a = 0.f;
#pragma unroll
                  for (int e4 = 0; e4 < 4; ++e4) { const f32x4 s4 = *(const f32x4*)(sp + 4 * e4); a += (wf[4 * e4] * s4[0] + wf[4 * e4 + 1] * s4[1]) + (wf[4 * e4 + 2] * s4[2] + wf[4 * e4 + 3] * s4[3]); }
                  a = wave_sum(a); if (lane == 0) dst[v * N + n] = a; }
          }
      }
    }
    xcd_barrier(bar);
    {
        PHASE_IDS();
        pg8::Gemm g{XN, Wqkv_t, MALL, 1536, 1024}; pg8::StaticOrder S; S.init(MALL, 1536, G, bx);
        pg8::EpiQKV E{QO, KB, VB, (ap->in[9]), (ap->in[10]), ROPEC, ROPES, attn_body::C2};
        pg8::gemm_phase<pg8::EpiQKV, pg8::StaticOrder, PG8_ALIGN, PG8_SP2>(lds, g, S, E);
    }
    xcd_barrier(bar);
    {
        PHASE_IDS();
        for (int i = 0; i < 8; ++i) {
            const int u = i * 256 + vcu; if (u >= 2048 || G != 256) break;
            const int combo = u >> 7, idx = u & 127, b = combo >> 2, kvh = combo & 3, hq = idx >> 5, qb = idx & 31, h = kvh * 4 + hq;
            const attn_body::bf16* Qu = (const attn_body::bf16*)QO + ((size_t)b * SEQ + qb * 256) * 1024 + h * 64;
            const attn_body::bf16* Kh = (const attn_body::bf16*)KB + (size_t)b * KVROWS * 256 + kvh * 64;
            const attn_body::bf16* Vh = (const attn_body::bf16*)VB + (size_t)b * KVROWS * 256 + kvh * 64;
            attn_body::attn_unit<8>(Qu, Kh, Vh, (attn_body::bf16*)XN + (Qu - (const attn_body::bf16*)QO), 132, (char*)lds_raw);
        }
        if (G != 256) for (int u = bx; u < 2048; u += G) {
            const int combo = u >> 7, idx = u & 127, b = combo >> 2, kvh = combo & 3, hq = idx >> 5, qb = idx & 31, h = kvh * 4 + hq;
            const attn_body::bf16* Qu = (const attn_body::bf16*)QO + ((size_t)b * SEQ + qb * 256) * 1024 + h * 64;
            const attn_body::bf16* Kh = (const attn_body::bf16*)KB + (size_t)b * KVROWS * 256 + kvh * 64;
            const attn_body::bf16* Vh = (const attn_body::bf16*)VB + (size_t)b * KVROWS * 256 + kvh * 64;
            attn_body::attn_unit<8>(Qu, Kh, Vh, (attn_body::bf16*)XN + (Qu - (const attn_body::bf16*)QO), 132, (char*)lds_raw);
        }
        for (int u = bx; u < 64; u += G) {
            const int b = u >> 4, h = u & 15, kvh = h >> 2;
            const attn_body::bf16* Qu = (const attn_body::bf16*)QO + ((size_t)NLAT + b * CTXL) * 1024 + h * 64;
            const attn_body::bf16* Kh = (const attn_body::bf16*)KB + (size_t)b * KVROWS * 256 + kvh * 64;
            const attn_body::bf16* Vh = (const attn_body::bf16*)VB + (size_t)b * KVROWS * 256 + kvh * 64;
            attn_body::attn_unit<8>(Qu, Kh, Vh, (attn_body::bf16*)XN + (Qu - (const attn_body::bf16*)QO), 4, (char*)lds_raw);
        }
    }
    xcd_barrier(bar);
    {
        PHASE_IDS();
        const int Mrows = (G == 256) ? NLAT : MALL;
        pg8::Gemm g{XN, Wo_t, Mrows, 1024, 1024}; pg8::StaticOrder S; S.init(Mrows, 1024, G, bx);
        pg8::EpiResidN E{(ap->in[0]), (ap->in[2]), (ap->out), HCTX, MOD + 2 * 1024, (bf16*)(ws + WS_XN2), SS0, (ap->in[7]), MOD + 4 * 1024, (LAS float*)(lds + 139264)};
        pg8::gemm_phase<pg8::EpiResidN, pg8::StaticOrder, PG8_ALIGN, PG8_SP2>(lds, g, S, E);
    }
    xcd_barrier(bar);
    {
        PHASE_IDS();
        pg8::EpiSwiGLU E{(bf16*)(ws + WS_HID0), SS0, SHW0};
        pg8::Gemm g{(const bf16*)(ws + WS_XN2), F1A_t, MALL, 5632, 1024};
        if (G == 256) {
            unsigned* cntW = (unsigned*)(ws + WS_BAR) + XCD_BAR_WORDS + 64; unsigned* cntU = cntW + 64; unsigned* cntD = cntW + 128;
            if (bx < 240) {
                const int x = bx & 7, idx = bx >> 3; const bool hasW = (x == 0 && idx < 16), hasH = idx < 6;
                if (hasW) {
                    pg8::Gemm gw_{XN, Wo_t, MALL, 1024, 1024}; pg8::OneUnit Sw{128 + (idx >> 2), idx & 3, cntW};
                    pg8::EpiResidN Ew{(ap->in[0]), (ap->in[2]), (ap->out), HCTX, MOD + 2 * 1024, (bf16*)(ws + WS_XN2), SS0, (ap->in[7]), MOD + 4 * 1024, (LAS float*)(lds + 139264)};
                    pg8::gemm_phase<pg8::EpiResidN, pg8::OneUnit, PG8_ALIGN, PG8_SP2>(lds, gw_, Sw, Ew);
                }
                pg8::UpOrder S{bx, hasW ? 1 : 0, hasH ? 11 : 12, cntW, cntU};
                pg8::gemm_phase<pg8::EpiSwiGLU, pg8::UpOrder, PG8_ALIGN, PG8_SP2>(lds, g, S, E);
                if (hasH) {
                    pg8::wave_wait_count(cntD, 16u); __syncthreads();
                    const int hidx = x * 6 + idx;
                    pg8::Gemm gh{XN, Hin_t, MALL, 5120, 1024}; pg8::OneUnit Sh{128 + hidx / 12, 8 + hidx % 12, nullptr};
                    pg8::EpiHgrnIn Eh{ws, (ap->in[13]), SS1, SHW1};
                    pg8::gemm_phase<pg8::EpiHgrnIn, pg8::OneUnit, PG8_ALIGN, PG8_SP2>(lds, gh, Sh, Eh);
                }
            } else {
                const int d = bx - 240;
                { pg8::UpOrderD S{d, 0, 3}; pg8::gemm_phase<pg8::EpiSwiGLU, pg8::UpOrderD, PG8_ALIGN, PG8_SP2>(lds, g, S, E); }
                pg8::wave_wait_count(cntU, 88u); __syncthreads();
                {
                    pg8::Gemm g2{(const bf16*)(ws + WS_HID0), F2A_t, MALL, 1024, FFH}; pg8::OneUnit S2{128 + (d >> 2), d & 3, cntD};
                    pg8::EpiResidN E2{(ap->out), HCTX, (ap->out), HCTX, MOD + 5 * 1024, XN, SS1, (ap->in[6]) + 1024, MOD1 + 1 * 1024, (LAS float*)(lds + 139264)};
                    pg8::gemm_phase<pg8::EpiResidN, pg8::OneUnit, PG8_ALIGN, PG8_SP2>(lds, g2, S2, E2);
                }
                { pg8::UpOrderD S{d, 3, 6}; pg8::gemm_phase<pg8::EpiSwiGLU, pg8::UpOrderD, PG8_ALIGN, PG8_SP2>(lds, g, S, E); }
            }
        } else {
            pg8::StaticOrder S; S.init(MALL, 5632, G, bx);
            pg8::gemm_phase<pg8::EpiSwiGLU, pg8::StaticOrder, PG8_ALIGN, PG8_SP2>(lds, g, S, E);
        }
    }
    xcd_barrier(bar);
    {
        PHASE_IDS();
        const int Mrows = (G == 256) ? NLAT : MALL;
        pg8::Gemm g{(const bf16*)(ws + WS_HID0), F2A_t, Mrows, 1024, FFH}; pg8::StaticOrder S; S.init(Mrows, 1024, G, bx);
        pg8::EpiResidN E{(ap->out), HCTX, (ap->out), HCTX, MOD + 5 * 1024, XN, SS1, (ap->in[6]) + 1024, MOD1 + 1 * 1024, (LAS float*)(lds + 139264)};
        pg8::gemm_phase<pg8::EpiResidN, pg8::StaticOrder, PG8_ALIGN, PG8_SP2>(lds, g, S, E);
    }
    xcd_barrier(bar);
    {
        PHASE_IDS();
        const int Mrows = (G == 256) ? NLAT : MALL;
        pg8::Gemm g{XN, Hin_t, Mrows, 5120, 1024}; pg8::StaticOrder S; S.init(Mrows, 5120, G, bx);
        pg8::EpiHgrnIn E{ws, (ap->in[13]), SS1, SHW1};
        pg8::gemm_phase<pg8::EpiHgrnIn, pg8::StaticOrder, PG8_ALIGN, PG8_SP2>(lds, g, S, E);
    }
    xcd_barrier(bar);
    { PHASE_IDS();
    for (int item = bx; item < 256; item += G)
        hgrn_scan_item<0>(lds, item, (const bf16*)(ws + WS_HQ), (const bf16*)(ws + WS_HV), (const bf16*)(ws + WS_LFW), (const bf16*)(ws + WS_LBW), (const bf16*)(ws + WS_HVC), (const bf16*)(ws + WS_LFWC), (const bf16*)(ws + WS_LBWC), (bf16*)(ws + WS_OFW), (bf16*)(ws + WS_OBW), (float*)(ws + WS_U), (float*)(ws + WS_D)); }
    xcd_barrier(bar);
    { PHASE_IDS();
    for (int item = bx; item < 256; item += G)
        hgrn_scan_item<1>(lds, item, (const bf16*)(ws + WS_HQ), (const bf16*)(ws + WS_HV), (const bf16*)(ws + WS_LFW), (const bf16*)(ws + WS_LBW), (const bf16*)(ws + WS_HVC), (const bf16*)(ws + WS_LFWC), (const bf16*)(ws + WS_LBWC), (bf16*)(ws + WS_OFW), (bf16*)(ws + WS_OBW), (float*)(ws + WS_U), (float*)(ws + WS_D)); }
    xcd_barrier(bar);
    { PHASE_IDS(); hgrn_combine(gw, NGW, lane, (const bf16*)(ws + WS_OFW), (const bf16*)(ws + WS_OBW), (const bf16*)(ws + WS_HG), (ap->in[14]), (bf16*)(ws + WS_OG)); }
    xcd_barrier(bar);
    {
        PHASE_IDS();
        pg8::Gemm g{(const bf16*)(ws + WS_OG), Ho_t, NLAT, 1024, 1024}; pg8::StaticOrder S; S.init(NLAT, 1024, G, bx);
        pg8::EpiResidN E{(ap->out), HCTX, (ap->out), HCTX, MOD1 + 2 * 1024, XN, SS2, (ap->in[7]) + 1024, MOD1 + 4 * 1024, (LAS float*)(lds + 139264)};
        pg8::gemm_phase<pg8::EpiResidN, pg8::StaticOrder, PG8_ALIGN, PG8_SP2>(lds, g, S, E);
    }
    xcd_barrier(bar);
    {
        PHASE_IDS();
        pg8::Gemm g{XN, F1B_t, NLAT, 5632, 1024}; pg8::StaticOrder S; S.init(NLAT, 5632, G, bx);
        pg8::EpiSwiGLU E{(bf16*)(ws + WS_HID1), SS2, SHW2};
        pg8::gemm_phase<pg8::EpiSwiGLU, pg8::StaticOrder, PG8_ALIGN, PG8_SP2>(lds, g, S, E);
    }
    xcd_barrier(bar);
    {
        PHASE_IDS();
        pg8::Gemm g{(const bf16*)(ws + WS_HID1), F2B_t, NLAT, 1024, FFH}; pg8::StaticOrder S; S.init(NLAT, 1024, G, bx);
        if (G == 256) {
            pg8::EpiResidFinal E{(ap->out), (ap->out), MOD1 + 5 * 1024, SS3, (unsigned*)(ws + WS_BAR) + XCD_BAR_WORDS + 256, (ap->in[18]), (LAS float*)(lds + 139264)};
            pg8::gemm_phase<pg8::EpiResidFinal, pg8::StaticOrder, PG8_ALIGN, PG8_SP2>(lds, g, S, E);
        } else {
            pg8::EpiResid E{(ap->out), HCTX, (ap->out), HCTX, MOD1 + 5 * 1024};
            pg8::gemm_phase<pg8::EpiResid, pg8::StaticOrder, PG8_ALIGN, PG8_SP2>(lds, g, S, E);
        }
    }
    if (gridDim.x != 256) {
        xcd_barrier(bar);
        { PHASE_IDS(); final_norm_rows(gw, NGW, lane, (ap->out), (ap->in[18])); }
    }
}


extern "C" void kernel_launch(void* const* d_in, const int* in_sizes, int n_in, void* d_out, int out_size, void* d_ws, size_t ws_size, hipStream_t stream) {
    static int grid = 0;
    if (grid == 0) {
        if (n_in != 19 || out_size != NLAT * DM || ws_size < WS_END) { fprintf(stderr, "kernel_launch: unexpected shapes: n_in %d out %d ws %zu\n", n_in, out_size, ws_size); grid = -1; return; }
        int dev = 0, cus = 0, per_cu = 0;
        if (hipGetDevice(&dev) != hipSuccess || hipDeviceGetAttribute(&cus, hipDeviceAttributeMultiprocessorCount, dev) != hipSuccess) { grid = -1; return; }
        if (hipFuncSetAttribute((const void*)mk_fwd, hipFuncAttributeMaxDynamicSharedMemorySize, LDS_BYTES) != hipSuccess) { fprintf(stderr, "kernel_launch: hipFuncSetAttribute failed\n"); grid = -1; return; }
        if (hipOccupancyMaxActiveBlocksPerMultiprocessor(&per_cu, (const void*)mk_fwd, NWAVES * 64, LDS_BYTES) != hipSuccess || per_cu < 1) { fprintf(stderr, "kernel_launch: occupancy query says %d\n", per_cu); per_cu = 1; }
        (void)hipGetLastError();
        grid = cus;
    }
    if (grid < 0) return;
    if (hipMemsetAsync((char*)d_ws + WS_BAR, 0, (XCD_BAR_WORDS + 512) * 4, stream) != hipSuccess) { fprintf(stderr, "kernel_launch: memset of the barrier words failed\n"); return; }
    Args a{};
    for (int i = 0; i < 19; ++i) a.in[i] = (const float*)d_in[i];
    a.out = (float*)d_out; a.ws = (unsigned char*)d_ws;
    void* kargs[] = {&a};
    hipError_t e = hipLaunchCooperativeKernel((const void*)mk_fwd, dim3(grid), dim3(NWAVES * 64), kargs, LDS_BYTES, stream);
    if (e != hipSuccess) fprintf(stderr, "kernel_launch: cooperative launch failed: %s (grid %d)\n", hipGetErrorString(e), grid);
}
```

```cpp
#include <hip/hip_cooperative_groups.h>
namespace cg = cooperative_groups;
#include <hip/hip_runtime.h>
#include <cstdio>
#include <cstdint>
namespace pg8 {
#define PG8_LAS __attribute__((address_space(3)))
typedef unsigned short bf16_t;
typedef short bf16x8 __attribute__((ext_vector_type(8)));
typedef float f32x4 __attribute__((ext_vector_type(4)));
typedef unsigned u32x4 __attribute__((ext_vector_type(4)));
constexpr int BM = 256, BK = 64, HALF = 128, HTB = HALF * BK * 2  , STAGE_BYTES = 8 * HTB, NXCD = 8, WGM = 8;

__host__ __device__ __forceinline__ int lds_byte(int r, int c) { const int st = (r >> 4) * 2 + (c >> 5), rr = r & 15, cc = c & 31, ob = rr * 64 + cc * 2; return st * 1024 + (ob ^ (((ob >> 9) & 1) << 5)); }
__host__ __device__ __forceinline__ void stage_rc(int b, int& R, int& C) { const int st = b / 1024, sb = b % 1024, swz = sb ^ (((sb >> 9) & 1) << 5); R = (st >> 1) * 16 + swz / 64; C = (st & 1) * 32 + (swz % 64) / 2; }
__host__ __device__ __forceinline__ int perm32(int rho) { const int n = rho >> 4, i = rho & 15; return 8 * (i >> 2) + 4 * n + (i & 3); }

struct Unit { int pm, pn; };
struct Gemm { const bf16_t* A; const bf16_t* Bt; int M, N, K; };

struct StaticOrder {
    int nM, nN, nwg, G, c;
    __host__ __device__ void init(int M, int N, int G_, int c_) { nM = M / BM; nN = N / BM; nwg = nM * nN; G = G_; c = c_; }
    __host__ __device__ bool next(int i, Unit& u) const {
        const long L = (long)i * G + c; if (L >= nwg) return false;
        int wgid = (int)L; { const int q = nwg / NXCD, r = nwg % NXCD, xcd = wgid % NXCD, off = wgid / NXCD; wgid = (xcd < r ? xcd * (q + 1) : r * (q + 1) + (xcd - r) * q) + off; }
        const int nig = WGM * nN, gid = wgid / nig, fm = gid * WGM, gsz = (nM - fm) < WGM ? (nM - fm) : WGM;
        u.pm = fm + ((wgid % nig) % gsz); u.pn = (wgid % nig) / gsz; return true;
    }
    __device__ __forceinline__ void a_ready(const Unit&) const {}
    __device__ __forceinline__ void done(const Unit&) const {}
};

__device__ __forceinline__ unsigned cvt_pk_bf16(float lo, float hi) { unsigned r; asm volatile("v_cvt_pk_bf16_f32 %0, %1, %2" : "=v"(r) : "v"(lo), "v"(hi)); return r; }
typedef unsigned u32x2 __attribute__((ext_vector_type(2)));
constexpr int NLAT = 32768, KVROWS = 8448;

struct EpiQKV {
    static constexpr bool PERM = false, AFTER_DRAIN = false;
    bf16_t* Q; bf16_t* Kall; bf16_t* Vall; const float* qn; const float* kn; const float* ropec; const float* ropes; float qscale;
    __device__ __forceinline__ void operator()(const f32x4 (&acc)[2][2][4][2], const Unit& u, int wr, int wc, int fr, int fq) const {
        const int pn = u.pn; const bool isv = (pn == 5), isk = (pn == 4);
        const float* nw = isk ? kn : qn;
        f32x4 w[2][2];
#pragma unroll
        for (int bj = 0; bj < 2; ++bj)
#pragma unroll
            for (int n = 0; n < 2; ++n) w[bj][n] = *(const f32x4*)(nw + 32 * bj + 16 * n + 4 * fq);
        const float osc = (pn < 4) ? qscale : 1.f;
#pragma unroll
        for (int ai = 0; ai < 2; ++ai)
#pragma unroll
            for (int m = 0; m < 4; ++m) {
                const int r = u.pm * BM + ai * HALF + wr * 64 + m * 16 + fr;
                const bool lat = r < NLAT; int b, t;
                if (lat) { b = r >> 13; t = r & 8191; } else { const int rc = r - NLAT; b = rc >> 8; t = rc & 255; }
                f32x4 x[2][2];
#pragma unroll
                for (int bj = 0; bj < 2; ++bj)
#pragma unroll
                    for (int n = 0; n < 2; ++n) x[bj][n] = acc[ai][bj][m][n];
                if (!isv) {
                    float ss = 0.f;
#pragma unroll
                    for (int bj = 0; bj < 2; ++bj)
#pragma unroll
                        for (int n = 0; n < 2; ++n) { const f32x4 v = x[bj][n]; ss += (v[0] * v[0] + v[1] * v[1]) + (v[2] * v[2] + v[3] * v[3]); }
                    ss += __shfl_xor(ss, 16); ss += __shfl_xor(ss, 32);
                    const float rs = rsqrtf(ss * (1.0f / 64.0f) + 1e-6f);
#pragma unroll
                    for (int bj = 0; bj < 2; ++bj)
#pragma unroll
                        for (int n = 0; n < 2; ++n) x[bj][n] = x[bj][n] * rs * w[bj][n];
                    if (lat) {
#pragma unroll
                        for (int bj = 0; bj < 2; ++bj) {
                            const int pos = bj == 0 ? (t >> 6) : (t & 63);
                            const f32x4 c = *(const f32x4*)(ropec + pos * 16 + 4 * fq), s = *(const f32x4*)(ropes + pos * 16 + 4 * fq);
                            const f32x4 x1 = x[bj][0], x2 = x[bj][1];
                            x[bj][0] = x1 * c - x2 * s; x[bj][1] = x2 * c + x1 * s;
                        }
                    }
#pragma unroll
                    for (int bj = 0; bj < 2; ++bj)
#pragma unroll
                        for (int n = 0; n < 2; ++n) x[bj][n] = x[bj][n] * osc;
                }
                bf16_t* dst;
                if (pn < 4) dst = Q + (size_t)r * 1024 + pn * 256 + 64 * wc;
                else { const size_t kr = (size_t)b * KVROWS + (lat ? 256 + t : t); dst = (isk ? Kall : Vall) + kr * 256 + 64 * wc; }
#pragma unroll
                for (int bj = 0; bj < 2; ++bj)
#pragma unroll
                    for (int n = 0; n < 2; ++n) { u32x2 p; p.x = cvt_pk_bf16(x[bj][n][0], x[bj][n][1]); p.y = cvt_pk_bf16(x[bj][n][2], x[bj][n][3]); *(u32x2*)(dst + 32 * bj + 16 * n + 4 * fq) = p; }
            }
    }
};

struct EpiResid {
    static constexpr bool PERM = true, AFTER_DRAIN = false;
    const float* base_lat; const float* base_ctx; float* out_lat; float* out_ctx; const float* gate;
    __device__ __forceinline__ void operator()(const f32x4 (&acc)[2][2][4][2], const Unit& u, int wr, int wc, int fr, int fq) const {
        const int rowt = u.pm * BM; const bool lat = rowt < NLAT; const int vec = lat ? (rowt >> 13) : 4;
        const float* bp = lat ? base_lat + (size_t)rowt * 1024 : base_ctx + (size_t)(rowt - NLAT) * 1024;
        float* op = lat ? out_lat + (size_t)rowt * 1024 : out_ctx + (size_t)(rowt - NLAT) * 1024;
        const int col0 = u.pn * BM + wc * 32 + 8 * fq;
#pragma unroll
        for (int bj = 0; bj < 2; ++bj) {
            const int cc = col0 + bj * HALF;
            const f32x4 g0 = *(const f32x4*)(gate + vec * 6144 + cc), g1 = *(const f32x4*)(gate + vec * 6144 + cc + 4);
#pragma unroll
            for (int ai = 0; ai < 2; ++ai)
#pragma unroll
                for (int m = 0; m < 4; ++m) { const size_t off = (size_t)(ai * HALF + wr * 64 + m * 16 + fr) * 1024 + cc;
                    const f32x4 hn0 = *(const f32x4*)(bp + off) + g0 * acc[ai][bj][m][0], hn1 = *(const f32x4*)(bp + off + 4) + g1 * acc[ai][bj][m][1];
                    *(f32x4*)(op + off) = hn0; *(f32x4*)(op + off + 4) = hn1; }
            asm volatile("" ::: "memory");
        }
    }
};

struct EpiResidFinal {
    static constexpr bool PERM = true, AFTER_DRAIN = false;
    const float* base; float* out; const float* gate; float* SS; unsigned* cnt; const float* fw; PG8_LAS float* red;
    __device__ __forceinline__ void operator()(const f32x4 (&acc)[2][2][4][2], const Unit& u, int wr, int wc, int fr, int fq) const {
        const int rowt = u.pm * BM, vec = rowt >> 13;
        const float* bp = base + (size_t)rowt * 1024; float* op = out + (size_t)rowt * 1024;
        const int col0 = u.pn * BM + wc * 32 + 8 * fq;
        float ss[8];
#pragma unroll
        for (int q = 0; q < 8; ++q) ss[q] = 0.f;
#pragma unroll
        for (int bj = 0; bj < 2; ++bj) {
            const int cc = col0 + bj * HALF;
            const f32x4 g0 = *(const f32x4*)(gate + vec * 6144 + cc), g1 = *(const f32x4*)(gate + vec * 6144 + cc + 4);
#pragma unroll
            for (int ai = 0; ai < 2; ++ai)
#pragma unroll
                for (int m = 0; m < 4; ++m) { const size_t off = (size_t)(ai * HALF + wr * 64 + m * 16 + fr) * 1024 + cc;
                    const f32x4 hn0 = *(const f32x4*)(bp + off) + g0 * acc[ai][bj][m][0], hn1 = *(const f32x4*)(bp + off + 4) + g1 * acc[ai][bj][m][1];
                    *(f32x4*)(op + off) = hn0; *(f32x4*)(op + off + 4) = hn1;
                    ss[ai * 4 + m] += ((hn0[0] * hn0[0] + hn0[1] * hn0[1]) + (hn0[2] * hn0[2] + hn0[3] * hn0[3])) + ((hn1[0] * hn1[0] + hn1[1] * hn1[1]) + (hn1[2] * hn1[2] + hn1[3] * hn1[3])); }
            asm volatile("" ::: "memory");
        }
#pragma unroll
        for (int q = 0; q < 8; ++q) { float s = ss[q]; s += __shfl_xor(s, 16); s += __shfl_xor(s, 32);
            if (fq == 0) red[((q >> 2) * HALF + wr * 64 + (q & 3) * 16 + fr) * 4 + wc] = s; }
        asm volatile("s_waitcnt lgkmcnt(0)" ::: "memory"); __builtin_amdgcn_s_barrier(); asm volatile("" ::: "memory");
        const int lane = fq * 16 + fr;
        if (lane < 32) { const int row = (wr * 4 + wc) * 32 + lane; const f32x4 p = *(const PG8_LAS f32x4*)(red + row * 4); atomicAdd(SS + rowt + row, (p[0] + p[1]) + (p[2] + p[3])); }
        asm volatile("s_waitcnt vmcnt(0)" ::: "memory"); __builtin_amdgcn_s_barrier(); asm volatile("" ::: "memory");
        if (threadIdx.x == 0) __hip_atomic_fetch_add(cnt + u.pm, 1u, __ATOMIC_RELAXED, __HIP_MEMORY_SCOPE_AGENT);
        { unsigned sp = 0; while ((unsigned)__builtin_amdgcn_readfirstlane(__hip_atomic_load(cnt + u.pm, __ATOMIC_RELAXED, __HIP_MEMORY_SCOPE_AGENT)) < 4u) { __builtin_amdgcn_s_sleep(2); if (++sp > (1u << 22)) break; } }
        asm volatile("" ::: "memory");
#pragma unroll
        for (int q = 0; q < 8; ++q) { const unsigned b = __hip_atomic_load((const unsigned*)SS + rowt + (q >> 2) * HALF + wr * 64 + (q & 3) * 16 + fr, __ATOMIC_RELAXED, __HIP_MEMORY_SCOPE_AGENT);
            ss[q] = rsqrtf(__builtin_bit_cast(float, b) * (1.0f / 1024.0f) + 1e-6f); }
#pragma unroll
        for (int bj = 0; bj < 2; ++bj) {
            const int cc = col0 + bj * HALF;
            const f32x4 w0 = *(const f32x4*)(fw + cc), w1 = *(const f32x4*)(fw + cc + 4);
#pragma unroll
            for (int ai = 0; ai < 2; ++ai)
#pragma unroll
                for (int m = 0; m < 4; ++m) { const size_t off = (size_t)(ai * HALF + wr * 64 + m * 16 + fr) * 1024 + cc;
                    const f32x4 hn0 = *(const f32x4*)(op + off), hn1 = *(const f32x4*)(op + off + 4);
                    *(f32x4*)(op + off) = hn0 * ss[ai * 4 + m] * w0; *(f32x4*)(op + off + 4) = hn1 * ss[ai * 4 + m] * w1; }
            asm volatile("" ::: "memory");
        }
    }
};

struct EpiResidN {
    static constexpr bool PERM = true, AFTER_DRAIN = false;
    const float* base_lat; const float* base_ctx; float* out_lat; float* out_ctx; const float* gate;
    bf16_t* XNr; float* SS; const float* nw; const float* sc;
    PG8_LAS float* red;
    __device__ __forceinline__ void operator()(const f32x4 (&acc)[2][2][4][2], const Unit& u, int wr, int wc, int fr, int fq) const {
        const int rowt = u.pm * BM; const bool lat = rowt < NLAT; const int vec = lat ? (rowt >> 13) : 4;
        const float* bp = lat ? base_lat + (size_t)rowt * 1024 : base_ctx + (size_t)(rowt - NLAT) * 1024;
        float* op = lat ? out_lat + (size_t)rowt * 1024 : out_ctx + (size_t)(rowt - NLAT) * 1024;
        const int col0 = u.pn * BM + wc * 32 + 8 * fq;
        float ss[8];
#pragma unroll
        for (int q = 0; q < 8; ++q) ss[q] = 0.f;
#pragma unroll
        for (int bj = 0; bj < 2; ++bj) {
            const int cc = col0 + bj * HALF;
            const f32x4 g0 = *(const f32x4*)(gate + vec * 6144 + cc), g1 = *(const f32x4*)(gate + vec * 6144 + cc + 4);
            const f32x4 gm0 = *(const f32x4*)(nw + cc) * (*(const f32x4*)(sc + vec * 6144 + cc) + 1.0f), gm1 = *(const f32x4*)(nw + cc + 4) * (*(const f32x4*)(sc + vec * 6144 + cc + 4) + 1.0f);
#pragma unroll
            for (int ai = 0; ai < 2; ++ai)
#pragma unroll
                for (int m = 0; m < 4; ++m) { const int rl = ai * HALF + wr * 64 + m * 16 + fr; const size_t off = (size_t)rl * 1024 + cc;
                    const f32x4 hn0 = *(const f32x4*)(bp + off) + g0 * acc[ai][bj][m][0], hn1 = *(const f32x4*)(bp + off + 4) + g1 * acc[ai][bj][m][1];
                    *(f32x4*)(op + off) = hn0; *(f32x4*)(op + off + 4) = hn1;
                    ss[ai * 4 + m] += ((hn0[0] * hn0[0] + hn0[1] * hn0[1]) + (hn0[2] * hn0[2] + hn0[3] * hn0[3])) + ((hn1[0] * hn1[0] + hn1[1] * hn1[1]) + (hn1[2] * hn1[2] + hn1[3] * hn1[3]));
                    const f32x4 y0 = hn0 * gm0, y1 = hn1 * gm1; u32x4 p; p.x = cvt_pk_bf16(y0[0], y0[1]); p.y = cvt_pk_bf16(y0[2], y0[3]); p.z = cvt_pk_bf16(y1[0], y1[1]); p.w = cvt_pk_bf16(y1[2], y1[3]);
                    *(u32x4*)(XNr + (size_t)rowt * 1024 + off) = p; }
            asm volatile("" ::: "memory");
        }
#pragma unroll
        for (int q = 0; q < 8; ++q) { float s = ss[q]; s += __shfl_xor(s, 16); s += __shfl_xor(s, 32);
            if (fq == 0) red[((q >> 2) * HALF + wr * 64 + (q & 3) * 16 + fr) * 4 + wc] = s; }
        asm volatile("s_waitcnt lgkmcnt(0)" ::: "memory"); __builtin_amdgcn_s_barrier(); asm volatile("" ::: "memory");
        const int lane = fq * 16 + fr;
        if (lane < 32) { const int row = (wr * 4 + wc) * 32 + lane; const f32x4 p = *(const PG8_LAS f32x4*)(red + row * 4); atomicAdd(SS + rowt + row, (p[0] + p[1]) + (p[2] + p[3])); }
    }
};

__device__ __forceinline__ float silu_f(float a) { return a * __builtin_amdgcn_rcpf(1.0f + __expf(-a)); }
struct EpiSwiGLU {
    static constexpr bool PERM = true, AFTER_DRAIN = false;
    bf16_t* O; const float* SS; const float* shw;
    __device__ __forceinline__ void operator()(const f32x4 (&acc)[2][2][4][2], const Unit& u, int wr, int wc, int fr, int fq) const {
        const int row0 = u.pm * BM + wr * 64 + fr, hc0 = u.pn * HALF + wc * 32 + 8 * fq;
        const int vec = (u.pm * BM < NLAT) ? ((u.pm * BM) >> 13) : 4;
        f32x4 sa0 = {0.f, 0.f, 0.f, 0.f}, sa1 = sa0, su0 = sa0, su1 = sa0;
        if (SS) { const float* sp = shw + vec * 5632 + u.pn * BM + wc * 32 + 8 * fq; sa0 = *(const f32x4*)sp; sa1 = *(const f32x4*)(sp + 4); su0 = *(const f32x4*)(sp + HALF); su1 = *(const f32x4*)(sp + HALF + 4); }
#pragma unroll
        for (int ai = 0; ai < 2; ++ai)
#pragma unroll
            for (int m = 0; m < 4; ++m) { const int r = row0 + ai * HALF + m * 16; bf16_t* rowp = O + (size_t)r * 2816 + hc0;
                const float rs = SS ? rsqrtf(SS[r] * (1.0f / 1024.0f) + 1e-6f) : 1.0f;
                const f32x4 a0 = acc[ai][0][m][0] * rs + sa0, a1 = acc[ai][0][m][1] * rs + sa1, u0 = acc[ai][1][m][0] * rs + su0, u1 = acc[ai][1][m][1] * rs + su1;
                u32x4 wv; wv.x = cvt_pk_bf16(silu_f(a0[0]) * u0[0], silu_f(a0[1]) * u0[1]); wv.y = cvt_pk_bf16(silu_f(a0[2]) * u0[2], silu_f(a0[3]) * u0[3]);
                wv.z = cvt_pk_bf16(silu_f(a1[0]) * u1[0], silu_f(a1[1]) * u1[1]); wv.w = cvt_pk_bf16(silu_f(a1[2]) * u1[2], silu_f(a1[3]) * u1[3]);
                *(u32x4*)rowp = wv; }
    }
};

__device__ __forceinline__ unsigned pk_f16(float lo, float hi) { const _Float16 a = (_Float16)lo, b = (_Float16)hi; return (unsigned)__builtin_bit_cast(unsigned short, a) | ((unsigned)__builtin_bit_cast(unsigned short, b) << 16); }
constexpr size_t OFF_MiB = 1u << 20, OFF_HQ = 122 * OFF_MiB, OFF_HG = 186 * OFF_MiB, OFF_HV = 250 * OFF_MiB, OFF_LFW = 314 * OFF_MiB, OFF_LBW = 378 * OFF_MiB, OFF_HVC = 506 * OFF_MiB, OFF_LFWC = 508 * OFF_MiB, OFF_LBWC = 510 * OFF_MiB;
struct EpiHgrnIn {
    static constexpr bool PERM = true, AFTER_DRAIN = false;
    unsigned char* ws; const float* lbl; const float* SS; const float* shw;
    __device__ __forceinline__ void operator()(const f32x4 (&acc)[2][2][4][2], const Unit& u, int wr, int wc, int fr, int fq) const {
        const int type = u.pn >> 2; const bool lat = u.pm < (NLAT / BM);
        if (type < 2 && !lat) return;
        const size_t doff = lat ? (type == 0 ? OFF_HQ : type == 1 ? OFF_HG : type == 2 ? OFF_LFW : type == 3 ? OFF_LBW : OFF_HV)
                                : (type == 2 ? OFF_LFWC : type == 3 ? OFF_LBWC : OFF_HVC) - (size_t)NLAT * 2048;
        bf16_t* dstb = (bf16_t*)(ws + doff);
        const int row0 = u.pm * BM + wr * 64 + fr; const int vec = lat ? ((u.pm * BM) >> 13) : 4;
#pragma unroll
        for (int bj = 0; bj < 2; ++bj) {
            const int ch = (u.pn & 3) * 256 + bj * HALF + wc * 32 + 8 * fq;
            const float* sp = shw + vec * 5120 + u.pn * BM + bj * HALF + wc * 32 + 8 * fq; const f32x4 sw0 = *(const f32x4*)sp, sw1 = *(const f32x4*)(sp + 4);
            float lb[8];
            if (type == 2 || type == 3) {
#pragma unroll
                for (int e = 0; e < 8; ++e) { const float l0 = lbl[ch + e], l1 = lbl[1024 + ch + e]; lb[e] = 1.0f / (1.0f + __expf(l0 - l1)); }
            } else {
#pragma unroll
                for (int e = 0; e < 8; ++e) lb[e] = 0.f;
            }
#pragma unroll
            for (int ai = 0; ai < 2; ++ai)
#pragma unroll
                for (int m = 0; m < 4; ++m) { const int r = row0 + ai * HALF + m * 16; bf16_t* p = dstb + (size_t)r * 1024 + ch;
                    const float rs = rsqrtf(SS[r] * (1.0f / 1024.0f) + 1e-6f);
                    float v[8];
#pragma unroll
                    for (int e = 0; e < 8; ++e) v[e] = acc[ai][bj][m][e >> 2][e & 3] * rs + (e < 4 ? sw0[e & 3] : sw1[e & 3]);
                    u32x4 wv;
                    if (type == 2 || type == 3) {
#pragma unroll
                        for (int e = 0; e < 8; ++e) { const float sg = __builtin_amdgcn_rcpf(1.0f + __expf(-v[e])); v[e] = __logf(lb[e] + (1.0f - lb[e]) * sg); }
                        wv.x = pk_f16(v[0], v[1]); wv.y = pk_f16(v[2], v[3]); wv.z = pk_f16(v[4], v[5]); wv.w = pk_f16(v[6], v[7]);
                    } else { wv.x = cvt_pk_bf16(v[0], v[1]); wv.y = cvt_pk_bf16(v[2], v[3]); wv.z = cvt_pk_bf16(v[4], v[5]); wv.w = cvt_pk_bf16(v[6], v[7]); }
                    *(u32x4*)p = wv; if (m & 1) asm volatile("" ::: "memory"); }
        }
    }
};

__device__ __forceinline__ void publish_unit(unsigned* cnt) {
    asm volatile("s_waitcnt vmcnt(0)" ::: "memory"); __builtin_amdgcn_s_barrier(); asm volatile("" ::: "memory");
    if (threadIdx.x == 0) { __builtin_amdgcn_fence(__ATOMIC_RELEASE, "agent"); asm volatile("s_waitcnt vmcnt(0)" ::: "memory"); __hip_atomic_fetch_add(cnt, 1u, __ATOMIC_RELAXED, __HIP_MEMORY_SCOPE_AGENT); }
}
__device__ __forceinline__ void wave_wait_count(unsigned* cnt, unsigned want) {
    unsigned sp = 0;
    while ((unsigned)__builtin_amdgcn_readfirstlane(__hip_atomic_load(cnt, __ATOMIC_RELAXED, __HIP_MEMORY_SCOPE_AGENT)) < want) { __builtin_amdgcn_s_sleep(4); if (++sp > (1u << 22)) break; }
    __builtin_amdgcn_fence(__ATOMIC_ACQUIRE, "agent"); asm volatile("s_waitcnt vmcnt(0)" ::: "memory");
}
__device__ __forceinline__ void latent_up_unit(int q, Unit& u) { const int nN = 22, nM = 128, nig = WGM * nN, gid = q / nig, fm = gid * WGM, gsz = (nM - fm) < WGM ? (nM - fm) : WGM; u.pm = fm + ((q % nig) % gsz); u.pn = (q % nig) / gsz; }
__device__ __forceinline__ int up_pos_type(int x, int j, int& idx) {
    if (x == 0 && j < 16) { idx = j; return 1; }
    if (j >= 30 && j < 60 && x < 3) { const int uu = x * 30 + (j - 30); if (uu < 88) { idx = uu; return 2; } }
    if (j >= 330 && j < 336) { idx = x * 6 + (j - 330); return 3; }
    int sp = 0;
    if (x == 0) sp += 16;
    if (x < 3) { const int lim = x < 2 ? 30 : 28; int t = j - 30; t = t < 0 ? 0 : (t > lim ? lim : t); sp += t; }
    { int t = j - 330; t = t < 0 ? 0 : (t > 6 ? 6 : t); sp += t; }
    const int prev = x == 0 ? 0 : x == 1 ? 52 : x == 2 ? 88 : 122 + (x - 3) * 6;
    idx = x * 360 + j - sp - prev; return 0;
}
struct UpOrder {
    int c, i0, i1; unsigned* cntW; unsigned* cntU;
    __device__ __forceinline__ bool next(int k, Unit& u) const {
        const int i = i0 + k; if (i >= i1) return false;
        int idx; const int t = up_pos_type(c & 7, i * 30 + (c >> 3), idx);
        if (t == 2) { u.pm = 128 + idx / 22; u.pn = idx % 22; } else latent_up_unit(idx, u);
        return true;
    }
    __device__ __forceinline__ void a_ready(const Unit& u) const { if (u.pm >= 128) wave_wait_count(cntW, 16u); }
    __device__ __forceinline__ void done(const Unit& u) const { if (u.pm >= 128) publish_unit(cntU); }
};
struct UpOrderD {
    int d, i0, i1;
    __device__ __forceinline__ bool next(int k, Unit& u) const { const int i = i0 + k; if (i >= i1) return false; const int q = 2728 + i * 16 + d; if (q >= 2816) return false; latent_up_unit(q, u); return true; }
    __device__ __forceinline__ void a_ready(const Unit&) const {}
    __device__ __forceinline__ void done(const Unit&) const {}
};
struct OneUnit {
    int pm, pn; unsigned* cnt;
    __device__ __forceinline__ bool next(int i, Unit& u) const { if (i > 0) return false; u.pm = pm; u.pn = pn; return true; }
    __device__ __forceinline__ void a_ready(const Unit&) const {}
    __device__ __forceinline__ void done(const Unit&) const { if (cnt) publish_unit(cnt); }
};
template <class Epi, class Sched, bool ALIGN_EPI = false, bool SP2 = false>
__device__ __forceinline__ void gemm_phase(PG8_LAS unsigned char* lds, const Gemm g, const Sched& S, const Epi& E) {
    int tid_ = threadIdx.x; asm volatile("" : "+v"(tid_));
    const int tid = tid_, wid = __builtin_amdgcn_readfirstlane(tid >> 6), lane = tid & 63, wr = wid >> 2, wc = wid & 3, fr = lane & 15, fq = lane >> 4;
    const int K = g.K, nt = K / BK;
    unsigned voffA[2], voffB[2];
#pragma unroll
    for (int i = 0; i < 2; ++i) { int R, C; stage_rc(tid * 16 + i * 8192, R, C); const int Rb = Epi::PERM ? ((R & ~31) + perm32(R & 31)) : R;
        voffA[i] = (unsigned)(R * K + C) * 2u; voffB[i] = (unsigned)(Rb * K + C) * 2u; }
    const size_t kstep = (size_t)(BK * 2);
    const size_t hstep = (size_t)HALF * K * 2;
    const size_t tstep = 2 * hstep;
    const unsigned ldsw = (unsigned)wid * 1024u;
    const int aoff = lds_byte(wr * 64 + fr, fq * 8), boff = lds_byte(wc * 32 + fr, fq * 8);
#define PG8_SA(b, h) (((b) * 2 + (h)) * HTB)
#define PG8_SB(b, h) ((4 + (b) * 2 + (h)) * HTB)
#define PG8_STAGE(bufoff, gbase, voff) do { _Pragma("unroll") for (int _i = 0; _i < 2; ++_i) \
        __builtin_amdgcn_global_load_lds((const unsigned*)((const char*)(gbase) + (voff)[_i]), (PG8_LAS unsigned*)(lds + (bufoff) + ldsw + _i * 8192), 16, 0, 0); } while (0)
#define PG8_LDA(dst, b, h) do { _Pragma("unroll") for (int m = 0; m < 4; ++m) _Pragma("unroll") for (int k = 0; k < 2; ++k) dst[m][k] = *(const PG8_LAS bf16x8*)(lds + PG8_SA(b, h) + aoff + m * 2048 + k * 1024); } while (0)
#define PG8_LDB(dst, b, h) do { _Pragma("unroll") for (int n = 0; n < 2; ++n) _Pragma("unroll") for (int k = 0; k < 2; ++k) dst[n][k] = *(const PG8_LAS bf16x8*)(lds + PG8_SB(b, h) + boff + n * 2048 + k * 1024); } while (0)
#define PG8_MMA(ai, bj, At, Bt) do { __builtin_amdgcn_s_setprio(1); _Pragma("unroll") for (int m = 0; m < 4; ++m) _Pragma("unroll") for (int n = 0; n < 2; ++n) _Pragma("unroll") for (int k = 0; k < 2; ++k) \
        acc[ai][bj][m][n] = __builtin_amdgcn_mfma_f32_16x16x32_bf16(Bt[n][k], At[m][k], acc[ai][bj][m][n], 0, 0, 0); __builtin_amdgcn_s_setprio(0); } while (0)
#define PG8_WAIT_V(n) asm volatile("s_waitcnt vmcnt(" #n ")" ::: "memory")
#define PG8_WAIT_L(n) asm volatile("s_waitcnt lgkmcnt(" #n ")" ::: "memory")
#define PG8_BAR __builtin_amdgcn_s_barrier()
#define PG8_SCHED __builtin_amdgcn_sched_barrier(0)
    Unit cur, nxt; int ui = 0;
    if (!S.next(0, cur)) return;
    f32x4 acc[2][2][4][2];
#pragma unroll
    for (int a = 0; a < 2; ++a)
#pragma unroll
        for (int b = 0; b < 2; ++b)
#pragma unroll
            for (int m = 0; m < 4; ++m)
#pragma unroll
                for (int n = 0; n < 2; ++n) acc[a][b][m][n] = (f32x4){0.f, 0.f, 0.f, 0.f};
    bf16x8 At[4][2], B0[2][2], B1[2][2];
    const char* cA = (const char*)g.A + (size_t)cur.pm * tstep; const char* cB = (const char*)g.Bt + (size_t)cur.pn * tstep;
    S.a_ready(cur);
    if constexpr (SP2) {
        PG8_STAGE(PG8_SB(0, 0), cB, voffB); PG8_STAGE(PG8_SB(0, 1), cB + hstep, voffB); PG8_STAGE(PG8_SA(0, 0), cA, voffA); PG8_STAGE(PG8_SA(0, 1), cA + hstep, voffA);
        if (wr == 1) PG8_BAR;
        PG8_WAIT_V(2); PG8_BAR;
        PG8_STAGE(PG8_SB(1, 0), cB + kstep, voffB); PG8_STAGE(PG8_SA(1, 0), cA + kstep, voffA); PG8_STAGE(PG8_SB(1, 1), cB + hstep + kstep, voffB);
        PG8_WAIT_V(6); PG8_BAR;
    } else {
        PG8_STAGE(PG8_SB(0, 0), cB, voffB); PG8_STAGE(PG8_SA(0, 0), cA, voffA); PG8_STAGE(PG8_SB(0, 1), cB + hstep, voffB); PG8_STAGE(PG8_SA(0, 1), cA + hstep, voffA);
        if (wr == 1) PG8_BAR;
        PG8_WAIT_V(4); PG8_BAR;
        PG8_STAGE(PG8_SB(1, 0), cB + kstep, voffB); PG8_STAGE(PG8_SA(1, 0), cA + kstep, voffA); PG8_STAGE(PG8_SB(1, 1), cB + hstep + kstep, voffB);
        PG8_WAIT_V(6); PG8_BAR;
    }
    for (;;) {
        const bool has_next = S.next(ui + 1, nxt);
        const char* nA = has_next ? (const char*)g.A + (size_t)nxt.pm * tstep : cA; const char* nB = has_next ? (const char*)g.Bt + (size_t)nxt.pn * tstep : cB;
        for (int t = 0; t < nt; t += 2) {
            const bool last = (t == nt - 2);
            const char* a1 = cA + (size_t)(t + 1) * kstep;
            const char* a2 = last ? nA : cA + (size_t)(t + 2) * kstep; const char* b2 = last ? nB : cB + (size_t)(t + 2) * kstep;
            const char* a3 = a2 + kstep; const char* b3 = b2 + kstep;
            if (last && has_next) S.a_ready(nxt);
            if constexpr (SP2) {
            PG8_LDB(B0, 0, 0); PG8_LDB(B1, 0, 1); PG8_SCHED; PG8_LDA(At, 0, 0); PG8_STAGE(PG8_SA(1, 1), a1 + hstep, voffA);
            PG8_WAIT_V(8); PG8_WAIT_L(0); PG8_BAR; PG8_MMA(0, 0, At, B0); PG8_MMA(0, 1, At, B1); PG8_BAR; PG8_SCHED;
            PG8_LDA(At, 0, 1); PG8_STAGE(PG8_SB(0, 0), b2, voffB); PG8_STAGE(PG8_SB(0, 1), b2 + hstep, voffB); PG8_STAGE(PG8_SA(0, 0), a2, voffA);
            PG8_WAIT_V(8); PG8_WAIT_L(0); PG8_BAR; PG8_MMA(1, 0, At, B0); PG8_MMA(1, 1, At, B1); PG8_BAR; PG8_SCHED;
            PG8_LDB(B0, 1, 0); PG8_LDB(B1, 1, 1); PG8_SCHED; PG8_LDA(At, 1, 0); PG8_STAGE(PG8_SA(0, 1), a2 + hstep, voffA);
            PG8_WAIT_V(8); PG8_WAIT_L(0); PG8_BAR; PG8_MMA(0, 0, At, B0); PG8_MMA(0, 1, At, B1); PG8_BAR; PG8_SCHED;
            PG8_LDA(At, 1, 1); PG8_STAGE(PG8_SB(1, 0), b3, voffB); PG8_STAGE(PG8_SB(1, 1), b3 + hstep, voffB); PG8_STAGE(PG8_SA(1, 0), a3, voffA);
            PG8_WAIT_V(8); PG8_WAIT_L(0); PG8_BAR; PG8_MMA(1, 0, At, B0); PG8_MMA(1, 1, At, B1); PG8_BAR; PG8_SCHED;
            } else {
            PG8_LDB(B0, 0, 0); PG8_SCHED; PG8_LDA(At, 0, 0); PG8_STAGE(PG8_SA(1, 1), a1 + hstep, voffA);
            PG8_WAIT_L(8); PG8_BAR; PG8_WAIT_L(0); PG8_MMA(0, 0, At, B0); PG8_BAR; PG8_SCHED;
            PG8_LDB(B1, 0, 1); PG8_STAGE(PG8_SB(0, 0), b2, voffB);
            PG8_BAR; PG8_WAIT_L(0); PG8_MMA(0, 1, At, B1); PG8_BAR;
            PG8_LDA(At, 0, 1); PG8_STAGE(PG8_SA(0, 0), a2, voffA);
            PG8_BAR; PG8_WAIT_L(0); PG8_MMA(1, 0, At, B0); PG8_BAR; PG8_SCHED;
            PG8_STAGE(PG8_SB(0, 1), b2 + hstep, voffB);
            PG8_WAIT_V(6); PG8_BAR; PG8_MMA(1, 1, At, B1); PG8_BAR;
            PG8_LDB(B0, 1, 0); PG8_SCHED; PG8_LDA(At, 1, 0); PG8_STAGE(PG8_SA(0, 1), a2 + hstep, voffA);
            PG8_WAIT_L(8); PG8_BAR; PG8_WAIT_L(0); PG8_MMA(0, 0, At, B0); PG8_BAR; PG8_SCHED;
            PG8_LDB(B1, 1, 1); PG8_STAGE(PG8_SB(1, 0), b3, voffB);
            PG8_BAR; PG8_WAIT_L(0); PG8_MMA(0, 1, At, B1); PG8_BAR;
            PG8_LDA(At, 1, 1); PG8_STAGE(PG8_SA(1, 0), a3, voffA);
            PG8_BAR; PG8_WAIT_L(0); PG8_MMA(1, 0, At, B0); PG8_BAR; PG8_SCHED;
            PG8_STAGE(PG8_SB(1, 1), b3 + hstep, voffB);
            PG8_WAIT_V(6); PG8_BAR; PG8_MMA(1, 1, At, B1); PG8_BAR;
            }
        }
        if constexpr (ALIGN_EPI) { if (wr == 0) PG8_BAR; }
        if constexpr (!Epi::AFTER_DRAIN) { E(acc, cur, wr, wc, fr, fq); S.done(cur); }
        if (!has_next) break;
#pragma unroll
        for (int a = 0; a < 2; ++a)
#pragma unroll
            for (int b = 0; b < 2; ++b)
#pragma unroll
                for (int m = 0; m < 4; ++m)
#pragma unroll
                    for (int n = 0; n < 2; ++n) acc[a][b][m][n] = (f32x4){0.f, 0.f, 0.f, 0.f};
        cur = nxt; cA = nA; cB = nB; ++ui;
        if constexpr (ALIGN_EPI) { if (wr == 1) PG8_BAR; }
    }
    PG8_WAIT_V(0);
    if constexpr (!ALIGN_EPI) { if (wr == 0) PG8_BAR; }
    PG8_BAR;
    if constexpr (Epi::AFTER_DRAIN) { E.fused(acc, cur, wr, wc, fr, fq, lds, wid, lane); S.done(cur); }
#undef PG8_SA
#undef PG8_SB
#undef PG8_STAGE
#undef PG8_LDA
#undef PG8_LDB
#undef PG8_MMA
#undef PG8_WAIT_V
#undef PG8_WAIT_L
#undef PG8_BAR
#undef PG8_SCHED
}
}

#ifndef PG8_SP2
#define PG8_SP2 true
#endif
#ifndef PG8_ALIGN
#define PG8_ALIGN true
#endif
#include <hip/hip_bf16.h>
#include <cmath>
namespace attn_body {
using bf16=__hip_bfloat16;
using bf16x8=__attribute__((ext_vector_type(8)))short;
using s16x4=__attribute__((ext_vector_type(4)))short;
using f32x16=__attribute__((ext_vector_type(16)))float;
using u32x4=__attribute__((ext_vector_type(4)))unsigned;
constexpr int D=64,QP=1024,KVP=256;
constexpr int NW=8,QBLK=32,QB=QBLK*NW,KVBLK=64;
__device__ __forceinline__ int crow(int r,int hi){return (r&3)+8*(r>>2)+4*hi;}
#define SBAR() __builtin_amdgcn_sched_barrier(0)
constexpr int NSLOT=3, SLOTB=8192;
constexpr int LDS_K=0, LDS_V=NSLOT*SLOTB, LDS_WS=2*NSLOT*SLOTB, LDS_OST=LDS_WS+NW*64*4, LDS_BYTES=LDS_OST+NW*4096;
constexpr float C2=0.125f*1.4426950408889634f;
__device__ __forceinline__ void glds16(const void*gsrc,unsigned lds_dst){unsigned keep;
  asm volatile("s_mov_b32 %0, m0\n\ts_mov_b32 m0, %2\n\ts_nop 0\n\tglobal_load_lds_dwordx4 %1, off\n\ts_mov_b32 m0, %0":"=&s"(keep):"v"(gsrc),"s"(lds_dst):"memory");}
__device__ __forceinline__ float max3f(float a,float b,float c){float r;asm("v_max3_f32 %0, %1, %2, %3":"=v"(r):"v"(a),"v"(b),"v"(c));return r;}
__device__ __forceinline__ float max2f(float a,float b){float r;asm("v_max_f32_e32 %0, %1, %2":"=v"(r):"v"(a),"v"(b));return r;}
__device__ __forceinline__ float fadd_s(float a,float b){float r;asm("v_add_f32_e32 %0, %1, %2":"=v"(r):"v"(a),"v"(b));return r;}
__device__ __forceinline__ float fsub_s(float a,float b){float r;asm("v_sub_f32_e32 %0, %1, %2":"=v"(r):"v"(a),"v"(b));return r;}
typedef float f32x2_t __attribute__((ext_vector_type(2))); typedef __bf16 bf16x2_t __attribute__((ext_vector_type(2)));
__device__ __forceinline__ unsigned cvtpk_s(float lo,float hi){f32x2_t v={lo,hi};bf16x2_t b=__builtin_convertvector(v,bf16x2_t);return __builtin_bit_cast(unsigned,b);}
#define WAIT_BAR(N) asm volatile("s_waitcnt vmcnt(" #N ") lgkmcnt(0)\n\ts_barrier":::"memory")

__device__ __forceinline__ void qkt(f32x16&p0,f32x16&p1,const char*Kslot,const bf16x8*qr,const f32x16&negm,int r32,int hi){
  const char*kb=Kslot+hi*1024+r32*16;
  #pragma unroll
  for(int d0=0;d0<4;++d0){
    const bf16x8 b0=*reinterpret_cast<const bf16x8*>(kb+d0*2048);
    const bf16x8 b1=*reinterpret_cast<const bf16x8*>(kb+d0*2048+512);
    if(d0==0){p0=__builtin_amdgcn_mfma_f32_32x32x16_bf16(b0,qr[0],negm,0,0,0);p1=__builtin_amdgcn_mfma_f32_32x32x16_bf16(b1,qr[0],negm,0,0,0);}
    else{p0=__builtin_amdgcn_mfma_f32_32x32x16_bf16(b0,qr[d0],p0,0,0,0);p1=__builtin_amdgcn_mfma_f32_32x32x16_bf16(b1,qr[d0],p1,0,0,0);}}
}
typedef __attribute__((address_space(3))) const char* lds_cptr;
typedef short v4i16_t __attribute__((ext_vector_type(4)));
__device__ __forceinline__ void kload8(bf16x8*kf,lds_cptr kp){
  kf[0]=*(const __attribute__((address_space(3))) bf16x8*)(kp);      kf[1]=*(const __attribute__((address_space(3))) bf16x8*)(kp+512);
  kf[2]=*(const __attribute__((address_space(3))) bf16x8*)(kp+2048); kf[3]=*(const __attribute__((address_space(3))) bf16x8*)(kp+2560);
  kf[4]=*(const __attribute__((address_space(3))) bf16x8*)(kp+4096); kf[5]=*(const __attribute__((address_space(3))) bf16x8*)(kp+4608);
  kf[6]=*(const __attribute__((address_space(3))) bf16x8*)(kp+6144); kf[7]=*(const __attribute__((address_space(3))) bf16x8*)(kp+6656);
}
__device__ __forceinline__ void kload2(bf16x8*kf,lds_cptr kp,int j){ kf[2*j]=*(const __attribute__((address_space(3))) bf16x8*)(kp+j*2048); kf[2*j+1]=*(const __attribute__((address_space(3))) bf16x8*)(kp+j*2048+512); }
__device__ __forceinline__ s16x4 vtr(lds_cptr p){ return __builtin_bit_cast(s16x4,__builtin_amdgcn_ds_read_tr16_b64_v4i16((__attribute__((address_space(3))) v4i16_t*)p)); }
__device__ __forceinline__ float rowmax(const f32x16&p0,const f32x16&p1){
  float a=max3f(p0[0],p0[1],p1[0]),b=max3f(p0[2],p0[3],p1[1]);a=max3f(a,p1[2],p1[3]);
  #pragma unroll
  for(int r=4;r<16;r+=4){a=max3f(a,p0[r],p0[r+1]);b=max3f(b,p0[r+2],p0[r+3]);a=max3f(a,p1[r],p1[r+1]);b=max3f(b,p1[r+2],p1[r+3]);}
  const float m=max2f(a,b);
  auto rr=__builtin_amdgcn_permlane32_swap(__float_as_uint(m),__float_as_uint(m),false,false);
  return max2f(__uint_as_float(rr[0]),__uint_as_float(rr[1]));
}
__device__ __forceinline__ void pv(f32x16*o,int vb,bf16x8 pa0,bf16x8 pa1,bf16x8 pa2,bf16x8 pa3){
  #pragma unroll
  for(int d0=0;d0<2;++d0){s16x4 lo[4],hi[4];
    #pragma unroll
    for(int ks=0;ks<4;++ks){
      asm volatile("ds_read_b64_tr_b16 %0,%1 offset:%c2":"=&v"(lo[ks]):"v"(vb),"i"(d0*4096+ks*1024):"memory");
      asm volatile("ds_read_b64_tr_b16 %0,%1 offset:%c2":"=&v"(hi[ks]):"v"(vb),"i"(d0*4096+ks*1024+512):"memory");}
    asm volatile("s_waitcnt lgkmcnt(0)":::"memory");SBAR();
    #define PK(k) (bf16x8){lo[k][0],lo[k][1],lo[k][2],lo[k][3],hi[k][0],hi[k][1],hi[k][2],hi[k][3]}
    o[d0]=__builtin_amdgcn_mfma_f32_32x32x16_bf16(pa0,PK(0),o[d0],0,0,0);
    o[d0]=__builtin_amdgcn_mfma_f32_32x32x16_bf16(pa1,PK(1),o[d0],0,0,0);
    o[d0]=__builtin_amdgcn_mfma_f32_32x32x16_bf16(pa2,PK(2),o[d0],0,0,0);
    o[d0]=__builtin_amdgcn_mfma_f32_32x32x16_bf16(pa3,PK(3),o[d0],0,0,0);
    #undef PK
  }
}

#ifndef ATTN_STORE16
#define ATTN_STORE16(p,v) (*(u32x4*)(p)=(v))
#endif
template<int THRL> __device__ __forceinline__ void attn_unit(const bf16*Qu,const bf16*__restrict__ Kh,const bf16*__restrict__ Vh,bf16*Ou,const int NT,char*shm){
  int tid_=threadIdx.x; asm volatile("":"+v"(tid_)); const int tid=tid_,lane=tid&63,r32=lane&31,hi=lane>>5; const int wid=__builtin_amdgcn_readfirstlane(tid>>6);
  const bf16*Qw=Qu+(long)(wid*QBLK)*QP;
  const unsigned lds0=(unsigned)(uintptr_t)shm;
  float*wsf=(float*)(shm+LDS_WS)+wid*64;
  const bf16*ksrc=Kh+(long)lane*KVP+wid*8;
  const bf16*vsrc=Vh+(long)(16*(wid&3)+(lane>>2))*KVP+(wid>>2)*32+(lane&3)*8;
  const unsigned kdst=lds0+LDS_K+wid*1024, vdst=lds0+LDS_V+wid*1024;
  #define DMA_K(t,slot) glds16(ksrc+(long)(t)*KVBLK*KVP,(unsigned)__builtin_amdgcn_readfirstlane(kdst+(slot)))
  #define DMA_V(t,slot) glds16(vsrc+(long)(t)*KVBLK*KVP,(unsigned)__builtin_amdgcn_readfirstlane(vdst+(slot)))
  const int vb0=(int)(lds0+LDS_V)+((lane>>4)&1)*32+(lane&3)*8+(4*hi+((lane&15)>>2))*64;
  const char*Kbase=shm+LDS_K; bf16x8 kf[8];
  const lds_cptr shm3=(lds_cptr)shm; const lds_cptr kp0=shm3+LDS_K+hi*1024+r32*16; const lds_cptr vp0=shm3+LDS_V+((lane>>4)&1)*32+(lane&3)*8+(4*hi+((lane&15)>>2))*64;
  DMA_K(0,0);DMA_V(0,0);DMA_K(1,SLOTB);
  bf16x8 qr[4];
  #pragma unroll
  for(int d0=0;d0<4;++d0)qr[d0]=*reinterpret_cast<const bf16x8*>(&Qw[(long)r32*QP+d0*16+hi*8]);
  float mhat=0.f,l_reg=0.f;f32x16 o[2];o[0]=f32x16{};o[1]=f32x16{};f32x16 negm=f32x16{};asm volatile("":"+v"(negm));
  #define CMASK(P0,P1,t) do{}while(0)
  bool resc=false;
  #define START(P0,P1) do{ const float rm=rowmax(P0,P1); resc=false; \
    { const float dl=rm; mhat=fadd_s(mhat,dl); \
      _Pragma("unroll") for(int r=0;r<16;++r){P0[r]=fsub_s(P0[r],dl);P1[r]=fsub_s(P1[r],dl);} \
      _Pragma("unroll") for(int r=0;r<16;++r)negm[r]=-mhat; asm volatile("":"+v"(negm)); } \
    _Pragma("unroll") for(int r=0;r<16;++r)P0[r]=__builtin_amdgcn_exp2f(P0[r]); }while(0)
  #define RESC() do{ if(resc){ asm volatile("s_waitcnt lgkmcnt(0)":::"memory"); \
      _Pragma("unroll") for(int d_=0;d_<2;++d_) _Pragma("unroll") for(int r=0;r<16;++r)o[d_][r]*=wsf[crow(r,hi)]; } }while(0)
  f32x16 pA0,pA1,pB0,pB1;
  int sl_prev=0,sl_cur=0,sl_next=SLOTB;
  #define ROT() do{sl_prev=sl_cur;sl_cur=sl_next;sl_next=(sl_next==(NSLOT-1)*SLOTB)?0:sl_next+SLOTB;}while(0)
  DMA_K(2,2*SLOTB);
  WAIT_BAR(3);
  qkt(pA0,pA1,Kbase,qr,negm,r32,hi);asm volatile("s_nop 15\n\ts_nop 7":"+v"(pA0),"+v"(pA1));CMASK(pA0,pA1,0);
  START(pA0,pA1);
  _Pragma("unroll") for(int r=0;r<16;++r)pA1[r]=__builtin_amdgcn_exp2f(pA1[r]);
  WAIT_BAR(0);
  DMA_K(3,0);DMA_V(1,SLOTB);
  ROT();
  kload8(kf,kp0+sl_cur);
  WAIT_BAR(2);
  s16x4 vlo[8],vhi[8]; u32x4 pw0,pw1,pw2,pw3;
  #define PKW(P,B) cvtpk_s(P[B],P[B+1])
  #define PAF(k) __builtin_bit_cast(bf16x8,pw##k)
  #define VFR(i) (bf16x8){vlo[i][0],vlo[i][1],vlo[i][2],vlo[i][3],vhi[i][0],vhi[i][1],vhi[i][2],vhi[i][3]}
  #define PIN(x) asm volatile("":"+v"(x))
  #define MX3(a,b,c) __builtin_fmaxf(__builtin_fmaxf((a),(b)),(c))
  #define GAPA(MF,A0,A1,A2,A3,W0,W1,PW) do{ MF; sacc+=A0; sacc+=A1; sacc+=A2; sacc+=A3; PIN(sacc); W0; W1; PIN(PW); SBAR(); }while(0)
  #define EX(v) __builtin_amdgcn_exp2f(v)
  #define GAPB(MF,X,B) do{ MF; X[B]=EX(X[B]); X[B+1]=EX(X[B+1]); X[B+2]=EX(X[B+2]); X[B+3]=EX(X[B+3]); PIN(X); SBAR(); }while(0)
  #define VRD(i) do{ vlo[i]=vtr(vp_+(((i)>>2)*4096+((i)&3)*1024)); vhi[i]=vtr(vp_+(((i)>>2)*4096+((i)&3)*1024+512)); }while(0)
  #define KRD(G,j) do{ if(G){ kload2(kf,kp0+sl_next,j); SBAR(); } }while(0)
  #define STEP(C0,C1,P0,P1,t,GK,GV,GL) do{ SBAR(); \
    const lds_cptr vp_=vp0+sl_prev; \
    VRD(0); SBAR(); float sacc=(P0[0]+P0[1]); \
    GAPA(C0=__builtin_amdgcn_mfma_f32_32x32x16_bf16(kf[0],qr[0],negm,0,0,0), P0[2],P0[3],P0[4],P0[5],     pw0[0]=PKW(P0,0), pw0[1]=PKW(P0,2), pw0); \
    VRD(4); SBAR(); GAPA(C1=__builtin_amdgcn_mfma_f32_32x32x16_bf16(kf[1],qr[0],negm,0,0,0), P0[6],P0[7],P0[8],P0[9],     pw0[2]=PKW(P0,4), pw0[3]=PKW(P0,6), pw0); \
    VRD(1); SBAR(); GAPA(C0=__builtin_amdgcn_mfma_f32_32x32x16_bf16(kf[2],qr[1],C0,0,0,0),   P0[10],P0[11],P0[12],P0[13], pw1[0]=PKW(P0,8), pw1[1]=PKW(P0,10), pw1); \
    VRD(5); SBAR(); GAPA(C1=__builtin_amdgcn_mfma_f32_32x32x16_bf16(kf[3],qr[1],C1,0,0,0),   P0[14],P0[15],P1[0],P1[1],   pw1[2]=PKW(P0,12),pw1[3]=PKW(P0,14), pw1); \
    VRD(2); SBAR(); GAPA(C0=__builtin_amdgcn_mfma_f32_32x32x16_bf16(kf[4],qr[2],C0,0,0,0),   P1[2],P1[3],P1[4],P1[5],     pw2[0]=PKW(P1,0), pw2[1]=PKW(P1,2), pw2); \
    VRD(6); SBAR(); GAPA(C1=__builtin_amdgcn_mfma_f32_32x32x16_bf16(kf[5],qr[2],C1,0,0,0),   P1[6],P1[7],P1[8],P1[9],     pw2[2]=PKW(P1,4), pw2[3]=PKW(P1,6), pw2); \
    VRD(3); SBAR(); GAPA(C0=__builtin_amdgcn_mfma_f32_32x32x16_bf16(kf[6],qr[3],C0,0,0,0),   P1[10],P1[11],P1[12],P1[13], pw3[0]=PKW(P1,8), pw3[1]=PKW(P1,10), pw3); \
    VRD(7); SBAR(); GAPA(C1=__builtin_amdgcn_mfma_f32_32x32x16_bf16(kf[7],qr[3],C1,0,0,0),   P1[14],P1[15],0.f,0.f,       pw3[2]=PKW(P1,12),pw3[3]=PKW(P1,14), pw3); \
    l_reg+=sacc; \
    if(GK){DMA_K((t)+3,sl_cur);} if(GV){DMA_V((t)+1,sl_next);} \
    CMASK(C0,C1,t); \
    { float a=MX3(C0[0],C0[1],C1[0]),b=MX3(C0[2],C0[3],C1[1]); a=MX3(a,C1[2],C1[3]); \
      _Pragma("unroll") for(int r=4;r<16;r+=4){a=MX3(a,C0[r],C0[r+1]);b=MX3(b,C0[r+2],C0[r+3]);a=MX3(a,C1[r],C1[r+1]);b=MX3(b,C1[r+2],C1[r+3]);} \
      float rm=__builtin_fmaxf(a,b); { auto rr=__builtin_amdgcn_permlane32_swap(__float_as_uint(rm),__float_as_uint(rm),false,false); rm=__builtin_fmaxf(__uint_as_float(rr[0]),__uint_as_float(rr[1])); } \
      resc=false; \
      if(__builtin_expect(__any(rm>(float)THRL),0)){ const float dl=__builtin_fmaxf(rm,0.f); mhat+=dl; \
        _Pragma("unroll") for(int r=0;r<16;++r){C0[r]-=dl;C1[r]-=dl;} \
        _Pragma("unroll") for(int r=0;r<16;++r)negm[r]=-mhat; asm volatile("":"+v"(negm)); \
        const float f=__builtin_amdgcn_exp2f(-dl); l_reg*=f; if(hi==0)wsf[r32]=f; resc=true; } } \
    SBAR(); \
    GAPB(o[0]=__builtin_amdgcn_mfma_f32_32x32x16_bf16(PAF(0),VFR(0),o[0],0,0,0), C0,0); \
    GAPB(o[1]=__builtin_amdgcn_mfma_f32_32x32x16_bf16(PAF(0),VFR(4),o[1],0,0,0), C0,4); \
    KRD(GL,0); GAPB(o[0]=__builtin_amdgcn_mfma_f32_32x32x16_bf16(PAF(1),VFR(1),o[0],0,0,0), C0,8); \
    KRD(GL,1); GAPB(o[1]=__builtin_amdgcn_mfma_f32_32x32x16_bf16(PAF(1),VFR(5),o[1],0,0,0), C0,12); \
    KRD(GL,2); GAPB(o[0]=__builtin_amdgcn_mfma_f32_32x32x16_bf16(PAF(2),VFR(2),o[0],0,0,0), C1,0); \
    KRD(GL,3); GAPB(o[1]=__builtin_amdgcn_mfma_f32_32x32x16_bf16(PAF(2),VFR(6),o[1],0,0,0), C1,4); \
    GAPB(o[0]=__builtin_amdgcn_mfma_f32_32x32x16_bf16(PAF(3),VFR(3),o[0],0,0,0), C1,8); \
    GAPB(o[1]=__builtin_amdgcn_mfma_f32_32x32x16_bf16(PAF(3),VFR(7),o[1],0,0,0), C1,12); \
    }while(0)
  int t=1;
  #undef CMASK
  #define CMASK(P0,P1,t) do{}while(0)
  for(;t+5<NT;t+=2){
    STEP(pB0,pB1,pA0,pA1,t,true,true,true);     WAIT_BAR(2); RESC(); ROT();
    STEP(pA0,pA1,pB0,pB1,t+1,true,true,true);   WAIT_BAR(2); RESC(); ROT();
  }
  #undef CMASK
  #define CMASK(P0,P1,t) do{}while(0)
  #define ENDW(tt) do{ if((tt)+3<NT){WAIT_BAR(2);} else if((tt)+2<NT){WAIT_BAR(1);} else {WAIT_BAR(0);} }while(0)
  for(;t+1<NT;t+=2){
    STEP(pB0,pB1,pA0,pA1,t,(t+3<NT),(t+1<NT),(t+1<NT));       ENDW(t);   RESC(); ROT();
    STEP(pA0,pA1,pB0,pB1,t+1,(t+4<NT),(t+2<NT),(t+2<NT));     ENDW(t+1); RESC(); ROT();
  }
  STEP(pB0,pB1,pA0,pA1,NT-1,false,false,false); RESC();
  { float sacc=pB0[0]+pB0[1]; _Pragma("unroll") for(int r=2;r<16;++r)sacc+=pB0[r]; _Pragma("unroll") for(int r=0;r<16;++r)sacc+=pB1[r]; l_reg+=sacc;
    pw0=(u32x4){PKW(pB0,0),PKW(pB0,2),PKW(pB0,4),PKW(pB0,6)};pw1=(u32x4){PKW(pB0,8),PKW(pB0,10),PKW(pB0,12),PKW(pB0,14)};pw2=(u32x4){PKW(pB1,0),PKW(pB1,2),PKW(pB1,4),PKW(pB1,6)};pw3=(u32x4){PKW(pB1,8),PKW(pB1,10),PKW(pB1,12),PKW(pB1,14)};
    SBAR(); pv(o,vb0+sl_cur,PAF(0),PAF(1),PAF(2),PAF(3)); }
  #undef PKW
  #undef PAF
  #undef VFR
  #undef PIN
  #undef MX3
  #undef GAPA
  #undef GAPB
  #undef EX
  #undef VRD
  #undef KRD
  #undef STEP
  #undef ENDW
  {auto rr=__builtin_amdgcn_permlane32_swap(__float_as_uint(l_reg),__float_as_uint(l_reg),false,false);l_reg=__uint_as_float(rr[0])+__uint_as_float(rr[1]);}
  if(hi==0)wsf[32+r32]=l_reg;asm volatile("s_waitcnt lgkmcnt(0)":::"memory");
  float rli[16];
  #pragma unroll
  for(int r=0;r<16;++r)rli[r]=__builtin_amdgcn_rcpf(wsf[32+crow(r,hi)]);
  bf16*Ow=Ou+(long)(wid*QBLK)*QP;
  { bf16*stg=(bf16*)(shm+LDS_OST)+wid*2048;
    #pragma unroll
    for(int r=0;r<16;++r){const int orow=crow(r,hi);
      #pragma unroll
      for(int d0=0;d0<2;++d0)stg[orow*64+d0*32+r32]=__float2bfloat16(o[d0][r]*rli[r]);}
    asm volatile("s_waitcnt lgkmcnt(0)":::"memory");
    #pragma unroll
    for(int i=0;i<4;++i){const int row=i*8+(lane>>3),ch=lane&7; const u32x4 v=*(const u32x4*)(stg+row*64+ch*8); ATTN_STORE16(Ow+(long)row*QP+ch*8,v);} }
  asm volatile("s_waitcnt lgkmcnt(0)\n\ts_barrier":::"memory");
  #undef DMA_K
  #undef DMA_V
  #undef CMASK
  #undef START
  #undef RESC
  #undef ROT
}
constexpr int ATTN_LDS_BYTES=LDS_BYTES;
#undef SBAR
#undef WAIT_BAR
}
constexpr int NWAVES = 8;
constexpr int NLAT = 32768, NCTX = 1024, MALL = NLAT + NCTX, DM = 1024, SEQ = 8192, CTXL = 256, KVROWS = 8448, FFH = 2816;
constexpr size_t MiB = 1u << 20;
constexpr size_t WS_MOD = 0, WS_ROPE = 256 * 1024, WS_BAR = 280 * 1024, WS_SS = 296 * 1024, WS_SHW = 51 * MiB + 512 * 1024;
constexpr size_t WS_XN2 = 304 * MiB;
constexpr size_t WS_WQKV = 1 * MiB, WS_WO = 4 * MiB, WS_F1A = 6 * MiB, WS_F2A = 17 * MiB, WS_HIN = 23 * MiB, WS_HO = 33 * MiB, WS_F1B = 35 * MiB, WS_F2B = 46 * MiB, WS_HCTX = 52 * MiB, WS_XN = 56 * MiB;
constexpr size_t WS_U = 1 * MiB, WS_D = 18 * MiB;
constexpr size_t WS_QO = 122 * MiB, WS_K = 188 * MiB, WS_V = 205 * MiB, WS_HID0 = 122 * MiB;
constexpr size_t WS_HQ = 122 * MiB, WS_HG = 186 * MiB, WS_HV = 250 * MiB, WS_LFW = 314 * MiB, WS_LBW = 378 * MiB, WS_OFW = 442 * MiB, WS_OBW = 56 * MiB, WS_OG = 122 * MiB, WS_HID1 = 186 * MiB;
constexpr size_t WS_HVC = 506 * MiB, WS_LFWC = 508 * MiB, WS_LBWC = 510 * MiB;
constexpr size_t WS_END = 512 * MiB;
static_assert(WS_HQ == pg8::OFF_HQ && WS_HG == pg8::OFF_HG && WS_HV == pg8::OFF_HV && WS_LFW == pg8::OFF_LFW && WS_LBW == pg8::OFF_LBW && WS_HVC == pg8::OFF_HVC && WS_LFWC == pg8::OFF_LFWC && WS_LBWC == pg8::OFF_LBWC, "EpiHgrnIn offsets");
constexpr size_t F1_ELEMS = (size_t)2 * FFH * DM, F2_ELEMS = (size_t)DM * FFH;
constexpr int RING_BYTES = 131072, LDS_BYTES = 147456;

#define LAS __attribute__((address_space(3)))
typedef unsigned short bf16;
typedef unsigned v4u __attribute__((ext_vector_type(4)));
typedef unsigned v2u __attribute__((ext_vector_type(2)));
typedef float f32x4 __attribute__((ext_vector_type(4)));
typedef float f32x16 __attribute__((ext_vector_type(16)));
typedef short bf16x8 __attribute__((ext_vector_type(8)));
typedef float f32x2_t __attribute__((ext_vector_type(2)));
typedef __bf16 bf16x2_t __attribute__((ext_vector_type(2)));
__device__ __forceinline__ unsigned pk2(float lo, float hi) { f32x2_t v = {lo, hi}; bf16x2_t b = __builtin_convertvector(v, bf16x2_t); return __builtin_bit_cast(unsigned, b); }
__device__ __forceinline__ unsigned short f2bf(float f) { return (unsigned short)(pk2(f, 0.f) & 0xffffu); }
__device__ __forceinline__ float bf2f(unsigned short h) { return __builtin_bit_cast(float, (unsigned)h << 16); }
__device__ __forceinline__ float h2f(unsigned short h) { return (float)__builtin_bit_cast(_Float16, h); }
__device__ __forceinline__ float wave_sum(float v) {
#pragma unroll
    for (int o = 1; o < 64; o <<= 1) v += __shfl_xor(v, o);
    return v;
}
#define LDS_WAIT() asm volatile("s_waitcnt lgkmcnt(0)" ::: "memory")

template <int MODE> __device__ __forceinline__ int wmap(int o) {
    if (MODE == 1) { const int tile = o >> 8, w = o & 255, wc = w >> 6, bj = (w >> 5) & 1, e = w & 31; return tile * 256 + 128 * bj + 32 * wc + e; }
    if (MODE == 2) { const int half = o >= FFH ? 1 : 0, idx = o - half * FFH, pn = idx >> 7, q = idx & 127; return 256 * pn + 128 * half + q; }
    return o;
}
template <int MODE> __device__ __forceinline__ void p0_transpose_item(const float* W, int K, int N, bf16* WT, LAS float* scr, int item, int lane) {
    const int nblk = N / 32, kb = item / nblk, nb = item % nblk, k0 = 64 * kb, n0 = 32 * nb;
#pragma unroll 8
    for (int i = 0; i < 32; ++i) { const int kk = 2 * i + (lane >> 5); scr[kk * 33 + (lane & 31)] = W[(size_t)(k0 + kk) * N + n0 + (lane & 31)]; }
    LDS_WAIT(); asm volatile("" ::: "memory");
    const int c = lane & 7;
#pragma unroll
    for (int j = 0; j < 4; ++j) { const int n = (lane >> 3) + 8 * j; const LAS float* s = scr + (8 * c) * 33 + n;
        v4u o; o.x = pk2(s[0 * 33], s[1 * 33]); o.y = pk2(s[2 * 33], s[3 * 33]); o.z = pk2(s[4 * 33], s[5 * 33]); o.w = pk2(s[6 * 33], s[7 * 33]);
        *(v4u*)(WT + (size_t)wmap<MODE>(n0 + n) * K + k0 + 8 * c) = o; }
    LDS_WAIT(); asm volatile("" ::: "memory");
}

__device__ __forceinline__ void norm_rows(int gw, int NGW, int lane, const float* src_lat, const float* src_ctx, int r0, int nrows, const float* w, const float* modl, int shi, int sci, bf16* XN) {
    for (int r = r0 + gw; r < nrows; r += NGW) {
        const bool lat = r < NLAT; const float* src = lat ? src_lat + (size_t)r * DM : src_ctx + (size_t)(r - NLAT) * DM; const int vec = lat ? (r >> 13) : 4;
        const f32x4* xr = (const f32x4*)src + lane;
        f32x4 v[4]; float s = 0.f;
#pragma unroll
        for (int j = 0; j < 4; ++j) { v[j] = xr[64 * j]; s += (v[j].x * v[j].x + v[j].y * v[j].y) + (v[j].z * v[j].z + v[j].w * v[j].w); }
        const float rstd = rsqrtf(wave_sum(s) * (1.f / DM) + 1e-6f);
        const f32x4* wp = (const f32x4*)w + lane; const f32x4* shp = (const f32x4*)(modl + vec * 6144 + shi * 1024) + lane; const f32x4* scp = (const f32x4*)(modl + vec * 6144 + sci * 1024) + lane;
        unsigned long long* o8 = (unsigned long long*)(XN + (size_t)r * DM) + lane;
#pragma unroll
        for (int j = 0; j < 4; ++j) { const f32x4 ww = wp[64 * j], sh = shp[64 * j], sc = scp[64 * j]; const f32x4 y = v[j] * rstd * ww * (sc + 1.0f) + sh;
            o8[64 * j] = (unsigned long long)pk2(y.x, y.y) | ((unsigned long long)pk2(y.z, y.w) << 32); }
    }
}
__device__ __forceinline__ void final_norm_rows(int gw, int NGW, int lane, float* h, const float* w) {
    for (int r = gw; r < NLAT; r += NGW) {
        f32x4* xr = (f32x4*)(h + (size_t)r * DM) + lane;
        f32x4 v[4]; float s = 0.f;
#pragma unroll
        for (int j = 0; j < 4; ++j) { v[j] = xr[64 * j]; s += (v[j].x * v[j].x + v[j].y * v[j].y) + (v[j].z * v[j].z + v[j].w * v[j].w); }
        const float rstd = rsqrtf(wave_sum(s) * (1.f / DM) + 1e-6f);
        const f32x4* wp = (const f32x4*)w + lane;
#pragma unroll
        for (int j = 0; j < 4; ++j) xr[64 * j] = v[j] * rstd * wp[64 * j];
    }
}

constexpr int SC_Q0 = 0, SC_QM = 17408, SC_KE = 34816, SC_KT = 52224, SC_VT = 70656, SC_ST = 89088, SC_AT = 123904, SC_PS = 133120, SC_EL = 137216;
constexpr int NSTR = 272, TSTR = 144;
static_assert(SC_EL + 512 <= LDS_BYTES, "scan LDS map");
__device__ __forceinline__ int crow(int r, int hi) { return (r & 3) + 8 * (r >> 2) + 4 * hi; }
__device__ __forceinline__ int scan_row(int c, int s, int b, int dir) {
    if (c < 4) { const int idx = 64 * c + s; return NLAT + b * CTXL + (dir ? (CTXL - 1 - idx) : idx); }
    const int idx = 64 * (c - 4) + s; return b * SEQ + (dir ? (SEQ - 1 - idx) : idx);
}
#define MFMA32(a, b, c) __builtin_amdgcn_mfma_f32_32x32x16_bf16((a), (b), (c), 0, 0, 0)
template <int MODE> __device__ __forceinline__ void hgrn_scan_item(LAS unsigned char* lds, int item, const bf16* HQ, const bf16* HV, const bf16* LFW, const bf16* LBW, const bf16* HVc, const bf16* LFWc, const bf16* LBWc, bf16* OFW, bf16* OBW, float* UB, float* DB) {
    int tid_ = threadIdx.x; asm volatile("" : "+v"(tid_));
    const int tid = tid_, lane = tid & 63, wid = __builtin_amdgcn_readfirstlane(tid >> 6), r32 = lane & 31, hi = lane >> 5;
    const int seg = item & 3, stream = item >> 2, dir = stream & 1, h = (stream >> 1) & 7, b = stream >> 4;
    if (MODE == 0 && seg == 3) return;
    const bf16* LF = dir ? LBW : LFW; bf16* OX = dir ? OBW : OFW;
    const bf16* LFc = (dir ? LBWc : LFWc) - (size_t)NLAT * DM; const bf16* HVcb = HVc - (size_t)NLAT * DM;
    const int kp = lane, g = wid;
    const unsigned voff2 = (unsigned)(h * 128 + 2 * kp) * 2u;
    const int vt = wid & 3, th = wid >> 2;
    unsigned lfrA[8], qrA[8], vrA[8], lfrB[8], qrB[8], vrB[8];
#define SCAN_LOAD(LFR, QR, VR, c) do { const bf16* lfb_ = (c) < 4 ? LFc : LF; const bf16* hvb_ = (c) < 4 ? HVcb : HV; \
        _Pragma("unroll") for (int i = 0; i < 8; ++i) { const size_t r_ = (size_t)__builtin_amdgcn_readfirstlane(scan_row((c), 8 * g + i, b, dir)) * (DM * 2);     \
            LFR[i] = *(const unsigned*)((const char*)lfb_ + r_ + voff2); VR[i] = *(const unsigned*)((const char*)hvb_ + r_ + voff2); \
            if (MODE == 1) QR[i] = *(const unsigned*)((const char*)HQ + r_ + voff2);     } } while (0)
    f32x16 S[2];
#pragma unroll
    for (int j = 0; j < 2; ++j)
#pragma unroll
        for (int i = 0; i < 16; ++i) S[j][i] = 0.f;
    if (MODE == 1) {
        for (int js = 0; js < seg; ++js) { const int it = stream * 4 + js;
#pragma unroll
            for (int j = 0; j < 2; ++j)
#pragma unroll
                for (int i = 0; i < 16; ++i) S[j][i] = S[j][i] * DB[it * 128 + 32 * (2 * th + j) + crow(i, hi)] + UB[((size_t)it * 32 + j * 16 + i) * 512 + tid]; }
        *(LAS unsigned*)(lds + SC_AT + (tid >> 4) * TSTR + 64 + 4 * (tid & 15)) = 0u;
    }
    float dacc0 = 1.f, dacc1 = 1.f;
    const int c0 = 33 * seg;
    SCAN_LOAD(lfrA, qrA, vrA, c0); SCAN_LOAD(lfrB, qrB, vrB, c0 + 1);
    for (int cc = c0; cc < c0 + 33; cc += 2) {
      { const int c = cc;
        const bool has_out = (MODE == 1) && c >= 4;
        f32x2_t lf[8]; f32x2_t ps = {0.f, 0.f};
#pragma unroll
        for (int i = 0; i < 8; ++i) { lf[i] = (f32x2_t){h2f((unsigned short)(lfrA[i] & 0xffffu)), h2f((unsigned short)(lfrA[i] >> 16))}; ps += lf[i]; }
        *(LAS f32x2_t*)(lds + SC_PS + (g * 128 + 2 * kp) * 4) = ps;
        LDS_WAIT(); __builtin_amdgcn_s_barrier(); asm volatile("" ::: "memory");
        {
            f32x2_t pre = {0.f, 0.f}, Lmid = {0.f, 0.f}, Lend = {0.f, 0.f};
#pragma unroll
            for (int gg = 0; gg < 8; ++gg) { const f32x2_t p = *(const LAS f32x2_t*)(lds + SC_PS + (gg * 128 + 2 * kp) * 4); if (gg < g) pre += p; if (gg < 4) Lmid += p; Lend += p; }
            const f32x2_t eLmid = {__expf(Lmid.x), __expf(Lmid.y)}, eEndMid = {__expf(Lend.x - Lmid.x), __expf(Lend.y - Lmid.y)};
            if (g == 0) { const f32x2_t el = {__expf(Lend.x), __expf(Lend.y)}; *(LAS f32x2_t*)(lds + SC_EL + 2 * kp * 4) = el; dacc0 *= el.x; dacc1 *= el.y; }
            f32x2_t E = {__expf(pre.x - Lmid.x), __expf(pre.y - Lmid.y)};
            unsigned kt0[4], kt1[4];
#pragma unroll
            for (int i = 0; i < 8; ++i) {
                const f32x2_t f = {__expf(lf[i].x), __expf(lf[i].y)};
                E = E * f;
                const f32x2_t re = {__builtin_amdgcn_rcpf(E.x), __builtin_amdgcn_rcpf(E.y)};
                const f32x2_t ke = (1.0f - f) * re, kend = ke * eEndMid;
                const int s = 8 * g + i;
                if (has_out) {
                    const f32x2_t q = {bf2f((unsigned short)(qrA[i] & 0xffffu)), bf2f((unsigned short)(qrA[i] >> 16))};
                    const f32x2_t qm = q * E, q0 = qm * eLmid;
                    *(LAS unsigned*)(lds + SC_Q0 + s * NSTR + 4 * kp) = pk2(q0.x, q0.y);
                    *(LAS unsigned*)(lds + SC_QM + s * NSTR + 4 * kp) = pk2(qm.x, qm.y);
                    *(LAS unsigned*)(lds + SC_KE + s * NSTR + 4 * kp) = pk2(ke.x, ke.y);
                }
                const unsigned kd = pk2(kend.x, kend.y);
                if (i & 1) { kt0[i >> 1] |= kd << 16; kt1[i >> 1] |= kd & 0xffff0000u; } else { kt0[i >> 1] = kd & 0xffffu; kt1[i >> 1] = kd >> 16; }
            }
            *(LAS v4u*)(lds + SC_KT + (2 * kp) * TSTR + 16 * g) = (v4u){kt0[0], kt0[1], kt0[2], kt0[3]};
            *(LAS v4u*)(lds + SC_KT + (2 * kp + 1) * TSTR + 16 * g) = (v4u){kt1[0], kt1[1], kt1[2], kt1[3]};
            v4u v0, v1;
#pragma unroll
            for (int i2 = 0; i2 < 4; ++i2) { v0[i2] = (vrA[2 * i2] & 0xffffu) | (vrA[2 * i2 + 1] << 16); v1[i2] = (vrA[2 * i2] >> 16) | (vrA[2 * i2 + 1] & 0xffff0000u); }
            *(LAS v4u*)(lds + SC_VT + (2 * kp) * TSTR + 16 * g) = v0;
            *(LAS v4u*)(lds + SC_VT + (2 * kp + 1) * TSTR + 16 * g) = v1;
            if (has_out) {
#pragma unroll
                for (int j = 0; j < 2; ++j)
#pragma unroll
                    for (int g4 = 0; g4 < 4; ++g4)
                        *(LAS v2u*)(lds + SC_ST + (32 * vt + r32) * NSTR + (32 * (2 * th + j) + 8 * g4 + 4 * hi) * 2) = (v2u){pk2(S[j][4 * g4], S[j][4 * g4 + 1]), pk2(S[j][4 * g4 + 2], S[j][4 * g4 + 3])};
            }
        }
        if (c + 2 < c0 + 33) SCAN_LOAD(lfrA, qrA, vrA, c + 2);
        LDS_WAIT(); __builtin_amdgcn_s_barrier(); asm volatile("" ::: "memory");
        f32x16 o;
#pragma unroll
        for (int i = 0; i < 16; ++i) o[i] = 0.f;
        if (has_out && wid < 3) {
            const int si = wid >> 1, ti = (wid + 1) >> 1;
            f32x16 a;
#pragma unroll
            for (int i = 0; i < 16; ++i) a[i] = 0.f;
#pragma unroll
            for (int kk = 0; kk < 8; ++kk) {
                const bf16x8 A = *(const LAS bf16x8*)(lds + SC_KE + (32 * si + r32) * NSTR + (16 * kk + 8 * hi) * 2);
                const bf16x8 B = *(const LAS bf16x8*)(lds + SC_QM + (32 * ti + r32) * NSTR + (16 * kk + 8 * hi) * 2);
                a = MFMA32(A, B, a);
            }
            const int t = 32 * ti + r32;
#pragma unroll
            for (int g4 = 0; g4 < 4; ++g4) {
                const int s0 = 32 * si + 8 * g4 + 4 * hi;
                const float a0 = (s0 + 0 <= t) ? a[4 * g4 + 0] : 0.f, a1 = (s0 + 1 <= t) ? a[4 * g4 + 1] : 0.f, a2 = (s0 + 2 <= t) ? a[4 * g4 + 2] : 0.f, a3 = (s0 + 3 <= t) ? a[4 * g4 + 3] : 0.f;
                *(LAS v2u*)(lds + SC_AT + t * TSTR + s0 * 2) = (v2u){pk2(a0, a1), pk2(a2, a3)};
            }
        }
        {
            const LAS float* EL = (const LAS float*)(lds + SC_EL);
#pragma unroll
            for (int j = 0; j < 2; ++j) {
                const int kq = 2 * th + j;
#pragma unroll
                for (int i = 0; i < 16; ++i) S[j][i] *= EL[32 * kq + crow(i, hi)];
#pragma unroll
                for (int kk = 0; kk < 4; ++kk) {
                    const bf16x8 A = *(const LAS bf16x8*)(lds + SC_KT + (32 * kq + r32) * TSTR + (16 * kk + 8 * hi) * 2);
                    const bf16x8 B = *(const LAS bf16x8*)(lds + SC_VT + (32 * vt + r32) * TSTR + (16 * kk + 8 * hi) * 2);
                    S[j] = MFMA32(A, B, S[j]);
                }
            }
            if (has_out) {
#pragma unroll
                for (int kk = 0; kk < 8; ++kk) {
                    const bf16x8 A = *(const LAS bf16x8*)(lds + SC_Q0 + (32 * th + r32) * NSTR + (16 * kk + 8 * hi) * 2);
                    const bf16x8 B = *(const LAS bf16x8*)(lds + SC_ST + (32 * vt + r32) * NSTR + (16 * kk + 8 * hi) * 2);
                    o = MFMA32(A, B, o);
                }
            }
        }
        LDS_WAIT(); __builtin_amdgcn_s_barrier(); asm volatile("" ::: "memory");
        if (has_out) {
#pragma unroll
            for (int kk = 0; kk < 4; ++kk) {
                const bf16x8 A = *(const LAS bf16x8*)(lds + SC_AT + (32 * th + r32) * TSTR + (16 * kk + 8 * hi) * 2);
                const bf16x8 B = *(const LAS bf16x8*)(lds + SC_VT + (32 * vt + r32) * TSTR + (16 * kk + 8 * hi) * 2);
                o = MFMA32(A, B, o);
            }
#pragma unroll
            for (int i = 0; i < 16; ++i) *(LAS unsigned short*)(lds + SC_Q0 + wid * 2560 + crow(i, hi) * 80 + 2 * r32) = f2bf(o[i]);
            LDS_WAIT(); asm volatile("" ::: "memory");
#pragma unroll
            for (int j2 = 0; j2 < 2; ++j2) { const int tl = j2 * 16 + (lane >> 2), pc = lane & 3; const v4u pv = *(const LAS v4u*)(lds + SC_Q0 + wid * 2560 + tl * 80 + 16 * pc);
                const size_t r_ = (size_t)scan_row(c, 32 * th + tl, b, dir); *(v4u*)(OX + r_ * DM + h * 128 + 32 * vt + 8 * pc) = pv; }
        }
          }
      if (cc + 1 < c0 + 33) { const int c = cc + 1;
        const bool has_out = (MODE == 1) && c >= 4;
        f32x2_t lf[8]; f32x2_t ps = {0.f, 0.f};
#pragma unroll
        for (int i = 0; i < 8; ++i) { lf[i] = (f32x2_t){h2f((unsigned short)(lfrB[i] & 0xffffu)), h2f((unsigned short)(lfrB[i] >> 16))}; ps += lf[i]; }
        *(LAS f32x2_t*)(lds + SC_PS + (g * 128 + 2 * kp) * 4) = ps;
        LDS_WAIT(); __builtin_amdgcn_s_barrier(); asm volatile("" ::: "memory");
        {
            f32x2_t pre = {0.f, 0.f}, Lmid = {0.f, 0.f}, Lend = {0.f, 0.f};
#pragma unroll
            for (int gg = 0; gg < 8; ++gg) { const f32x2_t p = *(const LAS f32x2_t*)(lds + SC_PS + (gg * 128 + 2 * kp) * 4); if (gg < g) pre += p; if (gg < 4) Lmid += p; Lend += p; }
            const f32x2_t eLmid = {__expf(Lmid.x), __expf(Lmid.y)}, eEndMid = {__expf(Lend.x - Lmid.x), __expf(Lend.y - Lmid.y)};
            if (g == 0) { const f32x2_t el = {__expf(Lend.x), __expf(Lend.y)}; *(LAS f32x2_t*)(lds + SC_EL + 2 * kp * 4) = el; dacc0 *= el.x; dacc1 *= el.y; }
            f32x2_t E = {__expf(pre.x - Lmid.x), __expf(pre.y - Lmid.y)};
            unsigned kt0[4], kt1[4];
#pragma unroll
            for (int i = 0; i < 8; ++i) {
                const f32x2_t f = {__expf(lf[i].x), __expf(lf[i].y)};
                E = E * f;
                const f32x2_t re = {__builtin_amdgcn_rcpf(E.x), __builtin_amdgcn_rcpf(E.y)};
                const f32x2_t ke = (1.0f - f) * re, kend = ke * eEndMid;
                const int s = 8 * g + i;
                if (has_out) {
                    const f32x2_t q = {bf2f((unsigned short)(qrB[i] & 0xffffu)), bf2f((unsigned short)(qrB[i] >> 16))};
                    const f32x2_t qm = q * E, q0 = qm * eLmid;
                    *(LAS unsigned*)(lds + SC_Q0 + s * NSTR + 4 * kp) = pk2(q0.x, q0.y);
                    *(LAS unsigned*)(lds + SC_QM + s * NSTR + 4 * kp) = pk2(qm.x, qm.y);
                    *(LAS unsigned*)(lds + SC_KE + s * NSTR + 4 * kp) = pk2(ke.x, ke.y);
                }
                const unsigned kd = pk2(kend.x, kend.y);
                if (i & 1) { kt0[i >> 1] |= kd << 16; kt1[i >> 1] |= kd & 0xffff0000u; } else { kt0[i >> 1] = kd & 0xffffu; kt1[i >> 1] = kd >> 16; }
            }
            *(LAS v4u*)(lds + SC_KT + (2 * kp) * TSTR + 16 * g) = (v4u){kt0[0], kt0[1], kt0[2], kt0[3]};
            *(LAS v4u*)(lds + SC_KT + (2 * kp + 1) * TSTR + 16 * g) = (v4u){kt1[0], kt1[1], kt1[2], kt1[3]};
            v4u v0, v1;
#pragma unroll
            for (int i2 = 0; i2 < 4; ++i2) { v0[i2] = (vrB[2 * i2] & 0xffffu) | (vrB[2 * i2 + 1] << 16); v1[i2] = (vrB[2 * i2] >> 16) | (vrB[2 * i2 + 1] & 0xffff0000u); }
            *(LAS v4u*)(lds + SC_VT + (2 * kp) * TSTR + 16 * g) = v0;
            *(LAS v4u*)(lds + SC_VT + (2 * kp + 1) * TSTR + 16 * g) = v1;
            if (has_out) {
#pragma unroll
                for (int j = 0; j < 2; ++j)
#pragma unroll
                    for (int g4 = 0; g4 < 4; ++g4)
                        *(LAS v2u*)(lds + SC_ST + (32 * vt + r32) * NSTR + (32 * (2 * th + j) + 8 * g4 + 4 * hi) * 2) = (v2u){pk2(S[j][4 * g4], S[j][4 * g4 + 1]), pk2(S[j][4 * g4 + 2], S[j][4 * g4 + 3])};
            }
        }
        if (c + 2 < c0 + 33) SCAN_LOAD(lfrB, qrB, vrB, c + 2);
        LDS_WAIT(); __builtin_amdgcn_s_barrier(); asm volatile("" ::: "memory");
        f32x16 o;
#pragma unroll
        for (int i = 0; i < 16; ++i) o[i] = 0.f;
        if (has_out && wid < 3) {
            const int si = wid >> 1, ti = (wid + 1) >> 1;
            f32x16 a;
#pragma unroll
            for (int i = 0; i < 16; ++i) a[i] = 0.f;
#pragma unroll
            for (int kk = 0; kk < 8; ++kk) {
                const bf16x8 A = *(const LAS bf16x8*)(lds + SC_KE + (32 * si + r32) * NSTR + (16 * kk + 8 * hi) * 2);
                const bf16x8 B = *(const LAS bf16x8*)(lds + SC_QM + (32 * ti + r32) * NSTR + (16 * kk + 8 * hi) * 2);
                a = MFMA32(A, B, a);
            }
            const int t = 32 * ti + r32;
#pragma unroll
            for (int g4 = 0; g4 < 4; ++g4) {
                const int s0 = 32 * si + 8 * g4 + 4 * hi;
                const float a0 = (s0 + 0 <= t) ? a[4 * g4 + 0] : 0.f, a1 = (s0 + 1 <= t) ? a[4 * g4 + 1] : 0.f, a2 = (s0 + 2 <= t) ? a[4 * g4 + 2] : 0.f, a3 = (s0 + 3 <= t) ? a[4 * g4 + 3] : 0.f;
                *(LAS v2u*)(lds + SC_AT + t * TSTR + s0 * 2) = (v2u){pk2(a0, a1), pk2(a2, a3)};
            }
        }
        {
            const LAS float* EL = (const LAS float*)(lds + SC_EL);
#pragma unroll
            for (int j = 0; j < 2; ++j) {
                const int kq = 2 * th + j;
#pragma unroll
                for (int i = 0; i < 16; ++i) S[j][i] *= EL[32 * kq + crow(i, hi)];
#pragma unroll
                for (int kk = 0; kk < 4; ++kk) {
                    const bf16x8 A = *(const LAS bf16x8*)(lds + SC_KT + (32 * kq + r32) * TSTR + (16 * kk + 8 * hi) * 2);
                    const bf16x8 B = *(const LAS bf16x8*)(lds + SC_VT + (32 * vt + r32) * TSTR + (16 * kk + 8 * hi) * 2);
                    S[j] = MFMA32(A, B, S[j]);
                }
            }
            if (has_out) {
#pragma unroll
                for (int kk = 0; kk < 8; ++kk) {
                    const bf16x8 A = *(const LAS bf16x8*)(lds + SC_Q0 + (32 * th + r32) * NSTR + (16 * kk + 8 * hi) * 2);
                    const bf16x8 B = *(const LAS bf16x8*)(lds + SC_ST + (32 * vt + r32) * NSTR + (16 * kk + 8 * hi) * 2);
                    o = MFMA32(A, B, o);
                }
            }
        }
        LDS_WAIT(); __builtin_amdgcn_s_barrier(); asm volatile("" ::: "memory");
        if (has_out) {
#pragma unroll
            for (int kk = 0; kk < 4; ++kk) {
                const bf16x8 A = *(const LAS bf16x8*)(lds + SC_AT + (32 * th + r32) * TSTR + (16 * kk + 8 * hi) * 2);
                const bf16x8 B = *(const LAS bf16x8*)(lds + SC_VT + (32 * vt + r32) * TSTR + (16 * kk + 8 * hi) * 2);
                o = MFMA32(A, B, o);
            }
#pragma unroll
            for (int i = 0; i < 16; ++i) *(LAS unsigned short*)(lds + SC_Q0 + wid * 2560 + crow(i, hi) * 80 + 2 * r32) = f2bf(o[i]);
            LDS_WAIT(); asm volatile("" ::: "memory");
#pragma unroll
            for (int j2 = 0; j2 < 2; ++j2) { const int tl = j2 * 16 + (lane >> 2), pc = lane & 3; const v4u pv = *(const LAS v4u*)(lds + SC_Q0 + wid * 2560 + tl * 80 + 16 * pc);
                const size_t r_ = (size_t)scan_row(c, 32 * th + tl, b, dir); *(v4u*)(OX + r_ * DM + h * 128 + 32 * vt + 8 * pc) = pv; }
        }
          }
    }
#undef SCAN_LOAD
    if (MODE == 0) {
#pragma unroll
        for (int j = 0; j < 2; ++j)
#pragma unroll
            for (int i = 0; i < 16; ++i) UB[((size_t)item * 32 + j * 16 + i) * 512 + tid] = S[j][i];
        if (g == 0) { DB[item * 128 + 2 * kp] = dacc0; DB[item * 128 + 2 * kp + 1] = dacc1; }
    }
    LDS_WAIT(); __builtin_amdgcn_s_barrier(); asm volatile("" ::: "memory");
}
__device__ __forceinline__ void hgrn_combine(int gw, int NGW, int lane, const bf16* OFW, const bf16* OBW, const bf16* HG, const float* onorm, bf16* OG) {
    for (int r = gw; r < NLAT; r += NGW) {
        const size_t off = (size_t)r * DM + lane * 16;
        float o[16], gt[16];
#pragma unroll
        for (int j = 0; j < 2; ++j) { const v4u a = *(const v4u*)(OFW + off + 8 * j), bq = *(const v4u*)(OBW + off + 8 * j), gg = *(const v4u*)(HG + off + 8 * j);
#pragma unroll
            for (int e = 0; e < 4; ++e) { o[8 * j + 2 * e] = bf2f((unsigned short)(a[e] & 0xffffu)) + bf2f((unsigned short)(bq[e] & 0xffffu)); o[8 * j + 2 * e + 1] = bf2f((unsigned short)(a[e] >> 16)) + bf2f((unsigned short)(bq[e] >> 16));
                gt[8 * j + 2 * e] = bf2f((unsigned short)(gg[e] & 0xffffu)); gt[8 * j + 2 * e + 1] = bf2f((unsigned short)(gg[e] >> 16)); } }
        float ss = 0.f;
#pragma unroll
        for (int e = 0; e < 16; ++e) ss += o[e] * o[e];
        ss += __shfl_xor(ss, 1); ss += __shfl_xor(ss, 2); ss += __shfl_xor(ss, 4);
        const float rstd = rsqrtf(ss * (1.f / 128.f) + 1e-6f);
        unsigned pk[8];
#pragma unroll
        for (int e = 0; e < 8; ++e) { const float w0 = onorm[lane * 16 + 2 * e], w1 = onorm[lane * 16 + 2 * e + 1];
            const float y0 = o[2 * e] * rstd * w0 * __builtin_amdgcn_rcpf(1.0f + __expf(-gt[2 * e])), y1 = o[2 * e + 1] * rstd * w1 * __builtin_amdgcn_rcpf(1.0f + __expf(-gt[2 * e + 1])); pk[e] = pk2(y0, y1); }
        *(v4u*)(OG + off) = (v4u){pk[0], pk[1], pk[2], pk[3]}; *(v4u*)(OG + off + 8) = (v4u){pk[4], pk[5], pk[6], pk[7]};
    }
}

#define XB_TMO      128
#define XB_XCNT(j)  (256  + 64 * (j))
#define XB_XSUB(j)  (1280 + 64 * (j))
#define XB_XGEN(j)  (2304 + 64 * (j))
#define XB_TOP      3328
#define XB_TOPGEN   3392
#define XCD_BAR_WORDS 3456
#define XB_SPIN_CAP (1u << 18)

__device__ __forceinline__ unsigned xb_ld(unsigned* p)              { return __hip_atomic_load(p, __ATOMIC_RELAXED, __HIP_MEMORY_SCOPE_AGENT); }
__device__ __forceinline__ unsigned xb_add(unsigned* p, unsigned v) { return __hip_atomic_fetch_add(p, v, __ATOMIC_RELAXED, __HIP_MEMORY_SCOPE_AGENT); }
__device__ __forceinline__ unsigned xb_xcc_id() { return (unsigned)__builtin_amdgcn_s_getreg((3 << 11) | 20) & 0xFu; }
#define XB_SPIN(cond, bar) do { unsigned _sp = 0; while (cond) { __builtin_amdgcn_s_sleep(1); \
    if ((++_sp & 255u) == 0u) { if (xb_ld(&(bar)[XB_TMO])) break; if (_sp > XB_SPIN_CAP) { atomicAdd(&(bar)[XB_TMO], 1u); break; } } } } while (0)

struct XcdBarrier {
    unsigned* bar; unsigned x;
    volatile LAS unsigned* st;
};

__device__ __forceinline__ XcdBarrier xcd_barrier_post(unsigned* bar, volatile LAS unsigned* st) {
    XcdBarrier b; b.bar = bar; b.x = xb_xcc_id(); b.st = st;
    if (threadIdx.x == 0) (void)xb_add(&bar[XB_XCNT(b.x)], 1u);
    return b;
}
__device__ __forceinline__ void xcd_barrier_complete(unsigned* bar, unsigned x, unsigned& nloc, unsigned& nx) {
    const unsigned G = gridDim.x * gridDim.y * gridDim.z;
    unsigned sum, cnt, mine, sp = 0u;
    for (;;) {
        sum = 0u; cnt = 0u; mine = 0u;
#pragma unroll
        for (unsigned j = 0; j < 16; ++j) { const unsigned c = xb_ld(&bar[XB_XCNT(j)]); sum += c; cnt += (c > 0u) ? 1u : 0u; mine = (j == x) ? c : mine; }
        if (sum == G) break;
        __builtin_amdgcn_s_sleep(1);
        if ((++sp & 255u) == 0u) { if (xb_ld(&bar[XB_TMO])) break; if (sp > XB_SPIN_CAP) { atomicAdd(&bar[XB_TMO], 1u); break; } }
    }
    nloc = mine > 0u ? mine : 1u; nx = cnt > 0u ? cnt : 1u;
}

__device__ __forceinline__ void xcd_barrier(const XcdBarrier& b) {
    asm volatile("s_waitcnt vmcnt(0)" ::: "memory");
    __syncthreads();
    if (threadIdx.x == 0) {
        unsigned* bar = b.bar;
        __builtin_amdgcn_s_waitcnt(0);
        unsigned nloc = b.st[0], nx = b.st[1];
        if (nloc == 0u) { xcd_barrier_complete(bar, b.x, nloc, nx); b.st[0] = nloc; b.st[1] = nx; }
        const unsigned old = xb_add(&bar[XB_XSUB(b.x)], 1u);
        const unsigned gen = old / nloc;
        if (old + 1u == (gen + 1u) * nloc) {
            __builtin_amdgcn_fence(__ATOMIC_RELEASE, "agent");
            asm volatile("s_waitcnt vmcnt(0)" ::: "memory");
            const unsigned og = xb_add(&bar[XB_TOP], 1u);
            const unsigned tg = og / nx;
            if (og + 1u == (tg + 1u) * nx) xb_add(&bar[XB_TOPGEN], 1u);
            else XB_SPIN(xb_ld(&bar[XB_TOPGEN]) == tg, bar);
            __builtin_amdgcn_fence(__ATOMIC_ACQUIRE, "agent");
            xb_add(&bar[XB_XGEN(b.x)], 1u);
            asm volatile("s_waitcnt vmcnt(0)" ::: "memory");
        } else {
            XB_SPIN(xb_ld(&bar[XB_XGEN(b.x)]) == gen, bar);
            __builtin_amdgcn_fence(__ATOMIC_ACQUIRE, "agent");
            asm volatile("s_waitcnt vmcnt(0)" ::: "memory");
        }
    }
    __syncthreads();
}

struct Args { const float* in[19]; float* out; unsigned char* ws; };
typedef __attribute__((address_space(4))) Args KArgs;
__device__ __forceinline__ int fresh_v(int t) { asm volatile("" : "+v"(t)); return t; }
__device__ __forceinline__ int fresh_s(int t) { asm volatile("" : "+s"(t)); return t; }
__global__ void __launch_bounds__(NWAVES * 64, 2) mk_fwd(Args args) {
    extern __shared__ __attribute__((aligned(16))) unsigned char lds_raw[];
    LAS unsigned char* lds = (LAS unsigned char*)lds_raw;
    cg::grid_group grid = cg::this_grid();
#define PHASE_IDS() const int tid = fresh_v((int)threadIdx.x), lane = tid & 63, wave = __builtin_amdgcn_readfirstlane(tid >> 6); (void)lane; (void)wave; \
    const int G = fresh_s((int)gridDim.x), bx = fresh_s((int)blockIdx.x); const int vcu = (G % 8 == 0) ? (bx % 8) * (G / 8) + bx / 8 : bx; (void)vcu; \
    const int gw = vcu * NWAVES + wave, NGW = G * NWAVES; (void)gw; (void)NGW; \
    const KArgs* ap = (const KArgs*)__builtin_amdgcn_kernarg_segment_ptr(); asm volatile("" : "+s"(ap)); unsigned char* ws = ap->ws; (void)ws
#define IN(k) (ap->in[k])
#define MOD ((float*)(ws + WS_MOD))
#define ROPEC ((float*)(ws + WS_ROPE))
#define ROPES (ROPEC + 128 * 16)
#define Wqkv_t ((bf16*)(ws + WS_WQKV))
#define Wo_t ((bf16*)(ws + WS_WO))
#define Hin_t ((bf16*)(ws + WS_HIN))
#define Ho_t ((bf16*)(ws + WS_HO))
#define F1A_t ((bf16*)(ws + WS_F1A))
#define F2A_t ((bf16*)(ws + WS_F2A))
#define F1B_t ((bf16*)(ws + WS_F1B))
#define F2B_t ((bf16*)(ws + WS_F2B))
#define HCTX ((float*)(ws + WS_HCTX))
#define XN ((bf16*)(ws + WS_XN))
#define QO ((bf16*)(ws + WS_QO))
#define KB ((bf16*)(ws + WS_K))
#define VB ((bf16*)(ws + WS_V))
#define MOD1 (MOD + 5 * 6144)
#define SS0 ((float*)(ws + WS_SS))
#define SS1 (SS0 + MALL)
#define SS2 (SS1 + MALL)
#define SS3 (SS2 + MALL)
#define SHW0 ((float*)(ws + WS_SHW))
#define SHW1 (SHW0 + 5 * 5632)
#define SHW2 (SHW1 + 5 * 5120)
    if (args.ws == nullptr) grid.sync();
    volatile LAS unsigned* bst = (volatile LAS unsigned*)(lds + LDS_BYTES - 16);
    if (threadIdx.x == 0) { bst[0] = 0u; bst[1] = 0u; }
    __syncthreads();
    const XcdBarrier bar = xcd_barrier_post((unsigned*)(args.ws + WS_BAR), bst);
    {
        PHASE_IDS();
        for (int i = (bx * NWAVES * 64) + tid; i < 4 * MALL; i += G * NWAVES * 64) SS0[i] = 0.f;
        LAS float* sl = (LAS float*)lds;
        for (int i = tid; i < 5 * 1024; i += NWAVES * 64) { const float v = i < 4096 ? (ap->in[1])[i] : (ap->in[3])[i - 4096]; sl[i] = v / (1.0f + __expf(-v)); }
        __syncthreads();
        for (int it = gw; it < 768; it += NGW) {
            const int l = it / 384, n0 = (it % 384) * 16, cg4 = lane & 3, ks = lane >> 2;
            const float* W = (ap->in[4]) + (size_t)l * 1024 * 6144 + n0 + 4 * cg4;
            f32x4 acc[5];
#pragma unroll
            for (int v = 0; v < 5; ++v) acc[v] = (f32x4){0.f, 0.f, 0.f, 0.f};
#pragma unroll 8
            for (int i = 0; i < 64; ++i) { const int kk = i * 16 + ks; const f32x4 w4 = *(const f32x4*)(W + (size_t)kk * 6144);
#pragma unroll
                for (int v = 0; v < 5; ++v) acc[v] += w4 * sl[v * 1024 + kk]; }
#pragma unroll
            for (int v = 0; v < 5; ++v)
#pragma unroll
                for (int e = 0; e < 4; ++e) { float a = acc[v][e]; a += __shfl_xor(a, 4); a += __shfl_xor(a, 8); a += __shfl_xor(a, 16); a += __shfl_xor(a, 32); acc[v][e] = a; }
            if (ks == 0) { const f32x4 bb = *(const f32x4*)((ap->in[5]) + l * 6144 + n0 + 4 * cg4);
#pragma unroll
                for (int v = 0; v < 5; ++v) *(f32x4*)(MOD + (size_t)(l * 5 + v) * 6144 + n0 + 4 * cg4) = acc[v] + bb; }
        }
        __syncthreads();
        for (int idx = bx * (NWAVES * 64) + tid; idx < 2048; idx += G * NWAVES * 64) {
            const int pos = idx >> 4, f = idx & 15;
            double inv = 1.0; for (int j = 0; j < f; ++j) inv *= 0.56234132519034908;
            const double ang = (double)pos * inv, TWO_PI = 6.283185307179586476925;
            const double kq = __builtin_rint(ang / TWO_PI); const double rr = ang - kq * TWO_PI, r2 = rr * rr;
            double cs = 1.0, sn = rr, tc = 1.0, tsn = rr;
            for (int n = 1; n <= 14; ++n) { tc *= -r2 / (double)((2 * n - 1) * (2 * n)); tsn *= -r2 / (double)((2 * n) * (2 * n + 1)); cs += tc; sn += tsn; }
            ROPEC[idx] = (float)cs; ROPES[idx] = (float)sn;
        }
        LAS float* scr = (LAS float*)(lds + wave * 16384);
        constexpr int I_QKV = 16 * 48, I_O = 16 * 32, I_HIN = 16 * 160, I_HO = 16 * 32, I_F1 = 16 * 176, I_F2 = 44 * 32;
        constexpr int NITEMS = I_QKV + I_O + I_HIN + I_HO + 2 * I_F1 + 2 * I_F2;
        for (int it = gw; it < NITEMS; it += NGW) {
            int r = it;
            if (r < I_QKV) { p0_transpose_item<1>((ap->in[8]), 1024, 1536, Wqkv_t, scr, r, lane); continue; } r -= I_QKV;
            if (r < I_O) { p0_transpose_item<0>((ap->in[11]), 1024, 1024, Wo_t, scr, r, lane); continue; } r -= I_O;
            if (r < I_HIN) { p0_transpose_item<0>((ap->in[12]), 1024, 5120, Hin_t, scr, r, lane); continue; } r -= I_HIN;
            if (r < I_HO) { p0_transpose_item<0>((ap->in[15]), 1024, 1024, Ho_t, scr, r, lane); continue; } r -= I_HO;
            if (r < I_F1) { p0_transpose_item<2>((ap->in[16]), 1024, 5632, F1A_t, scr, r, lane); continue; } r -= I_F1;
            if (r < I_F1) { p0_transpose_item<2>((ap->in[16]) + (size_t)1024 * 5632, 1024, 5632, F1B_t, scr, r, lane); continue; } r -= I_F1;
            if (r < I_F2) { p0_transpose_item<0>((ap->in[17]), 2816, 1024, F2A_t, scr, r, lane); continue; } r -= I_F2;
            p0_transpose_item<0>((ap->in[17]) + (size_t)2816 * 1024, 2816, 1024, F2B_t, scr, r, lane);
        }
    }
    xcd_barrier(bar);
    { PHASE_IDS();
      const bool qcu = (G == 256) && bx < 24;
      if (qcu) {
          const int pm = 128 + bx / 6, pn = bx % 6;
          norm_rows(wave, NWAVES, lane, (ap->in[0]), (ap->in[2]), pm * 256, pm * 256 + 256, (ap->in[6]), MOD, 0, 1, XN);
          asm volatile("s_waitcnt vmcnt(0)" ::: "memory"); __syncthreads();
          if (tid == 0) { __builtin_amdgcn_fence(__ATOMIC_ACQUIRE, "agent"); asm volatile("s_waitcnt vmcnt(0)" ::: "memory"); }
          __syncthreads();
          pg8::Gemm gq{XN, Wqkv_t, MALL, 1536, 1024}; pg8::OneUnit Sq{pm, pn, nullptr};
          pg8::EpiQKV Eq{QO, KB, VB, (ap->in[9]), (ap->in[10]), ROPEC, ROPES, attn_body::C2};
          pg8::gemm_phase<pg8::EpiQKV, pg8::OneUnit, PG8_ALIGN, PG8_SP2>(lds, gq, Sq, Eq);
      } else {
      const int gw1 = (G == 256) ? (bx - 24) * NWAVES + wave : gw, NGW1 = (G == 256) ? 232 * NWAVES : NGW;
      norm_rows(gw1, NGW1, lane, (ap->in[0]), (ap->in[2]), 0, (G == 256) ? NLAT : MALL, (ap->in[6]), MOD, 0, 1, XN);
      for (int site = 0; site < 3; ++site) {
          const bf16* Bt = site == 0 ? F1A_t : site == 1 ? Hin_t : F1B_t; const int N = site == 1 ? 5120 : 5632;
          const float* shv = (site == 0 ? MOD : MOD1) + (site == 1 ? 0 : 3) * 1024; float* dst = site == 0 ? SHW0 : site == 1 ? SHW1 : SHW2;
          for (int n = gw1; n < N; n += NGW1) {
              const v4u w0 = *(const v4u*)(Bt + (size_t)n * 1024 + lane * 16), w1 = *(const v4u*)(Bt + (size_t)n * 1024 + lane * 16 + 8);
              float wf[16];
#pragma unroll
              for (int e = 0; e < 4; ++e) { wf[2 * e] = bf2f((unsigned short)(w0[e] & 0xffffu)); wf[2 * e + 1] = bf2f((unsigned short)(w0[e] >> 16)); wf[8 + 2 * e] = bf2f((unsigned short)(w1[e] & 0xffffu)); wf[8 + 2 * e + 1] = bf2f((unsigned short)(w1[e] >> 16)); }
#pragma unroll
              for (int v = 0; v < 5; ++v) { const float* sp = shv + v * 6144 + lane * 16; float a = 0.f;
#pragma unroll
                  for (int e4 = 0; e4 < 4; ++e4) { const f32x4 s4 = *(const f32x4*)(sp + 4 * e4); a += (wf[4 * e4] * s4[0] + wf[4 * e4 + 1] * s4[1]) + (wf[4 * e4 + 2] * s4[2] + wf[4 * e4 + 3] * s4[3]); }
                  a = wave_sum(a); if (lane == 0) dst[v * N + n] = a; }
          }
      }
      }
    }
    xcd_barrier(bar);
    {
        PHASE_IDS();
        const int Mrows = (G == 256) ? NLAT : MALL;
        pg8::Gemm g{XN, Wqkv_t, Mrows, 1536, 1024}; pg8::StaticOrder S; S.init(Mrows, 1536, G, bx);
        pg8::EpiQKV E{QO, KB, VB, (ap->in[9]), (ap->in[10]), ROPEC, ROPES, attn_body::C2};
        pg8::gemm_phase<pg8::EpiQKV, pg8::StaticOrder, PG8_ALIGN, PG8_SP2>(lds, g, S, E);
    }
    xcd_barrier(bar);
    {
        PHASE_IDS();
        for (int i = 0; i < 8; ++i) {
            const int u = i * 256 + vcu; if (u >= 2048 || G != 256) break;
            const int combo = u >> 7, idx = u & 127, b = combo >> 2, kvh = combo & 3, hq = idx >> 5, qb = idx & 31, h = kvh * 4 + hq;
            const attn_body::bf16* Qu = (const attn_body::bf16*)QO + ((size_t)b * SEQ + qb * 256) * 1024 + h * 64;
            const attn_body::bf16* Kh = (const attn_body::bf16*)KB + (size_t)b * KVROWS * 256 + kvh * 64;
            const attn_body::bf16* Vh = (const attn_body::bf16*)VB + (size_t)b * KVROWS * 256 + kvh * 64;
            attn_body::attn_unit<8>(Qu, Kh, Vh, (attn_body::bf16*)XN + (Qu - (const attn_body::bf16*)QO), 132, (char*)lds_raw);
        }
        if (G != 256) for (int u = bx; u < 2048; u += G) {
            const int combo = u >> 7, idx = u & 127, b = combo >> 2, kvh = combo & 3, hq = idx >> 5, qb = idx & 31, h = kvh * 4 + hq;
            const attn_body::bf16* Qu = (const attn_body::bf16*)QO + ((size_t)b * SEQ + qb * 256) * 1024 + h * 64;
            const attn_body::bf16* Kh = (const attn_body::bf16*)KB + (size_t)b * KVROWS * 256 + kvh * 64;
            const attn_body::bf16* Vh = (const attn_body::bf16*)VB + (size_t)b * KVROWS * 256 + kvh * 64;
            attn_body::attn_unit<8>(Qu, Kh, Vh, (attn_body::bf16*)XN + (Qu - (const attn_body::bf16*)QO), 132, (char*)lds_raw);
        }
        for (int u = bx; u < 64; u += G) {
            const int b = u >> 4, h = u & 15, kvh = h >> 2;
            const attn_body::bf16* Qu = (const attn_body::bf16*)QO + ((size_t)NLAT + b * CTXL) * 1024 + h * 64;
            const attn_body::bf16* Kh = (const attn_body::bf16*)KB + (size_t)b * KVROWS * 256 + kvh * 64;
            const attn_body::bf16* Vh = (const attn_body::bf16*)VB + (size_t)b * KVROWS * 256 + kvh * 64;
            attn_body::attn_unit<8>(Qu, Kh, Vh, (attn_body::bf16*)XN + (Qu - (const attn_body::bf16*)QO), 4, (char*)lds_raw);
        }
    }
    xcd_barrier(bar);
    {
        PHASE_IDS();
        const int Mrows = (G == 256) ? NLAT : MALL;
        pg8::Gemm g{XN, Wo_t, Mrows, 1024, 1024}; pg8::StaticOrder S; S.init(Mrows, 1024, G, bx);
        pg8::EpiResidN E{(ap->in[0]), (ap->in[2]), (ap->out), HCTX, MOD + 2 * 1024, (bf16*)(ws + WS_XN2), SS0, (ap->in[7]), MOD + 4 * 1024, (LAS float*)(lds + 139264)};
        pg8::gemm_phase<pg8::EpiResidN, pg8::StaticOrder, PG8_ALIGN, PG8_SP2>(lds, g, S, E);
    }
    xcd_barrier(bar);
    {
        PHASE_IDS();
        pg8::EpiSwiGLU E{(bf16*)(ws + WS_HID0), SS0, SHW0};
        pg8::Gemm g{(const bf16*)(ws + WS_XN2), F1A_t, MALL, 5632, 1024};
        if (G == 256) {
            unsigned* cntW = (unsigned*)(ws + WS_BAR) + XCD_BAR_WORDS + 64; unsigned* cntU = cntW + 64; unsigned* cntD = cntW + 128;
            if (bx < 240) {
                const int x = bx & 7, idx = bx >> 3; const bool hasW = (x == 0 && idx < 16), hasH = idx < 6;
                if (hasW) {
                    pg8::Gemm gw_{XN, Wo_t, MALL, 1024, 1024}; pg8::OneUnit Sw{128 + (idx >> 2), idx & 3, cntW};
                    pg8::EpiResidN Ew{(ap->in[0]), (ap->in[2]), (ap->out), HCTX, MOD + 2 * 1024, (bf16*)(ws + WS_XN2), SS0, (ap->in[7]), MOD + 4 * 1024, (LAS float*)(lds + 139264)};
                    pg8::gemm_phase<pg8::EpiResidN, pg8::OneUnit, PG8_ALIGN, PG8_SP2>(lds, gw_, Sw, Ew);
                }
                pg8::UpOrder S{bx, hasW ? 1 : 0, hasH ? 11 : 12, cntW, cntU};
                pg8::gemm_phase<pg8::EpiSwiGLU, pg8::UpOrder, PG8_ALIGN, PG8_SP2>(lds, g, S, E);
                if (hasH) {
                    pg8::wave_wait_count(cntD, 16u); __syncthreads();
                    const int hidx = x * 6 + idx;
                    pg8::Gemm gh{XN, Hin_t, MALL, 5120, 1024}; pg8::OneUnit Sh{128 + hidx / 12, 8 + hidx % 12, nullptr};
                    pg8::EpiHgrnIn Eh{ws, (ap->in[13]), SS1, SHW1};
                    pg8::gemm_phase<pg8::EpiHgrnIn, pg8::OneUnit, PG8_ALIGN, PG8_SP2>(lds, gh, Sh, Eh);
                }
            } else {
                const int d = bx - 240;
                { pg8::UpOrderD S{d, 0, 3}; pg8::gemm_phase<pg8::EpiSwiGLU, pg8::UpOrderD, PG8_ALIGN, PG8_SP2>(lds, g, S, E); }
                pg8::wave_wait_count(cntU, 88u); __syncthreads();
                {
                    pg8::Gemm g2{(const bf16*)(ws + WS_HID0), F2A_t, MALL, 1024, FFH}; pg8::OneUnit S2{128 + (d >> 2), d & 3, cntD};
                    pg8::EpiResidN E2{(ap->out), HCTX, (ap->out), HCTX, MOD + 5 * 1024, XN, SS1, (ap->in[6]) + 1024, MOD1 + 1 * 1024, (LAS float*)(lds + 139264)};
                    pg8::gemm_phase<pg8::EpiResidN, pg8::OneUnit, PG8_ALIGN, PG8_SP2>(lds, g2, S2, E2);
                }
                { pg8::UpOrderD S{d, 3, 6}; pg8::gemm_phase<pg8::EpiSwiGLU, pg8::UpOrderD, PG8_ALIGN, PG8_SP2>(lds, g, S, E); }
            }
        } else {
            pg8::StaticOrder S; S.init(MALL, 5632, G, bx);
            pg8::gemm_phase<pg8::EpiSwiGLU, pg8::StaticOrder, PG8_ALIGN, PG8_SP2>(lds, g, S, E);
        }
    }
    xcd_barrier(bar);
    {
        PHASE_IDS();
        const int Mrows = (G == 256) ? NLAT : MALL;
        pg8::Gemm g{(const bf16*)(ws + WS_HID0), F2A_t, Mrows, 1024, FFH}; pg8::StaticOrder S; S.init(Mrows, 1024, G, bx);
        pg8::EpiResidN E{(ap->out), HCTX, (ap->out), HCTX, MOD + 5 * 1024, XN, SS1, (ap->in[6]) + 1024, MOD1 + 1 * 1024, (LAS float*)(lds + 139264)};
        pg8::gemm_phase<pg8::EpiResidN, pg8::StaticOrder, PG8_ALIGN, PG8_SP2>(lds, g, S, E);
    }
    xcd_barrier(bar);
    {
        PHASE_IDS();
        const int Mrows = (G == 256) ? NLAT : MALL;
        pg8::Gemm g{XN, Hin_t, Mrows, 5120, 1024}; pg8::StaticOrder S; S.init(Mrows, 5120, G, bx);
        pg8::EpiHgrnIn E{ws, (ap->in[13]), SS1, SHW1};
        pg8::gemm_phase<pg8::EpiHgrnIn, pg8::StaticOrder, PG8_ALIGN, PG8_SP2>(lds, g, S, E);
    }
    xcd_barrier(bar);
    { PHASE_IDS();
    for (int item = bx; item < 256; item += G)
        hgrn_scan_item<0>(lds, item, (const bf16*)(ws + WS_HQ), (const bf16*)(ws + WS_HV), (const bf16*)(ws + WS_LFW), (const bf16*)(ws + WS_LBW), (const bf16*)(ws + WS_HVC), (const bf16*)(ws + WS_LFWC), (const bf16*)(ws + WS_LBWC), (bf16*)(ws + WS_OFW), (bf16*)(ws + WS_OBW), (float*)(ws + WS_U), (float*)(ws + WS_D)); }
    xcd_barrier(bar);
    { PHASE_IDS();
    for (int item = bx; item < 256; item += G)
        hgrn_scan_item<1>(lds, item, (const bf16*)(ws + WS_HQ), (const bf16*)(ws + WS_HV), (const bf16*)(ws + WS_LFW), (const bf16*)(ws + WS_LBW), (const bf16*)(ws + WS_HVC), (const bf16*)(ws + WS_LFWC), (const bf16*)(ws + WS_LBWC), (bf16*)(ws + WS_OFW), (bf16*)(ws + WS_OBW), (float*)(ws + WS_U), (float*)(ws + WS_D)); }
    xcd_barrier(bar);
    { PHASE_IDS(); hgrn_combine(gw, NGW, lane, (const bf16*)(ws + WS_OFW), (const bf16*)(ws + WS_OBW), (const bf16*)(ws + WS_HG), (ap->in[14]), (bf16*)(ws + WS_OG)); }
    xcd_barrier(bar);
    {
        PHASE_IDS();
        pg8::Gemm g{(const bf16*)(ws + WS_OG), Ho_t, NLAT, 1024, 1024}; pg8::StaticOrder S; S.init(NLAT, 1024, G, bx);
        pg8::EpiResidN E{(ap->out), HCTX, (ap->out), HCTX, MOD1 + 2 * 1024, XN, SS2, (ap->in[7]) + 1024, MOD1 + 4 * 1024, (LAS float*)(lds + 139264)};
        pg8::gemm_phase<pg8::EpiResidN, pg8::StaticOrder, PG8_ALIGN, PG8_SP2>(lds, g, S, E);
    }
    xcd_barrier(bar);
    {
        PHASE_IDS();
        pg8::Gemm g{XN, F1B_t, NLAT, 5632, 1024}; pg8::StaticOrder S; S.init(NLAT, 5632, G, bx);
        pg8::EpiSwiGLU E{(bf16*)(ws + WS_HID1), SS2, SHW2};
        pg8::gemm_phase<pg8::EpiSwiGLU, pg8::StaticOrder, PG8_ALIGN, PG8_SP2>(lds, g, S, E);
    }
    xcd_barrier(bar);
    {
        PHASE_IDS();
        pg8::Gemm g{(const bf16*)(ws + WS_HID1), F2B_t, NLAT, 1024, FFH}; pg8::StaticOrder S; S.init(NLAT, 1024, G, bx);
        if (G == 256) {
            pg8::EpiResidFinal E{(ap->out), (ap->out), MOD1 + 5 * 1024, SS3, (unsigned*)(ws + WS_BAR) + XCD_BAR_WORDS + 256, (ap->in[18]), (LAS float*)(lds + 139264)};
            pg8::gemm_phase<pg8::EpiResidFinal, pg8::StaticOrder, PG8_ALIGN, PG8_SP2>(lds, g, S, E);
        } else {
            pg8::EpiResid E{(ap->out), HCTX, (ap->out), HCTX, MOD1 + 5 * 1024};
            pg8::gemm_phase<pg8::EpiResid, pg8::StaticOrder, PG8_ALIGN, PG8_SP2>(lds, g, S, E);
        }
    }
    if (gridDim.x != 256) {
        xcd_barrier(bar);
        { PHASE_IDS(); final_norm_rows(gw, NGW, lane, (ap->out), (ap->in[18])); }
    }
}


extern "C" void kernel_launch(void* const* d_in, const int* in_sizes, int n_in, void* d_out, int out_size, void* d_ws, size_t ws_size, hipStream_t stream) {
    static int grid = 0;
    if (grid == 0) {
        if (n_in != 19 || out_size != NLAT * DM || ws_size < WS_END) { fprintf(stderr, "kernel_launch: unexpected shapes: n_in %d out %d ws %zu\n", n_in, out_size, ws_size); grid = -1; return; }
        int dev = 0, cus = 0, per_cu = 0;
        if (hipGetDevice(&dev) != hipSuccess || hipDeviceGetAttribute(&cus, hipDeviceAttributeMultiprocessorCount, dev) != hipSuccess) { grid = -1; return; }
        if (hipFuncSetAttribute((const void*)mk_fwd, hipFuncAttributeMaxDynamicSharedMemorySize, LDS_BYTES) != hipSuccess) { fprintf(stderr, "kernel_launch: hipFuncSetAttribute failed\n"); grid = -1; return; }
        if (hipOccupancyMaxActiveBlocksPerMultiprocessor(&per_cu, (const void*)mk_fwd, NWAVES * 64, LDS_BYTES) != hipSuccess || per_cu < 1) { fprintf(stderr, "kernel_launch: occupancy query says %d\n", per_cu); per_cu = 1; }
        (void)hipGetLastError();
        grid = cus;
    }
    if (grid < 0) return;
    if (hipMemsetAsync((char*)d_ws + WS_BAR, 0, (XCD_BAR_WORDS + 512) * 4, stream) != hipSuccess) { fprintf(stderr, "kernel_launch: memset of the barrier words failed\n"); return; }
    Args a{};
    for (int i = 0; i < 19; ++i) a.in[i] = (const float*)d_in[i];
    a.out = (float*)d_out; a.ws = (unsigned char*)d_ws;
    void* kargs[] = {&a};
    hipError_t e = hipLaunchCooperativeKernel((const void*)mk_fwd, dim3(grid), dim3(NWAVES * 64), kargs, LDS_BYTES, stream);
    if (e != hipSuccess) fprintf(stderr, "kernel_launch: cooperative launch failed: %s (grid %d)\n", hipGetErrorString(e), grid);
}
```

```cpp
#include <hip/hip_cooperative_groups.h>
namespace cg = cooperative_groups;
#include <hip/hip_runtime.h>
#include <cstdio>
#include <cstdint>
namespace pg8 {
#define PG8_LAS __attribute__((address_space(3)))
typedef unsigned short bf16_t;
typedef short bf16x8 __attribute__((ext_vector_type(8)));
typedef float f32x4 __attribute__((ext_vector_type(4)));
typedef unsigned u32x4 __attribute__((ext_vector_type(4)));
constexpr int BM = 256, BK = 64, HALF = 128, HTB = HALF * BK * 2  , STAGE_BYTES = 8 * HTB, NXCD = 8, WGM = 8;

__host__ __device__ __forceinline__ int lds_byte(int r, int c) { const int st = (r >> 4) * 2 + (c >> 5), rr = r & 15, cc = c & 31, ob = rr * 64 + cc * 2; return st * 1024 + (ob ^ (((ob >> 9) & 1) << 5)); }
__host__ __device__ __forceinline__ void stage_rc(int b, int& R, int& C) { const int st = b / 1024, sb = b % 1024, swz = sb ^ (((sb >> 9) & 1) << 5); R = (st >> 1) * 16 + swz / 64; C = (st & 1) * 32 + (swz % 64) / 2; }
__host__ __device__ __forceinline__ int perm32(int rho) { const int n = rho >> 4, i = rho & 15; return 8 * (i >> 2) + 4 * n + (i & 3); }

struct Unit { int pm, pn; };
struct Gemm { const bf16_t* A; const bf16_t* Bt; int M, N, K; };

struct StaticOrder {
    int nM, nN, nwg, G, c;
    __host__ __device__ void init(int M, int N, int G_, int c_) { nM = M / BM; nN = N / BM; nwg = nM * nN; G = G_; c = c_; }
    __host__ __device__ bool next(int i, Unit& u) const {
        const long L = (long)i * G + c; if (L >= nwg) return false;
        int wgid = (int)L; { const int q = nwg / NXCD, r = nwg % NXCD, xcd = wgid % NXCD, off = wgid / NXCD; wgid = (xcd < r ? xcd * (q + 1) : r * (q + 1) + (xcd - r) * q) + off; }
        const int nig = WGM * nN, gid = wgid / nig, fm = gid * WGM, gsz = (nM - fm) < WGM ? (nM - fm) : WGM;
        u.pm = fm + ((wgid % nig) % gsz); u.pn = (wgid % nig) / gsz; return true;
    }
    __device__ __forceinline__ void a_ready(const Unit&) const {}
    __device__ __forceinline__ void done(const Unit&) const {}
};

__device__ __forceinline__ unsigned cvt_pk_bf16(float lo, float hi) { unsigned r; asm volatile("v_cvt_pk_bf16_f32 %0, %1, %2" : "=v"(r) : "v"(lo), "v"(hi)); return r; }
typedef unsigned u32x2 __attribute__((ext_vector_type(2)));
constexpr int NLAT = 32768, KVROWS = 8448;

struct EpiQKV {
    static constexpr bool PERM = false, AFTER_DRAIN = false;
    bf16_t* Q; bf16_t* Kall; bf16_t* Vall; const float* qn; const float* kn; const float* ropec; const float* ropes; float qscale;
    __device__ __forceinline__ void operator()(const f32x4 (&acc)[2][2][4][2], const Unit& u, int wr, int wc, int fr, int fq) const {
        const int pn = u.pn; const bool isv = (pn == 5), isk = (pn == 4);
        const float* nw = isk ? kn : qn;
        f32x4 w[2][2];
#pragma unroll
        for (int bj = 0; bj < 2; ++bj)
#pragma unroll
            for (int n = 0; n < 2; ++n) w[bj][n] = *(const f32x4*)(nw + 32 * bj + 16 * n + 4 * fq);
        const float osc = (pn < 4) ? qscale : 1.f;
        float ifr[4];
        int fq2 = fq; asm volatile("" : "+v"(fq2));
#pragma unroll
        for (int j = 0; j < 4; ++j) ifr[j] = __builtin_amdgcn_exp2f(-0.83048202372184058696f * (float)(4 * fq2 + j)) * 0.15915494309189533577f;
#pragma unroll
        for (int ai = 0; ai < 2; ++ai)
#pragma unroll
            for (int m = 0; m < 4; ++m) {
                const int r = u.pm * BM + ai * HALF + wr * 64 + m * 16 + fr;
                const bool lat = r < NLAT; int b, t;
                if (lat) { b = r >> 13; t = r & 8191; } else { const int rc = r - NLAT; b = rc >> 8; t = rc & 255; }
                f32x4 x[2][2];
#pragma unroll
                for (int bj = 0; bj < 2; ++bj)
#pragma unroll
                    for (int n = 0; n < 2; ++n) x[bj][n] = acc[ai][bj][m][n];
                if (!isv) {
                    float ss = 0.f;
#pragma unroll
                    for (int bj = 0; bj < 2; ++bj)
#pragma unroll
                        for (int n = 0; n < 2; ++n) { const f32x4 v = x[bj][n]; ss += (v[0] * v[0] + v[1] * v[1]) + (v[2] * v[2] + v[3] * v[3]); }
                    ss += __shfl_xor(ss, 16); ss += __shfl_xor(ss, 32);
                    const float rs = rsqrtf(ss * (1.0f / 64.0f) + 1e-6f);
#pragma unroll
                    for (int bj = 0; bj < 2; ++bj)
#pragma unroll
                        for (int n = 0; n < 2; ++n) x[bj][n] = x[bj][n] * rs * w[bj][n];
                    if (lat) {
#pragma unroll
                        for (int bj = 0; bj < 2; ++bj) {
                            const int pos = bj == 0 ? (t >> 6) : (t & 63);
                            f32x4 c, s;
#pragma unroll
                            for (int j = 0; j < 4; ++j) { const float rev = __builtin_amdgcn_fractf((float)pos * ifr[j]); c[j] = __builtin_amdgcn_cosf(rev); s[j] = __builtin_amdgcn_sinf(rev); }
                            const f32x4 x1 = x[bj][0], x2 = x[bj][1];
                            x[bj][0] = x1 * c - x2 * s; x[bj][1] = x2 * c + x1 * s;
                        }
                    }
#pragma unroll
                    for (int bj = 0; bj < 2; ++bj)
#pragma unroll
                        for (int n = 0; n < 2; ++n) x[bj][n] = x[bj][n] * osc;
                }
                bf16_t* dst;
                if (pn < 4) dst = Q + (size_t)r * 1024 + pn * 256 + 64 * wc;
                else { const size_t kr = (size_t)b * KVROWS + (lat ? 256 + t : t); dst = (isk ? Kall : Vall) + kr * 256 + 64 * wc; }
#pragma unroll
                for (int bj = 0; bj < 2; ++bj)
#pragma unroll
                    for (int n = 0; n < 2; ++n) { u32x2 p; p.x = cvt_pk_bf16(x[bj][n][0], x[bj][n][1]); p.y = cvt_pk_bf16(x[bj][n][2], x[bj][n][3]); *(u32x2*)(dst + 32 * bj + 16 * n + 4 * fq) = p; }
                asm volatile("" ::: "memory");
            }
    }
};

struct EpiResid {
    static constexpr bool PERM = true, AFTER_DRAIN = false;
    const float* base_lat; const float* base_ctx; float* out_lat; float* out_ctx; const float* gate;
    __device__ __forceinline__ void operator()(const f32x4 (&acc)[2][2][4][2], const Unit& u, int wr, int wc, int fr, int fq) const {
        const int rowt = u.pm * BM; const bool lat = rowt < NLAT; const int vec = lat ? (rowt >> 13) : 4;
        const float* bp = lat ? base_lat + (size_t)rowt * 1024 : base_ctx + (size_t)(rowt - NLAT) * 1024;
        float* op = lat ? out_lat + (size_t)rowt * 1024 : out_ctx + (size_t)(rowt - NLAT) * 1024;
        const int col0 = u.pn * BM + wc * 32 + 8 * fq;
#pragma unroll
        for (int bj = 0; bj < 2; ++bj) {
            const int cc = col0 + bj * HALF;
            const f32x4 g0 = *(const f32x4*)(gate + vec * 6144 + cc), g1 = *(const f32x4*)(gate + vec * 6144 + cc + 4);
#pragma unroll
            for (int ai = 0; ai < 2; ++ai)
#pragma unroll
                for (int m = 0; m < 4; ++m) { const size_t off = (size_t)(ai * HALF + wr * 64 + m * 16 + fr) * 1024 + cc;
                    const f32x4 hn0 = *(const f32x4*)(bp + off) + g0 * acc[ai][bj][m][0], hn1 = *(const f32x4*)(bp + off + 4) + g1 * acc[ai][bj][m][1];
                    *(f32x4*)(op + off) = hn0; *(f32x4*)(op + off + 4) = hn1; }
            asm volatile("" ::: "memory");
        }
    }
};

struct EpiResidFinal {
    static constexpr bool PERM = true, AFTER_DRAIN = false;
    const float* base; float* out; const float* gate; float* SS; unsigned* cnt; const float* fw; PG8_LAS float* red;
    __device__ __forceinline__ void operator()(const f32x4 (&acc)[2][2][4][2], const Unit& u, int wr, int wc, int fr, int fq) const {
        const int rowt = u.pm * BM, vec = rowt >> 13;
        const float* bp = base + (size_t)rowt * 1024; float* op = out + (size_t)rowt * 1024;
        const int col0 = u.pn * BM + wc * 32 + 8 * fq;
        float ss[8];
#pragma unroll
        for (int q = 0; q < 8; ++q) ss[q] = 0.f;
#pragma unroll
        for (int bj = 0; bj < 2; ++bj) {
            const int cc = col0 + bj * HALF;
            const f32x4 g0 = *(const f32x4*)(gate + vec * 6144 + cc), g1 = *(const f32x4*)(gate + vec * 6144 + cc + 4);
#pragma unroll
            for (int ai = 0; ai < 2; ++ai)
#pragma unroll
                for (int m = 0; m < 4; ++m) { const size_t off = (size_t)(ai * HALF + wr * 64 + m * 16 + fr) * 1024 + cc;
                    const f32x4 hn0 = *(const f32x4*)(bp + off) + g0 * acc[ai][bj][m][0], hn1 = *(const f32x4*)(bp + off + 4) + g1 * acc[ai][bj][m][1];
                    *(f32x4*)(op + off) = hn0; *(f32x4*)(op + off + 4) = hn1;
                    ss[ai * 4 + m] += ((hn0[0] * hn0[0] + hn0[1] * hn0[1]) + (hn0[2] * hn0[2] + hn0[3] * hn0[3])) + ((hn1[0] * hn1[0] + hn1[1] * hn1[1]) + (hn1[2] * hn1[2] + hn1[3] * hn1[3])); }
            asm volatile("" ::: "memory");
        }
#pragma unroll
        for (int q = 0; q < 8; ++q) { float s = ss[q]; s += __shfl_xor(s, 16); s += __shfl_xor(s, 32);
            if (fq == 0) red[((q >> 2) * HALF + wr * 64 + (q & 3) * 16 + fr) * 4 + wc] = s; }
        asm volatile("s_waitcnt lgkmcnt(0)" ::: "memory"); __builtin_amdgcn_s_barrier(); asm volatile("" ::: "memory");
        const int lane = fq * 16 + fr;
        if (lane < 32) { const int row = (wr * 4 + wc) * 32 + lane; const f32x4 p = *(const PG8_LAS f32x4*)(red + row * 4); atomicAdd(SS + rowt + row, (p[0] + p[1]) + (p[2] + p[3])); }
        asm volatile("s_waitcnt vmcnt(0)" ::: "memory"); __builtin_amdgcn_s_barrier(); asm volatile("" ::: "memory");
        if (threadIdx.x == 0) __hip_atomic_fetch_add(cnt + u.pm, 1u, __ATOMIC_RELAXED, __HIP_MEMORY_SCOPE_AGENT);
        { unsigned sp = 0; while ((unsigned)__builtin_amdgcn_readfirstlane(__hip_atomic_load(cnt + u.pm, __ATOMIC_RELAXED, __HIP_MEMORY_SCOPE_AGENT)) < 4u) { __builtin_amdgcn_s_sleep(2); if (++sp > (1u << 22)) break; } }
        asm volatile("" ::: "memory");
#pragma unroll
        for (int q = 0; q < 8; ++q) { const unsigned b = __hip_atomic_load((const unsigned*)SS + rowt + (q >> 2) * HALF + wr * 64 + (q & 3) * 16 + fr, __ATOMIC_RELAXED, __HIP_MEMORY_SCOPE_AGENT);
            ss[q] = rsqrtf(__builtin_bit_cast(float, b) * (1.0f / 1024.0f) + 1e-6f); }
#pragma unroll
        for (int bj = 0; bj < 2; ++bj) {
            const int cc = col0 + bj * HALF;
            const f32x4 w0 = *(const f32x4*)(fw + cc), w1 = *(const f32x4*)(fw + cc + 4);
#pragma unroll
            for (int ai = 0; ai < 2; ++ai)
#pragma unroll
                for (int m = 0; m < 4; ++m) { const size_t off = (size_t)(ai * HALF + wr * 64 + m * 16 + fr) * 1024 + cc;
                    const f32x4 hn0 = *(const f32x4*)(op + off), hn1 = *(const f32x4*)(op + off + 4);
                    *(f32x4*)(op + off) = hn0 * ss[ai * 4 + m] * w0; *(f32x4*)(op + off + 4) = hn1 * ss[ai * 4 + m] * w1; }
            asm volatile("" ::: "memory");
        }
    }
};

struct EpiResidN {
    static constexpr bool PERM = true, AFTER_DRAIN = false;
    const float* base_lat; const float* base_ctx; float* out_lat; float* out_ctx; const float* gate;
    bf16_t* XNr; float* SS; const float* nw; const float* sc;
    PG8_LAS float* red;
    __device__ __forceinline__ void operator()(const f32x4 (&acc)[2][2][4][2], const Unit& u, int wr, int wc, int fr, int fq) const {
        const int rowt = u.pm * BM; const bool lat = rowt < NLAT; const int vec = lat ? (rowt >> 13) : 4;
        const float* bp = lat ? base_lat + (size_t)rowt * 1024 : base_ctx + (size_t)(rowt - NLAT) * 1024;
        float* op = lat ? out_lat + (size_t)rowt * 1024 : out_ctx + (size_t)(rowt - NLAT) * 1024;
        const int col0 = u.pn * BM + wc * 32 + 8 * fq;
        float ss[8];
#pragma unroll
        for (int q = 0; q < 8; ++q) ss[q] = 0.f;
#pragma unroll
        for (int bj = 0; bj < 2; ++bj) {
            const int cc = col0 + bj * HALF;
            const f32x4 g0 = *(const f32x4*)(gate + vec * 6144 + cc), g1 = *(const f32x4*)(gate + vec * 6144 + cc + 4);
            const f32x4 gm0 = *(const f32x4*)(nw + cc) * (*(const f32x4*)(sc + vec * 6144 + cc) + 1.0f), gm1 = *(const f32x4*)(nw + cc + 4) * (*(const f32x4*)(sc + vec * 6144 + cc + 4) + 1.0f);
#pragma unroll
            for (int ai = 0; ai < 2; ++ai)
#pragma unroll
                for (int m = 0; m < 4; ++m) { const int rl = ai * HALF + wr * 64 + m * 16 + fr; const size_t off = (size_t)rl * 1024 + cc;
                    const f32x4 hn0 = *(const f32x4*)(bp + off) + g0 * acc[ai][bj][m][0], hn1 = *(const f32x4*)(bp + off + 4) + g1 * acc[ai][bj][m][1];
                    *(f32x4*)(op + off) = hn0; *(f32x4*)(op + off + 4) = hn1;
                    ss[ai * 4 + m] += ((hn0[0] * hn0[0] + hn0[1] * hn0[1]) + (hn0[2] * hn0[2] + hn0[3] * hn0[3])) + ((hn1[0] * hn1[0] + hn1[1] * hn1[1]) + (hn1[2] * hn1[2] + hn1[3] * hn1[3]));
                    const f32x4 y0 = hn0 * gm0, y1 = hn1 * gm1; u32x4 p; p.x = cvt_pk_bf16(y0[0], y0[1]); p.y = cvt_pk_bf16(y0[2], y0[3]); p.z = cvt_pk_bf16(y1[0], y1[1]); p.w = cvt_pk_bf16(y1[2], y1[3]);
                    *(u32x4*)(XNr + (size_t)rowt * 1024 + off) = p; }
            asm volatile("" ::: "memory");
        }
#pragma unroll
        for (int q = 0; q < 8; ++q) { float s = ss[q]; s += __shfl_xor(s, 16); s += __shfl_xor(s, 32);
            if (fq == 0) red[((q >> 2) * HALF + wr * 64 + (q & 3) * 16 + fr) * 4 + wc] = s; }
        asm volatile("s_waitcnt lgkmcnt(0)" ::: "memory"); __builtin_amdgcn_s_barrier(); asm volatile("" ::: "memory");
        const int lane = fq * 16 + fr;
        if (lane < 32) { const int row = (wr * 4 + wc) * 32 + lane; const f32x4 p = *(const PG8_LAS f32x4*)(red + row * 4); atomicAdd(SS + rowt + row, (p[0] + p[1]) + (p[2] + p[3])); }
    }
};

__device__ __forceinline__ float silu_f(float a) { return a * __builtin_amdgcn_rcpf(1.0f + __expf(-a)); }
struct EpiSwiGLU {
    static constexpr bool PERM = true, AFTER_DRAIN = false;
    bf16_t* O; const float* SS; const float* shw;
    __device__ __forceinline__ void operator()(const f32x4 (&acc)[2][2][4][2], const Unit& u, int wr, int wc, int fr, int fq) const {
        const int row0 = u.pm * BM + wr * 64 + fr, hc0 = u.pn * HALF + wc * 32 + 8 * fq;
        const int vec = (u.pm * BM < NLAT) ? ((u.pm * BM) >> 13) : 4;
        f32x4 sa0 = {0.f, 0.f, 0.f, 0.f}, sa1 = sa0, su0 = sa0, su1 = sa0;
        if (SS) { const float* sp = shw + vec * 5632 + u.pn * BM + wc * 32 + 8 * fq; sa0 = *(const f32x4*)sp; sa1 = *(const f32x4*)(sp + 4); su0 = *(const f32x4*)(sp + HALF); su1 = *(const f32x4*)(sp + HALF + 4); }
        float rs8[8];
#pragma unroll
        for (int q = 0; q < 8; ++q) rs8[q] = SS ? SS[row0 + (q >> 2) * HALF + (q & 3) * 16] : 0.f;
#pragma unroll
        for (int q = 0; q < 8; ++q) rs8[q] = SS ? rsqrtf(rs8[q] * (1.0f / 1024.0f) + 1e-6f) : 1.0f;
#pragma unroll
        for (int ai = 0; ai < 2; ++ai)
#pragma unroll
            for (int m = 0; m < 4; ++m) { const int r = row0 + ai * HALF + m * 16; bf16_t* rowp = O + (size_t)r * 2816 + hc0;
                const float rs = rs8[ai * 4 + m];
                const f32x4 a0 = acc[ai][0][m][0] * rs + sa0, a1 = acc[ai][0][m][1] * rs + sa1, u0 = acc[ai][1][m][0] * rs + su0, u1 = acc[ai][1][m][1] * rs + su1;
                u32x4 wv; wv.x = cvt_pk_bf16(silu_f(a0[0]) * u0[0], silu_f(a0[1]) * u0[1]); wv.y = cvt_pk_bf16(silu_f(a0[2]) * u0[2], silu_f(a0[3]) * u0[3]);
                wv.z = cvt_pk_bf16(silu_f(a1[0]) * u1[0], silu_f(a1[1]) * u1[1]); wv.w = cvt_pk_bf16(silu_f(a1[2]) * u1[2], silu_f(a1[3]) * u1[3]);
                *(u32x4*)rowp = wv; }
    }
};

__device__ __forceinline__ unsigned pk_f16(float lo, float hi) { const _Float16 a = (_Float16)lo, b = (_Float16)hi; return (unsigned)__builtin_bit_cast(unsigned short, a) | ((unsigned)__builtin_bit_cast(unsigned short, b) << 16); }
constexpr size_t OFF_MiB = 1u << 20, OFF_HQ = 122 * OFF_MiB, OFF_HG = 186 * OFF_MiB, OFF_HV = 250 * OFF_MiB, OFF_LFW = 314 * OFF_MiB, OFF_LBW = 378 * OFF_MiB, OFF_HVC = 506 * OFF_MiB, OFF_LFWC = 508 * OFF_MiB, OFF_LBWC = 510 * OFF_MiB;
struct EpiHgrnIn {
    static constexpr bool PERM = true, AFTER_DRAIN = false;
    unsigned char* ws; const float* lbl; const float* SS; const float* shw;
    __device__ __forceinline__ void operator()(const f32x4 (&acc)[2][2][4][2], const Unit& u, int wr, int wc, int fr, int fq) const {
        const int type = u.pn >> 2; const bool lat = u.pm < (NLAT / BM);
        if (type < 2 && !lat) return;
        const size_t doff = lat ? (type == 0 ? OFF_HQ : type == 1 ? OFF_HG : type == 2 ? OFF_LFW : type == 3 ? OFF_LBW : OFF_HV)
                                : (type == 2 ? OFF_LFWC : type == 3 ? OFF_LBWC : OFF_HVC) - (size_t)NLAT * 2048;
        bf16_t* dstb = (bf16_t*)(ws + doff);
        const int row0 = u.pm * BM + wr * 64 + fr; const int vec = lat ? ((u.pm * BM) >> 13) : 4;
        float rs8[8];
#pragma unroll
        for (int q = 0; q < 8; ++q) rs8[q] = SS[row0 + (q >> 2) * HALF + (q & 3) * 16];
#pragma unroll
        for (int q = 0; q < 8; ++q) rs8[q] = rsqrtf(rs8[q] * (1.0f / 1024.0f) + 1e-6f);
#pragma unroll
        for (int bj = 0; bj < 2; ++bj) {
            const int ch = (u.pn & 3) * 256 + bj * HALF + wc * 32 + 8 * fq;
            const float* sp = shw + vec * 5120 + u.pn * BM + bj * HALF + wc * 32 + 8 * fq; const f32x4 sw0 = *(const f32x4*)sp, sw1 = *(const f32x4*)(sp + 4);
            float lb[8];
            if (type == 2 || type == 3) {
#pragma unroll
                for (int e = 0; e < 8; ++e) { const float l0 = lbl[ch + e], l1 = lbl[1024 + ch + e]; lb[e] = 1.0f / (1.0f + __expf(l0 - l1)); }
            } else {
#pragma unroll
                for (int e = 0; e < 8; ++e) lb[e] = 0.f;
            }
#pragma unroll
            for (int ai = 0; ai < 2; ++ai)
#pragma unroll
                for (int m = 0; m < 4; ++m) { const int r = row0 + ai * HALF + m * 16; bf16_t* p = dstb + (size_t)r * 1024 + ch;
                    const float rs = rs8[ai * 4 + m];
                    float v[8];
#pragma unroll
                    for (int e = 0; e < 8; ++e) v[e] = acc[ai][bj][m][e >> 2][e & 3] * rs + (e < 4 ? sw0[e & 3] : sw1[e & 3]);
                    u32x4 wv;
                    if (type == 2 || type == 3) {
#pragma unroll
                        for (int e = 0; e < 8; ++e) { const float sg = __builtin_amdgcn_rcpf(1.0f + __expf(-v[e])); v[e] = __logf(lb[e] + (1.0f - lb[e]) * sg); }
                        wv.x = pk_f16(v[0], v[1]); wv.y = pk_f16(v[2], v[3]); wv.z = pk_f16(v[4], v[5]); wv.w = pk_f16(v[6], v[7]);
                    } else { wv.x = cvt_pk_bf16(v[0], v[1]); wv.y = cvt_pk_bf16(v[2], v[3]); wv.z = cvt_pk_bf16(v[4], v[5]); wv.w = cvt_pk_bf16(v[6], v[7]); }
                    *(u32x4*)p = wv; if (m & 1) asm volatile("" ::: "memory"); }
        }
    }
};

__device__ __forceinline__ void publish_unit(unsigned* cnt) {
    asm volatile("s_waitcnt vmcnt(0)" ::: "memory"); __builtin_amdgcn_s_barrier(); asm volatile("" ::: "memory");
    if (threadIdx.x == 0) { __builtin_amdgcn_fence(__ATOMIC_RELEASE, "agent"); asm volatile("s_waitcnt vmcnt(0)" ::: "memory"); __hip_atomic_fetch_add(cnt, 1u, __ATOMIC_RELAXED, __HIP_MEMORY_SCOPE_AGENT); }
}
__device__ __forceinline__ void wave_wait_count(unsigned* cnt, unsigned want) {
    unsigned sp = 0;
    while ((unsigned)__builtin_amdgcn_readfirstlane(__hip_atomic_load(cnt, __ATOMIC_RELAXED, __HIP_MEMORY_SCOPE_AGENT)) < want) { __builtin_amdgcn_s_sleep(4); if (++sp > (1u << 22)) break; }
    __builtin_amdgcn_fence(__ATOMIC_ACQUIRE, "agent"); asm volatile("s_waitcnt vmcnt(0)" ::: "memory");
}
__device__ __forceinline__ void latent_up_unit(int q, Unit& u) { const int nN = 22, nM = 128, nig = WGM * nN, gid = q / nig, fm = gid * WGM, gsz = (nM - fm) < WGM ? (nM - fm) : WGM; u.pm = fm + ((q % nig) % gsz); u.pn = (q % nig) / gsz; }
__device__ __forceinline__ int up_pos_type(int x, int j, int& idx) {
    if (x == 0 && j < 16) { idx = j; return 1; }
    if (j >= 30 && j < 60 && x < 3) { const int uu = x * 30 + (j - 30); if (uu < 88) { idx = uu; return 2; } }
    if (j >= 330 && j < 336) { idx = x * 6 + (j - 330); return 3; }
    int sp = 0;
    if (x == 0) sp += 16;
    if (x < 3) { const int lim = x < 2 ? 30 : 28; int t = j - 30; t = t < 0 ? 0 : (t > lim ? lim : t); sp += t; }
    { int t = j - 330; t = t < 0 ? 0 : (t > 6 ? 6 : t); sp += t; }
    const int prev = x == 0 ? 0 : x == 1 ? 52 : x == 2 ? 88 : 122 + (x - 3) * 6;
    idx = x * 360 + j - sp - prev; return 0;
}
struct UpOrder {
    int c, i0, i1; unsigned* cntW; unsigned* cntU;
    __device__ __forceinline__ bool next(int k, Unit& u) const {
        const int i = i0 + k; if (i >= i1) return false;
        int idx; const int t = up_pos_type(c & 7, i * 30 + (c >> 3), idx);
        if (t == 2) { u.pm = 128 + idx / 22; u.pn = idx % 22; } else latent_up_unit(idx, u);
        return true;
    }
    __device__ __forceinline__ void a_ready(const Unit& u) const { if (u.pm >= 128) wave_wait_count(cntW, 16u); }
    __device__ __forceinline__ void done(const Unit& u) const { if (u.pm >= 128) publish_unit(cntU); }
};
struct UpOrderD {
    int d, i0, i1;
    __device__ __forceinline__ bool next(int k, Unit& u) const { const int i = i0 + k; if (i >= i1) return false; const int q = 2728 + i * 16 + d; if (q >= 2816) return false; latent_up_unit(q, u); return true; }
    __device__ __forceinline__ void a_ready(const Unit&) const {}
    __device__ __forceinline__ void done(const Unit&) const {}
};
struct OneUnit {
    int pm, pn; unsigned* cnt;
    __device__ __forceinline__ bool next(int i, Unit& u) const { if (i > 0) return false; u.pm = pm; u.pn = pn; return true; }
    __device__ __forceinline__ void a_ready(const Unit&) const {}
    __device__ __forceinline__ void done(const Unit&) const { if (cnt) publish_unit(cnt); }
};
template <class Epi, class Sched, bool ALIGN_EPI = false, bool SP2 = false>
__device__ __forceinline__ void gemm_phase(PG8_LAS unsigned char* lds, const Gemm g, const Sched& S, const Epi& E) {
    int tid_ = threadIdx.x; asm volatile("" : "+v"(tid_));
    const int tid = tid_, wid = __builtin_amdgcn_readfirstlane(tid >> 6), lane = tid & 63, wr = wid >> 2, wc = wid & 3, fr = lane & 15, fq = lane >> 4;
    const int K = g.K, nt = K / BK;
    unsigned voffA[2], voffB[2];
#pragma unroll
    for (int i = 0; i < 2; ++i) { int R, C; stage_rc(tid * 16 + i * 8192, R, C); const int Rb = Epi::PERM ? ((R & ~31) + perm32(R & 31)) : R;
        voffA[i] = (unsigned)(R * K + C) * 2u; voffB[i] = (unsigned)(Rb * K + C) * 2u; }
    const size_t kstep = (size_t)(BK * 2);
    const size_t hstep = (size_t)HALF * K * 2;
    const size_t tstep = 2 * hstep;
    const unsigned ldsw = (unsigned)wid * 1024u;
    const int aoff = lds_byte(wr * 64 + fr, fq * 8), boff = lds_byte(wc * 32 + fr, fq * 8);
#define PG8_SA(b, h) (((b) * 2 + (h)) * HTB)
#define PG8_SB(b, h) ((4 + (b) * 2 + (h)) * HTB)
#define PG8_STAGE(bufoff, gbase, voff) do { _Pragma("unroll") for (int _i = 0; _i < 2; ++_i) \
        __builtin_amdgcn_global_load_lds((const unsigned*)((const char*)(gbase) + (voff)[_i]), (PG8_LAS unsigned*)(lds + (bufoff) + ldsw + _i * 8192), 16, 0, 0); } while (0)
#define PG8_LDA(dst, b, h) do { _Pragma("unroll") for (int m = 0; m < 4; ++m) _Pragma("unroll") for (int k = 0; k < 2; ++k) dst[m][k] = *(const PG8_LAS bf16x8*)(lds + PG8_SA(b, h) + aoff + m * 2048 + k * 1024); } while (0)
#define PG8_LDB(dst, b, h) do { _Pragma("unroll") for (int n = 0; n < 2; ++n) _Pragma("unroll") for (int k = 0; k < 2; ++k) dst[n][k] = *(const PG8_LAS bf16x8*)(lds + PG8_SB(b, h) + boff + n * 2048 + k * 1024); } while (0)
#define PG8_MMA(ai, bj, At, Bt) do { __builtin_amdgcn_s_setprio(1); _Pragma("unroll") for (int m = 0; m < 4; ++m) _Pragma("unroll") for (int n = 0; n < 2; ++n) _Pragma("unroll") for (int k = 0; k < 2; ++k) \
        acc[ai][bj][m][n] = __builtin_amdgcn_mfma_f32_16x16x32_bf16(Bt[n][k], At[m][k], acc[ai][bj][m][n], 0, 0, 0); __builtin_amdgcn_s_setprio(0); } while (0)
#define PG8_WAIT_V(n) asm volatile("s_waitcnt vmcnt(" #n ")" ::: "memory")
#define PG8_WAIT_L(n) asm volatile("s_waitcnt lgkmcnt(" #n ")" ::: "memory")
#define PG8_BAR __builtin_amdgcn_s_barrier()
#define PG8_SCHED __builtin_amdgcn_sched_barrier(0)
    Unit cur, nxt; int ui = 0;
    if (!S.next(0, cur)) return;
    f32x4 acc[2][2][4][2];
#pragma unroll
    for (int a = 0; a < 2; ++a)
#pragma unroll
        for (int b = 0; b < 2; ++b)
#pragma unroll
            for (int m = 0; m < 4; ++m)
#pragma unroll
                for (int n = 0; n < 2; ++n) acc[a][b][m][n] = (f32x4){0.f, 0.f, 0.f, 0.f};
    bf16x8 At[4][2], B0[2][2], B1[2][2];
    const char* cA = (const char*)g.A + (size_t)cur.pm * tstep; const char* cB = (const char*)g.Bt + (size_t)cur.pn * tstep;
    S.a_ready(cur);
    if constexpr (SP2) {
        PG8_STAGE(PG8_SB(0, 0), cB, voffB); PG8_STAGE(PG8_SB(0, 1), cB + hstep, voffB); PG8_STAGE(PG8_SA(0, 0), cA, voffA); PG8_STAGE(PG8_SA(0, 1), cA + hstep, voffA);
        if (wr == 1) PG8_BAR;
        PG8_WAIT_V(2); PG8_BAR;
        PG8_STAGE(PG8_SB(1, 0), cB + kstep, voffB); PG8_STAGE(PG8_SA(1, 0), cA + kstep, voffA); PG8_STAGE(PG8_SB(1, 1), cB + hstep + kstep, voffB);
        PG8_WAIT_V(6); PG8_BAR;
    } else {
        PG8_STAGE(PG8_SB(0, 0), cB, voffB); PG8_STAGE(PG8_SA(0, 0), cA, voffA); PG8_STAGE(PG8_SB(0, 1), cB + hstep, voffB); PG8_STAGE(PG8_SA(0, 1), cA + hstep, voffA);
        if (wr == 1) PG8_BAR;
        PG8_WAIT_V(4); PG8_BAR;
        PG8_STAGE(PG8_SB(1, 0), cB + kstep, voffB); PG8_STAGE(PG8_SA(1, 0), cA + kstep, voffA); PG8_STAGE(PG8_SB(1, 1), cB + hstep + kstep, voffB);
        PG8_WAIT_V(6); PG8_BAR;
    }
    for (;;) {
        const bool has_next = S.next(ui + 1, nxt);
        const char* nA = has_next ? (const char*)g.A + (size_t)nxt.pm * tstep : cA; const char* nB = has_next ? (const char*)g.Bt + (size_t)nxt.pn * tstep : cB;
        for (int t = 0; t < nt; t += 2) {
            const bool last = (t == nt - 2);
            const char* a1 = cA + (size_t)(t + 1) * kstep;
            const char* a2 = last ? nA : cA + (size_t)(t + 2) * kstep; const char* b2 = last ? nB : cB + (size_t)(t + 2) * kstep;
            const char* a3 = a2 + kstep; const char* b3 = b2 + kstep;
            if (last && has_next) S.a_ready(nxt);
            if constexpr (SP2) {
            PG8_LDB(B0, 0, 0); PG8_LDB(B1, 0, 1); PG8_SCHED; PG8_LDA(At, 0, 0); PG8_STAGE(PG8_SA(1, 1), a1 + hstep, voffA);
            PG8_WAIT_V(8); PG8_WAIT_L(0); PG8_BAR; PG8_MMA(0, 0, At, B0); PG8_MMA(0, 1, At, B1); PG8_BAR; PG8_SCHED;
            PG8_LDA(At, 0, 1); PG8_STAGE(PG8_SB(0, 0), b2, voffB); PG8_STAGE(PG8_SB(0, 1), b2 + hstep, voffB); PG8_STAGE(PG8_SA(0, 0), a2, voffA);
            PG8_WAIT_V(8); PG8_WAIT_L(0); PG8_BAR; PG8_MMA(1, 0, At, B0); PG8_MMA(1, 1, At, B1); PG8_BAR; PG8_SCHED;
            PG8_LDB(B0, 1, 0); PG8_LDB(B1, 1, 1); PG8_SCHED; PG8_LDA(At, 1, 0); PG8_STAGE(PG8_SA(0, 1), a2 + hstep, voffA);
            PG8_WAIT_V(8); PG8_WAIT_L(0); PG8_BAR; PG8_MMA(0, 0, At, B0); PG8_MMA(0, 1, At, B1); PG8_BAR; PG8_SCHED;
            PG8_LDA(At, 1, 1); PG8_STAGE(PG8_SB(1, 0), b3, voffB); PG8_STAGE(PG8_SB(1, 1), b3 + hstep, voffB); PG8_STAGE(PG8_SA(1, 0), a3, voffA);
            PG8_WAIT_V(8); PG8_WAIT_L(0); PG8_BAR; PG8_MMA(1, 0, At, B0); PG8_MMA(1, 1, At, B1); PG8_BAR; PG8_SCHED;
            } else {
            PG8_LDB(B0, 0, 0); PG8_SCHED; PG8_LDA(At, 0, 0); PG8_STAGE(PG8_SA(1, 1), a1 + hstep, voffA);
            PG8_WAIT_L(8); PG8_BAR; PG8_WAIT_L(0); PG8_MMA(0, 0, At, B0); PG8_BAR; PG8_SCHED;
            PG8_LDB(B1, 0, 1); PG8_STAGE(PG8_SB(0, 0), b2, voffB);
            PG8_BAR; PG8_WAIT_L(0); PG8_MMA(0, 1, At, B1); PG8_BAR;
            PG8_LDA(At, 0, 1); PG8_STAGE(PG8_SA(0, 0), a2, voffA);
            PG8_BAR; PG8_WAIT_L(0); PG8_MMA(1, 0, At, B0); PG8_BAR; PG8_SCHED;
            PG8_STAGE(PG8_SB(0, 1), b2 + hstep, voffB);
            PG8_WAIT_V(6); PG8_BAR; PG8_MMA(1, 1, At, B1); PG8_BAR;
            PG8_LDB(B0, 1, 0); PG8_SCHED; PG8_LDA(At, 1, 0); PG8_STAGE(PG8_SA(0, 1), a2 + hstep, voffA);
            PG8_WAIT_L(8); PG8_BAR; PG8_WAIT_L(0); PG8_MMA(0, 0, At, B0); PG8_BAR; PG8_SCHED;
            PG8_LDB(B1, 1, 1); PG8_STAGE(PG8_SB(1, 0), b3, voffB);
            PG8_BAR; PG8_WAIT_L(0); PG8_MMA(0, 1, At, B1); PG8_BAR;
            PG8_LDA(At, 1, 1); PG8_STAGE(PG8_SA(1, 0), a3, voffA);
            PG8_BAR; PG8_WAIT_L(0); PG8_MMA(1, 0, At, B0); PG8_BAR; PG8_SCHED;
            PG8_STAGE(PG8_SB(1, 1), b3 + hstep, voffB);
            PG8_WAIT_V(6); PG8_BAR; PG8_MMA(1, 1, At, B1); PG8_BAR;
            }
        }
        if constexpr (ALIGN_EPI) { if (wr == 0) PG8_BAR; }
        if constexpr (!Epi::AFTER_DRAIN) { E(acc, cur, wr, wc, fr, fq); S.done(cur); }
        if (!has_next) break;
#pragma unroll
        for (int a = 0; a < 2; ++a)
#pragma unroll
            for (int b = 0; b < 2; ++b)
#pragma unroll
                for (int m = 0; m < 4; ++m)
#pragma unroll
                    for (int n = 0; n < 2; ++n) acc[a][b][m][n] = (f32x4){0.f, 0.f, 0.f, 0.f};
        cur = nxt; cA = nA; cB = nB; ++ui;
        if constexpr (ALIGN_EPI) { if (wr == 1) PG8_BAR; }
    }
    PG8_WAIT_V(0);
    if constexpr (!ALIGN_EPI) { if (wr == 0) PG8_BAR; }
    PG8_BAR;
    if constexpr (Epi::AFTER_DRAIN) { E.fused(acc, cur, wr, wc, fr, fq, lds, wid, lane); S.done(cur); }
#undef PG8_SA
#undef PG8_SB
#undef PG8_STAGE
#undef PG8_LDA
#undef PG8_LDB
#undef PG8_MMA
#undef PG8_WAIT_V
#undef PG8_WAIT_L
#undef PG8_BAR
#undef PG8_SCHED
}
}

#ifndef PG8_SP2
#define PG8_SP2 true
#endif
#ifndef PG8_ALIGN
#define PG8_ALIGN true
#endif
#include <hip/hip_bf16.h>
#include <cmath>
namespace attn_body {
using bf16=__hip_bfloat16;
using bf16x8=__attribute__((ext_vector_type(8)))short;
using s16x4=__attribute__((ext_vector_type(4)))short;
using f32x16=__attribute__((ext_vector_type(16)))float;
using u32x4=__attribute__((ext_vector_type(4)))unsigned;
constexpr int D=64,QP=1024,KVP=256;
constexpr int NW=8,QBLK=32,QB=QBLK*NW,KVBLK=64;
__device__ __forceinline__ int crow(int r,int hi){return (r&3)+8*(r>>2)+4*hi;}
#define SBAR() __builtin_amdgcn_sched_barrier(0)
constexpr int NSLOT=3, SLOTB=8192;
constexpr int LDS_K=0, LDS_V=NSLOT*SLOTB, LDS_WS=2*NSLOT*SLOTB, LDS_OST=LDS_WS+NW*64*4, LDS_BYTES=LDS_OST+NW*4096;
constexpr float C2=0.125f*1.4426950408889634f;
__device__ __forceinline__ void glds16(const void*gsrc,unsigned lds_dst){unsigned keep;
  asm volatile("s_mov_b32 %0, m0\n\ts_mov_b32 m0, %2\n\ts_nop 0\n\tglobal_load_lds_dwordx4 %1, off\n\ts_mov_b32 m0, %0":"=&s"(keep):"v"(gsrc),"s"(lds_dst):"memory");}
__device__ __forceinline__ float max3f(float a,float b,float c){float r;asm("v_max3_f32 %0, %1, %2, %3":"=v"(r):"v"(a),"v"(b),"v"(c));return r;}
__device__ __forceinline__ float max2f(float a,float b){float r;asm("v_max_f32_e32 %0, %1, %2":"=v"(r):"v"(a),"v"(b));return r;}
__device__ __forceinline__ float fadd_s(float a,float b){float r;asm("v_add_f32_e32 %0, %1, %2":"=v"(r):"v"(a),"v"(b));return r;}
__device__ __forceinline__ float fsub_s(float a,float b){float r;asm("v_sub_f32_e32 %0, %1, %2":"=v"(r):"v"(a),"v"(b));return r;}
typedef float f32x2_t __attribute__((ext_vector_type(2))); typedef __bf16 bf16x2_t __attribute__((ext_vector_type(2)));
__device__ __forceinline__ unsigned cvtpk_s(float lo,float hi){f32x2_t v={lo,hi};bf16x2_t b=__builtin_convertvector(v,bf16x2_t);return __builtin_bit_cast(unsigned,b);}
#define WAIT_BAR(N) asm volatile("s_waitcnt vmcnt(" #N ") lgkmcnt(0)\n\ts_barrier":::"memory")

__device__ __forceinline__ void qkt(f32x16&p0,f32x16&p1,const char*Kslot,const bf16x8*qr,const f32x16&negm,int r32,int hi){
  const char*kb=Kslot+hi*1024+r32*16;
  #pragma unroll
  for(int d0=0;d0<4;++d0){
    const bf16x8 b0=*reinterpret_cast<const bf16x8*>(kb+d0*2048);
    const bf16x8 b1=*reinterpret_cast<const bf16x8*>(kb+d0*2048+512);
    if(d0==0){p0=__builtin_amdgcn_mfma_f32_32x32x16_bf16(b0,qr[0],negm,0,0,0);p1=__builtin_amdgcn_mfma_f32_32x32x16_bf16(b1,qr[0],negm,0,0,0);}
    else{p0=__builtin_amdgcn_mfma_f32_32x32x16_bf16(b0,qr[d0],p0,0,0,0);p1=__builtin_amdgcn_mfma_f32_32x32x16_bf16(b1,qr[d0],p1,0,0,0);}}
}
typedef __attribute__((address_space(3))) const char* lds_cptr;
typedef short v4i16_t __attribute__((ext_vector_type(4)));
__device__ __forceinline__ void kload8(bf16x8*kf,lds_cptr kp){
  kf[0]=*(const __attribute__((address_space(3))) bf16x8*)(kp);      kf[1]=*(const __attribute__((address_space(3))) bf16x8*)(kp+512);
  kf[2]=*(const __attribute__((address_space(3))) bf16x8*)(kp+2048); kf[3]=*(const __attribute__((address_space(3))) bf16x8*)(kp+2560);
  kf[4]=*(const __attribute__((address_space(3))) bf16x8*)(kp+4096); kf[5]=*(const __attribute__((address_space(3))) bf16x8*)(kp+4608);
  kf[6]=*(const __attribute__((address_space(3))) bf16x8*)(kp+6144); kf[7]=*(const __attribute__((address_space(3))) bf16x8*)(kp+6656);
}
__device__ __forceinline__ void kload2(bf16x8*kf,lds_cptr kp,int j){ kf[2*j]=*(const __attribute__((address_space(3))) bf16x8*)(kp+j*2048); kf[2*j+1]=*(const __attribute__((address_space(3))) bf16x8*)(kp+j*2048+512); }
__device__ __forceinline__ s16x4 vtr(lds_cptr p){ return __builtin_bit_cast(s16x4,__builtin_amdgcn_ds_read_tr16_b64_v4i16((__attribute__((address_space(3))) v4i16_t*)p)); }
__device__ __forceinline__ float rowmax(const f32x16&p0,const f32x16&p1){
  float a=max3f(p0[0],p0[1],p1[0]),b=max3f(p0[2],p0[3],p1[1]);a=max3f(a,p1[2],p1[3]);
  #pragma unroll
  for(int r=4;r<16;r+=4){a=max3f(a,p0[r],p0[r+1]);b=max3f(b,p0[r+2],p0[r+3]);a=max3f(a,p1[r],p1[r+1]);b=max3f(b,p1[r+2],p1[r+3]);}
  const float m=max2f(a,b);
  auto rr=__builtin_amdgcn_permlane32_swap(__float_as_uint(m),__float_as_uint(m),false,false);
  return max2f(__uint_as_float(rr[0]),__uint_as_float(rr[1]));
}
__device__ __forceinline__ void pv(f32x16*o,int vb,bf16x8 pa0,bf16x8 pa1,bf16x8 pa2,bf16x8 pa3){
  #pragma unroll
  for(int d0=0;d0<2;++d0){s16x4 lo[4],hi[4];
    #pragma unroll
    for(int ks=0;ks<4;++ks){
      asm volatile("ds_read_b64_tr_b16 %0,%1 offset:%c2":"=&v"(lo[ks]):"v"(vb),"i"(d0*4096+ks*1024):"memory");
      asm volatile("ds_read_b64_tr_b16 %0,%1 offset:%c2":"=&v"(hi[ks]):"v"(vb),"i"(d0*4096+ks*1024+512):"memory");}
    asm volatile("s_waitcnt lgkmcnt(0)":::"memory");SBAR();
    #define PK(k) (bf16x8){lo[k][0],lo[k][1],lo[k][2],lo[k][3],hi[k][0],hi[k][1],hi[k][2],hi[k][3]}
    o[d0]=__builtin_amdgcn_mfma_f32_32x32x16_bf16(pa0,PK(0),o[d0],0,0,0);
    o[d0]=__builtin_amdgcn_mfma_f32_32x32x16_bf16(pa1,PK(1),o[d0],0,0,0);
    o[d0]=__builtin_amdgcn_mfma_f32_32x32x16_bf16(pa2,PK(2),o[d0],0,0,0);
    o[d0]=__builtin_amdgcn_mfma_f32_32x32x16_bf16(pa3,PK(3),o[d0],0,0,0);
    #undef PK
  }
}

#ifndef ATTN_STORE16
#define ATTN_STORE16(p,v) (*(u32x4*)(p)=(v))
#endif
template<int THRL> __device__ __forceinline__ void attn_unit(const bf16*Qu,const bf16*__restrict__ Kh,const bf16*__restrict__ Vh,bf16*Ou,const int NT,char*shm){
  int tid_=threadIdx.x; asm volatile("":"+v"(tid_)); const int tid=tid_,lane=tid&63,r32=lane&31,hi=lane>>5; const int wid=__builtin_amdgcn_readfirstlane(tid>>6);
  const bf16*Qw=Qu+(long)(wid*QBLK)*QP;
  const unsigned lds0=(unsigned)(uintptr_t)shm;
  float*wsf=(float*)(shm+LDS_WS)+wid*64;
  const bf16*ksrc=Kh+(long)lane*KVP+wid*8;
  const bf16*vsrc=Vh+(long)(16*(wid&3)+(lane>>2))*KVP+(wid>>2)*32+(lane&3)*8;
  const unsigned kdst=lds0+LDS_K+wid*1024, vdst=lds0+LDS_V+wid*1024;
  #define DMA_K(t,slot) glds16(ksrc+(long)(t)*KVBLK*KVP,(unsigned)__builtin_amdgcn_readfirstlane(kdst+(slot)))
  #define DMA_V(t,slot) glds16(vsrc+(long)(t)*KVBLK*KVP,(unsigned)__builtin_amdgcn_readfirstlane(vdst+(slot)))
  const int vb0=(int)(lds0+LDS_V)+((lane>>4)&1)*32+(lane&3)*8+(4*hi+((lane&15)>>2))*64;
  const char*Kbase=shm+LDS_K; bf16x8 kf[8];
  const lds_cptr shm3=(lds_cptr)shm; const lds_cptr kp0=shm3+LDS_K+hi*1024+r32*16; const lds_cptr vp0=shm3+LDS_V+((lane>>4)&1)*32+(lane&3)*8+(4*hi+((lane&15)>>2))*64;
  DMA_K(0,0);DMA_V(0,0);DMA_K(1,SLOTB);
  bf16x8 qr[4];
  #pragma unroll
  for(int d0=0;d0<4;++d0)qr[d0]=*reinterpret_cast<const bf16x8*>(&Qw[(long)r32*QP+d0*16+hi*8]);
  float mhat=0.f,l_reg=0.f;f32x16 o[2];o[0]=f32x16{};o[1]=f32x16{};f32x16 negm=f32x16{};asm volatile("":"+v"(negm));
  #define CMASK(P0,P1,t) do{}while(0)
  bool resc=false;
  #define START(P0,P1) do{ const float rm=rowmax(P0,P1); resc=false; \
    { const float dl=rm; mhat=fadd_s(mhat,dl); \
      _Pragma("unroll") for(int r=0;r<16;++r){P0[r]=fsub_s(P0[r],dl);P1[r]=fsub_s(P1[r],dl);} \
      _Pragma("unroll") for(int r=0;r<16;++r)negm[r]=-mhat; asm volatile("":"+v"(negm)); } \
    _Pragma("unroll") for(int r=0;r<16;++r)P0[r]=__builtin_amdgcn_exp2f(P0[r]); }while(0)
  #define RESC() do{ if(resc){ asm volatile("s_waitcnt lgkmcnt(0)":::"memory"); \
      _Pragma("unroll") for(int d_=0;d_<2;++d_) _Pragma("unroll") for(int r=0;r<16;++r)o[d_][r]*=wsf[crow(r,hi)]; } }while(0)
  f32x16 pA0,pA1,pB0,pB1;
  int sl_prev=0,sl_cur=0,sl_next=SLOTB;
  #define ROT() do{sl_prev=sl_cur;sl_cur=sl_next;sl_next=(sl_next==(NSLOT-1)*SLOTB)?0:sl_next+SLOTB;}while(0)
  DMA_K(2,2*SLOTB);
  WAIT_BAR(3);
  qkt(pA0,pA1,Kbase,qr,negm,r32,hi);asm volatile("s_nop 15\n\ts_nop 7":"+v"(pA0),"+v"(pA1));CMASK(pA0,pA1,0);
  START(pA0,pA1);
  _Pragma("unroll") for(int r=0;r<16;++r)pA1[r]=__builtin_amdgcn_exp2f(pA1[r]);
  WAIT_BAR(0);
  DMA_K(3,0);DMA_V(1,SLOTB);
  ROT();
  kload8(kf,kp0+sl_cur);
  WAIT_BAR(2);
  s16x4 vlo[8],vhi[8]; u32x4 pw0,pw1,pw2,pw3;
  #define PKW(P,B) cvtpk_s(P[B],P[B+1])
  #define PAF(k) __builtin_bit_cast(bf16x8,pw##k)
  #define VFR(i) (bf16x8){vlo[i][0],vlo[i][1],vlo[i][2],vlo[i][3],vhi[i][0],vhi[i][1],vhi[i][2],vhi[i][3]}
  #define PIN(x) asm volatile("":"+v"(x))
  #define MX3(a,b,c) __builtin_fmaxf(__builtin_fmaxf((a),(b)),(c))
  #define GAPA(MF,A0,A1,A2,A3,W0,W1,PW) do{ MF; sacc+=A0; sacc+=A1; sacc+=A2; sacc+=A3; PIN(sacc); W0; W1; PIN(PW); SBAR(); }while(0)
  #define EX(v) __builtin_amdgcn_exp2f(v)
  #define GAPB(MF,X,B) do{ MF; X[B]=EX(X[B]); X[B+1]=EX(X[B+1]); X[B+2]=EX(X[B+2]); X[B+3]=EX(X[B+3]); PIN(X); SBAR(); }while(0)
  #define VRD(i) do{ vlo[i]=vtr(vp_+(((i)>>2)*4096+((i)&3)*1024)); vhi[i]=vtr(vp_+(((i)>>2)*4096+((i)&3)*1024+512)); }while(0)
  #define KRD(G,j) do{ if(G){ kload2(kf,kp0+sl_next,j); SBAR(); } }while(0)
  #define STEP(C0,C1,P0,P1,t,GK,GV,GL) do{ SBAR(); \
    const lds_cptr vp_=vp0+sl_prev; \
    VRD(0); SBAR(); float sacc=(P0[0]+P0[1]); \
    GAPA(C0=__builtin_amdgcn_mfma_f32_32x32x16_bf16(kf[0],qr[0],negm,0,0,0), P0[2],P0[3],P0[4],P0[5],     pw0[0]=PKW(P0,0), pw0[1]=PKW(P0,2), pw0); \
    VRD(4); SBAR(); GAPA(C1=__builtin_amdgcn_mfma_f32_32x32x16_bf16(kf[1],qr[0],negm,0,0,0), P0[6],P0[7],P0[8],P0[9],     pw0[2]=PKW(P0,4), pw0[3]=PKW(P0,6), pw0); \
    VRD(1); SBAR(); GAPA(C0=__builtin_amdgcn_mfma_f32_32x32x16_bf16(kf[2],qr[1],C0,0,0,0),   P0[10],P0[11],P0[12],P0[13], pw1[0]=PKW(P0,8), pw1[1]=PKW(P0,10), pw1); \
    VRD(5); SBAR(); GAPA(C1=__builtin_amdgcn_mfma_f32_32x32x16_bf16(kf[3],qr[1],C1,0,0,0),   P0[14],P0[15],P1[0],P1[1],   pw1[2]=PKW(P0,12),pw1[3]=PKW(P0,14), pw1); \
    VRD(2); SBAR(); GAPA(C0=__builtin_amdgcn_mfma_f32_32x32x16_bf16(kf[4],qr[2],C0,0,0,0),   P1[2],P1[3],P1[4],P1[5],     pw2[0]=PKW(P1,0), pw2[1]=PKW(P1,2), pw2); \
    VRD(6); SBAR(); GAPA(C1=__builtin_amdgcn_mfma_f32_32x32x16_bf16(kf[5],qr[2],C1,0,0,0),   P1[6],P1[7],P1[8],P1[9],     pw2[2]=PKW(P1,4), pw2[3]=PKW(P1,6), pw2); \
    VRD(3); SBAR(); GAPA(C0=__builtin_amdgcn_mfma_f32_32x32x16_bf16(kf[6],qr[3],C0,0,0,0),   P1[10],P1[11],P1[12],P1[13], pw3[0]=PKW(P1,8), pw3[1]=PKW(P1,10), pw3); \
    VRD(7); SBAR(); GAPA(C1=__builtin_amdgcn_mfma_f32_32x32x16_bf16(kf[7],qr[3],C1,0,0,0),   P1[14],P1[15],0.f,0.f,       pw3[2]=PKW(P1,12),pw3[3]=PKW(P1,14), pw3); \
    l_reg+=sacc; \
    if(GK){DMA_K((t)+3,sl_cur);} if(GV){DMA_V((t)+1,sl_next);} \
    CMASK(C0,C1,t); \
    { float a=MX3(C0[0],C0[1],C1[0]),b=MX3(C0[2],C0[3],C1[1]); a=MX3(a,C1[2],C1[3]); \
      _Pragma("unroll") for(int r=4;r<16;r+=4){a=MX3(a,C0[r],C0[r+1]);b=MX3(b,C0[r+2],C0[r+3]);a=MX3(a,C1[r],C1[r+1]);b=MX3(b,C1[r+2],C1[r+3]);} \
      float rm=__builtin_fmaxf(a,b); { auto rr=__builtin_amdgcn_permlane32_swap(__float_as_uint(rm),__float_as_uint(rm),false,false); rm=__builtin_fmaxf(__uint_as_float(rr[0]),__uint_as_float(rr[1])); } \
      resc=false; \
      if(__builtin_expect(__any(rm>(float)THRL),0)){ const float dl=__builtin_fmaxf(rm,0.f); mhat+=dl; \
        _Pragma("unroll") for(int r=0;r<16;++r){C0[r]-=dl;C1[r]-=dl;} \
        _Pragma("unroll") for(int r=0;r<16;++r)negm[r]=-mhat; asm volatile("":"+v"(negm)); \
        const float f=__builtin_amdgcn_exp2f(-dl); l_reg*=f; if(hi==0)wsf[r32]=f; resc=true; } } \
    SBAR(); \
    GAPB(o[0]=__builtin_amdgcn_mfma_f32_32x32x16_bf16(PAF(0),VFR(0),o[0],0,0,0), C0,0); \
    GAPB(o[1]=__builtin_amdgcn_mfma_f32_32x32x16_bf16(PAF(0),VFR(4),o[1],0,0,0), C0,4); \
    KRD(GL,0); GAPB(o[0]=__builtin_amdgcn_mfma_f32_32x32x16_bf16(PAF(1),VFR(1),o[0],0,0,0), C0,8); \
    KRD(GL,1); GAPB(o[1]=__builtin_amdgcn_mfma_f32_32x32x16_bf16(PAF(1),VFR(5),o[1],0,0,0), C0,12); \
    KRD(GL,2); GAPB(o[0]=__builtin_amdgcn_mfma_f32_32x32x16_bf16(PAF(2),VFR(2),o[0],0,0,0), C1,0); \
    KRD(GL,3); GAPB(o[1]=__builtin_amdgcn_mfma_f32_32x32x16_bf16(PAF(2),VFR(6),o[1],0,0,0), C1,4); \
    GAPB(o[0]=__builtin_amdgcn_mfma_f32_32x32x16_bf16(PAF(3),VFR(3),o[0],0,0,0), C1,8); \
    GAPB(o[1]=__builtin_amdgcn_mfma_f32_32x32x16_bf16(PAF(3),VFR(7),o[1],0,0,0), C1,12); \
    }while(0)
  int t=1;
  #undef CMASK
  #define CMASK(P0,P1,t) do{}while(0)
  for(;t+5<NT;t+=2){
    STEP(pB0,pB1,pA0,pA1,t,true,true,true);     WAIT_BAR(2); RESC(); ROT();
    STEP(pA0,pA1,pB0,pB1,t+1,true,true,true);   WAIT_BAR(2); RESC(); ROT();
  }
  #undef CMASK
  #define CMASK(P0,P1,t) do{}while(0)
  #define ENDW(tt) do{ if((tt)+3<NT){WAIT_BAR(2);} else if((tt)+2<NT){WAIT_BAR(1);} else {WAIT_BAR(0);} }while(0)
  for(;t+1<NT;t+=2){
    STEP(pB0,pB1,pA0,pA1,t,(t+3<NT),(t+1<NT),(t+1<NT));       ENDW(t);   RESC(); ROT();
    STEP(pA0,pA1,pB0,pB1,t+1,(t+4<NT),(t+2<NT),(t+2<NT));     ENDW(t+1); RESC(); ROT();
  }
  STEP(pB0,pB1,pA0,pA1,NT-1,false,false,false); RESC();
  { float sacc=pB0[0]+pB0[1]; _Pragma("unroll") for(int r=2;r<16;++r)sacc+=pB0[r]; _Pragma("unroll") for(int r=0;r<16;++r)sacc+=pB1[r]; l_reg+=sacc;
    pw0=(u32x4){PKW(pB0,0),PKW(pB0,2),PKW(pB0,4),PKW(pB0,6)};pw1=(u32x4){PKW(pB0,8),PKW(pB0,10),PKW(pB0,12),PKW(pB0,14)};pw2=(u32x4){PKW(pB1,0),PKW(pB1,2),PKW(pB1,4),PKW(pB1,6)};pw3=(u32x4){PKW(pB1,8),PKW(pB1,10),PKW(pB1,12),PKW(pB1,14)};
    SBAR(); pv(o,vb0+sl_cur,PAF(0),PAF(1),PAF(2),PAF(3)); }
  #undef PKW
  #undef PAF
  #undef VFR
  #undef PIN
  #undef MX3
  #undef GAPA
  #undef GAPB
  #undef EX
  #undef VRD
  #undef KRD
  #undef STEP
  #undef ENDW
  {auto rr=__builtin_amdgcn_permlane32_swap(__float_as_uint(l_reg),__float_as_uint(l_reg),false,false);l_reg=__uint_as_float(rr[0])+__uint_as_float(rr[1]);}
  if(hi==0)wsf[32+r32]=l_reg;asm volatile("s_waitcnt lgkmcnt(0)":::"memory");
  float rli[16];
  #pragma unroll
  for(int r=0;r<16;++r)rli[r]=__builtin_amdgcn_rcpf(wsf[32+crow(r,hi)]);
  bf16*Ow=Ou+(long)(wid*QBLK)*QP;
  { bf16*stg=(bf16*)(shm+LDS_OST)+wid*2048;
    #pragma unroll
    for(int r=0;r<16;++r){const int orow=crow(r,hi);
      #pragma unroll
      for(int d0=0;d0<2;++d0)stg[orow*64+d0*32+r32]=__float2bfloat16(o[d0][r]*rli[r]);}
    asm volatile("s_waitcnt lgkmcnt(0)":::"memory");
    #pragma unroll
    for(int i=0;i<4;++i){const int row=i*8+(lane>>3),ch=lane&7; const u32x4 v=*(const u32x4*)(stg+row*64+ch*8); ATTN_STORE16(Ow+(long)row*QP+ch*8,v);} }
  asm volatile("s_waitcnt lgkmcnt(0)\n\ts_barrier":::"memory");
  #undef DMA_K
  #undef DMA_V
  #undef CMASK
  #undef START
  #undef RESC
  #undef ROT
}
constexpr int ATTN_LDS_BYTES=LDS_BYTES;
#undef SBAR
#undef WAIT_BAR
}
constexpr int NWAVES = 8;
constexpr int NLAT = 32768, NCTX = 1024, MALL = NLAT + NCTX, DM = 1024, SEQ = 8192, CTXL = 256, KVROWS = 8448, FFH = 2816;
constexpr size_t MiB = 1u << 20;
constexpr size_t WS_MOD = 0, WS_ROPE = 256 * 1024, WS_BAR = 280 * 1024, WS_SS = 296 * 1024, WS_SHW = 51 * MiB + 512 * 1024;
constexpr size_t WS_XN2 = 304 * MiB;
constexpr size_t WS_WQKV = 1 * MiB, WS_WO = 4 * MiB, WS_F1A = 6 * MiB, WS_F2A = 17 * MiB, WS_HIN = 23 * MiB, WS_HO = 33 * MiB, WS_F1B = 35 * MiB, WS_F2B = 46 * MiB, WS_HCTX = 52 * MiB, WS_XN = 56 * MiB;
constexpr size_t WS_U = 1 * MiB, WS_D = 18 * MiB;
constexpr size_t WS_QO = 122 * MiB, WS_K = 188 * MiB, WS_V = 205 * MiB, WS_HID0 = 122 * MiB;
constexpr size_t WS_HQ = 122 * MiB, WS_HG = 186 * MiB, WS_HV = 250 * MiB, WS_LFW = 314 * MiB, WS_LBW = 378 * MiB, WS_OFW = 442 * MiB, WS_OBW = 56 * MiB, WS_OG = 122 * MiB, WS_HID1 = 186 * MiB;
constexpr size_t WS_HVC = 506 * MiB, WS_LFWC = 508 * MiB, WS_LBWC = 510 * MiB;
constexpr size_t WS_END = 512 * MiB;
static_assert(WS_HQ == pg8::OFF_HQ && WS_HG == pg8::OFF_HG && WS_HV == pg8::OFF_HV && WS_LFW == pg8::OFF_LFW && WS_LBW == pg8::OFF_LBW && WS_HVC == pg8::OFF_HVC && WS_LFWC == pg8::OFF_LFWC && WS_LBWC == pg8::OFF_LBWC, "EpiHgrnIn offsets");
constexpr size_t F1_ELEMS = (size_t)2 * FFH * DM, F2_ELEMS = (size_t)DM * FFH;
constexpr int RING_BYTES = 131072, LDS_BYTES = 147456;

#define LAS __attribute__((address_space(3)))
typedef unsigned short bf16;
typedef unsigned v4u __attribute__((ext_vector_type(4)));
typedef unsigned v2u __attribute__((ext_vector_type(2)));
typedef float f32x4 __attribute__((ext_vector_type(4)));
typedef float f32x16 __attribute__((ext_vector_type(16)));
typedef short bf16x8 __attribute__((ext_vector_type(8)));
typedef float f32x2_t __attribute__((ext_vector_type(2)));
typedef __bf16 bf16x2_t __attribute__((ext_vector_type(2)));
__device__ __forceinline__ unsigned pk2(float lo, float hi) { f32x2_t v = {lo, hi}; bf16x2_t b = __builtin_convertvector(v, bf16x2_t); return __builtin_bit_cast(unsigned, b); }
__device__ __forceinline__ unsigned short f2bf(float f) { return (unsigned short)(pk2(f, 0.f) & 0xffffu); }
__device__ __forceinline__ float bf2f(unsigned short h) { return __builtin_bit_cast(float, (unsigned)h << 16); }
__device__ __forceinline__ float h2f(unsigned short h) { return (float)__builtin_bit_cast(_Float16, h); }
__device__ __forceinline__ float wave_sum(float v) {
#pragma unroll
    for (int o = 1; o < 64; o <<= 1) v += __shfl_xor(v, o);
    return v;
}
#define LDS_WAIT() asm volatile("s_waitcnt lgkmcnt(0)" ::: "memory")

template <int MODE> __device__ __forceinline__ int wmap(int o) {
    if (MODE == 1) { const int tile = o >> 8, w = o & 255, wc = w >> 6, bj = (w >> 5) & 1, e = w & 31; return tile * 256 + 128 * bj + 32 * wc + e; }
    if (MODE == 2) { const int half = o >= FFH ? 1 : 0, idx = o - half * FFH, pn = idx >> 7, q = idx & 127; return 256 * pn + 128 * half + q; }
    return o;
}
template <int MODE> __device__ __forceinline__ void p0_transpose_item(const float* W, int K, int N, bf16* WT, LAS float* scr, int item, int lane) {
    const int nblk = N / 32, kb = item / nblk, nb = item % nblk, k0 = 64 * kb, n0 = 32 * nb;
#pragma unroll 8
    for (int i = 0; i < 32; ++i) { const int kk = 2 * i + (lane >> 5); scr[kk * 33 + (lane & 31)] = W[(size_t)(k0 + kk) * N + n0 + (lane & 31)]; }
    LDS_WAIT(); asm volatile("" ::: "memory");
    const int c = lane & 7;
#pragma unroll
    for (int j = 0; j < 4; ++j) { const int n = (lane >> 3) + 8 * j; const LAS float* s = scr + (8 * c) * 33 + n;
        v4u o; o.x = pk2(s[0 * 33], s[1 * 33]); o.y = pk2(s[2 * 33], s[3 * 33]); o.z = pk2(s[4 * 33], s[5 * 33]); o.w = pk2(s[6 * 33], s[7 * 33]);
        *(v4u*)(WT + (size_t)wmap<MODE>(n0 + n) * K + k0 + 8 * c) = o; }
    LDS_WAIT(); asm volatile("" ::: "memory");
}

__device__ __forceinline__ void norm_rows(int gw, int NGW, int lane, const float* src_lat, const float* src_ctx, int r0, int nrows, const float* w, const float* modl, int shi, int sci, bf16* XN) {
    for (int r = r0 + gw; r < nrows; r += NGW) {
        const bool lat = r < NLAT; const float* src = lat ? src_lat + (size_t)r * DM : src_ctx + (size_t)(r - NLAT) * DM; const int vec = lat ? (r >> 13) : 4;
        const f32x4* xr = (const f32x4*)src + lane;
        f32x4 v[4]; float s = 0.f;
#pragma unroll
        for (int j = 0; j < 4; ++j) { v[j] = xr[64 * j]; s += (v[j].x * v[j].x + v[j].y * v[j].y) + (v[j].z * v[j].z + v[j].w * v[j].w); }
        const float rstd = rsqrtf(wave_sum(s) * (1.f / DM) + 1e-6f);
        const f32x4* wp = (const f32x4*)w + lane; const f32x4* shp = (const f32x4*)(modl + vec * 6144 + shi * 1024) + lane; const f32x4* scp = (const f32x4*)(modl + vec * 6144 + sci * 1024) + lane;
        unsigned long long* o8 = (unsigned long long*)(XN + (size_t)r * DM) + lane;
#pragma unroll
        for (int j = 0; j < 4; ++j) { const f32x4 ww = wp[64 * j], sh = shp[64 * j], sc = scp[64 * j]; const f32x4 y = v[j] * rstd * ww * (sc + 1.0f) + sh;
            o8[64 * j] = (unsigned long long)pk2(y.x, y.y) | ((unsigned long long)pk2(y.z, y.w) << 32); }
    }
}
__device__ __forceinline__ void final_norm_rows(int gw, int NGW, int lane, float* h, const float* w) {
    for (int r = gw; r < NLAT; r += NGW) {
        f32x4* xr = (f32x4*)(h + (size_t)r * DM) + lane;
        f32x4 v[4]; float s = 0.f;
#pragma unroll
        for (int j = 0; j < 4; ++j) { v[j] = xr[64 * j]; s += (v[j].x * v[j].x + v[j].y * v[j].y) + (v[j].z * v[j].z + v[j].w * v[j].w); }
        const float rstd = rsqrtf(wave_sum(s) * (1.f / DM) + 1e-6f);
        const f32x4* wp = (const f32x4*)w + lane;
#pragma unroll
        for (int j = 0; j < 4; ++j) xr[64 * j] = v[j] * rstd * wp[64 * j];
    }
}

constexpr int SC_Q0 = 0, SC_QM = 17408, SC_KE = 34816, SC_KT = 52224, SC_VT = 70656, SC_ST = 89088, SC_AT = 123904, SC_PS = 133120, SC_EL = 137216;
constexpr int NSTR = 272, TSTR = 144;
static_assert(SC_EL + 512 <= LDS_BYTES, "scan LDS map");
__device__ __forceinline__ int crow(int r, int hi) { return (r & 3) + 8 * (r >> 2) + 4 * hi; }
__device__ __forceinline__ int scan_row(int c, int s, int b, int dir) {
    if (c < 4) { const int idx = 64 * c + s; return NLAT + b * CTXL + (dir ? (CTXL - 1 - idx) : idx); }
    const int idx = 64 * (c - 4) + s; return b * SEQ + (dir ? (SEQ - 1 - idx) : idx);
}
#define MFMA32(a, b, c) __builtin_amdgcn_mfma_f32_32x32x16_bf16((a), (b), (c), 0, 0, 0)
template <int MODE> __device__ __forceinline__ void hgrn_scan_item(LAS unsigned char* lds, int item, const bf16* HQ, const bf16* HV, const bf16* LFW, const bf16* LBW, const bf16* HVc, const bf16* LFWc, const bf16* LBWc, bf16* OFW, bf16* OBW, float* UB, float* DB) {
    int tid_ = threadIdx.x; asm volatile("" : "+v"(tid_));
    const int tid = tid_, lane = tid & 63, wid = __builtin_amdgcn_readfirstlane(tid >> 6), r32 = lane & 31, hi = lane >> 5;
    const int seg = item & 3, stream = item >> 2, dir = stream & 1, h = (stream >> 1) & 7, b = stream >> 4;
    if (MODE == 0 && seg == 3) return;
    const bf16* LF = dir ? LBW : LFW; bf16* OX = dir ? OBW : OFW;
    const bf16* LFc = (dir ? LBWc : LFWc) - (size_t)NLAT * DM; const bf16* HVcb = HVc - (size_t)NLAT * DM;
    const int kp = lane, g = wid;
    const unsigned voff2 = (unsigned)(h * 128 + 2 * kp) * 2u;
    const int vt = wid & 3, th = wid >> 2;
    unsigned lfrA[8], qrA[8], vrA[8], lfrB[8], qrB[8], vrB[8];
#define SCAN_LOAD(LFR, QR, VR, c) do { const bf16* lfb_ = (c) < 4 ? LFc : LF; const bf16* hvb_ = (c) < 4 ? HVcb : HV; \
        _Pragma("unroll") for (int i = 0; i < 8; ++i) { const size_t r_ = (size_t)__builtin_amdgcn_readfirstlane(scan_row((c), 8 * g + i, b, dir)) * (DM * 2);     \
            LFR[i] = *(const unsigned*)((const char*)lfb_ + r_ + voff2); VR[i] = *(const unsigned*)((const char*)hvb_ + r_ + voff2); \
            if (MODE == 1) QR[i] = *(const unsigned*)((const char*)HQ + r_ + voff2);     } } while (0)
    f32x16 S[2];
#pragma unroll
    for (int j = 0; j < 2; ++j)
#pragma unroll
        for (int i = 0; i < 16; ++i) S[j][i] = 0.f;
    if (MODE == 1) {
        for (int js = 0; js < seg; ++js) { const int it = stream * 4 + js;
#pragma unroll
            for (int j = 0; j < 2; ++j)
#pragma unroll
                for (int i = 0; i < 16; ++i) S[j][i] = S[j][i] * DB[it * 128 + 32 * (2 * th + j) + crow(i, hi)] + UB[((size_t)it * 32 + j * 16 + i) * 512 + tid]; }
        *(LAS unsigned*)(lds + SC_AT + (tid >> 4) * TSTR + 64 + 4 * (tid & 15)) = 0u;
    }
    float dacc0 = 1.f, dacc1 = 1.f;
    const int c0 = 33 * seg;
    SCAN_LOAD(lfrA, qrA, vrA, c0); SCAN_LOAD(lfrB, qrB, vrB, c0 + 1);
    for (int cc = c0; cc < c0 + 33; cc += 2) {
      { const int c = cc;
        const bool has_out = (MODE == 1) && c >= 4;
        f32x2_t lf[8]; f32x2_t ps = {0.f, 0.f};
#pragma unroll
        for (int i = 0; i < 8; ++i) { lf[i] = (f32x2_t){h2f((unsigned short)(lfrA[i] & 0xffffu)), h2f((unsigned short)(lfrA[i] >> 16))}; ps += lf[i]; }
        *(LAS f32x2_t*)(lds + SC_PS + (g * 128 + 2 * kp) * 4) = ps;
        LDS_WAIT(); __builtin_amdgcn_s_barrier(); asm volatile("" ::: "memory");
        {
            f32x2_t pre = {0.f, 0.f}, Lmid = {0.f, 0.f}, Lend = {0.f, 0.f};
#pragma unroll
            for (int gg = 0; gg < 8; ++gg) { const f32x2_t p = *(const LAS f32x2_t*)(lds + SC_PS + (gg * 128 + 2 * kp) * 4); if (gg < g) pre += p; if (gg < 4) Lmid += p; Lend += p; }
            const f32x2_t eLmid = {__expf(Lmid.x), __expf(Lmid.y)}, eEndMid = {__expf(Lend.x - Lmid.x), __expf(Lend.y - Lmid.y)};
            if (g == 0) { const f32x2_t el = {__expf(Lend.x), __expf(Lend.y)}; *(LAS f32x2_t*)(lds + SC_EL + 2 * kp * 4) = el; dacc0 *= el.x; dacc1 *= el.y; }
            f32x2_t E = {__expf(pre.x - Lmid.x), __expf(pre.y - Lmid.y)};
            unsigned kt0[4], kt1[4];
#pragma unroll
            for (int i = 0; i < 8; ++i) {
                const f32x2_t f = {__expf(lf[i].x), __expf(lf[i].y)};
                E = E * f;
                const f32x2_t re = {__builtin_amdgcn_rcpf(E.x), __builtin_amdgcn_rcpf(E.y)};
                const f32x2_t ke = (1.0f - f) * re, kend = ke * eEndMid;
                const int s = 8 * g + i;
                if (has_out) {
                    const f32x2_t q = {bf2f((unsigned short)(qrA[i] & 0xffffu)), bf2f((unsigned short)(qrA[i] >> 16))};
                    const f32x2_t qm = q * E, q0 = qm * eLmid;
                    *(LAS unsigned*)(lds + SC_Q0 + s * NSTR + 4 * kp) = pk2(q0.x, q0.y);
                    *(LAS unsigned*)(lds + SC_QM + s * NSTR + 4 * kp) = pk2(qm.x, qm.y);
                    *(LAS unsigned*)(lds + SC_KE + s * NSTR + 4 * kp) = pk2(ke.x, ke.y);
                }
                const unsigned kd = pk2(kend.x, kend.y);
                if (i & 1) { kt0[i >> 1] |= kd << 16; kt1[i >> 1] |= kd & 0xffff0000u; } else { kt0[i >> 1] = kd & 0xffffu; kt1[i >> 1] = kd >> 16; }
            }
            *(LAS v4u*)(lds + SC_KT + (2 * kp) * TSTR + 16 * g) = (v4u){kt0[0], kt0[1], kt0[2], kt0[3]};
            *(LAS v4u*)(lds + SC_KT + (2 * kp + 1) * TSTR + 16 * g) = (v4u){kt1[0], kt1[1], kt1[2], kt1[3]};
            v4u v0, v1;
#pragma unroll
            for (int i2 = 0; i2 < 4; ++i2) { v0[i2] = (vrA[2 * i2] & 0xffffu) | (vrA[2 * i2 + 1] << 16); v1[i2] = (vrA[2 * i2] >> 16) | (vrA[2 * i2 + 1] & 0xffff0000u); }
            *(LAS v4u*)(lds + SC_VT + (2 * kp) * TSTR + 16 * g) = v0;
            *(LAS v4u*)(lds + SC_VT + (2 * kp + 1) * TSTR + 16 * g) = v1;
            if (has_out) {
#pragma unroll
                for (int j = 0; j < 2; ++j)
#pragma unroll
                    for (int g4 = 0; g4 < 4; ++g4)
                        *(LAS v2u*)(lds + SC_ST + (32 * vt + r32) * NSTR + (32 * (2 * th + j) + 8 * g4 + 4 * hi) * 2) = (v2u){pk2(S[j][4 * g4], S[j][4 * g4 + 1]), pk2(S[j][4 * g4 + 2], S[j][4 * g4 + 3])};
            }
        }
        if (c + 2 < c0 + 33) SCAN_LOAD(lfrA, qrA, vrA, c + 2);
        LDS_WAIT(); __builtin_amdgcn_s_barrier(); asm volatile("" ::: "memory");
        f32x16 o;
#pragma unroll
        for (int i = 0; i < 16; ++i) o[i] = 0.f;
        if (has_out && wid < 3) {
            const int si = wid >> 1, ti = (wid + 1) >> 1;
            f32x16 a;
#pragma unroll
            for (int i = 0; i < 16; ++i) a[i] = 0.f;
#pragma unroll
            for (int kk = 0; kk < 8; ++kk) {
                const bf16x8 A = *(const LAS bf16x8*)(lds + SC_KE + (32 * si + r32) * NSTR + (16 * kk + 8 * hi) * 2);
                const bf16x8 B = *(const LAS bf16x8*)(lds + SC_QM + (32 * ti + r32) * NSTR + (16 * kk + 8 * hi) * 2);
                a = MFMA32(A, B, a);
            }
            const int t = 32 * ti + r32;
#pragma unroll
            for (int g4 = 0; g4 < 4; ++g4) {
                const int s0 = 32 * si + 8 * g4 + 4 * hi;
                const float a0 = (s0 + 0 <= t) ? a[4 * g4 + 0] : 0.f, a1 = (s0 + 1 <= t) ? a[4 * g4 + 1] : 0.f, a2 = (s0 + 2 <= t) ? a[4 * g4 + 2] : 0.f, a3 = (s0 + 3 <= t) ? a[4 * g4 + 3] : 0.f;
                *(LAS v2u*)(lds + SC_AT + t * TSTR + s0 * 2) = (v2u){pk2(a0, a1), pk2(a2, a3)};
            }
        }
        {
            const LAS float* EL = (const LAS float*)(lds + SC_EL);
#pragma unroll
            for (int j = 0; j < 2; ++j) {
                const int kq = 2 * th + j;
#pragma unroll
                for (int i = 0; i < 16; ++i) S[j][i] *= EL[32 * kq + crow(i, hi)];
#pragma unroll
                for (int kk = 0; kk < 4; ++kk) {
                    const bf16x8 A = *(const LAS bf16x8*)(lds + SC_KT + (32 * kq + r32) * TSTR + (16 * kk + 8 * hi) * 2);
                    const bf16x8 B = *(const LAS bf16x8*)(lds + SC_VT + (32 * vt + r32) * TSTR + (16 * kk + 8 * hi) * 2);
                    S[j] = MFMA32(A, B, S[j]);
                }
            }
            if (has_out) {
#pragma unroll
                for (int kk = 0; kk < 8; ++kk) {
                    const bf16x8 A = *(const LAS bf16x8*)(lds + SC_Q0 + (32 * th + r32) * NSTR + (16 * kk + 8 * hi) * 2);
                    const bf16x8 B = *(const LAS bf16x8*)(lds + SC_ST + (32 * vt + r32) * NSTR + (16 * kk + 8 * hi) * 2);
                    o = MFMA32(A, B, o);
                }
            }
        }
        LDS_WAIT(); __builtin_amdgcn_s_barrier(); asm volatile("" ::: "memory");
        if (has_out) {
#pragma unroll
            for (int kk = 0; kk < 4; ++kk) {
                const bf16x8 A = *(const LAS bf16x8*)(lds + SC_AT + (32 * th + r32) * TSTR + (16 * kk + 8 * hi) * 2);
                const bf16x8 B = *(const LAS bf16x8*)(lds + SC_VT + (32 * vt + r32) * TSTR + (16 * kk + 8 * hi) * 2);
                o = MFMA32(A, B, o);
            }
#pragma unroll
            for (int i = 0; i < 16; ++i) *(LAS unsigned short*)(lds + SC_Q0 + wid * 2560 + crow(i, hi) * 80 + 2 * r32) = f2bf(o[i]);
            LDS_WAIT(); asm volatile("" ::: "memory");
#pragma unroll
            for (int j2 = 0; j2 < 2; ++j2) { const int tl = j2 * 16 + (lane >> 2), pc = lane & 3; const v4u pv = *(const LAS v4u*)(lds + SC_Q0 + wid * 2560 + tl * 80 + 16 * pc);
                const size_t r_ = (size_t)scan_row(c, 32 * th + tl, b, dir); *(v4u*)(OX + r_ * DM + h * 128 + 32 * vt + 8 * pc) = pv; }
        }
          }
      if (cc + 1 < c0 + 33) { const int c = cc + 1;
        const bool has_out = (MODE == 1) && c >= 4;
        f32x2_t lf[8]; f32x2_t ps = {0.f, 0.f};
#pragma unroll
        for (int i = 0; i < 8; ++i) { lf[i] = (f32x2_t){h2f((unsigned short)(lfrB[i] & 0xffffu)), h2f((unsigned short)(lfrB[i] >> 16))}; ps += lf[i]; }
        *(LAS f32x2_t*)(lds + SC_PS + (g * 128 + 2 * kp) * 4) = ps;
        LDS_WAIT(); __builtin_amdgcn_s_barrier(); asm volatile("" ::: "memory");
        {
            f32x2_t pre = {0.f, 0.f}, Lmid = {0.f, 0.f}, Lend = {0.f, 0.f};
#pragma unroll
            for (int gg = 0; gg < 8; ++gg) { const f32x2_t p = *(const LAS f32x2_t*)(lds + SC_PS + (gg * 128 + 2 * kp) * 4); if (gg < g) pre += p; if (gg < 4) Lmid += p; Lend += p; }
            const f32x2_t eLmid = {__expf(Lmid.x), __expf(Lmid.y)}, eEndMid = {__expf(Lend.x - Lmid.x), __expf(Lend.y - Lmid.y)};
            if (g == 0) { const f32x2_t el = {__expf(Lend.x), __expf(Lend.y)}; *(LAS f32x2_t*)(lds + SC_EL + 2 * kp * 4) = el; dacc0 *= el.x; dacc1 *= el.y; }
            f32x2_t E = {__expf(pre.x - Lmid.x), __expf(pre.y - Lmid.y)};
            unsigned kt0[4], kt1[4];
#pragma unroll
            for (int i = 0; i < 8; ++i) {
                const f32x2_t f = {__expf(lf[i].x), __expf(lf[i].y)};
                E = E * f;
                const f32x2_t re = {__builtin_amdgcn_rcpf(E.x), __builtin_amdgcn_rcpf(E.y)};
                const f32x2_t ke = (1.0f - f) * re, kend = ke * eEndMid;
                const int s = 8 * g + i;
                if (has_out) {
                    const f32x2_t q = {bf2f((unsigned short)(qrB[i] & 0xffffu)), bf2f((unsigned short)(qrB[i] >> 16))};
                    const f32x2_t qm = q * E, q0 = qm * eLmid;
                    *(LAS unsigned*)(lds + SC_Q0 + s * NSTR + 4 * kp) = pk2(q0.x, q0.y);
                    *(LAS unsigned*)(lds + SC_QM + s * NSTR + 4 * kp) = pk2(qm.x, qm.y);
                    *(LAS unsigned*)(lds + SC_KE + s * NSTR + 4 * kp) = pk2(ke.x, ke.y);
                }
                const unsigned kd = pk2(kend.x, kend.y);
                if (i & 1) { kt0[i >> 1] |= kd << 16; kt1[i >> 1] |= kd & 0xffff0000u; } else { kt0[i >> 1] = kd & 0xffffu; kt1[i >> 1] = kd >> 16; }
            }
            *(LAS v4u*)(lds + SC_KT + (2 * kp) * TSTR + 16 * g) = (v4u){kt0[0], kt0[1], kt0[2], kt0[3]};
            *(LAS v4u*)(lds + SC_KT + (2 * kp + 1) * TSTR + 16 * g) = (v4u){kt1[0], kt1[1], kt1[2], kt1[3]};
            v4u v0, v1;
#pragma unroll
            for (int i2 = 0; i2 < 4; ++i2) { v0[i2] = (vrB[2 * i2] & 0xffffu) | (vrB[2 * i2 + 1] << 16); v1[i2] = (vrB[2 * i2] >> 16) | (vrB[2 * i2 + 1] & 0xffff0000u); }
            *(LAS v4u*)(lds + SC_VT + (2 * kp) * TSTR + 16 * g) = v0;
            *(LAS v4u*)(lds + SC_VT + (2 * kp + 1) * TSTR + 16 * g) = v1;
            if (has_out) {
#pragma unroll
                for (int j = 0; j < 2; ++j)
#pragma unroll
                    for (int g4 = 0; g4 < 4; ++g4)
                        *(LAS v2u*)(lds + SC_ST + (32 * vt + r32) * NSTR + (32 * (2 * th + j) + 8 * g4 + 4 * hi) * 2) = (v2u){pk2(S[j][4 * g4], S[j][4 * g4 + 1]), pk2(S[j][4 * g4 + 2], S[j][4 * g4 + 3])};
            }
        }
        if (c + 2 < c0 + 33) SCAN_LOAD(lfrB, qrB, vrB, c + 2);
        LDS_WAIT(); __builtin_amdgcn_s_barrier(); asm volatile("" ::: "memory");
        f32x16 o;
#pragma unroll
        for (int i = 0; i < 16; ++i) o[i] = 0.f;
        if (has_out && wid < 3) {
            const int si = wid >> 1, ti = (wid + 1) >> 1;
            f32x16 a;
#pragma unroll
            for (int i = 0; i < 16; ++i) a[i] = 0.f;
#pragma unroll
            for (int kk = 0; kk < 8; ++kk) {
                const bf16x8 A = *(const LAS bf16x8*)(lds + SC_KE + (32 * si + r32) * NSTR + (16 * kk + 8 * hi) * 2);
                const bf16x8 B = *(const LAS bf16x8*)(lds + SC_QM + (32 * ti + r32) * NSTR + (16 * kk + 8 * hi) * 2);
                a = MFMA32(A, B, a);
            }
            const int t = 32 * ti + r32;
#pragma unroll
            for (int g4 = 0; g4 < 4; ++g4) {
                const int s0 = 32 * si + 8 * g4 + 4 * hi;
                const float a0 = (s0 + 0 <= t) ? a[4 * g4 + 0] : 0.f, a1 = (s0 + 1 <= t) ? a[4 * g4 + 1] : 0.f, a2 = (s0 + 2 <= t) ? a[4 * g4 + 2] : 0.f, a3 = (s0 + 3 <= t) ? a[4 * g4 + 3] : 0.f;
                *(LAS v2u*)(lds + SC_AT + t * TSTR + s0 * 2) = (v2u){pk2(a0, a1), pk2(a2, a3)};
            }
        }
        {
            const LAS float* EL = (const LAS float*)(lds + SC_EL);
#pragma unroll
            for (int j = 0; j < 2; ++j) {
                const int kq = 2 * th + j;
#pragma unroll
                for (int i = 0; i < 16; ++i) S[j][i] *= EL[32 * kq + crow(i, hi)];
#pragma unroll
                for (int kk = 0; kk < 4; ++kk) {
                    const bf16x8 A = *(const LAS bf16x8*)(lds + SC_KT + (32 * kq + r32) * TSTR + (16 * kk + 8 * hi) * 2);
                    const bf16x8 B = *(const LAS bf16x8*)(lds + SC_VT + (32 * vt + r32) * TSTR + (16 * kk + 8 * hi) * 2);
                    S[j] = MFMA32(A, B, S[j]);
                }
            }
            if (has_out) {
#pragma unroll
                for (int kk = 0; kk < 8; ++kk) {
                    const bf16x8 A = *(const LAS bf16x8*)(lds + SC_Q0 + (32 * th + r32) * NSTR + (16 * kk + 8 * hi) * 2);
                    const bf16x8 B = *(const LAS bf16x8*)(lds + SC_ST + (32 * vt + r32) * NSTR + (16 * kk + 8 * hi) * 2);
                    o = MFMA32(A, B, o);
                }
            }
        }
        LDS_WAIT(); __builtin_amdgcn_s_barrier(); asm volatile("" ::: "memory");
        if (has_out) {
#pragma unroll
            for (int kk = 0; kk < 4; ++kk) {
                const bf16x8 A = *(const LAS bf16x8*)(lds + SC_AT + (32 * th + r32) * TSTR + (16 * kk + 8 * hi) * 2);
                const bf16x8 B = *(const LAS bf16x8*)(lds + SC_VT + (32 * vt + r32) * TSTR + (16 * kk + 8 * hi) * 2);
                o = MFMA32(A, B, o);
            }
#pragma unroll
            for (int i = 0; i < 16; ++i) *(LAS unsigned short*)(lds + SC_Q0 + wid * 2560 + crow(i, hi) * 80 + 2 * r32) = f2bf(o[i]);
            LDS_WAIT(); asm volatile("" ::: "memory");
#pragma unroll
            for (int j2 = 0; j2 < 2; ++j2) { const int tl = j2 * 16 + (lane >> 2), pc = lane & 3; const v4u pv = *(const LAS v4u*)(lds + SC_Q0 + wid * 2560 + tl * 80 + 16 * pc);
                const size_t r_ = (size_t)scan_row(c, 32 * th + tl, b, dir); *(v4u*)(OX + r_ * DM + h * 128 + 32 * vt + 8 * pc) = pv; }
        }
          }
    }
#undef SCAN_LOAD
    if (MODE == 0) {
#pragma unroll
        for (int j = 0; j < 2; ++j)
#pragma unroll
            for (int i = 0; i < 16; ++i) UB[((size_t)item * 32 + j * 16 + i) * 512 + tid] = S[j][i];
        if (g == 0) { DB[item * 128 + 2 * kp] = dacc0; DB[item * 128 + 2 * kp + 1] = dacc1; }
    }
    LDS_WAIT(); __builtin_amdgcn_s_barrier(); asm volatile("" ::: "memory");
}
__device__ __forceinline__ void hgrn_combine(int gw, int NGW, int lane, const bf16* OFW, const bf16* OBW, const bf16* HG, const float* onorm, bf16* OG) {
    for (int r = gw; r < NLAT; r += NGW) {
        const size_t off = (size_t)r * DM + lane * 16;
        float o[16], gt[16];
#pragma unroll
        for (int j = 0; j < 2; ++j) { const v4u a = *(const v4u*)(OFW + off + 8 * j), bq = *(const v4u*)(OBW + off + 8 * j), gg = *(const v4u*)(HG + off + 8 * j);
#pragma unroll
            for (int e = 0; e < 4; ++e) { o[8 * j + 2 * e] = bf2f((unsigned short)(a[e] & 0xffffu)) + bf2f((unsigned short)(bq[e] & 0xffffu)); o[8 * j + 2 * e + 1] = bf2f((unsigned short)(a[e] >> 16)) + bf2f((unsigned short)(bq[e] >> 16));
                gt[8 * j + 2 * e] = bf2f((unsigned short)(gg[e] & 0xffffu)); gt[8 * j + 2 * e + 1] = bf2f((unsigned short)(gg[e] >> 16)); } }
        float ss = 0.f;
#pragma unroll
        for (int e = 0; e < 16; ++e) ss += o[e] * o[e];
        ss += __shfl_xor(ss, 1); ss += __shfl_xor(ss, 2); ss += __shfl_xor(ss, 4);
        const float rstd = rsqrtf(ss * (1.f / 128.f) + 1e-6f);
        unsigned pk[8];
#pragma unroll
        for (int e = 0; e < 8; ++e) { const float w0 = onorm[lane * 16 + 2 * e], w1 = onorm[lane * 16 + 2 * e + 1];
            const float y0 = o[2 * e] * rstd * w0 * __builtin_amdgcn_rcpf(1.0f + __expf(-gt[2 * e])), y1 = o[2 * e + 1] * rstd * w1 * __builtin_amdgcn_rcpf(1.0f + __expf(-gt[2 * e + 1])); pk[e] = pk2(y0, y1); }
        *(v4u*)(OG + off) = (v4u){pk[0], pk[1], pk[2], pk[3]}; *(v4u*)(OG + off + 8) = (v4u){pk[4], pk[5], pk[6], pk[7]};
    }
}

#define XB_TMO      128
#define XB_XCNT(j)  (256  + 64 * (j))
#define XB_XSUB(j)  (1280 + 64 * (j))
#define XB_XGEN(j)  (2304 + 64 * (j))
#define XB_TOP      3328
#define XB_TOPGEN   3392
#define XCD_BAR_WORDS 3456
#define XB_SPIN_CAP (1u << 18)

__device__ __forceinline__ unsigned xb_ld(unsigned* p)              { return __hip_atomic_load(p, __ATOMIC_RELAXED, __HIP_MEMORY_SCOPE_AGENT); }
__device__ __forceinline__ unsigned xb_add(unsigned* p, unsigned v) { return __hip_atomic_fetch_add(p, v, __ATOMIC_RELAXED, __HIP_MEMORY_SCOPE_AGENT); }
__device__ __forceinline__ unsigned xb_xcc_id() { return (unsigned)__builtin_amdgcn_s_getreg((3 << 11) | 20) & 0xFu; }
#define XB_SPIN(cond, bar) do { unsigned _sp = 0; while (cond) { __builtin_amdgcn_s_sleep(1); \
    if ((++_sp & 255u) == 0u) { if (xb_ld(&(bar)[XB_TMO])) break; if (_sp > XB_SPIN_CAP) { atomicAdd(&(bar)[XB_TMO], 1u); break; } } } } while (0)

struct XcdBarrier {
    unsigned* bar; unsigned x;
    volatile LAS unsigned* st;
};

__device__ __forceinline__ XcdBarrier xcd_barrier_post(unsigned* bar, volatile LAS unsigned* st) {
    XcdBarrier b; b.bar = bar; b.x = xb_xcc_id(); b.st = st;
    if (threadIdx.x == 0) (void)xb_add(&bar[XB_XCNT(b.x)], 1u);
    return b;
}
__device__ __forceinline__ void xcd_barrier_complete(unsigned* bar, unsigned x, unsigned& nloc, unsigned& nx) {
    const unsigned G = gridDim.x * gridDim.y * gridDim.z;
    unsigned sum, cnt, mine, sp = 0u;
    for (;;) {
        sum = 0u; cnt = 0u; mine = 0u;
#pragma unroll
        for (unsigned j = 0; j < 16; ++j) { const unsigned c = xb_ld(&bar[XB_XCNT(j)]); sum += c; cnt += (c > 0u) ? 1u : 0u; mine = (j == x) ? c : mine; }
        if (sum == G) break;
        __builtin_amdgcn_s_sleep(1);
        if ((++sp & 255u) == 0u) { if (xb_ld(&bar[XB_TMO])) break; if (sp > XB_SPIN_CAP) { atomicAdd(&bar[XB_TMO], 1u); break; } }
    }
    nloc = mine > 0u ? mine : 1u; nx = cnt > 0u ? cnt : 1u;
}

__device__ __forceinline__ void xcd_barrier(const XcdBarrier& b) {
    asm volatile("s_waitcnt vmcnt(0)" ::: "memory");
    __syncthreads();
    if (threadIdx.x == 0) {
        unsigned* bar = b.bar;
        __builtin_amdgcn_s_waitcnt(0);
        unsigned nloc = b.st[0], nx = b.st[1];
        if (nloc == 0u) { xcd_barrier_complete(bar, b.x, nloc, nx); b.st[0] = nloc; b.st[1] = nx; }
        const unsigned old = xb_add(&bar[XB_XSUB(b.x)], 1u);
        const unsigned gen = old / nloc;
        if (old + 1u == (gen + 1u) * nloc) {
            __builtin_amdgcn_fence(__ATOMIC_RELEASE, "agent");
            asm volatile("s_waitcnt vmcnt(0)" ::: "memory");
            const unsigned og = xb_add(&bar[XB_TOP], 1u);
            const unsigned tg = og / nx;
            if (og + 1u == (tg + 1u) * nx) xb_add(&bar[XB_TOPGEN], 1u);
            else XB_SPIN(xb_ld(&bar[XB_TOPGEN]) == tg, bar);
            __builtin_amdgcn_fence(__ATOMIC_ACQUIRE, "agent");
            xb_add(&bar[XB_XGEN(b.x)], 1u);
            asm volatile("s_waitcnt vmcnt(0)" ::: "memory");
        } else {
            XB_SPIN(xb_ld(&bar[XB_XGEN(b.x)]) == gen, bar);
            __builtin_amdgcn_fence(__ATOMIC_ACQUIRE, "agent");
            asm volatile("s_waitcnt vmcnt(0)" ::: "memory");
        }
    }
    __syncthreads();
}

struct Args { const float* in[19]; float* out; unsigned char* ws; };
typedef __attribute__((address_space(4))) Args KArgs;
__device__ __forceinline__ int fresh_v(int t) { asm volatile("" : "+v"(t)); return t; }
__device__ __forceinline__ int fresh_s(int t) { asm volatile("" : "+s"(t)); return t; }
__global__ void __launch_bounds__(NWAVES * 64, 2) mk_fwd(Args args) {
    extern __shared__ __attribute__((aligned(16))) unsigned char lds_raw[];
    LAS unsigned char* lds = (LAS unsigned char*)lds_raw;
    cg::grid_group grid = cg::this_grid();
#define PHASE_IDS() const int tid = fresh_v((int)threadIdx.x), lane = tid & 63, wave = __builtin_amdgcn_readfirstlane(tid >> 6); (void)lane; (void)wave; \
    const int G = fresh_s((int)gridDim.x), bx = fresh_s((int)blockIdx.x); const int vcu = (G % 8 == 0) ? (bx % 8) * (G / 8) + bx / 8 : bx; (void)vcu; \
    const int gw = vcu * NWAVES + wave, NGW = G * NWAVES; (void)gw; (void)NGW; \
    const KArgs* ap = (const KArgs*)__builtin_amdgcn_kernarg_segment_ptr(); asm volatile("" : "+s"(ap)); unsigned char* ws = ap->ws; (void)ws
#define IN(k) (ap->in[k])
#define MOD ((float*)(ws + WS_MOD))
#define ROPEC ((float*)(ws + WS_ROPE))
#define ROPES (ROPEC + 128 * 16)
#define Wqkv_t ((bf16*)(ws + WS_WQKV))
#define Wo_t ((bf16*)(ws + WS_WO))
#define Hin_t ((bf16*)(ws + WS_HIN))
#define Ho_t ((bf16*)(ws + WS_HO))
#define F1A_t ((bf16*)(ws + WS_F1A))
#define F2A_t ((bf16*)(ws + WS_F2A))
#define F1B_t ((bf16*)(ws + WS_F1B))
#define F2B_t ((bf16*)(ws + WS_F2B))
#define HCTX ((float*)(ws + WS_HCTX))
#define XN ((bf16*)(ws + WS_XN))
#define QO ((bf16*)(ws + WS_QO))
#define KB ((bf16*)(ws + WS_K))
#define VB ((bf16*)(ws + WS_V))
#define MOD1 (MOD + 5 * 6144)
#define SS0 ((float*)(ws + WS_SS))
#define SS1 (SS0 + MALL)
#define SS2 (SS1 + MALL)
#define SS3 (SS2 + MALL)
#define SHW0 ((float*)(ws + WS_SHW))
#define SHW1 (SHW0 + 5 * 5632)
#define SHW2 (SHW1 + 5 * 5120)
    if (args.ws == nullptr) grid.sync();
    volatile LAS unsigned* bst = (volatile LAS unsigned*)(lds + LDS_BYTES - 16);
    if (threadIdx.x == 0) { bst[0] = 0u; bst[1] = 0u; }
    __syncthreads();
    const XcdBarrier bar = xcd_barrier_post((unsigned*)(args.ws + WS_BAR), bst);
    {
        PHASE_IDS();
        for (int i = (bx * NWAVES * 64) + tid; i < 4 * MALL; i += G * NWAVES * 64) SS0[i] = 0.f;
        LAS float* sl = (LAS float*)(lds + 73728);
        for (int i = tid; i < 5 * 1024; i += NWAVES * 64) { const float v = i < 4096 ? (ap->in[1])[i] : (ap->in[3])[i - 4096]; sl[i] = v / (1.0f + __expf(-v)); }
        __syncthreads();
        for (int it = gw; it < 768; it += NGW) {
            const int l = it / 384, n0 = (it % 384) * 16, cg4 = lane & 3, ks = lane >> 2;
            const float* W = (ap->in[4]) + (size_t)l * 1024 * 6144 + n0 + 4 * cg4;
            f32x4 acc[5];
#pragma unroll
            for (int v = 0; v < 5; ++v) acc[v] = (f32x4){0.f, 0.f, 0.f, 0.f};
#pragma unroll 8
            for (int i = 0; i < 64; ++i) { const int kk = i * 16 + ks; const f32x4 w4 = *(const f32x4*)(W + (size_t)kk * 6144);
#pragma unroll
                for (int v = 0; v < 5; ++v) acc[v] += w4 * sl[v * 1024 + kk]; }
#pragma unroll
            for (int v = 0; v < 5; ++v)
#pragma unroll
                for (int e = 0; e < 4; ++e) { float a = acc[v][e]; a += __shfl_xor(a, 4); a += __shfl_xor(a, 8); a += __shfl_xor(a, 16); a += __shfl_xor(a, 32); acc[v][e] = a; }
            if (ks == 0) { const f32x4 bb = *(const f32x4*)((ap->in[5]) + l * 6144 + n0 + 4 * cg4);
#pragma unroll
                for (int v = 0; v < 5; ++v) *(f32x4*)(MOD + (size_t)(l * 5 + v) * 6144 + n0 + 4 * cg4) = acc[v] + bb; }
        }
        for (int idx = bx * (NWAVES * 64) + tid; idx < 2048; idx += G * NWAVES * 64) {
            const int pos = idx >> 4, f = idx & 15;
            double inv = 1.0; for (int j = 0; j < f; ++j) inv *= 0.56234132519034908;
            const double ang = (double)pos * inv, TWO_PI = 6.283185307179586476925;
            const double kq = __builtin_rint(ang / TWO_PI); const double rr = ang - kq * TWO_PI, r2 = rr * rr;
            double cs = 1.0, sn = rr, tc = 1.0, tsn = rr;
            for (int n = 1; n <= 14; ++n) { tc *= -r2 / (double)((2 * n - 1) * (2 * n)); tsn *= -r2 / (double)((2 * n) * (2 * n + 1)); cs += tc; sn += tsn; }
            ROPEC[idx] = (float)cs; ROPES[idx] = (float)sn;
        }
        LAS float* scr = (LAS float*)(lds + wave * 8448);
        constexpr int I_QKV = 16 * 48, I_O = 16 * 32, I_HIN = 16 * 160, I_HO = 16 * 32, I_F1 = 16 * 176, I_F2 = 44 * 32;
        constexpr int NITEMS = I_QKV + I_O + I_HIN + I_HO + 2 * I_F1 + 2 * I_F2;
        for (int it = gw; it < NITEMS; it += NGW) {
            int r = it;
            if (r < I_QKV) { p0_transpose_item<1>((ap->in[8]), 1024, 1536, Wqkv_t, scr, r, lane); continue; } r -= I_QKV;
            if (r < I_O) { p0_transpose_item<0>((ap->in[11]), 1024, 1024, Wo_t, scr, r, lane); continue; } r -= I_O;
            if (r < I_HIN) { p0_transpose_item<0>((ap->in[12]), 1024, 5120, Hin_t, scr, r, lane); continue; } r -= I_HIN;
            if (r < I_HO) { p0_transpose_item<0>((ap->in[15]), 1024, 1024, Ho_t, scr, r, lane); continue; } r -= I_HO;
            if (r < I_F1) { p0_transpose_item<2>((ap->in[16]), 1024, 5632, F1A_t, scr, r, lane); continue; } r -= I_F1;
            if (r < I_F1) { p0_transpose_item<2>((ap->in[16]) + (size_t)1024 * 5632, 1024, 5632, F1B_t, scr, r, lane); continue; } r -= I_F1;
            if (r < I_F2) { p0_transpose_item<0>((ap->in[17]), 2816, 1024, F2A_t, scr, r, lane); continue; } r -= I_F2;
            p0_transpose_item<0>((ap->in[17]) + (size_t)2816 * 1024, 2816, 1024, F2B_t, scr, r, lane);
        }
    }
    xcd_barrier(bar);
    { PHASE_IDS();
      const bool qcu = (G == 256) && bx < 24;
      if (qcu) {
          const int pm = 128 + bx / 6, pn = bx % 6;
          norm_rows(wave, NWAVES, lane, (ap->in[0]), (ap->in[2]), pm * 256, pm * 256 + 256, (ap->in[6]), MOD, 0, 1, XN);
          asm volatile("s_waitcnt vmcnt(0)" ::: "memory"); __syncthreads();
          if (tid == 0) { __builtin_amdgcn_fence(__ATOMIC_ACQUIRE, "agent"); asm volatile("s_waitcnt vmcnt(0)" ::: "memory"); }
          __syncthreads();
          pg8::Gemm gq{XN, Wqkv_t, MALL, 1536, 1024}; pg8::OneUnit Sq{pm, pn, nullptr};
          pg8::EpiQKV Eq{QO, KB, VB, (ap->in[9]), (ap->in[10]), ROPEC, ROPES, attn_body::C2};
          pg8::gemm_phase<pg8::EpiQKV, pg8::OneUnit, PG8_ALIGN, PG8_SP2>(lds, gq, Sq, Eq);
      } else {
      const int gw1 = (G == 256) ? (bx - 24) * NWAVES + wave : gw, NGW1 = (G == 256) ? 232 * NWAVES : NGW;
      norm_rows(gw1, NGW1, lane, (ap->in[0]), (ap->in[2]), 0, (G == 256) ? NLAT : MALL, (ap->in[6]), MOD, 0, 1, XN);
      for (int site = 0; site < 3; ++site) {
          const bf16* Bt = site == 0 ? F1A_t : site == 1 ? Hin_t : F1B_t; const int N = site == 1 ? 5120 : 5632;
          const float* shv = (site == 0 ? MOD : MOD1) + (site == 1 ? 0 : 3) * 1024; float* dst = site == 0 ? SHW0 : site == 1 ? SHW1 : SHW2;
          for (int n = gw1; n < N; n += NGW1) {
              const v4u w0 = *(const v4u*)(Bt + (size_t)n * 1024 + lane * 16), w1 = *(const v4u*)(Bt + (size_t)n * 1024 + lane * 16 + 8);
              float wf[16];
#pragma unroll
              for (int e = 0; e < 4; ++e) { wf[2 * e] = bf2f((unsigned short)(w0[e] & 0xffffu)); wf[2 * e + 1] = bf2f((unsigned short)(w0[e] >> 16)); wf[8 + 2 * e] = bf2f((unsigned short)(w1[e] & 0xffffu)); wf[8 + 2 * e + 1] = bf2f((unsigned short)(w1[e] >> 16)); }
#pragma unroll
              for (int v = 0; v < 5; ++v) { const float* sp = shv + v * 6144 + lane * 16; float a = 0.f;
#pragma unroll
                  for (int e4 = 0; e4 < 4; ++e4) { const f32x4 s4 = *(const f32x4*)(sp + 4 * e4); a += (wf[4 * e4] * s4[0] + wf[4 * e4 + 1] * s4[1]) + (wf[4 * e4 + 2] * s4[2] + wf[4 * e4 + 3] * s4[3]); }
                  a = wave_sum(a); if (lane == 0) dst[v * N + n] = a; }
          }
      }
      }
    }
    xcd_barrier(bar);
    {
        PHASE_IDS();
        const int Mrows = (G == 256) ? NLAT : MALL;
        pg8::Gemm g{XN, Wqkv_t, Mrows, 1536, 1024}; pg8::StaticOrder S; S.init(Mrows, 1536, G, bx);
        pg8::EpiQKV E{QO, KB, VB, (ap->in[9]), (ap->in[10]), ROPEC, ROPES, attn_body::C2};
        pg8::gemm_phase<pg8::EpiQKV, pg8::StaticOrder, PG8_ALIGN, PG8_SP2>(lds, g, S, E);
    }
    xcd_barrier(bar);
    {
        PHASE_IDS();
        for (int i = 0; i < 8; ++i) {
            const int u = i * 256 + vcu; if (u >= 2048 || G != 256) break;
            const int combo = u >> 7, idx = u & 127, b = combo >> 2, kvh = combo & 3, hq = idx >> 5, qb = idx & 31, h = kvh * 4 + hq;
            const attn_body::bf16* Qu = (const attn_body::bf16*)QO + ((size_t)b * SEQ + qb * 256) * 1024 + h * 64;
            const attn_body::bf16* Kh = (const attn_body::bf16*)KB + (size_t)b * KVROWS * 256 + kvh * 64;
            const attn_body::bf16* Vh = (const attn_body::bf16*)VB + (size_t)b * KVROWS * 256 + kvh * 64;
            attn_body::attn_unit<8>(Qu, Kh, Vh, (attn_body::bf16*)XN + (Qu - (const attn_body::bf16*)QO), 132, (char*)lds_raw);
        }
        if (G != 256) for (int u = bx; u < 2048; u += G) {
            const int combo = u >> 7, idx = u & 127, b = combo >> 2, kvh = combo & 3, hq = idx >> 5, qb = idx & 31, h = kvh * 4 + hq;
            const attn_body::bf16* Qu = (const attn_body::bf16*)QO + ((size_t)b * SEQ + qb * 256) * 1024 + h * 64;
            const attn_body::bf16* Kh = (const attn_body::bf16*)KB + (size_t)b * KVROWS * 256 + kvh * 64;
            const attn_body::bf16* Vh = (const attn_body::bf16*)VB + (size_t)b * KVROWS * 256 + kvh * 64;
            attn_body::attn_unit<8>(Qu, Kh, Vh, (attn_body::bf16*)XN + (Qu - (const attn_body::bf16*)QO), 132, (char*)lds_raw);
        }
        for (int u = bx; u < 64; u += G) {
            const int b = u >> 4, h = u & 15, kvh = h >> 2;
            const attn_body::bf16* Qu = (const attn_body::bf16*)QO + ((size_t)NLAT + b * CTXL) * 1024 + h * 64;
            const attn_body::bf16* Kh = (const attn_body::bf16*)KB + (size_t)b * KVROWS * 256 + kvh * 64;
            const attn_body::bf16* Vh = (const attn_body::bf16*)VB + (size_t)b * KVROWS * 256 + kvh * 64;
            attn_body::attn_unit<8>(Qu, Kh, Vh, (attn_body::bf16*)XN + (Qu - (const attn_body::bf16*)QO), 4, (char*)lds_raw);
        }
    }
    xcd_barrier(bar);
    {
        PHASE_IDS();
        const int Mrows = (G == 256) ? NLAT : MALL;
        pg8::Gemm g{XN, Wo_t, Mrows, 1024, 1024}; pg8::StaticOrder S; S.init(Mrows, 1024, G, bx);
        pg8::EpiResidN E{(ap->in[0]), (ap->in[2]), (ap->out), HCTX, MOD + 2 * 1024, (bf16*)(ws + WS_XN2), SS0, (ap->in[7]), MOD + 4 * 1024, (LAS float*)(lds + 139264)};
        pg8::gemm_phase<pg8::EpiResidN, pg8::StaticOrder, PG8_ALIGN, PG8_SP2>(lds, g, S, E);
    }
    xcd_barrier(bar);
    {
        PHASE_IDS();
        pg8::EpiSwiGLU E{(bf16*)(ws + WS_HID0), SS0, SHW0};
        pg8::Gemm g{(const bf16*)(ws + WS_XN2), F1A_t, MALL, 5632, 1024};
        if (G == 256) {
            unsigned* cntW = (unsigned*)(ws + WS_BAR) + XCD_BAR_WORDS + 64; unsigned* cntU = cntW + 64; unsigned* cntD = cntW + 128;
            if (bx < 240) {
                const int x = bx & 7, idx = bx >> 3; const bool hasW = (x == 0 && idx < 16), hasH = idx < 6;
                if (hasW) {
                    pg8::Gemm gw_{XN, Wo_t, MALL, 1024, 1024}; pg8::OneUnit Sw{128 + (idx >> 2), idx & 3, cntW};
                    pg8::EpiResidN Ew{(ap->in[0]), (ap->in[2]), (ap->out), HCTX, MOD + 2 * 1024, (bf16*)(ws + WS_XN2), SS0, (ap->in[7]), MOD + 4 * 1024, (LAS float*)(lds + 139264)};
                    pg8::gemm_phase<pg8::EpiResidN, pg8::OneUnit, PG8_ALIGN, PG8_SP2>(lds, gw_, Sw, Ew);
                }
                pg8::UpOrder S{bx, hasW ? 1 : 0, hasH ? 11 : 12, cntW, cntU};
                pg8::gemm_phase<pg8::EpiSwiGLU, pg8::UpOrder, PG8_ALIGN, PG8_SP2>(lds, g, S, E);
                if (hasH) {
                    pg8::wave_wait_count(cntD, 16u); __syncthreads();
                    const int hidx = x * 6 + idx;
                    pg8::Gemm gh{XN, Hin_t, MALL, 5120, 1024}; pg8::OneUnit Sh{128 + hidx / 12, 8 + hidx % 12, nullptr};
                    pg8::EpiHgrnIn Eh{ws, (ap->in[13]), SS1, SHW1};
                    pg8::gemm_phase<pg8::EpiHgrnIn, pg8::OneUnit, PG8_ALIGN, PG8_SP2>(lds, gh, Sh, Eh);
                }
            } else {
                const int d = bx - 240;
                { pg8::UpOrderD S{d, 0, 3}; pg8::gemm_phase<pg8::EpiSwiGLU, pg8::UpOrderD, PG8_ALIGN, PG8_SP2>(lds, g, S, E); }
                pg8::wave_wait_count(cntU, 88u); __syncthreads();
                {
                    pg8::Gemm g2{(const bf16*)(ws + WS_HID0), F2A_t, MALL, 1024, FFH}; pg8::OneUnit S2{128 + (d >> 2), d & 3, cntD};
                    pg8::EpiResidN E2{(ap->out), HCTX, (ap->out), HCTX, MOD + 5 * 1024, XN, SS1, (ap->in[6]) + 1024, MOD1 + 1 * 1024, (LAS float*)(lds + 139264)};
                    pg8::gemm_phase<pg8::EpiResidN, pg8::OneUnit, PG8_ALIGN, PG8_SP2>(lds, g2, S2, E2);
                }
                { pg8::UpOrderD S{d, 3, 6}; pg8::gemm_phase<pg8::EpiSwiGLU, pg8::UpOrderD, PG8_ALIGN, PG8_SP2>(lds, g, S, E); }
            }
        } else {
            pg8::StaticOrder S; S.init(MALL, 5632, G, bx);
            pg8::gemm_phase<pg8::EpiSwiGLU, pg8::StaticOrder, PG8_ALIGN, PG8_SP2>(lds, g, S, E);
        }
    }
    xcd_barrier(bar);
    {
        PHASE_IDS();
        const int Mrows = (G == 256) ? NLAT : MALL;
        pg8::Gemm g{(const bf16*)(ws + WS_HID0), F2A_t, Mrows, 1024, FFH}; pg8::StaticOrder S; S.init(Mrows, 1024, G, bx);
        pg8::EpiResidN E{(ap->out), HCTX, (ap->out), HCTX, MOD + 5 * 1024, XN, SS1, (ap->in[6]) + 1024, MOD1 + 1 * 1024, (LAS float*)(lds + 139264)};
        pg8::gemm_phase<pg8::EpiResidN, pg8::StaticOrder, PG8_ALIGN, PG8_SP2>(lds, g, S, E);
    }
    xcd_barrier(bar);
    {
        PHASE_IDS();
        const int Mrows = (G == 256) ? NLAT : MALL;
        pg8::Gemm g{XN, Hin_t, Mrows, 5120, 1024}; pg8::StaticOrder S; S.init(Mrows, 5120, G, bx);
        pg8::EpiHgrnIn E{ws, (ap->in[13]), SS1, SHW1};
        pg8::gemm_phase<pg8::EpiHgrnIn, pg8::StaticOrder, PG8_ALIGN, PG8_SP2>(lds, g, S, E);
    }
    xcd_barrier(bar);
    { PHASE_IDS();
    for (int item = bx; item < 256; item += G)
        hgrn_scan_item<0>(lds, item, (const bf16*)(ws + WS_HQ), (const bf16*)(ws + WS_HV), (const bf16*)(ws + WS_LFW), (const bf16*)(ws + WS_LBW), (const bf16*)(ws + WS_HVC), (const bf16*)(ws + WS_LFWC), (const bf16*)(ws + WS_LBWC), (bf16*)(ws + WS_OFW), (bf16*)(ws + WS_OBW), (float*)(ws + WS_U), (float*)(ws + WS_D)); }
    xcd_barrier(bar);
    { PHASE_IDS();
    for (int item = bx; item < 256; item += G)
        hgrn_scan_item<1>(lds, item, (const bf16*)(ws + WS_HQ), (const bf16*)(ws + WS_HV), (const bf16*)(ws + WS_LFW), (const bf16*)(ws + WS_LBW), (const bf16*)(ws + WS_HVC), (const bf16*)(ws + WS_LFWC), (const bf16*)(ws + WS_LBWC), (bf16*)(ws + WS_OFW), (bf16*)(ws + WS_OBW), (float*)(ws + WS_U), (float*)(ws + WS_D)); }
    xcd_barrier(bar);
    { PHASE_IDS(); hgrn_combine(gw, NGW, lane, (const bf16*)(ws + WS_OFW), (const bf16*)(ws + WS_OBW), (const bf16*)(ws + WS_HG), (ap->in[14]), (bf16*)(ws + WS_OG)); }
    xcd_barrier(bar);
    {
        PHASE_IDS();
        pg8::Gemm g{(const bf16*)(ws + WS_OG), Ho_t, NLAT, 1024, 1024}; pg8::StaticOrder S; S.init(NLAT, 1024, G, bx);
        pg8::EpiResidN E{(ap->out), HCTX, (ap->out), HCTX, MOD1 + 2 * 1024, XN, SS2, (ap->in[7]) + 1024, MOD1 + 4 * 1024, (LAS float*)(lds + 139264)};
        pg8::gemm_phase<pg8::EpiResidN, pg8::StaticOrder, PG8_ALIGN, PG8_SP2>(lds, g, S, E);
    }
    xcd_barrier(bar);
    {
        PHASE_IDS();
        pg8::Gemm g{XN, F1B_t, NLAT, 5632, 1024}; pg8::StaticOrder S; S.init(NLAT, 5632, G, bx);
        pg8::EpiSwiGLU E{(bf16*)(ws + WS_HID1), SS2, SHW2};
        pg8::gemm_phase<pg8::EpiSwiGLU, pg8::StaticOrder, PG8_ALIGN, PG8_SP2>(lds, g, S, E);
    }
    xcd_barrier(bar);
    {
        PHASE_IDS();
        pg8::Gemm g{(const bf16*)(ws + WS_HID1), F2B_t, NLAT, 1024, FFH}; pg8::StaticOrder S; S.init(NLAT, 1024, G, bx);
        if (G == 256) {
            pg8::EpiResidFinal E{(ap->out), (ap->out), MOD1 + 5 * 1024, SS3, (unsigned*)(ws + WS_BAR) + XCD_BAR_WORDS + 256, (ap->in[18]), (LAS float*)(lds + 139264)};
            pg8::gemm_phase<pg8::EpiResidFinal, pg8::StaticOrder, PG8_ALIGN, PG8_SP2>(lds, g, S, E);
        } else {
            pg8::EpiResid E{(ap->out), HCTX, (ap->out), HCTX, MOD1 + 5 * 1024};
            pg8::gemm_phase<pg8::EpiResid, pg8::StaticOrder, PG8_ALIGN, PG8_SP2>(lds, g, S, E);
        }
    }
    if (gridDim.x != 256) {
        xcd_barrier(bar);
        { PHASE_IDS(); final_norm_rows(gw, NGW, lane, (ap->out), (ap->in[18])); }
    }
}


extern "C" void kernel_launch(void* const* d_in, const int* in_sizes, int n_in, void* d_out, int out_size, void* d_ws, size_t ws_size, hipStream_t stream) {
    static int grid = 0;
    if (grid == 0) {
        if (n_in != 19 || out_size != NLAT * DM || ws_size < WS_END) { fprintf(stderr, "kernel_launch: unexpected shapes: n_in %d out %d ws %zu\n", n_in, out_size, ws_size); grid = -1; return; }
        int dev = 0, cus = 0, per_cu = 0;
        if (hipGetDevice(&dev) != hipSuccess || hipDeviceGetAttribute(&cus, hipDeviceAttributeMultiprocessorCount, dev) != hipSuccess) { grid = -1; return; }
        if (hipFuncSetAttribute((const void*)mk_fwd, hipFuncAttributeMaxDynamicSharedMemorySize, LDS_BYTES) != hipSuccess) { fprintf(stderr, "kernel_launch: hipFuncSetAttribute failed\n"); grid = -1; return; }
        if (hipOccupancyMaxActiveBlocksPerMultiprocessor(&per_cu, (const void*)mk_fwd, NWAVES * 64, LDS_BYTES) != hipSuccess || per_cu < 1) { fprintf(stderr, "kernel_launch: occupancy query says %d\n", per_cu); per_cu = 1; }
        (void)hipGetLastError();
        grid = cus;
    }
    if (grid < 0) return;
    if (hipMemsetAsync((char*)d_ws + WS_BAR, 0, (XCD_BAR_WORDS + 512) * 4, stream) != hipSuccess) { fprintf(stderr, "kernel_launch: memset of the barrier words failed\n"); return; }
    Args a{};
    for (int i = 0; i < 19; ++i) a.in[i] = (const float*)d_in[i];
    a.out = (float*)d_out; a.ws = (unsigned char*)d_ws;
    void* kargs[] = {&a};
    hipError_t e = hipLaunchCooperativeKernel((const void*)mk_fwd, dim3(grid), dim3(NWAVES * 64), kargs, LDS_BYTES, stream);
    if (e != hipSuccess) fprintf(stderr, "kernel_launch: cooperative launch failed: %s (grid %d)\n", hipGetErrorString(e), grid);
}
```

```cpp
#include <hip/hip_cooperative_groups.h>
namespace cg = cooperative_groups;
#include <hip/hip_runtime.h>
#include <cstdio>
#include <cstdint>
namespace pg8 {
#define PG8_LAS __attribute__((address_space(3)))
typedef unsigned short bf16_t;
typedef short bf16x8 __attribute__((ext_vector_type(8)));
typedef float f32x4 __attribute__((ext_vector_type(4)));
typedef unsigned u32x4 __attribute__((ext_vector_type(4)));
constexpr int BM = 256, BK = 64, HALF = 128, HTB = HALF * BK * 2  , STAGE_BYTES = 8 * HTB, NXCD = 8, WGM = 8;

__host__ __device__ __forceinline__ int lds_byte(int r, int c) { const int st = (r >> 4) * 2 + (c >> 5), rr = r & 15, cc = c & 31, ob = rr * 64 + cc * 2; return st * 1024 + (ob ^ (((ob >> 9) & 1) << 5)); }
__host__ __device__ __forceinline__ void stage_rc(int b, int& R, int& C) { const int st = b / 1024, sb = b % 1024, swz = sb ^ (((sb >> 9) & 1) << 5); R = (st >> 1) * 16 + swz / 64; C = (st & 1) * 32 + (swz % 64) / 2; }
__host__ __device__ __forceinline__ int perm32(int rho) { const int n = rho >> 4, i = rho & 15; return 8 * (i >> 2) + 4 * n + (i & 3); }

struct Unit { int pm, pn; };
struct Gemm { const bf16_t* A; const bf16_t* Bt; int M, N, K; };

struct StaticOrder {
    int nM, nN, nwg, G, c;
    __host__ __device__ void init(int M, int N, int G_, int c_) { nM = M / BM; nN = N / BM; nwg = nM * nN; G = G_; c = c_; }
    __host__ __device__ bool next(int i, Unit& u) const {
        const long L = (long)i * G + c; if (L >= nwg) return false;
        int wgid = (int)L; { const int q = nwg / NXCD, r = nwg % NXCD, xcd = wgid % NXCD, off = wgid / NXCD; wgid = (xcd < r ? xcd * (q + 1) : r * (q + 1) + (xcd - r) * q) + off; }
        const int nig = WGM * nN, gid = wgid / nig, fm = gid * WGM, gsz = (nM - fm) < WGM ? (nM - fm) : WGM;
        u.pm = fm + ((wgid % nig) % gsz); u.pn = (wgid % nig) / gsz; return true;
    }
    __device__ __forceinline__ void a_ready(const Unit&) const {}
    __device__ __forceinline__ void done(const Unit&) const {}
};

__device__ __forceinline__ unsigned cvt_pk_bf16(float lo, float hi) { unsigned r; asm volatile("v_cvt_pk_bf16_f32 %0, %1, %2" : "=v"(r) : "v"(lo), "v"(hi)); return r; }
typedef unsigned u32x2 __attribute__((ext_vector_type(2)));
constexpr int NLAT = 32768, KVROWS = 8448;

struct EpiQKV {
    static constexpr bool PERM = false, AFTER_DRAIN = false;
    bf16_t* Q; bf16_t* Kall; bf16_t* Vall; const float* qn; const float* kn; const float* ropec; const float* ropes; float qscale;
    __device__ __forceinline__ void operator()(const f32x4 (&acc)[2][2][4][2], const Unit& u, int wr, int wc, int fr, int fq) const {
        const int pn = u.pn; const bool isv = (pn == 5), isk = (pn == 4);
        const float* nw = isk ? kn : qn;
        f32x4 w[2][2];
#pragma unroll
        for (int bj = 0; bj < 2; ++bj)
#pragma unroll
            for (int n = 0; n < 2; ++n) w[bj][n] = *(const f32x4*)(nw + 32 * bj + 16 * n + 4 * fq);
        const float osc = (pn < 4) ? qscale : 1.f;
        float ifr[4];
        int fq2 = fq; asm volatile("" : "+v"(fq2));
#pragma unroll
        for (int j = 0; j < 4; ++j) ifr[j] = __builtin_amdgcn_exp2f(-0.83048202372184058696f * (float)(4 * fq2 + j)) * 0.15915494309189533577f;
#pragma unroll
        for (int ai = 0; ai < 2; ++ai)
#pragma unroll
            for (int m = 0; m < 4; ++m) {
                const int r = u.pm * BM + ai * HALF + wr * 64 + m * 16 + fr;
                const bool lat = r < NLAT; int b, t;
                if (lat) { b = r >> 13; t = r & 8191; } else { const int rc = r - NLAT; b = rc >> 8; t = rc & 255; }
                f32x4 x[2][2];
#pragma unroll
                for (int bj = 0; bj < 2; ++bj)
#pragma unroll
                    for (int n = 0; n < 2; ++n) x[bj][n] = acc[ai][bj][m][n];
                if (!isv) {
                    float ss = 0.f;
#pragma unroll
                    for (int bj = 0; bj < 2; ++bj)
#pragma unroll
                        for (int n = 0; n < 2; ++n) { const f32x4 v = x[bj][n]; ss += (v[0] * v[0] + v[1] * v[1]) + (v[2] * v[2] + v[3] * v[3]); }
                    ss += __shfl_xor(ss, 16); ss += __shfl_xor(ss, 32);
                    const float rs = rsqrtf(ss * (1.0f / 64.0f) + 1e-6f);
#pragma unroll
                    for (int bj = 0; bj < 2; ++bj)
#pragma unroll
                        for (int n = 0; n < 2; ++n) x[bj][n] = x[bj][n] * rs * w[bj][n];
                    if (lat) {
#pragma unroll
                        for (int bj = 0; bj < 2; ++bj) {
                            const int pos = bj == 0 ? (t >> 6) : (t & 63);
                            f32x4 c, s;
#pragma unroll
                            for (int j = 0; j < 4; ++j) { const float rev = __builtin_amdgcn_fractf((float)pos * ifr[j]); c[j] = __builtin_amdgcn_cosf(rev); s[j] = __builtin_amdgcn_sinf(rev); }
                            const f32x4 x1 = x[bj][0], x2 = x[bj][1];
                            x[bj][0] = x1 * c - x2 * s; x[bj][1] = x2 * c + x1 * s;
                        }
                    }
#pragma unroll
                    for (int bj = 0; bj < 2; ++bj)
#pragma unroll
                        for (int n = 0; n < 2; ++n) x[bj][n] = x[bj][n] * osc;
                }
                bf16_t* dst;
                if (pn < 4) dst = Q + (size_t)r * 1024 + pn * 256 + 64 * wc;
                else { const size_t kr = (size_t)b * KVROWS + (lat ? 256 + t : t); dst = (isk ? Kall : Vall) + kr * 256 + 64 * wc; }
#pragma unroll
                for (int bj = 0; bj < 2; ++bj)
#pragma unroll
                    for (int n = 0; n < 2; ++n) { u32x2 p; p.x = cvt_pk_bf16(x[bj][n][0], x[bj][n][1]); p.y = cvt_pk_bf16(x[bj][n][2], x[bj][n][3]); *(u32x2*)(dst + 32 * bj + 16 * n + 4 * fq) = p; }
                asm volatile("" ::: "memory");
            }
    }
};

struct EpiResid {
    static constexpr bool PERM = true, AFTER_DRAIN = false;
    const float* base_lat; const float* base_ctx; float* out_lat; float* out_ctx; const float* gate;
    __device__ __forceinline__ void operator()(const f32x4 (&acc)[2][2][4][2], const Unit& u, int wr, int wc, int fr, int fq) const {
        const int rowt = u.pm * BM; const bool lat = rowt < NLAT; const int vec = lat ? (rowt >> 13) : 4;
        const float* bp = lat ? base_lat + (size_t)rowt * 1024 : base_ctx + (size_t)(rowt - NLAT) * 1024;
        float* op = lat ? out_lat + (size_t)rowt * 1024 : out_ctx + (size_t)(rowt - NLAT) * 1024;
        const int col0 = u.pn * BM + wc * 32 + 8 * fq;
#pragma unroll
        for (int bj = 0; bj < 2; ++bj) {
            const int cc = col0 + bj * HALF;
            const f32x4 g0 = *(const f32x4*)(gate + vec * 6144 + cc), g1 = *(const f32x4*)(gate + vec * 6144 + cc + 4);
#pragma unroll
            for (int ai = 0; ai < 2; ++ai)
#pragma unroll
                for (int m = 0; m < 4; ++m) { const size_t off = (size_t)(ai * HALF + wr * 64 + m * 16 + fr) * 1024 + cc;
                    const f32x4 hn0 = *(const f32x4*)(bp + off) + g0 * acc[ai][bj][m][0], hn1 = *(const f32x4*)(bp + off + 4) + g1 * acc[ai][bj][m][1];
                    *(f32x4*)(op + off) = hn0; *(f32x4*)(op + off + 4) = hn1; }
            asm volatile("" ::: "memory");
        }
    }
};

struct EpiResidFinal {
    static constexpr bool PERM = true, AFTER_DRAIN = false;
    const float* base; float* out; const float* gate; float* SS; unsigned* cnt; const float* fw; PG8_LAS float* red;
    __device__ __forceinline__ void operator()(const f32x4 (&acc)[2][2][4][2], const Unit& u, int wr, int wc, int fr, int fq) const {
        const int rowt = u.pm * BM, vec = rowt >> 13;
        const float* bp = base + (size_t)rowt * 1024; float* op = out + (size_t)rowt * 1024;
        const int col0 = u.pn * BM + wc * 32 + 8 * fq;
        float ss[8];
#pragma unroll
        for (int q = 0; q < 8; ++q) ss[q] = 0.f;
#pragma unroll
        for (int bj = 0; bj < 2; ++bj) {
            const int cc = col0 + bj * HALF;
            const f32x4 g0 = *(const f32x4*)(gate + vec * 6144 + cc), g1 = *(const f32x4*)(gate + vec * 6144 + cc + 4);
#pragma unroll
            for (int ai = 0; ai < 2; ++ai)
#pragma unroll
                for (int m = 0; m < 4; ++m) { const size_t off = (size_t)(ai * HALF + wr * 64 + m * 16 + fr) * 1024 + cc;
                    const f32x4 hn0 = *(const f32x4*)(bp + off) + g0 * acc[ai][bj][m][0], hn1 = *(const f32x4*)(bp + off + 4) + g1 * acc[ai][bj][m][1];
                    *(f32x4*)(op + off) = hn0; *(f32x4*)(op + off + 4) = hn1;
                    ss[ai * 4 + m] += ((hn0[0] * hn0[0] + hn0[1] * hn0[1]) + (hn0[2] * hn0[2] + hn0[3] * hn0[3])) + ((hn1[0] * hn1[0] + hn1[1] * hn1[1]) + (hn1[2] * hn1[2] + hn1[3] * hn1[3])); }
            asm volatile("" ::: "memory");
        }
#pragma unroll
        for (int q = 0; q < 8; ++q) { float s = ss[q]; s += __shfl_xor(s, 16); s += __shfl_xor(s, 32);
            if (fq == 0) red[((q >> 2) * HALF + wr * 64 + (q & 3) * 16 + fr) * 4 + wc] = s; }
        asm volatile("s_waitcnt lgkmcnt(0)" ::: "memory"); __builtin_amdgcn_s_barrier(); asm volatile("" ::: "memory");
        const int lane = fq * 16 + fr;
        if (lane < 32) { const int row = (wr * 4 + wc) * 32 + lane; const f32x4 p = *(const PG8_LAS f32x4*)(red + row * 4); atomicAdd(SS + rowt + row, (p[0] + p[1]) + (p[2] + p[3])); }
        asm volatile("s_waitcnt vmcnt(0)" ::: "memory"); __builtin_amdgcn_s_barrier(); asm volatile("" ::: "memory");
        if (threadIdx.x == 0) __hip_atomic_fetch_add(cnt + u.pm, 1u, __ATOMIC_RELAXED, __HIP_MEMORY_SCOPE_AGENT);
        { unsigned sp = 0; while ((unsigned)__builtin_amdgcn_readfirstlane(__hip_atomic_load(cnt + u.pm, __ATOMIC_RELAXED, __HIP_MEMORY_SCOPE_AGENT)) < 4u) { __builtin_amdgcn_s_sleep(2); if (++sp > (1u << 22)) break; } }
        asm volatile("" ::: "memory");
#pragma unroll
        for (int q = 0; q < 8; ++q) { const unsigned b = __hip_atomic_load((const unsigned*)SS + rowt + (q >> 2) * HALF + wr * 64 + (q & 3) * 16 + fr, __ATOMIC_RELAXED, __HIP_MEMORY_SCOPE_AGENT);
            ss[q] = rsqrtf(__builtin_bit_cast(float, b) * (1.0f / 1024.0f) + 1e-6f); }
#pragma unroll
        for (int bj = 0; bj < 2; ++bj) {
            const int cc = col0 + bj * HALF;
            const f32x4 w0 = *(const f32x4*)(fw + cc), w1 = *(const f32x4*)(fw + cc + 4);
#pragma unroll
            for (int ai = 0; ai < 2; ++ai)
#pragma unroll
                for (int m = 0; m < 4; ++m) { const size_t off = (size_t)(ai * HALF + wr * 64 + m * 16 + fr) * 1024 + cc;
                    const f32x4 hn0 = *(const f32x4*)(op + off), hn1 = *(const f32x4*)(op + off + 4);
                    *(f32x4*)(op + off) = hn0 * ss[ai * 4 + m] * w0; *(f32x4*)(op + off + 4) = hn1 * ss[ai * 4 + m] * w1; }
            asm volatile("" ::: "memory");
        }
    }
};

struct EpiResidN {
    static constexpr bool PERM = true, AFTER_DRAIN = false;
    const float* base_lat; const float* base_ctx; float* out_lat; float* out_ctx; const float* gate;
    bf16_t* XNr; float* SS; const float* nw; const float* sc;
    PG8_LAS float* red;
    __device__ __forceinline__ void operator()(const f32x4 (&acc)[2][2][4][2], const Unit& u, int wr, int wc, int fr, int fq) const {
        const int rowt = u.pm * BM; const bool lat = rowt < NLAT; const int vec = lat ? (rowt >> 13) : 4;
        const float* bp = lat ? base_lat + (size_t)rowt * 1024 : base_ctx + (size_t)(rowt - NLAT) * 1024;
        float* op = lat ? out_lat + (size_t)rowt * 1024 : out_ctx + (size_t)(rowt - NLAT) * 1024;
        const int col0 = u.pn * BM + wc * 32 + 8 * fq;
        float ss[8];
#pragma unroll
        for (int q = 0; q < 8; ++q) ss[q] = 0.f;
#pragma unroll
        for (int bj = 0; bj < 2; ++bj) {
            const int cc = col0 + bj * HALF;
            const f32x4 g0 = *(const f32x4*)(gate + vec * 6144 + cc), g1 = *(const f32x4*)(gate + vec * 6144 + cc + 4);
            const f32x4 gm0 = *(const f32x4*)(nw + cc) * (*(const f32x4*)(sc + vec * 6144 + cc) + 1.0f), gm1 = *(const f32x4*)(nw + cc + 4) * (*(const f32x4*)(sc + vec * 6144 + cc + 4) + 1.0f);
#pragma unroll
            for (int ai = 0; ai < 2; ++ai)
#pragma unroll
                for (int m = 0; m < 4; ++m) { const int rl = ai * HALF + wr * 64 + m * 16 + fr; const size_t off = (size_t)rl * 1024 + cc;
                    const f32x4 hn0 = *(const f32x4*)(bp + off) + g0 * acc[ai][bj][m][0], hn1 = *(const f32x4*)(bp + off + 4) + g1 * acc[ai][bj][m][1];
                    *(f32x4*)(op + off) = hn0; *(f32x4*)(op + off + 4) = hn1;
                    ss[ai * 4 + m] += ((hn0[0] * hn0[0] + hn0[1] * hn0[1]) + (hn0[2] * hn0[2] + hn0[3] * hn0[3])) + ((hn1[0] * hn1[0] + hn1[1] * hn1[1]) + (hn1[2] * hn1[2] + hn1[3] * hn1[3]));
                    const f32x4 y0 = hn0 * gm0, y1 = hn1 * gm1; u32x4 p; p.x = cvt_pk_bf16(y0[0], y0[1]); p.y = cvt_pk_bf16(y0[2], y0[3]); p.z = cvt_pk_bf16(y1[0], y1[1]); p.w = cvt_pk_bf16(y1[2], y1[3]);
                    *(u32x4*)(XNr + (size_t)rowt * 1024 + off) = p; }
            asm volatile("" ::: "memory");
        }
#pragma unroll
        for (int q = 0; q < 8; ++q) { float s = ss[q]; s += __shfl_xor(s, 16); s += __shfl_xor(s, 32);
            if (fq == 0) red[((q >> 2) * HALF + wr * 64 + (q & 3) * 16 + fr) * 4 + wc] = s; }
        asm volatile("s_waitcnt lgkmcnt(0)" ::: "memory"); __builtin_amdgcn_s_barrier(); asm volatile("" ::: "memory");
        const int lane = fq * 16 + fr;
        if (lane < 32) { const int row = (wr * 4 + wc) * 32 + lane; const f32x4 p = *(const PG8_LAS f32x4*)(red + row * 4); atomicAdd(SS + rowt + row, (p[0] + p[1]) + (p[2] + p[3])); }
    }
};

__device__ __forceinline__ float silu_f(float a) { return a * __builtin_amdgcn_rcpf(1.0f + __expf(-a)); }
struct EpiSwiGLU {
    static constexpr bool PERM = true, AFTER_DRAIN = false;
    bf16_t* O; const float* SS; const float* shw;
    __device__ __forceinline__ void operator()(const f32x4 (&acc)[2][2][4][2], const Unit& u, int wr, int wc, int fr, int fq) const {
        const int row0 = u.pm * BM + wr * 64 + fr, hc0 = u.pn * HALF + wc * 32 + 8 * fq;
        const int vec = (u.pm * BM < NLAT) ? ((u.pm * BM) >> 13) : 4;
        f32x4 sa0 = {0.f, 0.f, 0.f, 0.f}, sa1 = sa0, su0 = sa0, su1 = sa0;
        if (SS) { const float* sp = shw + vec * 5632 + u.pn * BM + wc * 32 + 8 * fq; sa0 = *(const f32x4*)sp; sa1 = *(const f32x4*)(sp + 4); su0 = *(const f32x4*)(sp + HALF); su1 = *(const f32x4*)(sp + HALF + 4); }
        float rs8[8];
#pragma unroll
        for (int q = 0; q < 8; ++q) rs8[q] = SS ? SS[row0 + (q >> 2) * HALF + (q & 3) * 16] : 0.f;
#pragma unroll
        for (int q = 0; q < 8; ++q) rs8[q] = SS ? rsqrtf(rs8[q] * (1.0f / 1024.0f) + 1e-6f) : 1.0f;
#pragma unroll
        for (int ai = 0; ai < 2; ++ai)
#pragma unroll
            for (int m = 0; m < 4; ++m) { const int r = row0 + ai * HALF + m * 16; bf16_t* rowp = O + (size_t)r * 2816 + hc0;
                const float rs = rs8[ai * 4 + m];
                const f32x4 a0 = acc[ai][0][m][0] * rs + sa0, a1 = acc[ai][0][m][1] * rs + sa1, u0 = acc[ai][1][m][0] * rs + su0, u1 = acc[ai][1][m][1] * rs + su1;
                u32x4 wv; wv.x = cvt_pk_bf16(silu_f(a0[0]) * u0[0], silu_f(a0[1]) * u0[1]); wv.y = cvt_pk_bf16(silu_f(a0[2]) * u0[2], silu_f(a0[3]) * u0[3]);
                wv.z = cvt_pk_bf16(silu_f(a1[0]) * u1[0], silu_f(a1[1]) * u1[1]); wv.w = cvt_pk_bf16(silu_f(a1[2]) * u1[2], silu_f(a1[3]) * u1[3]);
                *(u32x4*)rowp = wv; }
    }
};

__device__ __forceinline__ unsigned pk_f16(float lo, float hi) { const _Float16 a = (_Float16)lo, b = (_Float16)hi; return (unsigned)__builtin_bit_cast(unsigned short, a) | ((unsigned)__builtin_bit_cast(unsigned short, b) << 16); }
constexpr size_t OFF_MiB = 1u << 20, OFF_HQ = 122 * OFF_MiB, OFF_HG = 186 * OFF_MiB, OFF_HV = 250 * OFF_MiB, OFF_LFW = 314 * OFF_MiB, OFF_LBW = 378 * OFF_MiB, OFF_HVC = 506 * OFF_MiB, OFF_LFWC = 508 * OFF_MiB, OFF_LBWC = 510 * OFF_MiB;
struct EpiHgrnIn {
    static constexpr bool PERM = true, AFTER_DRAIN = false;
    unsigned char* ws; const float* lbl; const float* SS; const float* shw;
    __device__ __forceinline__ void operator()(const f32x4 (&acc)[2][2][4][2], const Unit& u, int wr, int wc, int fr, int fq) const {
        const int type = u.pn >> 2; const bool lat = u.pm < (NLAT / BM);
        if (type < 2 && !lat) return;
        const size_t doff = lat ? (type == 0 ? OFF_HQ : type == 1 ? OFF_HG : type == 2 ? OFF_LFW : type == 3 ? OFF_LBW : OFF_HV)
                                : (type == 2 ? OFF_LFWC : type == 3 ? OFF_LBWC : OFF_HVC) - (size_t)NLAT * 2048;
        bf16_t* dstb = (bf16_t*)(ws + doff);
        const int row0 = u.pm * BM + wr * 64 + fr; const int vec = lat ? ((u.pm * BM) >> 13) : 4;
        float rs8[8];
#pragma unroll
        for (int q = 0; q < 8; ++q) rs8[q] = SS[row0 + (q >> 2) * HALF + (q & 3) * 16];
#pragma unroll
        for (int q = 0; q < 8; ++q) rs8[q] = rsqrtf(rs8[q] * (1.0f / 1024.0f) + 1e-6f);
#pragma unroll
        for (int bj = 0; bj < 2; ++bj) {
            const int ch = (u.pn & 3) * 256 + bj * HALF + wc * 32 + 8 * fq;
            const float* sp = shw + vec * 5120 + u.pn * BM + bj * HALF + wc * 32 + 8 * fq; const f32x4 sw0 = *(const f32x4*)sp, sw1 = *(const f32x4*)(sp + 4);
            float lb[8];
            if (type == 2 || type == 3) {
#pragma unroll
                for (int e = 0; e < 8; ++e) { const float l0 = lbl[ch + e], l1 = lbl[1024 + ch + e]; lb[e] = 1.0f / (1.0f + __expf(l0 - l1)); }
            } else {
#pragma unroll
                for (int e = 0; e < 8; ++e) lb[e] = 0.f;
            }
#pragma unroll
            for (int ai = 0; ai < 2; ++ai)
#pragma unroll
                for (int m = 0; m < 4; ++m) { const int r = row0 + ai * HALF + m * 16; bf16_t* p = dstb + (size_t)r * 1024 + ch;
                    const float rs = rs8[ai * 4 + m];
                    float v[8];
#pragma unroll
                    for (int e = 0; e < 8; ++e) v[e] = acc[ai][bj][m][e >> 2][e & 3] * rs + (e < 4 ? sw0[e & 3] : sw1[e & 3]);
                    u32x4 wv;
                    if (type == 2 || type == 3) {
#pragma unroll
                        for (int e = 0; e < 8; ++e) { const float sg = __builtin_amdgcn_rcpf(1.0f + __expf(-v[e])); v[e] = __logf(lb[e] + (1.0f - lb[e]) * sg); }
                        wv.x = pk_f16(v[0], v[1]); wv.y = pk_f16(v[2], v[3]); wv.z = pk_f16(v[4], v[5]); wv.w = pk_f16(v[6], v[7]);
                    } else { wv.x = cvt_pk_bf16(v[0], v[1]); wv.y = cvt_pk_bf16(v[2], v[3]); wv.z = cvt_pk_bf16(v[4], v[5]); wv.w = cvt_pk_bf16(v[6], v[7]); }
                    *(u32x4*)p = wv; if (m & 1) asm volatile("" ::: "memory"); }
        }
    }
};

__device__ __forceinline__ void publish_unit(unsigned* cnt) {
    asm volatile("s_waitcnt vmcnt(0)" ::: "memory"); __builtin_amdgcn_s_barrier(); asm volatile("" ::: "memory");
    if (threadIdx.x == 0) { __builtin_amdgcn_fence(__ATOMIC_RELEASE, "agent"); asm volatile("s_waitcnt vmcnt(0)" ::: "memory"); __hip_atomic_fetch_add(cnt, 1u, __ATOMIC_RELAXED, __HIP_MEMORY_SCOPE_AGENT); }
}
__device__ __forceinline__ void wave_wait_count(unsigned* cnt, unsigned want) {
    unsigned sp = 0;
    while ((unsigned)__builtin_amdgcn_readfirstlane(__hip_atomic_load(cnt, __ATOMIC_RELAXED, __HIP_MEMORY_SCOPE_AGENT)) < want) { __builtin_amdgcn_s_sleep(4); if (++sp > (1u << 22)) break; }
    __builtin_amdgcn_fence(__ATOMIC_ACQUIRE, "agent"); asm volatile("s_waitcnt vmcnt(0)" ::: "memory");
}
__device__ __forceinline__ void latent_up_unit(int q, Unit& u) { const int nN = 22, nM = 128, nig = WGM * nN, gid = q / nig, fm = gid * WGM, gsz = (nM - fm) < WGM ? (nM - fm) : WGM; u.pm = fm + ((q % nig) % gsz); u.pn = (q % nig) / gsz; }
__device__ __forceinline__ int up_pos_type(int x, int j, int& idx) {
    if (x == 0 && j < 16) { idx = j; return 1; }
    if (j >= 30 && j < 60 && x < 3) { const int uu = x * 30 + (j - 30); if (uu < 88) { idx = uu; return 2; } }
    if (j >= 330 && j < 336) { idx = x * 6 + (j - 330); return 3; }
    int sp = 0;
    if (x == 0) sp += 16;
    if (x < 3) { const int lim = x < 2 ? 30 : 28; int t = j - 30; t = t < 0 ? 0 : (t > lim ? lim : t); sp += t; }
    { int t = j - 330; t = t < 0 ? 0 : (t > 6 ? 6 : t); sp += t; }
    const int prev = x == 0 ? 0 : x == 1 ? 52 : x == 2 ? 88 : 122 + (x - 3) * 6;
    idx = x * 360 + j - sp - prev; return 0;
}
struct UpOrder {
    int c, i0, i1; unsigned* cntW; unsigned* cntU;
    __device__ __forceinline__ bool next(int k, Unit& u) const {
        const int i = i0 + k; if (i >= i1) return false;
        int idx; const int t = up_pos_type(c & 7, i * 30 + (c >> 3), idx);
        if (t == 2) { u.pm = 128 + idx / 22; u.pn = idx % 22; } else latent_up_unit(idx, u);
        return true;
    }
    __device__ __forceinline__ void a_ready(const Unit& u) const { if (u.pm >= 128) wave_wait_count(cntW, 16u); }
    __device__ __forceinline__ void done(const Unit& u) const { if (u.pm >= 128) publish_unit(cntU); }
};
struct UpOrderD {
    int d, i0, i1;
    __device__ __forceinline__ bool next(int k, Unit& u) const { const int i = i0 + k; if (i >= i1) return false; const int q = 2728 + i * 16 + d; if (q >= 2816) return false; latent_up_unit(q, u); return true; }
    __device__ __forceinline__ void a_ready(const Unit&) const {}
    __device__ __forceinline__ void done(const Unit&) const {}
};
struct OneUnit {
    int pm, pn; unsigned* cnt;
    __device__ __forceinline__ bool next(int i, Unit& u) const { if (i > 0) return false; u.pm = pm; u.pn = pn; return true; }
    __device__ __forceinline__ void a_ready(const Unit&) const {}
    __device__ __forceinline__ void done(const Unit&) const { if (cnt) publish_unit(cnt); }
};
template <class Epi, class Sched, bool ALIGN_EPI = false, bool SP2 = false>
__device__ __forceinline__ void gemm_phase(PG8_LAS unsigned char* lds, const Gemm g, const Sched& S, const Epi& E) {
    int tid_ = threadIdx.x; asm volatile("" : "+v"(tid_));
    const int tid = tid_, wid = __builtin_amdgcn_readfirstlane(tid >> 6), lane = tid & 63, wr = wid >> 2, wc = wid & 3, fr = lane & 15, fq = lane >> 4;
    const int K = g.K, nt = K / BK;
    unsigned voffA[2], voffB[2];
#pragma unroll
    for (int i = 0; i < 2; ++i) { int R, C; stage_rc(tid * 16 + i * 8192, R, C); const int Rb = Epi::PERM ? ((R & ~31) + perm32(R & 31)) : R;
        voffA[i] = (unsigned)(R * K + C) * 2u; voffB[i] = (unsigned)(Rb * K + C) * 2u; }
    const size_t kstep = (size_t)(BK * 2);
    const size_t hstep = (size_t)HALF * K * 2;
    const size_t tstep = 2 * hstep;
    const unsigned ldsw = (unsigned)wid * 1024u;
    const int aoff = lds_byte(wr * 64 + fr, fq * 8), boff = lds_byte(wc * 32 + fr, fq * 8);
#define PG8_SA(b, h) (((b) * 2 + (h)) * HTB)
#define PG8_SB(b, h) ((4 + (b) * 2 + (h)) * HTB)
#define PG8_STAGE(bufoff, gbase, voff) do { _Pragma("unroll") for (int _i = 0; _i < 2; ++_i) \
        __builtin_amdgcn_global_load_lds((const unsigned*)((const char*)(gbase) + (voff)[_i]), (PG8_LAS unsigned*)(lds + (bufoff) + ldsw + _i * 8192), 16, 0, 0); } while (0)
#define PG8_LDA(dst, b, h) do { _Pragma("unroll") for (int m = 0; m < 4; ++m) _Pragma("unroll") for (int k = 0; k < 2; ++k) dst[m][k] = *(const PG8_LAS bf16x8*)(lds + PG8_SA(b, h) + aoff + m * 2048 + k * 1024); } while (0)
#define PG8_LDB(dst, b, h) do { _Pragma("unroll") for (int n = 0; n < 2; ++n) _Pragma("unroll") for (int k = 0; k < 2; ++k) dst[n][k] = *(const PG8_LAS bf16x8*)(lds + PG8_SB(b, h) + boff + n * 2048 + k * 1024); } while (0)
#define PG8_MMA(ai, bj, At, Bt) do { __builtin_amdgcn_s_setprio(1); _Pragma("unroll") for (int m = 0; m < 4; ++m) _Pragma("unroll") for (int n = 0; n < 2; ++n) _Pragma("unroll") for (int k = 0; k < 2; ++k) \
        acc[ai][bj][m][n] = __builtin_amdgcn_mfma_f32_16x16x32_bf16(Bt[n][k], At[m][k], acc[ai][bj][m][n], 0, 0, 0); __builtin_amdgcn_s_setprio(0); } while (0)
#define PG8_WAIT_V(n) asm volatile("s_waitcnt vmcnt(" #n ")" ::: "memory")
#define PG8_WAIT_L(n) asm volatile("s_waitcnt lgkmcnt(" #n ")" ::: "memory")
#define PG8_BAR __builtin_amdgcn_s_barrier()
#define PG8_SCHED __builtin_amdgcn_sched_barrier(0)
    Unit cur, nxt; int ui = 0;
    if (!S.next(0, cur)) return;
    f32x4 acc[2][2][4][2];
#pragma unroll
    for (int a = 0; a < 2; ++a)
#pragma unroll
        for (int b = 0; b < 2; ++b)
#pragma unroll
            for (int m = 0; m < 4; ++m)
#pragma unroll
                for (int n = 0; n < 2; ++n) acc[a][b][m][n] = (f32x4){0.f, 0.f, 0.f, 0.f};
    bf16x8 At[4][2], B0[2][2], B1[2][2];
    const char* cA = (const char*)g.A + (size_t)cur.pm * tstep; const char* cB = (const char*)g.Bt + (size_t)cur.pn * tstep;
    S.a_ready(cur);
    if constexpr (SP2) {
        PG8_STAGE(PG8_SB(0, 0), cB, voffB); PG8_STAGE(PG8_SB(0, 1), cB + hstep, voffB); PG8_STAGE(PG8_SA(0, 0), cA, voffA); PG8_STAGE(PG8_SA(0, 1), cA + hstep, voffA);
        if (wr == 1) PG8_BAR;
        PG8_WAIT_V(2); PG8_BAR;
        PG8_STAGE(PG8_SB(1, 0), cB + kstep, voffB); PG8_STAGE(PG8_SA(1, 0), cA + kstep, voffA); PG8_STAGE(PG8_SB(1, 1), cB + hstep + kstep, voffB);
        PG8_WAIT_V(6); PG8_BAR;
    } else {
        PG8_STAGE(PG8_SB(0, 0), cB, voffB); PG8_STAGE(PG8_SA(0, 0), cA, voffA); PG8_STAGE(PG8_SB(0, 1), cB + hstep, voffB); PG8_STAGE(PG8_SA(0, 1), cA + hstep, voffA);
        if (wr == 1) PG8_BAR;
        PG8_WAIT_V(4); PG8_BAR;
        PG8_STAGE(PG8_SB(1, 0), cB + kstep, voffB); PG8_STAGE(PG8_SA(1, 0), cA + kstep, voffA); PG8_STAGE(PG8_SB(1, 1), cB + hstep + kstep, voffB);
        PG8_WAIT_V(6); PG8_BAR;
    }
    for (;;) {
        const bool has_next = S.next(ui + 1, nxt);
        const char* nA = has_next ? (const char*)g.A + (size_t)nxt.pm * tstep : cA; const char* nB = has_next ? (const char*)g.Bt + (size_t)nxt.pn * tstep : cB;
        for (int t = 0; t < nt; t += 2) {
            const bool last = (t == nt - 2);
            const char* a1 = cA + (size_t)(t + 1) * kstep;
            const char* a2 = last ? nA : cA + (size_t)(t + 2) * kstep; const char* b2 = last ? nB : cB + (size_t)(t + 2) * kstep;
            const char* a3 = a2 + kstep; const char* b3 = b2 + kstep;
            if (last && has_next) S.a_ready(nxt);
            if constexpr (SP2) {
            PG8_LDB(B0, 0, 0); PG8_LDB(B1, 0, 1); PG8_SCHED; PG8_LDA(At, 0, 0); PG8_STAGE(PG8_SA(1, 1), a1 + hstep, voffA);
            PG8_WAIT_V(8); PG8_WAIT_L(0); PG8_BAR; PG8_MMA(0, 0, At, B0); PG8_MMA(0, 1, At, B1); PG8_BAR; PG8_SCHED;
            PG8_LDA(At, 0, 1); PG8_STAGE(PG8_SB(0, 0), b2, voffB); PG8_STAGE(PG8_SB(0, 1), b2 + hstep, voffB); PG8_STAGE(PG8_SA(0, 0), a2, voffA);
            PG8_WAIT_V(8); PG8_WAIT_L(0); PG8_BAR; PG8_MMA(1, 0, At, B0); PG8_MMA(1, 1, At, B1); PG8_BAR; PG8_SCHED;
            PG8_LDB(B0, 1, 0); PG8_LDB(B1, 1, 1); PG8_SCHED; PG8_LDA(At, 1, 0); PG8_STAGE(PG8_SA(0, 1), a2 + hstep, voffA);
            PG8_WAIT_V(8); PG8_WAIT_L(0); PG8_BAR; PG8_MMA(0, 0, At, B0); PG8_MMA(0, 1, At, B1); PG8_BAR; PG8_SCHED;
            PG8_LDA(At, 1, 1); PG8_STAGE(PG8_SB(1, 0), b3, voffB); PG8_STAGE(PG8_SB(1, 1), b3 + hstep, voffB); PG8_STAGE(PG8_SA(1, 0), a3, voffA);
            PG8_WAIT_V(8); PG8_WAIT_L(0); PG8_BAR; PG8_MMA(1, 0, At, B0); PG8_MMA(1, 1, At, B1); PG8_BAR; PG8_SCHED;
            } else {
            PG8_LDB(B0, 0, 0); PG8_SCHED; PG8_LDA(At, 0, 0); PG8_STAGE(PG8_SA(1, 1), a1 + hstep, voffA);
            PG8_WAIT_L(8); PG8_BAR; PG8_WAIT_L(0); PG8_MMA(0, 0, At, B0); PG8_BAR; PG8_SCHED;
            PG8_LDB(B1, 0, 1); PG8_STAGE(PG8_SB(0, 0), b2, voffB);
            PG8_BAR; PG8_WAIT_L(0); PG8_MMA(0, 1, At, B1); PG8_BAR;
            PG8_LDA(At, 0, 1); PG8_STAGE(PG8_SA(0, 0), a2, voffA);
            PG8_BAR; PG8_WAIT_L(0); PG8_MMA(1, 0, At, B0); PG8_BAR; PG8_SCHED;
            PG8_STAGE(PG8_SB(0, 1), b2 + hstep, voffB);
            PG8_WAIT_V(6); PG8_BAR; PG8_MMA(1, 1, At, B1); PG8_BAR;
            PG8_LDB(B0, 1, 0); PG8_SCHED; PG8_LDA(At, 1, 0); PG8_STAGE(PG8_SA(0, 1), a2 + hstep, voffA);
            PG8_WAIT_L(8); PG8_BAR; PG8_WAIT_L(0); PG8_MMA(0, 0, At, B0); PG8_BAR; PG8_SCHED;
            PG8_LDB(B1, 1, 1); PG8_STAGE(PG8_SB(1, 0), b3, voffB);
            PG8_BAR; PG8_WAIT_L(0); PG8_MMA(0, 1, At, B1); PG8_BAR;
            PG8_LDA(At, 1, 1); PG8_STAGE(PG8_SA(1, 0), a3, voffA);
            PG8_BAR; PG8_WAIT_L(0); PG8_MMA(1, 0, At, B0); PG8_BAR; PG8_SCHED;
            PG8_STAGE(PG8_SB(1, 1), b3 + hstep, voffB);
            PG8_WAIT_V(6); PG8_BAR; PG8_MMA(1, 1, At, B1); PG8_BAR;
            }
        }
        if constexpr (ALIGN_EPI) { if (wr == 0) PG8_BAR; }
        if constexpr (!Epi::AFTER_DRAIN) { E(acc, cur, wr, wc, fr, fq); S.done(cur); }
        if (!has_next) break;
#pragma unroll
        for (int a = 0; a < 2; ++a)
#pragma unroll
            for (int b = 0; b < 2; ++b)
#pragma unroll
                for (int m = 0; m < 4; ++m)
#pragma unroll
                    for (int n = 0; n < 2; ++n) acc[a][b][m][n] = (f32x4){0.f, 0.f, 0.f, 0.f};
        cur = nxt; cA = nA; cB = nB; ++ui;
        if constexpr (ALIGN_EPI) { if (wr == 1) PG8_BAR; }
    }
    PG8_WAIT_V(0);
    if constexpr (!ALIGN_EPI) { if (wr == 0) PG8_BAR; }
    PG8_BAR;
    if constexpr (Epi::AFTER_DRAIN) { E.fused(acc, cur, wr, wc, fr, fq, lds, wid, lane); S.done(cur); }
#undef PG8_SA
#undef PG8_SB
#undef PG8_STAGE
#undef PG8_LDA
#undef PG8_LDB
#undef PG8_MMA
#undef PG8_WAIT_V
#undef PG8_WAIT_L
#undef PG8_BAR
#undef PG8_SCHED
}
}

#ifndef PG8_SP2
#define PG8_SP2 true
#endif
#ifndef PG8_ALIGN
#define PG8_ALIGN true
#endif
#include <hip/hip_bf16.h>
#include <cmath>
namespace attn_body {
using bf16=__hip_bfloat16;
using bf16x8=__attribute__((ext_vector_type(8)))short;
using s16x4=__attribute__((ext_vector_type(4)))short;
using f32x16=__attribute__((ext_vector_type(16)))float;
using u32x4=__attribute__((ext_vector_type(4)))unsigned;
constexpr int D=64,QP=1024,KVP=256;
constexpr int NW=8,QBLK=32,QB=QBLK*NW,KVBLK=64;
__device__ __forceinline__ int crow(int r,int hi){return (r&3)+8*(r>>2)+4*hi;}
#define SBAR() __builtin_amdgcn_sched_barrier(0)
constexpr int NSLOT=3, SLOTB=8192;
constexpr int LDS_K=0, LDS_V=NSLOT*SLOTB, LDS_WS=2*NSLOT*SLOTB, LDS_OST=LDS_WS+NW*64*4, LDS_BYTES=LDS_OST+NW*4096;
constexpr float C2=0.125f*1.4426950408889634f;
__device__ __forceinline__ void glds16(const void*gsrc,unsigned lds_dst){unsigned keep;
  asm volatile("s_mov_b32 %0, m0\n\ts_mov_b32 m0, %2\n\ts_nop 0\n\tglobal_load_lds_dwordx4 %1, off\n\ts_mov_b32 m0, %0":"=&s"(keep):"v"(gsrc),"s"(lds_dst):"memory");}
__device__ __forceinline__ float max3f(float a,float b,float c){float r;asm("v_max3_f32 %0, %1, %2, %3":"=v"(r):"v"(a),"v"(b),"v"(c));return r;}
__device__ __forceinline__ float max2f(float a,float b){float r;asm("v_max_f32_e32 %0, %1, %2":"=v"(r):"v"(a),"v"(b));return r;}
__device__ __forceinline__ float fadd_s(float a,float b){float r;asm("v_add_f32_e32 %0, %1, %2":"=v"(r):"v"(a),"v"(b));return r;}
__device__ __forceinline__ float fsub_s(float a,float b){float r;asm("v_sub_f32_e32 %0, %1, %2":"=v"(r):"v"(a),"v"(b));return r;}
typedef float f32x2_t __attribute__((ext_vector_type(2))); typedef __bf16 bf16x2_t __attribute__((ext_vector_type(2)));
__device__ __forceinline__ unsigned cvtpk_s(float lo,float hi){f32x2_t v={lo,hi};bf16x2_t b=__builtin_convertvector(v,bf16x2_t);return __builtin_bit_cast(unsigned,b);}
#define WAIT_BAR(N) asm volatile("s_waitcnt vmcnt(" #N ") lgkmcnt(0)\n\ts_barrier":::"memory")

__device__ __forceinline__ void qkt(f32x16&p0,f32x16&p1,const char*Kslot,const bf16x8*qr,const f32x16&negm,int r32,int hi){
  const char*kb=Kslot+hi*1024+r32*16;
  #pragma unroll
  for(int d0=0;d0<4;++d0){
    const bf16x8 b0=*reinterpret_cast<const bf16x8*>(kb+d0*2048);
    const bf16x8 b1=*reinterpret_cast<const bf16x8*>(kb+d0*2048+512);
    if(d0==0){p0=__builtin_amdgcn_mfma_f32_32x32x16_bf16(b0,qr[0],negm,0,0,0);p1=__builtin_amdgcn_mfma_f32_32x32x16_bf16(b1,qr[0],negm,0,0,0);}
    else{p0=__builtin_amdgcn_mfma_f32_32x32x16_bf16(b0,qr[d0],p0,0,0,0);p1=__builtin_amdgcn_mfma_f32_32x32x16_bf16(b1,qr[d0],p1,0,0,0);}}
}
typedef __attribute__((address_space(3))) const char* lds_cptr;
typedef short v4i16_t __attribute__((ext_vector_type(4)));
__device__ __forceinline__ void kload8(bf16x8*kf,lds_cptr kp){
  kf[0]=*(const __attribute__((address_space(3))) bf16x8*)(kp);      kf[1]=*(const __attribute__((address_space(3))) bf16x8*)(kp+512);
  kf[2]=*(const __attribute__((address_space(3))) bf16x8*)(kp+2048); kf[3]=*(const __attribute__((address_space(3))) bf16x8*)(kp+2560);
  kf[4]=*(const __attribute__((address_space(3))) bf16x8*)(kp+4096); kf[5]=*(const __attribute__((address_space(3))) bf16x8*)(kp+4608);
  kf[6]=*(const __attribute__((address_space(3))) bf16x8*)(kp+6144); kf[7]=*(const __attribute__((address_space(3))) bf16x8*)(kp+6656);
}
__device__ __forceinline__ void kload2(bf16x8*kf,lds_cptr kp,int j){ kf[2*j]=*(const __attribute__((address_space(3))) bf16x8*)(kp+j*2048); kf[2*j+1]=*(const __attribute__((address_space(3))) bf16x8*)(kp+j*2048+512); }
__device__ __forceinline__ s16x4 vtr(lds_cptr p){ return __builtin_bit_cast(s16x4,__builtin_amdgcn_ds_read_tr16_b64_v4i16((__attribute__((address_space(3))) v4i16_t*)p)); }
__device__ __forceinline__ float rowmax(const f32x16&p0,const f32x16&p1){
  float a=max3f(p0[0],p0[1],p1[0]),b=max3f(p0[2],p0[3],p1[1]);a=max3f(a,p1[2],p1[3]);
  #pragma unroll
  for(int r=4;r<16;r+=4){a=max3f(a,p0[r],p0[r+1]);b=max3f(b,p0[r+2],p0[r+3]);a=max3f(a,p1[r],p1[r+1]);b=max3f(b,p1[r+2],p1[r+3]);}
  const float m=max2f(a,b);
  auto rr=__builtin_amdgcn_permlane32_swap(__float_as_uint(m),__float_as_uint(m),false,false);
  return max2f(__uint_as_float(rr[0]),__uint_as_float(rr[1]));
}
__device__ __forceinline__ void pv(f32x16*o,int vb,bf16x8 pa0,bf16x8 pa1,bf16x8 pa2,bf16x8 pa3){
  #pragma unroll
  for(int d0=0;d0<2;++d0){s16x4 lo[4],hi[4];
    #pragma unroll
    for(int ks=0;ks<4;++ks){
      asm volatile("ds_read_b64_tr_b16 %0,%1 offset:%c2":"=&v"(lo[ks]):"v"(vb),"i"(d0*4096+ks*1024):"memory");
      asm volatile("ds_read_b64_tr_b16 %0,%1 offset:%c2":"=&v"(hi[ks]):"v"(vb),"i"(d0*4096+ks*1024+512):"memory");}
    asm volatile("s_waitcnt lgkmcnt(0)":::"memory");SBAR();
    #define PK(k) (bf16x8){lo[k][0],lo[k][1],lo[k][2],lo[k][3],hi[k][0],hi[k][1],hi[k][2],hi[k][3]}
    o[d0]=__builtin_amdgcn_mfma_f32_32x32x16_bf16(pa0,PK(0),o[d0],0,0,0);
    o[d0]=__builtin_amdgcn_mfma_f32_32x32x16_bf16(pa1,PK(1),o[d0],0,0,0);
    o[d0]=__builtin_amdgcn_mfma_f32_32x32x16_bf16(pa2,PK(2),o[d0],0,0,0);
    o[d0]=__builtin_amdgcn_mfma_f32_32x32x16_bf16(pa3,PK(3),o[d0],0,0,0);
    #undef PK
  }
}

#ifndef ATTN_STORE16
#define ATTN_STORE16(p,v) (*(u32x4*)(p)=(v))
#endif
template<int THRL> __device__ __forceinline__ void attn_unit(const bf16*Qu,const bf16*__restrict__ Kh,const bf16*__restrict__ Vh,bf16*Ou,const int NT,char*shm){
  int tid_=threadIdx.x; asm volatile("":"+v"(tid_)); const int tid=tid_,lane=tid&63,r32=lane&31,hi=lane>>5; const int wid=__builtin_amdgcn_readfirstlane(tid>>6);
  const bf16*Qw=Qu+(long)(wid*QBLK)*QP;
  const unsigned lds0=(unsigned)(uintptr_t)shm;
  float*wsf=(float*)(shm+LDS_WS)+wid*64;
  const bf16*ksrc=Kh+(long)lane*KVP+wid*8;
  const bf16*vsrc=Vh+(long)(16*(wid&3)+(lane>>2))*KVP+(wid>>2)*32+(lane&3)*8;
  const unsigned kdst=lds0+LDS_K+wid*1024, vdst=lds0+LDS_V+wid*1024;
  #define DMA_K(t,slot) glds16(ksrc+(long)(t)*KVBLK*KVP,(unsigned)__builtin_amdgcn_readfirstlane(kdst+(slot)))
  #define DMA_V(t,slot) glds16(vsrc+(long)(t)*KVBLK*KVP,(unsigned)__builtin_amdgcn_readfirstlane(vdst+(slot)))
  const int vb0=(int)(lds0+LDS_V)+((lane>>4)&1)*32+(lane&3)*8+(4*hi+((lane&15)>>2))*64;
  const char*Kbase=shm+LDS_K; bf16x8 kf[8];
  const lds_cptr shm3=(lds_cptr)shm; const lds_cptr kp0=shm3+LDS_K+hi*1024+r32*16; const lds_cptr vp0=shm3+LDS_V+((lane>>4)&1)*32+(lane&3)*8+(4*hi+((lane&15)>>2))*64;
  DMA_K(0,0);DMA_V(0,0);DMA_K(1,SLOTB);
  bf16x8 qr[4];
  #pragma unroll
  for(int d0=0;d0<4;++d0)qr[d0]=*reinterpret_cast<const bf16x8*>(&Qw[(long)r32*QP+d0*16+hi*8]);
  float mhat=0.f,l_reg=0.f;f32x16 o[2];o[0]=f32x16{};o[1]=f32x16{};f32x16 negm=f32x16{};asm volatile("":"+v"(negm));
  #define CMASK(P0,P1,t) do{}while(0)
  bool resc=false;
  #define START(P0,P1) do{ const float rm=rowmax(P0,P1); resc=false; \
    { const float dl=rm; mhat=fadd_s(mhat,dl); \
      _Pragma("unroll") for(int r=0;r<16;++r){P0[r]=fsub_s(P0[r],dl);P1[r]=fsub_s(P1[r],dl);} \
      _Pragma("unroll") for(int r=0;r<16;++r)negm[r]=-mhat; asm volatile("":"+v"(negm)); } \
    _Pragma("unroll") for(int r=0;r<16;++r)P0[r]=__builtin_amdgcn_exp2f(P0[r]); }while(0)
  #define RESC() do{ if(resc){ asm volatile("s_waitcnt lgkmcnt(0)":::"memory"); \
      _Pragma("unroll") for(int d_=0;d_<2;++d_) _Pragma("unroll") for(int r=0;r<16;++r)o[d_][r]*=wsf[crow(r,hi)]; } }while(0)
  f32x16 pA0,pA1,pB0,pB1;
  int sl_prev=0,sl_cur=0,sl_next=SLOTB;
  #define ROT() do{sl_prev=sl_cur;sl_cur=sl_next;sl_next=(sl_next==(NSLOT-1)*SLOTB)?0:sl_next+SLOTB;}while(0)
  DMA_K(2,2*SLOTB);
  WAIT_BAR(3);
  qkt(pA0,pA1,Kbase,qr,negm,r32,hi);asm volatile("s_nop 15\n\ts_nop 7":"+v"(pA0),"+v"(pA1));CMASK(pA0,pA1,0);
  START(pA0,pA1);
  _Pragma("unroll") for(int r=0;r<16;++r)pA1[r]=__builtin_amdgcn_exp2f(pA1[r]);
  WAIT_BAR(0);
  DMA_K(3,0);DMA_V(1,SLOTB);
  ROT();
  kload8(kf,kp0+sl_cur);
  WAIT_BAR(2);
  s16x4 vlo[8],vhi[8]; u32x4 pw0,pw1,pw2,pw3;
  #define PKW(P,B) cvtpk_s(P[B],P[B+1])
  #define PAF(k) __builtin_bit_cast(bf16x8,pw##k)
  #define VFR(i) (bf16x8){vlo[i][0],vlo[i][1],vlo[i][2],vlo[i][3],vhi[i][0],vhi[i][1],vhi[i][2],vhi[i][3]}
  #define PIN(x) asm volatile("":"+v"(x))
  #define MX3(a,b,c) __builtin_fmaxf(__builtin_fmaxf((a),(b)),(c))
  #define GAPA(MF,A0,A1,A2,A3,W0,W1,PW) do{ MF; sacc+=A0; sacc+=A1; sacc+=A2; sacc+=A3; PIN(sacc); W0; W1; PIN(PW); SBAR(); }while(0)
  #define EX(v) __builtin_amdgcn_exp2f(v)
  #define GAPB(MF,X,B) do{ MF; X[B]=EX(X[B]); X[B+1]=EX(X[B+1]); X[B+2]=EX(X[B+2]); X[B+3]=EX(X[B+3]); PIN(X); SBAR(); }while(0)
  #define VRD(i) do{ vlo[i]=vtr(vp_+(((i)>>2)*4096+((i)&3)*1024)); vhi[i]=vtr(vp_+(((i)>>2)*4096+((i)&3)*1024+512)); }while(0)
  #define KRD(G,j) do{ if(G){ kload2(kf,kp0+sl_next,j); SBAR(); } }while(0)
  #define STEP(C0,C1,P0,P1,t,GK,GV,GL) do{ SBAR(); \
    const lds_cptr vp_=vp0+sl_prev; \
    VRD(0); SBAR(); float sacc=(P0[0]+P0[1]); \
    GAPA(C0=__builtin_amdgcn_mfma_f32_32x32x16_bf16(kf[0],qr[0],negm,0,0,0), P0[2],P0[3],P0[4],P0[5],     pw0[0]=PKW(P0,0), pw0[1]=PKW(P0,2), pw0); \
    VRD(4); SBAR(); GAPA(C1=__builtin_amdgcn_mfma_f32_32x32x16_bf16(kf[1],qr[0],negm,0,0,0), P0[6],P0[7],P0[8],P0[9],     pw0[2]=PKW(P0,4), pw0[3]=PKW(P0,6), pw0); \
    VRD(1); SBAR(); GAPA(C0=__builtin_amdgcn_mfma_f32_32x32x16_bf16(kf[2],qr[1],C0,0,0,0),   P0[10],P0[11],P0[12],P0[13], pw1[0]=PKW(P0,8), pw1[1]=PKW(P0,10), pw1); \
    VRD(5); SBAR(); GAPA(C1=__builtin_amdgcn_mfma_f32_32x32x16_bf16(kf[3],qr[1],C1,0,0,0),   P0[14],P0[15],P1[0],P1[1],   pw1[2]=PKW(P0,12),pw1[3]=PKW(P0,14), pw1); \
    VRD(2); SBAR(); GAPA(C0=__builtin_amdgcn_mfma_f32_32x32x16_bf16(kf[4],qr[2],C0,0,0,0),   P1[2],P1[3],P1[4],P1[5],     pw2[0]=PKW(P1,0), pw2[1]=PKW(P1,2), pw2); \
    VRD(6); SBAR(); GAPA(C1=__builtin_amdgcn_mfma_f32_32x32x16_bf16(kf[5],qr[2],C1,0,0,0),   P1[6],P1[7],P1[8],P1[9],     pw2[2]=PKW(P1,4), pw2[3]=PKW(P1,6), pw2); \
    VRD(3); SBAR(); GAPA(C0=__builtin_amdgcn_mfma_f32_32x32x16_bf16(kf[6],qr[3],C0,0,0,0),   P1[10],P1[11],P1[12],P1[13], pw3[0]=PKW(P1,8), pw3[1]=PKW(P1,10), pw3); \
    VRD(7); SBAR(); GAPA(C1=__builtin_amdgcn_mfma_f32_32x32x16_bf16(kf[7],qr[3],C1,0,0,0),   P1[14],P1[15],0.f,0.f,       pw3[2]=PKW(P1,12),pw3[3]=PKW(P1,14), pw3); \
    l_reg+=sacc; \
    if(GK){DMA_K((t)+3,sl_cur);} if(GV){DMA_V((t)+1,sl_next);} \
    CMASK(C0,C1,t); \
    { float a=MX3(C0[0],C0[1],C1[0]),b=MX3(C0[2],C0[3],C1[1]); a=MX3(a,C1[2],C1[3]); \
      _Pragma("unroll") for(int r=4;r<16;r+=4){a=MX3(a,C0[r],C0[r+1]);b=MX3(b,C0[r+2],C0[r+3]);a=MX3(a,C1[r],C1[r+1]);b=MX3(b,C1[r+2],C1[r+3]);} \
      float rm=__builtin_fmaxf(a,b); { auto rr=__builtin_amdgcn_permlane32_swap(__float_as_uint(rm),__float_as_uint(rm),false,false); rm=__builtin_fmaxf(__uint_as_float(rr[0]),__uint_as_float(rr[1])); } \
      resc=false; \
      if(__builtin_expect(__any(rm>(float)THRL),0)){ const float dl=__builtin_fmaxf(rm,0.f); mhat+=dl; \
        _Pragma("unroll") for(int r=0;r<16;++r){C0[r]-=dl;C1[r]-=dl;} \
        _Pragma("unroll") for(int r=0;r<16;++r)negm[r]=-mhat; asm volatile("":"+v"(negm)); \
        const float f=__builtin_amdgcn_exp2f(-dl); l_reg*=f; if(hi==0)wsf[r32]=f; resc=true; } } \
    SBAR(); \
    GAPB(o[0]=__builtin_amdgcn_mfma_f32_32x32x16_bf16(PAF(0),VFR(0),o[0],0,0,0), C0,0); \
    GAPB(o[1]=__builtin_amdgcn_mfma_f32_32x32x16_bf16(PAF(0),VFR(4),o[1],0,0,0), C0,4); \
    KRD(GL,0); GAPB(o[0]=__builtin_amdgcn_mfma_f32_32x32x16_bf16(PAF(1),VFR(1),o[0],0,0,0), C0,8); \
    KRD(GL,1); GAPB(o[1]=__builtin_amdgcn_mfma_f32_32x32x16_bf16(PAF(1),VFR(5),o[1],0,0,0), C0,12); \
    KRD(GL,2); GAPB(o[0]=__builtin_amdgcn_mfma_f32_32x32x16_bf16(PAF(2),VFR(2),o[0],0,0,0), C1,0); \
    KRD(GL,3); GAPB(o[1]=__builtin_amdgcn_mfma_f32_32x32x16_bf16(PAF(2),VFR(6),o[1],0,0,0), C1,4); \
    GAPB(o[0]=__builtin_amdgcn_mfma_f32_32x32x16_bf16(PAF(3),VFR(3),o[0],0,0,0), C1,8); \
    GAPB(o[1]=__builtin_amdgcn_mfma_f32_32x32x16_bf16(PAF(3),VFR(7),o[1],0,0,0), C1,12); \
    }while(0)
  int t=1;
  #undef CMASK
  #define CMASK(P0,P1,t) do{}while(0)
  for(;t+5<NT;t+=2){
    STEP(pB0,pB1,pA0,pA1,t,true,true,true);     WAIT_BAR(2); RESC(); ROT();
    STEP(pA0,pA1,pB0,pB1,t+1,true,true,true);   WAIT_BAR(2); RESC(); ROT();
  }
  #undef CMASK
  #define CMASK(P0,P1,t) do{}while(0)
  #define ENDW(tt) do{ if((tt)+3<NT){WAIT_BAR(2);} else if((tt)+2<NT){WAIT_BAR(1);} else {WAIT_BAR(0);} }while(0)
  for(;t+1<NT;t+=2){
    STEP(pB0,pB1,pA0,pA1,t,(t+3<NT),(t+1<NT),(t+1<NT));       ENDW(t);   RESC(); ROT();
    STEP(pA0,pA1,pB0,pB1,t+1,(t+4<NT),(t+2<NT),(t+2<NT));     ENDW(t+1); RESC(); ROT();
  }
  STEP(pB0,pB1,pA0,pA1,NT-1,false,false,false); RESC();
  { float sacc=pB0[0]+pB0[1]; _Pragma("unroll") for(int r=2;r<16;++r)sacc+=pB0[r]; _Pragma("unroll") for(int r=0;r<16;++r)sacc+=pB1[r]; l_reg+=sacc;
    pw0=(u32x4){PKW(pB0,0),PKW(pB0,2),PKW(pB0,4),PKW(pB0,6)};pw1=(u32x4){PKW(pB0,8),PKW(pB0,10),PKW(pB0,12),PKW(pB0,14)};pw2=(u32x4){PKW(pB1,0),PKW(pB1,2),PKW(pB1,4),PKW(pB1,6)};pw3=(u32x4){PKW(pB1,8),PKW(pB1,10),PKW(pB1,12),PKW(pB1,14)};
    SBAR(); pv(o,vb0+sl_cur,PAF(0),PAF(1),PAF(2),PAF(3)); }
  #undef PKW
  #undef PAF
  #undef VFR
  #undef PIN
  #undef MX3
  #undef GAPA
  #undef GAPB
  #undef EX
  #undef VRD
  #undef KRD
  #undef STEP
  #undef ENDW
  {auto rr=__builtin_amdgcn_permlane32_swap(__float_as_uint(l_reg),__float_as_uint(l_reg),false,false);l_reg=__uint_as_float(rr[0])+__uint_as_float(rr[1]);}
  if(hi==0)wsf[32+r32]=l_reg;asm volatile("s_waitcnt lgkmcnt(0)":::"memory");
  float rli[16];
  #pragma unroll
  for(int r=0;r<16;++r)rli[r]=__builtin_amdgcn_rcpf(wsf[32+crow(r,hi)]);
  bf16*Ow=Ou+(long)(wid*QBLK)*QP;
  { bf16*stg=(bf16*)(shm+LDS_OST)+wid*2048;
    #pragma unroll
    for(int r=0;r<16;++r){const int orow=crow(r,hi);
      #pragma unroll
      for(int d0=0;d0<2;++d0)stg[orow*64+d0*32+r32]=__float2bfloat16(o[d0][r]*rli[r]);}
    asm volatile("s_waitcnt lgkmcnt(0)":::"memory");
    #pragma unroll
    for(int i=0;i<4;++i){const int row=i*8+(lane>>3),ch=lane&7; const u32x4 v=*(const u32x4*)(stg+row*64+ch*8); ATTN_STORE16(Ow+(long)row*QP+ch*8,v);} }
  asm volatile("s_waitcnt lgkmcnt(0)\n\ts_barrier":::"memory");
  #undef DMA_K
  #undef DMA_V
  #undef CMASK
  #undef START
  #undef RESC
  #undef ROT
}
constexpr int ATTN_LDS_BYTES=LDS_BYTES;
#undef SBAR
#undef WAIT_BAR
}
constexpr int NWAVES = 8;
constexpr int NLAT = 32768, NCTX = 1024, MALL = NLAT + NCTX, DM = 1024, SEQ = 8192, CTXL = 256, KVROWS = 8448, FFH = 2816;
constexpr size_t MiB = 1u << 20;
constexpr size_t WS_MOD = 0, WS_ROPE = 256 * 1024, WS_BAR = 280 * 1024, WS_SS = 296 * 1024, WS_SHW = 51 * MiB + 512 * 1024;
constexpr size_t WS_XN2 = 304 * MiB;
constexpr size_t WS_WQKV = 1 * MiB, WS_WO = 4 * MiB, WS_F1A = 6 * MiB, WS_F2A = 17 * MiB, WS_HIN = 23 * MiB, WS_HO = 33 * MiB, WS_F1B = 35 * MiB, WS_F2B = 46 * MiB, WS_HCTX = 52 * MiB, WS_XN = 56 * MiB;
constexpr size_t WS_U = 1 * MiB, WS_D = 18 * MiB;
constexpr size_t WS_QO = 122 * MiB, WS_K = 188 * MiB, WS_V = 205 * MiB, WS_HID0 = 122 * MiB;
constexpr size_t WS_HQ = 122 * MiB, WS_HG = 186 * MiB, WS_HV = 250 * MiB, WS_LFW = 314 * MiB, WS_LBW = 378 * MiB, WS_OFW = 442 * MiB, WS_OBW = 56 * MiB, WS_OG = 122 * MiB, WS_HID1 = 186 * MiB;
constexpr size_t WS_HVC = 506 * MiB, WS_LFWC = 508 * MiB, WS_LBWC = 510 * MiB;
constexpr size_t WS_END = 512 * MiB;
static_assert(WS_HQ == pg8::OFF_HQ && WS_HG == pg8::OFF_HG && WS_HV == pg8::OFF_HV && WS_LFW == pg8::OFF_LFW && WS_LBW == pg8::OFF_LBW && WS_HVC == pg8::OFF_HVC && WS_LFWC == pg8::OFF_LFWC && WS_LBWC == pg8::OFF_LBWC, "EpiHgrnIn offsets");
constexpr size_t F1_ELEMS = (size_t)2 * FFH * DM, F2_ELEMS = (size_t)DM * FFH;
constexpr int RING_BYTES = 131072, LDS_BYTES = 147456;

#define LAS __attribute__((address_space(3)))
typedef unsigned short bf16;
typedef unsigned v4u __attribute__((ext_vector_type(4)));
typedef unsigned v2u __attribute__((ext_vector_type(2)));
typedef float f32x4 __attribute__((ext_vector_type(4)));
typedef float f32x16 __attribute__((ext_vector_type(16)));
typedef short bf16x8 __attribute__((ext_vector_type(8)));
typedef float f32x2_t __attribute__((ext_vector_type(2)));
typedef __bf16 bf16x2_t __attribute__((ext_vector_type(2)));
__device__ __forceinline__ unsigned pk2(float lo, float hi) { f32x2_t v = {lo, hi}; bf16x2_t b = __builtin_convertvector(v, bf16x2_t); return __builtin_bit_cast(unsigned, b); }
__device__ __forceinline__ unsigned short f2bf(float f) { return (unsigned short)(pk2(f, 0.f) & 0xffffu); }
__device__ __forceinline__ float bf2f(unsigned short h) { return __builtin_bit_cast(float, (unsigned)h << 16); }
__device__ __forceinline__ float h2f(unsigned short h) { return (float)__builtin_bit_cast(_Float16, h); }
__device__ __forceinline__ float wave_sum(float v) {
#pragma unroll
    for (int o = 1; o < 64; o <<= 1) v += __shfl_xor(v, o);
    return v;
}
#define LDS_WAIT() asm volatile("s_waitcnt lgkmcnt(0)" ::: "memory")

template <int MODE> __device__ __forceinline__ int wmap(int o) {
    if (MODE == 1) { const int tile = o >> 8, w = o & 255, wc = w >> 6, bj = (w >> 5) & 1, e = w & 31; return tile * 256 + 128 * bj + 32 * wc + e; }
    if (MODE == 2) { const int half = o >= FFH ? 1 : 0, idx = o - half * FFH, pn = idx >> 7, q = idx & 127; return 256 * pn + 128 * half + q; }
    return o;
}
template <int MODE> __device__ __forceinline__ void p0_transpose_item(const float* W, int K, int N, bf16* WT, LAS float* scr, int item, int lane) {
    const int nblk = N / 32, kb = item / nblk, nb = item % nblk, k0 = 64 * kb, n0 = 32 * nb;
    float tv[32];
#pragma unroll
    for (int i = 0; i < 32; ++i) tv[i] = W[(size_t)(k0 + 2 * i + (lane >> 5)) * N + n0 + (lane & 31)];
#pragma unroll
    for (int i = 0; i < 32; ++i) scr[(2 * i + (lane >> 5)) * 33 + (lane & 31)] = tv[i];
    LDS_WAIT(); asm volatile("" ::: "memory");
    const int c = lane & 7;
#pragma unroll
    for (int j = 0; j < 4; ++j) { const int n = (lane >> 3) + 8 * j; const LAS float* s = scr + (8 * c) * 33 + n;
        v4u o; o.x = pk2(s[0 * 33], s[1 * 33]); o.y = pk2(s[2 * 33], s[3 * 33]); o.z = pk2(s[4 * 33], s[5 * 33]); o.w = pk2(s[6 * 33], s[7 * 33]);
        *(v4u*)(WT + (size_t)wmap<MODE>(n0 + n) * K + k0 + 8 * c) = o; }
    LDS_WAIT(); asm volatile("" ::: "memory");
}

__device__ __forceinline__ void norm_row_pair(int ra, int rb, bool hasb, int lane, const float* src_lat, const float* src_ctx, const float* w, const float* modl, int shi, int sci, bf16* XN) {
    const float* srca = ra < NLAT ? src_lat + (size_t)ra * DM : src_ctx + (size_t)(ra - NLAT) * DM;
    const float* srcb = rb < NLAT ? src_lat + (size_t)rb * DM : src_ctx + (size_t)(rb - NLAT) * DM;
    const int veca = ra < NLAT ? (ra >> 13) : 4, vecb = rb < NLAT ? (rb >> 13) : 4;
    f32x4 va[4], vb[4]; float sa = 0.f, sb = 0.f;
#pragma unroll
    for (int j = 0; j < 4; ++j) { va[j] = ((const f32x4*)srca + lane)[64 * j]; vb[j] = ((const f32x4*)srcb + lane)[64 * j]; }
#pragma unroll
    for (int j = 0; j < 4; ++j) { sa += (va[j].x * va[j].x + va[j].y * va[j].y) + (va[j].z * va[j].z + va[j].w * va[j].w); sb += (vb[j].x * vb[j].x + vb[j].y * vb[j].y) + (vb[j].z * vb[j].z + vb[j].w * vb[j].w); }
    const float rstda = rsqrtf(wave_sum(sa) * (1.f / DM) + 1e-6f), rstdb = rsqrtf(wave_sum(sb) * (1.f / DM) + 1e-6f);
    const f32x4* wp = (const f32x4*)w + lane;
    const f32x4* sha = (const f32x4*)(modl + veca * 6144 + shi * 1024) + lane; const f32x4* sca = (const f32x4*)(modl + veca * 6144 + sci * 1024) + lane;
    const f32x4* shb = (const f32x4*)(modl + vecb * 6144 + shi * 1024) + lane; const f32x4* scb = (const f32x4*)(modl + vecb * 6144 + sci * 1024) + lane;
    unsigned long long* oa = (unsigned long long*)(XN + (size_t)ra * DM) + lane; unsigned long long* ob = (unsigned long long*)(XN + (size_t)rb * DM) + lane;
#pragma unroll
    for (int j = 0; j < 4; ++j) { const f32x4 ww = wp[64 * j];
        const f32x4 ya = va[j] * rstda * ww * (sca[64 * j] + 1.0f) + sha[64 * j];
        oa[64 * j] = (unsigned long long)pk2(ya.x, ya.y) | ((unsigned long long)pk2(ya.z, ya.w) << 32);
        if (hasb) { const f32x4 yb = vb[j] * rstdb * ww * (scb[64 * j] + 1.0f) + shb[64 * j]; ob[64 * j] = (unsigned long long)pk2(yb.x, yb.y) | ((unsigned long long)pk2(yb.z, yb.w) << 32); } }
}
__device__ __forceinline__ void norm_rows(int gw, int NGW, int lane, const float* src_lat, const float* src_ctx, int r0, int nrows, const float* w, const float* modl, int shi, int sci, bf16* XN) {
    for (int r = r0 + gw; r < nrows; r += 2 * NGW) { const bool hasb = r + NGW < nrows; norm_row_pair(r, hasb ? r + NGW : r, hasb, lane, src_lat, src_ctx, w, modl, shi, sci, XN); }
}
__device__ __forceinline__ void final_norm_rows(int gw, int NGW, int lane, float* h, const float* w) {
    for (int r = gw; r < NLAT; r += NGW) {
        f32x4* xr = (f32x4*)(h + (size_t)r * DM) + lane;
        f32x4 v[4]; float s = 0.f;
#pragma unroll
        for (int j = 0; j < 4; ++j) { v[j] = xr[64 * j]; s += (v[j].x * v[j].x + v[j].y * v[j].y) + (v[j].z * v[j].z + v[j].w * v[j].w); }
        const float rstd = rsqrtf(wave_sum(s) * (1.f / DM) + 1e-6f);
        const f32x4* wp = (const f32x4*)w + lane;
#pragma unroll
        for (int j = 0; j < 4; ++j) xr[64 * j] = v[j] * rstd * wp[64 * j];
    }
}

constexpr int SC_Q0 = 0, SC_QM = 17408, SC_KE = 34816, SC_KT = 52224, SC_VT = 70656, SC_ST = 89088, SC_AT = 123904, SC_PS = 133120, SC_EL = 137216;
constexpr int NSTR = 272, TSTR = 144;
static_assert(SC_EL + 512 <= LDS_BYTES, "scan LDS map");
__device__ __forceinline__ int crow(int r, int hi) { return (r & 3) + 8 * (r >> 2) + 4 * hi; }
__device__ __forceinline__ int scan_row(int c, int s, int b, int dir) {
    if (c < 4) { const int idx = 64 * c + s; return NLAT + b * CTXL + (dir ? (CTXL - 1 - idx) : idx); }
    const int idx = 64 * (c - 4) + s; return b * SEQ + (dir ? (SEQ - 1 - idx) : idx);
}
#define MFMA32(a, b, c) __builtin_amdgcn_mfma_f32_32x32x16_bf16((a), (b), (c), 0, 0, 0)
template <int MODE> __device__ __forceinline__ void hgrn_scan_item(LAS unsigned char* lds, int item, const bf16* HQ, const bf16* HV, const bf16* LFW, const bf16* LBW, const bf16* HVc, const bf16* LFWc, const bf16* LBWc, bf16* OFW, bf16* OBW, float* UB, float* DB) {
    int tid_ = threadIdx.x; asm volatile("" : "+v"(tid_));
    const int tid = tid_, lane = tid & 63, wid = __builtin_amdgcn_readfirstlane(tid >> 6), r32 = lane & 31, hi = lane >> 5;
    const int seg = item & 3, stream = item >> 2, dir = stream & 1, h = (stream >> 1) & 7, b = stream >> 4;
    if (MODE == 0 && seg == 3) return;
    const bf16* LF = dir ? LBW : LFW; bf16* OX = dir ? OBW : OFW;
    const bf16* LFc = (dir ? LBWc : LFWc) - (size_t)NLAT * DM; const bf16* HVcb = HVc - (size_t)NLAT * DM;
    const int kp = lane, g = wid;
    const unsigned voff2 = (unsigned)(h * 128 + 2 * kp) * 2u;
    const int vt = wid & 3, th = wid >> 2;
    unsigned lfrA[8], qrA[8], vrA[8], lfrB[8], qrB[8], vrB[8];
#define SCAN_LOAD(LFR, QR, VR, c) do { const bf16* lfb_ = (c) < 4 ? LFc : LF; const bf16* hvb_ = (c) < 4 ? HVcb : HV; \
        _Pragma("unroll") for (int i = 0; i < 8; ++i) { const size_t r_ = (size_t)__builtin_amdgcn_readfirstlane(scan_row((c), 8 * g + i, b, dir)) * (DM * 2);     \
            LFR[i] = *(const unsigned*)((const char*)lfb_ + r_ + voff2); VR[i] = *(const unsigned*)((const char*)hvb_ + r_ + voff2); \
            if (MODE == 1) QR[i] = *(const unsigned*)((const char*)HQ + r_ + voff2);     } } while (0)
    f32x16 S[2];
#pragma unroll
    for (int j = 0; j < 2; ++j)
#pragma unroll
        for (int i = 0; i < 16; ++i) S[j][i] = 0.f;
    if (MODE == 1) {
        for (int js = 0; js < seg; ++js) { const int it = stream * 4 + js;
#pragma unroll
            for (int j = 0; j < 2; ++j)
#pragma unroll
                for (int i = 0; i < 16; ++i) S[j][i] = S[j][i] * DB[it * 128 + 32 * (2 * th + j) + crow(i, hi)] + UB[((size_t)it * 32 + j * 16 + i) * 512 + tid]; }
        *(LAS unsigned*)(lds + SC_AT + (tid >> 4) * TSTR + 64 + 4 * (tid & 15)) = 0u;
    }
    float dacc0 = 1.f, dacc1 = 1.f;
    const int c0 = 33 * seg;
    SCAN_LOAD(lfrA, qrA, vrA, c0); SCAN_LOAD(lfrB, qrB, vrB, c0 + 1);
    for (int cc = c0; cc < c0 + 33; cc += 2) {
      { const int c = cc;
        const bool has_out = (MODE == 1) && c >= 4;
        f32x2_t lf[8]; f32x2_t ps = {0.f, 0.f};
#pragma unroll
        for (int i = 0; i < 8; ++i) { lf[i] = (f32x2_t){h2f((unsigned short)(lfrA[i] & 0xffffu)), h2f((unsigned short)(lfrA[i] >> 16))}; ps += lf[i]; }
        *(LAS f32x2_t*)(lds + SC_PS + (g * 128 + 2 * kp) * 4) = ps;
        LDS_WAIT(); __builtin_amdgcn_s_barrier(); asm volatile("" ::: "memory");
        {
            f32x2_t pre = {0.f, 0.f}, Lmid = {0.f, 0.f}, Lend = {0.f, 0.f};
#pragma unroll
            for (int gg = 0; gg < 8; ++gg) { const f32x2_t p = *(const LAS f32x2_t*)(lds + SC_PS + (gg * 128 + 2 * kp) * 4); if (gg < g) pre += p; if (gg < 4) Lmid += p; Lend += p; }
            const f32x2_t eLmid = {__expf(Lmid.x), __expf(Lmid.y)}, eEndMid = {__expf(Lend.x - Lmid.x), __expf(Lend.y - Lmid.y)};
            if (g == 0) { const f32x2_t el = {__expf(Lend.x), __expf(Lend.y)}; *(LAS f32x2_t*)(lds + SC_EL + 2 * kp * 4) = el; dacc0 *= el.x; dacc1 *= el.y; }
            f32x2_t E = {__expf(pre.x - Lmid.x), __expf(pre.y - Lmid.y)};
            unsigned kt0[4], kt1[4];
#pragma unroll
            for (int i = 0; i < 8; ++i) {
                const f32x2_t f = {__expf(lf[i].x), __expf(lf[i].y)};
                E = E * f;
                const f32x2_t re = {__builtin_amdgcn_rcpf(E.x), __builtin_amdgcn_rcpf(E.y)};
                const f32x2_t ke = (1.0f - f) * re, kend = ke * eEndMid;
                const int s = 8 * g + i;
                if (has_out) {
                    const f32x2_t q = {bf2f((unsigned short)(qrA[i] & 0xffffu)), bf2f((unsigned short)(qrA[i] >> 16))};
                    const f32x2_t qm = q * E, q0 = qm * eLmid;
                    *(LAS unsigned*)(lds + SC_Q0 + s * NSTR + 4 * kp) = pk2(q0.x, q0.y);
                    *(LAS unsigned*)(lds + SC_QM + s * NSTR + 4 * kp) = pk2(qm.x, qm.y);
                    *(LAS unsigned*)(lds + SC_KE + s * NSTR + 4 * kp) = pk2(ke.x, ke.y);
                }
                const unsigned kd = pk2(kend.x, kend.y);
                if (i & 1) { kt0[i >> 1] |= kd << 16; kt1[i >> 1] |= kd & 0xffff0000u; } else { kt0[i >> 1] = kd & 0xffffu; kt1[i >> 1] = kd >> 16; }
            }
            *(LAS v4u*)(lds + SC_KT + (2 * kp) * TSTR + 16 * g) = (v4u){kt0[0], kt0[1], kt0[2], kt0[3]};
            *(LAS v4u*)(lds + SC_KT + (2 * kp + 1) * TSTR + 16 * g) = (v4u){kt1[0], kt1[1], kt1[2], kt1[3]};
            v4u v0, v1;
#pragma unroll
            for (int i2 = 0; i2 < 4; ++i2) { v0[i2] = (vrA[2 * i2] & 0xffffu) | (vrA[2 * i2 + 1] << 16); v1[i2] = (vrA[2 * i2] >> 16) | (vrA[2 * i2 + 1] & 0xffff0000u); }
            *(LAS v4u*)(lds + SC_VT + (2 * kp) * TSTR + 16 * g) = v0;
            *(LAS v4u*)(lds + SC_VT + (2 * kp + 1) * TSTR + 16 * g) = v1;
            if (has_out) {
#pragma unroll
                for (int j = 0; j < 2; ++j)
#pragma unroll
                    for (int g4 = 0; g4 < 4; ++g4)
                        *(LAS v2u*)(lds + SC_ST + (32 * vt + r32) * NSTR + (32 * (2 * th + j) + 8 * g4 + 4 * hi) * 2) = (v2u){pk2(S[j][4 * g4], S[j][4 * g4 + 1]), pk2(S[j][4 * g4 + 2], S[j][4 * g4 + 3])};
            }
        }
        if (c + 2 < c0 + 33) SCAN_LOAD(lfrA, qrA, vrA, c + 2);
        LDS_WAIT(); __builtin_amdgcn_s_barrier(); asm volatile("" ::: "memory");
        f32x16 o;
#pragma unroll
        for (int i = 0; i < 16; ++i) o[i] = 0.f;
        if (has_out && wid < 3) {
            const int si = wid >> 1, ti = (wid + 1) >> 1;
            f32x16 a;
#pragma unroll
            for (int i = 0; i < 16; ++i) a[i] = 0.f;
#pragma unroll
            for (int kk = 0; kk < 8; ++kk) {
                const bf16x8 A = *(const LAS bf16x8*)(lds + SC_KE + (32 * si + r32) * NSTR + (16 * kk + 8 * hi) * 2);
                const bf16x8 B = *(const LAS bf16x8*)(lds + SC_QM + (32 * ti + r32) * NSTR + (16 * kk + 8 * hi) * 2);
                a = MFMA32(A, B, a);
            }
            const int t = 32 * ti + r32;
#pragma unroll
            for (int g4 = 0; g4 < 4; ++g4) {
                const int s0 = 32 * si + 8 * g4 + 4 * hi;
                const float a0 = (s0 + 0 <= t) ? a[4 * g4 + 0] : 0.f, a1 = (s0 + 1 <= t) ? a[4 * g4 + 1] : 0.f, a2 = (s0 + 2 <= t) ? a[4 * g4 + 2] : 0.f, a3 = (s0 + 3 <= t) ? a[4 * g4 + 3] : 0.f;
                *(LAS v2u*)(lds + SC_AT + t * TSTR + s0 * 2) = (v2u){pk2(a0, a1), pk2(a2, a3)};
            }
        }
        {
            const LAS float* EL = (const LAS float*)(lds + SC_EL);
#pragma unroll
            for (int j = 0; j < 2; ++j) {
                const int kq = 2 * th + j;
#pragma unroll
                for (int i = 0; i < 16; ++i) S[j][i] *= EL[32 * kq + crow(i, hi)];
#pragma unroll
                for (int kk = 0; kk < 4; ++kk) {
                    const bf16x8 A = *(const LAS bf16x8*)(lds + SC_KT + (32 * kq + r32) * TSTR + (16 * kk + 8 * hi) * 2);
                    const bf16x8 B = *(const LAS bf16x8*)(lds + SC_VT + (32 * vt + r32) * TSTR + (16 * kk + 8 * hi) * 2);
                    S[j] = MFMA32(A, B, S[j]);
                }
            }
            if (has_out) {
#pragma unroll
                for (int kk = 0; kk < 8; ++kk) {
                    const bf16x8 A = *(const LAS bf16x8*)(lds + SC_Q0 + (32 * th + r32) * NSTR + (16 * kk + 8 * hi) * 2);
                    const bf16x8 B = *(const LAS bf16x8*)(lds + SC_ST + (32 * vt + r32) * NSTR + (16 * kk + 8 * hi) * 2);
                    o = MFMA32(A, B, o);
                }
            }
        }
        LDS_WAIT(); __builtin_amdgcn_s_barrier(); asm volatile("" ::: "memory");
        if (has_out) {
#pragma unroll
            for (int kk = 0; kk < 4; ++kk) {
                const bf16x8 A = *(const LAS bf16x8*)(lds + SC_AT + (32 * th + r32) * TSTR + (16 * kk + 8 * hi) * 2);
                const bf16x8 B = *(const LAS bf16x8*)(lds + SC_VT + (32 * vt + r32) * TSTR + (16 * kk + 8 * hi) * 2);
                o = MFMA32(A, B, o);
            }
#pragma unroll
            for (int i = 0; i < 16; ++i) *(LAS unsigned short*)(lds + SC_Q0 + wid * 2560 + crow(i, hi) * 80 + 2 * r32) = f2bf(o[i]);
            LDS_WAIT(); asm volatile("" ::: "memory");
#pragma unroll
            for (int j2 = 0; j2 < 2; ++j2) { const int tl = j2 * 16 + (lane >> 2), pc = lane & 3; const v4u pv = *(const LAS v4u*)(lds + SC_Q0 + wid * 2560 + tl * 80 + 16 * pc);
                const size_t r_ = (size_t)scan_row(c, 32 * th + tl, b, dir); *(v4u*)(OX + r_ * DM + h * 128 + 32 * vt + 8 * pc) = pv; }
        }
          }
      if (cc + 1 < c0 + 33) { const int c = cc + 1;
        const bool has_out = (MODE == 1) && c >= 4;
        f32x2_t lf[8]; f32x2_t ps = {0.f, 0.f};
#pragma unroll
        for (int i = 0; i < 8; ++i) { lf[i] = (f32x2_t){h2f((unsigned short)(lfrB[i] & 0xffffu)), h2f((unsigned short)(lfrB[i] >> 16))}; ps += lf[i]; }
        *(LAS f32x2_t*)(lds + SC_PS + (g * 128 + 2 * kp) * 4) = ps;
        LDS_WAIT(); __builtin_amdgcn_s_barrier(); asm volatile("" ::: "memory");
        {
            f32x2_t pre = {0.f, 0.f}, Lmid = {0.f, 0.f}, Lend = {0.f, 0.f};
#pragma unroll
            for (int gg = 0; gg < 8; ++gg) { const f32x2_t p = *(const LAS f32x2_t*)(lds + SC_PS + (gg * 128 + 2 * kp) * 4); if (gg < g) pre += p; if (gg < 4) Lmid += p; Lend += p; }
            const f32x2_t eLmid = {__expf(Lmid.x), __expf(Lmid.y)}, eEndMid = {__expf(Lend.x - Lmid.x), __expf(Lend.y - Lmid.y)};
            if (g == 0) { const f32x2_t el = {__expf(Lend.x), __expf(Lend.y)}; *(LAS f32x2_t*)(lds + SC_EL + 2 * kp * 4) = el; dacc0 *= el.x; dacc1 *= el.y; }
            f32x2_t E = {__expf(pre.x - Lmid.x), __expf(pre.y - Lmid.y)};
            unsigned kt0[4], kt1[4];
#pragma unroll
            for (int i = 0; i < 8; ++i) {
                const f32x2_t f = {__expf(lf[i].x), __expf(lf[i].y)};
                E = E * f;
                const f32x2_t re = {__builtin_amdgcn_rcpf(E.x), __builtin_amdgcn_rcpf(E.y)};
                const f32x2_t ke = (1.0f - f) * re, kend = ke * eEndMid;
                const int s = 8 * g + i;
                if (has_out) {
                    const f32x2_t q = {bf2f((unsigned short)(qrB[i] & 0xffffu)), bf2f((unsigned short)(qrB[i] >> 16))};
                    const f32x2_t qm = q * E, q0 = qm * eLmid;
                    *(LAS unsigned*)(lds + SC_Q0 + s * NSTR + 4 * kp) = pk2(q0.x, q0.y);
                    *(LAS unsigned*)(lds + SC_QM + s * NSTR + 4 * kp) = pk2(qm.x, qm.y);
                    *(LAS unsigned*)(lds + SC_KE + s * NSTR + 4 * kp) = pk2(ke.x, ke.y);
                }
                const unsigned kd = pk2(kend.x, kend.y);
                if (i & 1) { kt0[i >> 1] |= kd << 16; kt1[i >> 1] |= kd & 0xffff0000u; } else { kt0[i >> 1] = kd & 0xffffu; kt1[i >> 1] = kd >> 16; }
            }
            *(LAS v4u*)(lds + SC_KT + (2 * kp) * TSTR + 16 * g) = (v4u){kt0[0], kt0[1], kt0[2], kt0[3]};
            *(LAS v4u*)(lds + SC_KT + (2 * kp + 1) * TSTR + 16 * g) = (v4u){kt1[0], kt1[1], kt1[2], kt1[3]};
            v4u v0, v1;
#pragma unroll
            for (int i2 = 0; i2 < 4; ++i2) { v0[i2] = (vrB[2 * i2] & 0xffffu) | (vrB[2 * i2 + 1] << 16); v1[i2] = (vrB[2 * i2] >> 16) | (vrB[2 * i2 + 1] & 0xffff0000u); }
            *(LAS v4u*)(lds + SC_VT + (2 * kp) * TSTR + 16 * g) = v0;
            *(LAS v4u*)(lds + SC_VT + (2 * kp + 1) * TSTR + 16 * g) = v1;
            if (has_out) {
#pragma unroll
                for (int j = 0; j < 2; ++j)
#pragma unroll
                    for (int g4 = 0; g4 < 4; ++g4)
                        *(LAS v2u*)(lds + SC_ST + (32 * vt + r32) * NSTR + (32 * (2 * th + j) + 8 * g4 + 4 * hi) * 2) = (v2u){pk2(S[j][4 * g4], S[j][4 * g4 + 1]), pk2(S[j][4 * g4 + 2], S[j][4 * g4 + 3])};
            }
        }
        if (c + 2 < c0 + 33) SCAN_LOAD(lfrB, qrB, vrB, c + 2);
        LDS_WAIT(); __builtin_amdgcn_s_barrier(); asm volatile("" ::: "memory");
        f32x16 o;
#pragma unroll
        for (int i = 0; i < 16; ++i) o[i] = 0.f;
        if (has_out && wid < 3) {
            const int si = wid >> 1, ti = (wid + 1) >> 1;
            f32x16 a;
#pragma unroll
            for (int i = 0; i < 16; ++i) a[i] = 0.f;
#pragma unroll
            for (int kk = 0; kk < 8; ++kk) {
                const bf16x8 A = *(const LAS bf16x8*)(lds + SC_KE + (32 * si + r32) * NSTR + (16 * kk + 8 * hi) * 2);
                const bf16x8 B = *(const LAS bf16x8*)(lds + SC_QM + (32 * ti + r32) * NSTR + (16 * kk + 8 * hi) * 2);
                a = MFMA32(A, B, a);
            }
            const int t = 32 * ti + r32;
#pragma unroll
            for (int g4 = 0; g4 < 4; ++g4) {
                const int s0 = 32 * si + 8 * g4 + 4 * hi;
                const float a0 = (s0 + 0 <= t) ? a[4 * g4 + 0] : 0.f, a1 = (s0 + 1 <= t) ? a[4 * g4 + 1] : 0.f, a2 = (s0 + 2 <= t) ? a[4 * g4 + 2] : 0.f, a3 = (s0 + 3 <= t) ? a[4 * g4 + 3] : 0.f;
                *(LAS v2u*)(lds + SC_AT + t * TSTR + s0 * 2) = (v2u){pk2(a0, a1), pk2(a2, a3)};
            }
        }
        {
            const LAS float* EL = (const LAS float*)(lds + SC_EL);
#pragma unroll
            for (int j = 0; j < 2; ++j) {
                const int kq = 2 * th + j;
#pragma unroll
                for (int i = 0; i < 16; ++i) S[j][i] *= EL[32 * kq + crow(i, hi)];
#pragma unroll
                for (int kk = 0; kk < 4; ++kk) {
                    const bf16x8 A = *(const LAS bf16x8*)(lds + SC_KT + (32 * kq + r32) * TSTR + (16 * kk + 8 * hi) * 2);
                    const bf16x8 B = *(const LAS bf16x8*)(lds + SC_VT + (32 * vt + r32) * TSTR + (16 * kk + 8 * hi) * 2);
                    S[j] = MFMA32(A, B, S[j]);
                }
            }
            if (has_out) {
#pragma unroll
                for (int kk = 0; kk < 8; ++kk) {
                    const bf16x8 A = *(const LAS bf16x8*)(lds + SC_Q0 + (32 * th + r32) * NSTR + (16 * kk + 8 * hi) * 2);
                    const bf16x8 B = *(const LAS bf16x8*)(lds + SC_ST + (32 * vt + r32) * NSTR + (16 * kk + 8 * hi) * 2);
                    o = MFMA32(A, B, o);
                }
            }
        }
        LDS_WAIT(); __builtin_amdgcn_s_barrier(); asm volatile("" ::: "memory");
        if (has_out) {
#pragma unroll
            for (int kk = 0; kk < 4; ++kk) {
                const bf16x8 A = *(const LAS bf16x8*)(lds + SC_AT + (32 * th + r32) * TSTR + (16 * kk + 8 * hi) * 2);
                const bf16x8 B = *(const LAS bf16x8*)(lds + SC_VT + (32 * vt + r32) * TSTR + (16 * kk + 8 * hi) * 2);
                o = MFMA32(A, B, o);
            }
#pragma unroll
            for (int i = 0; i < 16; ++i) *(LAS unsigned short*)(lds + SC_Q0 + wid * 2560 + crow(i, hi) * 80 + 2 * r32) = f2bf(o[i]);
            LDS_WAIT(); asm volatile("" ::: "memory");
#pragma unroll
            for (int j2 = 0; j2 < 2; ++j2) { const int tl = j2 * 16 + (lane >> 2), pc = lane & 3; const v4u pv = *(const LAS v4u*)(lds + SC_Q0 + wid * 2560 + tl * 80 + 16 * pc);
                const size_t r_ = (size_t)scan_row(c, 32 * th + tl, b, dir); *(v4u*)(OX + r_ * DM + h * 128 + 32 * vt + 8 * pc) = pv; }
        }
          }
    }
#undef SCAN_LOAD
    if (MODE == 0) {
#pragma unroll
        for (int j = 0; j < 2; ++j)
#pragma unroll
            for (int i = 0; i < 16; ++i) UB[((size_t)item * 32 + j * 16 + i) * 512 + tid] = S[j][i];
        if (g == 0) { DB[item * 128 + 2 * kp] = dacc0; DB[item * 128 + 2 * kp + 1] = dacc1; }
    }
    LDS_WAIT(); __builtin_amdgcn_s_barrier(); asm volatile("" ::: "memory");
}
__device__ __forceinline__ void hgrn_combine(int gw, int NGW, int lane, const bf16* OFW, const bf16* OBW, const bf16* HG, const float* onorm, bf16* OG) {
    float wn[16];
#pragma unroll
    for (int e = 0; e < 16; ++e) wn[e] = onorm[lane * 16 + e];
    for (int r0 = gw; r0 < NLAT; r0 += 2 * NGW) {
        const bool hasb = r0 + NGW < NLAT; const int r1 = hasb ? r0 + NGW : r0;
        v4u a[2][2], bq[2][2], gg[2][2];
#pragma unroll
        for (int k = 0; k < 2; ++k) { const size_t off = (size_t)(k ? r1 : r0) * DM + lane * 16;
#pragma unroll
            for (int j = 0; j < 2; ++j) { a[k][j] = *(const v4u*)(OFW + off + 8 * j); bq[k][j] = *(const v4u*)(OBW + off + 8 * j); gg[k][j] = *(const v4u*)(HG + off + 8 * j); } }
#pragma unroll
        for (int k = 0; k < 2; ++k) {
            if (k == 1 && !hasb) break;
            float o[16], gt[16];
#pragma unroll
            for (int j = 0; j < 2; ++j)
#pragma unroll
                for (int e = 0; e < 4; ++e) { o[8 * j + 2 * e] = bf2f((unsigned short)(a[k][j][e] & 0xffffu)) + bf2f((unsigned short)(bq[k][j][e] & 0xffffu)); o[8 * j + 2 * e + 1] = bf2f((unsigned short)(a[k][j][e] >> 16)) + bf2f((unsigned short)(bq[k][j][e] >> 16));
                    gt[8 * j + 2 * e] = bf2f((unsigned short)(gg[k][j][e] & 0xffffu)); gt[8 * j + 2 * e + 1] = bf2f((unsigned short)(gg[k][j][e] >> 16)); }
            float ss = 0.f;
#pragma unroll
            for (int e = 0; e < 16; ++e) ss += o[e] * o[e];
            ss += __shfl_xor(ss, 1); ss += __shfl_xor(ss, 2); ss += __shfl_xor(ss, 4);
            const float rstd = rsqrtf(ss * (1.f / 128.f) + 1e-6f);
            unsigned pk[8];
#pragma unroll
            for (int e = 0; e < 8; ++e) { const float y0 = o[2 * e] * rstd * wn[2 * e] * __builtin_amdgcn_rcpf(1.0f + __expf(-gt[2 * e])), y1 = o[2 * e + 1] * rstd * wn[2 * e + 1] * __builtin_amdgcn_rcpf(1.0f + __expf(-gt[2 * e + 1])); pk[e] = pk2(y0, y1); }
            const size_t off = (size_t)(k ? r1 : r0) * DM + lane * 16;
            *(v4u*)(OG + off) = (v4u){pk[0], pk[1], pk[2], pk[3]}; *(v4u*)(OG + off + 8) = (v4u){pk[4], pk[5], pk[6], pk[7]};
        }
    }
}

#define XB_TMO      128
#define XB_XCNT(j)  (256  + 64 * (j))
#define XB_XSUB(j)  (1280 + 64 * (j))
#define XB_XGEN(j)  (2304 + 64 * (j))
#define XB_TOP      3328
#define XB_TOPGEN   3392
#define XCD_BAR_WORDS 3456
#define XB_SPIN_CAP (1u << 18)

__device__ __forceinline__ unsigned xb_ld(unsigned* p)              { return __hip_atomic_load(p, __ATOMIC_RELAXED, __HIP_MEMORY_SCOPE_AGENT); }
__device__ __forceinline__ unsigned xb_add(unsigned* p, unsigned v) { return __hip_atomic_fetch_add(p, v, __ATOMIC_RELAXED, __HIP_MEMORY_SCOPE_AGENT); }
__device__ __forceinline__ unsigned xb_xcc_id() { return (unsigned)__builtin_amdgcn_s_getreg((3 << 11) | 20) & 0xFu; }
#define XB_SPIN(cond, bar) do { unsigned _sp = 0; while (cond) { __builtin_amdgcn_s_sleep(1); \
    if ((++_sp & 255u) == 0u) { if (xb_ld(&(bar)[XB_TMO])) break; if (_sp > XB_SPIN_CAP) { atomicAdd(&(bar)[XB_TMO], 1u); break; } } } } while (0)

struct XcdBarrier {
    unsigned* bar; unsigned x;
    volatile LAS unsigned* st;
};

__device__ __forceinline__ XcdBarrier xcd_barrier_post(unsigned* bar, volatile LAS unsigned* st) {
    XcdBarrier b; b.bar = bar; b.x = xb_xcc_id(); b.st = st;
    if (threadIdx.x == 0) (void)xb_add(&bar[XB_XCNT(b.x)], 1u);
    return b;
}
__device__ __forceinline__ void xcd_barrier_complete(unsigned* bar, unsigned x, unsigned& nloc, unsigned& nx) {
    const unsigned G = gridDim.x * gridDim.y * gridDim.z;
    unsigned sum, cnt, mine, sp = 0u;
    for (;;) {
        sum = 0u; cnt = 0u; mine = 0u;
#pragma unroll
        for (unsigned j = 0; j < 16; ++j) { const unsigned c = xb_ld(&bar[XB_XCNT(j)]); sum += c; cnt += (c > 0u) ? 1u : 0u; mine = (j == x) ? c : mine; }
        if (sum == G) break;
        __builtin_amdgcn_s_sleep(1);
        if ((++sp & 255u) == 0u) { if (xb_ld(&bar[XB_TMO])) break; if (sp > XB_SPIN_CAP) { atomicAdd(&bar[XB_TMO], 1u); break; } }
    }
    nloc = mine > 0u ? mine : 1u; nx = cnt > 0u ? cnt : 1u;
}

__device__ __forceinline__ void xcd_barrier(const XcdBarrier& b) {
    asm volatile("s_waitcnt vmcnt(0)" ::: "memory");
    __syncthreads();
    if (threadIdx.x == 0) {
        unsigned* bar = b.bar;
        __builtin_amdgcn_s_waitcnt(0);
        unsigned nloc = b.st[0], nx = b.st[1];
        if (nloc == 0u) { xcd_barrier_complete(bar, b.x, nloc, nx); b.st[0] = nloc; b.st[1] = nx; }
        const unsigned old = xb_add(&bar[XB_XSUB(b.x)], 1u);
        const unsigned gen = old / nloc;
        if (old + 1u == (gen + 1u) * nloc) {
            __builtin_amdgcn_fence(__ATOMIC_RELEASE, "agent");
            asm volatile("s_waitcnt vmcnt(0)" ::: "memory");
            const unsigned og = xb_add(&bar[XB_TOP], 1u);
            const unsigned tg = og / nx;
            if (og + 1u == (tg + 1u) * nx) xb_add(&bar[XB_TOPGEN], 1u);
            else XB_SPIN(xb_ld(&bar[XB_TOPGEN]) == tg, bar);
            __builtin_amdgcn_fence(__ATOMIC_ACQUIRE, "agent");
            xb_add(&bar[XB_XGEN(b.x)], 1u);
            asm volatile("s_waitcnt vmcnt(0)" ::: "memory");
        } else {
            XB_SPIN(xb_ld(&bar[XB_XGEN(b.x)]) == gen, bar);
            __builtin_amdgcn_fence(__ATOMIC_ACQUIRE, "agent");
            asm volatile("s_waitcnt vmcnt(0)" ::: "memory");
        }
    }
    __syncthreads();
}

struct Args { const float* in[19]; float* out; unsigned char* ws; };
typedef __attribute__((address_space(4))) Args KArgs;
__device__ __forceinline__ int fresh_v(int t) { asm volatile("" : "+v"(t)); return t; }
__device__ __forceinline__ int fresh_s(int t) { asm volatile("" : "+s"(t)); return t; }
__global__ void __launch_bounds__(NWAVES * 64, 2) mk_fwd(Args args) {
    extern __shared__ __attribute__((aligned(16))) unsigned char lds_raw[];
    LAS unsigned char* lds = (LAS unsigned char*)lds_raw;
    cg::grid_group grid = cg::this_grid();
#define PHASE_IDS() const int tid = fresh_v((int)threadIdx.x), lane = tid & 63, wave = __builtin_amdgcn_readfirstlane(tid >> 6); (void)lane; (void)wave; \
    const int G = fresh_s((int)gridDim.x), bx = fresh_s((int)blockIdx.x); const int vcu = (G % 8 == 0) ? (bx % 8) * (G / 8) + bx / 8 : bx; (void)vcu; \
    const int gw = vcu * NWAVES + wave, NGW = G * NWAVES; (void)gw; (void)NGW; \
    const KArgs* ap = (const KArgs*)__builtin_amdgcn_kernarg_segment_ptr(); asm volatile("" : "+s"(ap)); unsigned char* ws = ap->ws; (void)ws
#define IN(k) (ap->in[k])
#define MOD ((float*)(ws + WS_MOD))
#define ROPEC ((float*)(ws + WS_ROPE))
#define ROPES (ROPEC + 128 * 16)
#define Wqkv_t ((bf16*)(ws + WS_WQKV))
#define Wo_t ((bf16*)(ws + WS_WO))
#define Hin_t ((bf16*)(ws + WS_HIN))
#define Ho_t ((bf16*)(ws + WS_HO))
#define F1A_t ((bf16*)(ws + WS_F1A))
#define F2A_t ((bf16*)(ws + WS_F2A))
#define F1B_t ((bf16*)(ws + WS_F1B))
#define F2B_t ((bf16*)(ws + WS_F2B))
#define HCTX ((float*)(ws + WS_HCTX))
#define XN ((bf16*)(ws + WS_XN))
#define QO ((bf16*)(ws + WS_QO))
#define KB ((bf16*)(ws + WS_K))
#define VB ((bf16*)(ws + WS_V))
#define MOD1 (MOD + 5 * 6144)
#define SS0 ((float*)(ws + WS_SS))
#define SS1 (SS0 + MALL)
#define SS2 (SS1 + MALL)
#define SS3 (SS2 + MALL)
#define SHW0 ((float*)(ws + WS_SHW))
#define SHW1 (SHW0 + 5 * 5632)
#define SHW2 (SHW1 + 5 * 5120)
    if (args.ws == nullptr) grid.sync();
    volatile LAS unsigned* bst = (volatile LAS unsigned*)(lds + LDS_BYTES - 16);
    if (threadIdx.x == 0) { bst[0] = 0u; bst[1] = 0u; }
    __syncthreads();
    const XcdBarrier bar = xcd_barrier_post((unsigned*)(args.ws + WS_BAR), bst);
    {
        PHASE_IDS();
        for (int i = (bx * NWAVES * 64) + tid; i < 4 * MALL; i += G * NWAVES * 64) SS0[i] = 0.f;
        LAS float* sl = (LAS float*)(lds + 73728);
        for (int i = tid; i < 5 * 1024; i += NWAVES * 64) { const float v = i < 4096 ? (ap->in[1])[i] : (ap->in[3])[i - 4096]; sl[i] = v / (1.0f + __expf(-v)); }
        __syncthreads();
        for (int it = gw; it < 768; it += NGW) {
            const int l = it / 384, n0 = (it % 384) * 16, cg4 = lane & 3, ks = lane >> 2;
            const float* W = (ap->in[4]) + (size_t)l * 1024 * 6144 + n0 + 4 * cg4;
            f32x4 acc[5];
#pragma unroll
            for (int v = 0; v < 5; ++v) acc[v] = (f32x4){0.f, 0.f, 0.f, 0.f};
#pragma unroll 8
            for (int i = 0; i < 64; ++i) { const int kk = i * 16 + ks; const f32x4 w4 = *(const f32x4*)(W + (size_t)kk * 6144);
#pragma unroll
                for (int v = 0; v < 5; ++v) acc[v] += w4 * sl[v * 1024 + kk]; }
#pragma unroll
            for (int v = 0; v < 5; ++v)
#pragma unroll
                for (int e = 0; e < 4; ++e) { float a = acc[v][e]; a += __shfl_xor(a, 4); a += __shfl_xor(a, 8); a += __shfl_xor(a, 16); a += __shfl_xor(a, 32); acc[v][e] = a; }
            if (ks == 0) { const f32x4 bb = *(const f32x4*)((ap->in[5]) + l * 6144 + n0 + 4 * cg4);
#pragma unroll
                for (int v = 0; v < 5; ++v) *(f32x4*)(MOD + (size_t)(l * 5 + v) * 6144 + n0 + 4 * cg4) = acc[v] + bb; }
        }
        for (int idx = bx * (NWAVES * 64) + tid; idx < 2048; idx += G * NWAVES * 64) {
            const int pos = idx >> 4, f = idx & 15;
            double inv = 1.0; for (int j = 0; j < f; ++j) inv *= 0.56234132519034908;
            const double ang = (double)pos * inv, TWO_PI = 6.283185307179586476925;
            const double kq = __builtin_rint(ang / TWO_PI); const double rr = ang - kq * TWO_PI, r2 = rr * rr;
            double cs = 1.0, sn = rr, tc = 1.0, tsn = rr;
            for (int n = 1; n <= 14; ++n) { tc *= -r2 / (double)((2 * n - 1) * (2 * n)); tsn *= -r2 / (double)((2 * n) * (2 * n + 1)); cs += tc; sn += tsn; }
            ROPEC[idx] = (float)cs; ROPES[idx] = (float)sn;
        }
        LAS float* scr = (LAS float*)(lds + wave * 8448);
        constexpr int I_QKV = 16 * 48, I_O = 16 * 32, I_HIN = 16 * 160, I_HO = 16 * 32, I_F1 = 16 * 176, I_F2 = 44 * 32;
        constexpr int NITEMS = I_QKV + I_O + I_HIN + I_HO + 2 * I_F1 + 2 * I_F2;
        for (int it = gw; it < NITEMS; it += NGW) {
            int r = it;
            if (r < I_QKV) { p0_transpose_item<1>((ap->in[8]), 1024, 1536, Wqkv_t, scr, r, lane); continue; } r -= I_QKV;
            if (r < I_O) { p0_transpose_item<0>((ap->in[11]), 1024, 1024, Wo_t, scr, r, lane); continue; } r -= I_O;
            if (r < I_HIN) { p0_transpose_item<0>((ap->in[12]), 1024, 5120, Hin_t, scr, r, lane); continue; } r -= I_HIN;
            if (r < I_HO) { p0_transpose_item<0>((ap->in[15]), 1024, 1024, Ho_t, scr, r, lane); continue; } r -= I_HO;
            if (r < I_F1) { p0_transpose_item<2>((ap->in[16]), 1024, 5632, F1A_t, scr, r, lane); continue; } r -= I_F1;
            if (r < I_F1) { p0_transpose_item<2>((ap->in[16]) + (size_t)1024 * 5632, 1024, 5632, F1B_t, scr, r, lane); continue; } r -= I_F1;
            if (r < I_F2) { p0_transpose_item<0>((ap->in[17]), 2816, 1024, F2A_t, scr, r, lane); continue; } r -= I_F2;
            p0_transpose_item<0>((ap->in[17]) + (size_t)2816 * 1024, 2816, 1024, F2B_t, scr, r, lane);
        }
    }
    xcd_barrier(bar);
    { PHASE_IDS();
      const bool qcu = (G == 256) && bx < 24;
      if (qcu) {
          const int pm = 128 + bx / 6, pn = bx % 6;
          norm_rows(wave, NWAVES, lane, (ap->in[0]), (ap->in[2]), pm * 256, pm * 256 + 256, (ap->in[6]), MOD, 0, 1, XN);
          asm volatile("s_waitcnt vmcnt(0)" ::: "memory"); __syncthreads();
          if (tid == 0) { __builtin_amdgcn_fence(__ATOMIC_ACQUIRE, "agent"); asm volatile("s_waitcnt vmcnt(0)" ::: "memory"); }
          __syncthreads();
          pg8::Gemm gq{XN, Wqkv_t, MALL, 1536, 1024}; pg8::OneUnit Sq{pm, pn, nullptr};
          pg8::EpiQKV Eq{QO, KB, VB, (ap->in[9]), (ap->in[10]), ROPEC, ROPES, attn_body::C2};
          pg8::gemm_phase<pg8::EpiQKV, pg8::OneUnit, PG8_ALIGN, PG8_SP2>(lds, gq, Sq, Eq);
      } else {
      const int gw1 = (G == 256) ? (bx - 24) * NWAVES + wave : gw, NGW1 = (G == 256) ? 232 * NWAVES : NGW;
      norm_rows(gw1, NGW1, lane, (ap->in[0]), (ap->in[2]), 0, (G == 256) ? NLAT : MALL, (ap->in[6]), MOD, 0, 1, XN);
      for (int site = 0; site < 3; ++site) {
          const bf16* Bt = site == 0 ? F1A_t : site == 1 ? Hin_t : F1B_t; const int N = site == 1 ? 5120 : 5632;
          const float* shv = (site == 0 ? MOD : MOD1) + (site == 1 ? 0 : 3) * 1024; float* dst = site == 0 ? SHW0 : site == 1 ? SHW1 : SHW2;
          for (int n = gw1; n < N; n += NGW1) {
              const v4u w0 = *(const v4u*)(Bt + (size_t)n * 1024 + lane * 16), w1 = *(const v4u*)(Bt + (size_t)n * 1024 + lane * 16 + 8);
              float wf[16];
#pragma unroll
              for (int e = 0; e < 4; ++e) { wf[2 * e] = bf2f((unsigned short)(w0[e] & 0xffffu)); wf[2 * e + 1] = bf2f((unsigned short)(w0[e] >> 16)); wf[8 + 2 * e] = bf2f((unsigned short)(w1[e] & 0xffffu)); wf[8 + 2 * e + 1] = bf2f((unsigned short)(w1[e] >> 16)); }
#pragma unroll
              for (int v = 0; v < 5; ++v) { const float* sp = shv + v * 6144 + lane * 16; float a = 0.f;
#pragma unroll
                  for (int e4 = 0; e4 < 4; ++e4) { const f32x4 s4 = *(const f32x4*)(sp + 4 * e4); a += (wf[4 * e4] * s4[0] + wf[4 * e4 + 1] * s4[1]) + (wf[4 * e4 + 2] * s4[2] + wf[4 * e4 + 3] * s4[3]); }
                  a = wave_sum(a); if (lane == 0) dst[v * N + n] = a; }
          }
      }
      }
    }
    xcd_barrier(bar);
    {
        PHASE_IDS();
        const int Mrows = (G == 256) ? NLAT : MALL;
        pg8::Gemm g{XN, Wqkv_t, Mrows, 1536, 1024}; pg8::StaticOrder S; S.init(Mrows, 1536, G, bx);
        pg8::EpiQKV E{QO, KB, VB, (ap->in[9]), (ap->in[10]), ROPEC, ROPES, attn_body::C2};
        pg8::gemm_phase<pg8::EpiQKV, pg8::StaticOrder, PG8_ALIGN, PG8_SP2>(lds, g, S, E);
    }
    xcd_barrier(bar);
    {
        PHASE_IDS();
        for (int i = 0; i < 8; ++i) {
            const int u = i * 256 + vcu; if (u >= 2048 || G != 256) break;
            const int combo = u >> 7, idx = u & 127, b = combo >> 2, kvh = combo & 3, hq = idx >> 5, qb = idx & 31, h = kvh * 4 + hq;
            const attn_body::bf16* Qu = (const attn_body::bf16*)QO + ((size_t)b * SEQ + qb * 256) * 1024 + h * 64;
            const attn_body::bf16* Kh = (const attn_body::bf16*)KB + (size_t)b * KVROWS * 256 + kvh * 64;
            const attn_body::bf16* Vh = (const attn_body::bf16*)VB + (size_t)b * KVROWS * 256 + kvh * 64;
            attn_body::attn_unit<8>(Qu, Kh, Vh, (attn_body::bf16*)XN + (Qu - (const attn_body::bf16*)QO), 132, (char*)lds_raw);
        }
        if (G != 256) for (int u = bx; u < 2048; u += G) {
            const int combo = u >> 7, idx = u & 127, b = combo >> 2, kvh = combo & 3, hq = idx >> 5, qb = idx & 31, h = kvh * 4 + hq;
            const attn_body::bf16* Qu = (const attn_body::bf16*)QO + ((size_t)b * SEQ + qb * 256) * 1024 + h * 64;
            const attn_body::bf16* Kh = (const attn_body::bf16*)KB + (size_t)b * KVROWS * 256 + kvh * 64;
            const attn_body::bf16* Vh = (const attn_body::bf16*)VB + (size_t)b * KVROWS * 256 + kvh * 64;
            attn_body::attn_unit<8>(Qu, Kh, Vh, (attn_body::bf16*)XN + (Qu - (const attn_body::bf16*)QO), 132, (char*)lds_raw);
        }
        for (int u = bx; u < 64; u += G) {
            const int b = u >> 4, h = u & 15, kvh = h >> 2;
            const attn_body::bf16* Qu = (const attn_body::bf16*)QO + ((size_t)NLAT + b * CTXL) * 1024 + h * 64;
            const attn_body::bf16* Kh = (const attn_body::bf16*)KB + (size_t)b * KVROWS * 256 + kvh * 64;
            const attn_body::bf16* Vh = (const attn_body::bf16*)VB + (size_t)b * KVROWS * 256 + kvh * 64;
            attn_body::attn_unit<8>(Qu, Kh, Vh, (attn_body::bf16*)XN + (Qu - (const attn_body::bf16*)QO), 4, (char*)lds_raw);
        }
    }
    xcd_barrier(bar);
    {
        PHASE_IDS();
        const int Mrows = (G == 256) ? NLAT : MALL;
        pg8::Gemm g{XN, Wo_t, Mrows, 1024, 1024}; pg8::StaticOrder S; S.init(Mrows, 1024, G, bx);
        pg8::EpiResidN E{(ap->in[0]), (ap->in[2]), (ap->out), HCTX, MOD + 2 * 1024, (bf16*)(ws + WS_XN2), SS0, (ap->in[7]), MOD + 4 * 1024, (LAS float*)(lds + 139264)};
        pg8::gemm_phase<pg8::EpiResidN, pg8::StaticOrder, PG8_ALIGN, PG8_SP2>(lds, g, S, E);
    }
    xcd_barrier(bar);
    {
        PHASE_IDS();
        pg8::EpiSwiGLU E{(bf16*)(ws + WS_HID0), SS0, SHW0};
        pg8::Gemm g{(const bf16*)(ws + WS_XN2), F1A_t, MALL, 5632, 1024};
        if (G == 256) {
            unsigned* cntW = (unsigned*)(ws + WS_BAR) + XCD_BAR_WORDS + 64; unsigned* cntU = cntW + 64; unsigned* cntD = cntW + 128;
            if (bx < 240) {
                const int x = bx & 7, idx = bx >> 3; const bool hasW = (x == 0 && idx < 16), hasH = idx < 6;
                if (hasW) {
                    pg8::Gemm gw_{XN, Wo_t, MALL, 1024, 1024}; pg8::OneUnit Sw{128 + (idx >> 2), idx & 3, cntW};
                    pg8::EpiResidN Ew{(ap->in[0]), (ap->in[2]), (ap->out), HCTX, MOD + 2 * 1024, (bf16*)(ws + WS_XN2), SS0, (ap->in[7]), MOD + 4 * 1024, (LAS float*)(lds + 139264)};
                    pg8::gemm_phase<pg8::EpiResidN, pg8::OneUnit, PG8_ALIGN, PG8_SP2>(lds, gw_, Sw, Ew);
                }
                pg8::UpOrder S{bx, hasW ? 1 : 0, hasH ? 11 : 12, cntW, cntU};
                pg8::gemm_phase<pg8::EpiSwiGLU, pg8::UpOrder, PG8_ALIGN, PG8_SP2>(lds, g, S, E);
                if (hasH) {
                    pg8::wave_wait_count(cntD, 16u); __syncthreads();
                    const int hidx = x * 6 + idx;
                    pg8::Gemm gh{XN, Hin_t, MALL, 5120, 1024}; pg8::OneUnit Sh{128 + hidx / 12, 8 + hidx % 12, nullptr};
                    pg8::EpiHgrnIn Eh{ws, (ap->in[13]), SS1, SHW1};
                    pg8::gemm_phase<pg8::EpiHgrnIn, pg8::OneUnit, PG8_ALIGN, PG8_SP2>(lds, gh, Sh, Eh);
                }
            } else {
                const int d = bx - 240;
                { pg8::UpOrderD S{d, 0, 3}; pg8::gemm_phase<pg8::EpiSwiGLU, pg8::UpOrderD, PG8_ALIGN, PG8_SP2>(lds, g, S, E); }
                pg8::wave_wait_count(cntU, 88u); __syncthreads();
                {
                    pg8::Gemm g2{(const bf16*)(ws + WS_HID0), F2A_t, MALL, 1024, FFH}; pg8::OneUnit S2{128 + (d >> 2), d & 3, cntD};
                    pg8::EpiResidN E2{(ap->out), HCTX, (ap->out), HCTX, MOD + 5 * 1024, XN, SS1, (ap->in[6]) + 1024, MOD1 + 1 * 1024, (LAS float*)(lds + 139264)};
                    pg8::gemm_phase<pg8::EpiResidN, pg8::OneUnit, PG8_ALIGN, PG8_SP2>(lds, g2, S2, E2);
                }
                { pg8::UpOrderD S{d, 3, 6}; pg8::gemm_phase<pg8::EpiSwiGLU, pg8::UpOrderD, PG8_ALIGN, PG8_SP2>(lds, g, S, E); }
            }
        } else {
            pg8::StaticOrder S; S.init(MALL, 5632, G, bx);
            pg8::gemm_phase<pg8::EpiSwiGLU, pg8::StaticOrder, PG8_ALIGN, PG8_SP2>(lds, g, S, E);
        }
    }
    xcd_barrier(bar);
    {
        PHASE_IDS();
        const int Mrows = (G == 256) ? NLAT : MALL;
        pg8::Gemm g{(const bf16*)(ws + WS_HID0), F2A_t, Mrows, 1024, FFH}; pg8::StaticOrder S; S.init(Mrows, 1024, G, bx);
        pg8::EpiResidN E{(ap->out), HCTX, (ap->out), HCTX, MOD + 5 * 1024, XN, SS1, (ap->in[6]) + 1024, MOD1 + 1 * 1024, (LAS float*)(lds + 139264)};
        pg8::gemm_phase<pg8::EpiResidN, pg8::StaticOrder, PG8_ALIGN, PG8_SP2>(lds, g, S, E);
    }
    xcd_barrier(bar);
    {
        PHASE_IDS();
        const int Mrows = (G == 256) ? NLAT : MALL;
        pg8::Gemm g{XN, Hin_t, Mrows, 5120, 1024}; pg8::StaticOrder S; S.init(Mrows, 5120, G, bx);
        pg8::EpiHgrnIn E{ws, (ap->in[13]), SS1, SHW1};
        pg8::gemm_phase<pg8::EpiHgrnIn, pg8::StaticOrder, PG8_ALIGN, PG8_SP2>(lds, g, S, E);
    }
    xcd_barrier(bar);
    { PHASE_IDS();
    for (int item = bx; item < 256; item += G)
        hgrn_scan_item<0>(lds, item, (const bf16*)(ws + WS_HQ), (const bf16*)(ws + WS_HV), (const bf16*)(ws + WS_LFW), (const bf16*)(ws + WS_LBW), (const bf16*)(ws + WS_HVC), (const bf16*)(ws + WS_LFWC), (const bf16*)(ws + WS_LBWC), (bf16*)(ws + WS_OFW), (bf16*)(ws + WS_OBW), (float*)(ws + WS_U), (float*)(ws + WS_D)); }
    xcd_barrier(bar);
    { PHASE_IDS();
    for (int item = bx; item < 256; item += G)
        hgrn_scan_item<1>(lds, item, (const bf16*)(ws + WS_HQ), (const bf16*)(ws + WS_HV), (const bf16*)(ws + WS_LFW), (const bf16*)(ws + WS_LBW), (const bf16*)(ws + WS_HVC), (const bf16*)(ws + WS_LFWC), (const bf16*)(ws + WS_LBWC), (bf16*)(ws + WS_OFW), (bf16*)(ws + WS_OBW), (float*)(ws + WS_U), (float*)(ws + WS_D)); }
    xcd_barrier(bar);
    { PHASE_IDS(); hgrn_combine(gw, NGW, lane, (const bf16*)(ws + WS_OFW), (const bf16*)(ws + WS_OBW), (const bf16*)(ws + WS_HG), (ap->in[14]), (bf16*)(ws + WS_OG)); }
    xcd_barrier(bar);
    {
        PHASE_IDS();
        pg8::Gemm g{(const bf16*)(ws + WS_OG), Ho_t, NLAT, 1024, 1024}; pg8::StaticOrder S; S.init(NLAT, 1024, G, bx);
        pg8::EpiResidN E{(ap->out), HCTX, (ap->out), HCTX, MOD1 + 2 * 1024, XN, SS2, (ap->in[7]) + 1024, MOD1 + 4 * 1024, (LAS float*)(lds + 139264)};
        pg8::gemm_phase<pg8::EpiResidN, pg8::StaticOrder, PG8_ALIGN, PG8_SP2>(lds, g, S, E);
    }
    xcd_barrier(bar);
    {
        PHASE_IDS();
        pg8::Gemm g{XN, F1B_t, NLAT, 5632, 1024}; pg8::StaticOrder S; S.init(NLAT, 5632, G, bx);
        pg8::EpiSwiGLU E{(bf16*)(ws + WS_HID1), SS2, SHW2};
        pg8::gemm_phase<pg8::EpiSwiGLU, pg8::StaticOrder, PG8_ALIGN, PG8_SP2>(lds, g, S, E);
    }
    xcd_barrier(bar);
    {
        PHASE_IDS();
        pg8::Gemm g{(const bf16*)(ws + WS_HID1), F2B_t, NLAT, 1024, FFH}; pg8::StaticOrder S; S.init(NLAT, 1024, G, bx);
        if (G == 256) {
            pg8::EpiResidFinal E{(ap->out), (ap->out), MOD1 + 5 * 1024, SS3, (unsigned*)(ws + WS_BAR) + XCD_BAR_WORDS + 256, (ap->in[18]), (LAS float*)(lds + 139264)};
            pg8::gemm_phase<pg8::EpiResidFinal, pg8::StaticOrder, PG8_ALIGN, PG8_SP2>(lds, g, S, E);
        } else {
            pg8::EpiResid E{(ap->out), HCTX, (ap->out), HCTX, MOD1 + 5 * 1024};
            pg8::gemm_phase<pg8::EpiResid, pg8::StaticOrder, PG8_ALIGN, PG8_SP2>(lds, g, S, E);
        }
    }
    if (gridDim.x != 256) {
        xcd_barrier(bar);
        { PHASE_IDS(); final_norm_rows(gw, NGW, lane, (ap->out), (ap->in[18])); }
    }
}


extern "C" void kernel_launch(void* const* d_in, const int* in_sizes, int n_in, void* d_out, int out_size, void* d_ws, size_t ws_size, hipStream_t stream) {
    static int grid = 0;
    if (grid == 0) {
        if (n_in != 19 || out_size != NLAT * DM || ws_size < WS_END) { fprintf(stderr, "kernel_launch: unexpected shapes: n_in %d out %d ws %zu\n", n_in, out_size, ws_size); grid = -1; return; }
        int dev = 0, cus = 0, per_cu = 0;
        if (hipGetDevice(&dev) != hipSuccess || hipDeviceGetAttribute(&cus, hipDeviceAttributeMultiprocessorCount, dev) != hipSuccess) { grid = -1; return; }
        if (hipFuncSetAttribute((const void*)mk_fwd, hipFuncAttributeMaxDynamicSharedMemorySize, LDS_BYTES) != hipSuccess) { fprintf(stderr, "kernel_launch: hipFuncSetAttribute failed\n"); grid = -1; return; }
        if (hipOccupancyMaxActiveBlocksPerMultiprocessor(&per_cu, (const void*)mk_fwd, NWAVES * 64, LDS_BYTES) != hipSuccess || per_cu < 1) { fprintf(stderr, "kernel_launch: occupancy query says %d\n", per_cu); per_cu = 1; }
        (void)hipGetLastError();
        grid = cus;
    }
    if (grid < 0) return;
    if (hipMemsetAsync((char*)d_ws + WS_BAR, 0, (XCD_BAR_WORDS + 512) * 4, stream) != hipSuccess) { fprintf(stderr, "kernel_launch: memset of the barrier words failed\n"); return; }
    Args a{};
    for (int i = 0; i < 19; ++i) a.in[i] = (const float*)d_in[i];
    a.out = (float*)d_out; a.ws = (unsigned char*)d_ws;
    void* kargs[] = {&a};
    hipError_t e = hipLaunchCooperativeKernel((const void*)mk_fwd, dim3(grid), dim3(NWAVES * 64), kargs, LDS_BYTES, stream);
    if (e != hipSuccess) fprintf(stderr, "kernel_launch: cooperative launch failed: %s (grid %d)\n", hipGetErrorString(e), grid);
}
```

```cpp
#include <hip/hip_cooperative_groups.h>
namespace cg = cooperative_groups;
#include <hip/hip_runtime.h>
#include <cstdio>
#include <cstdint>
namespace pg8 {
#define PG8_LAS __attribute__((address_space(3)))
typedef unsigned short bf16_t;
typedef short bf16x8 __attribute__((ext_vector_type(8)));
typedef float f32x4 __attribute__((ext_vector_type(4)));
typedef unsigned u32x4 __attribute__((ext_vector_type(4)));
constexpr int BM = 256, BK = 64, HALF = 128, HTB = HALF * BK * 2  , STAGE_BYTES = 8 * HTB, NXCD = 8, WGM = 8;

__host__ __device__ __forceinline__ int lds_byte(int r, int c) { const int st = (r >> 4) * 2 + (c >> 5), rr = r & 15, cc = c & 31, ob = rr * 64 + cc * 2; return st * 1024 + (ob ^ (((ob >> 9) & 1) << 5)); }
__host__ __device__ __forceinline__ void stage_rc(int b, int& R, int& C) { const int st = b / 1024, sb = b % 1024, swz = sb ^ (((sb >> 9) & 1) << 5); R = (st >> 1) * 16 + swz / 64; C = (st & 1) * 32 + (swz % 64) / 2; }
__host__ __device__ __forceinline__ int perm32(int rho) { const int n = rho >> 4, i = rho & 15; return 8 * (i >> 2) + 4 * n + (i & 3); }

struct Unit { int pm, pn; };
struct Gemm { const bf16_t* A; const bf16_t* Bt; int M, N, K; };

struct StaticOrder {
    int nM, nN, nwg, G, c;
    __host__ __device__ void init(int M, int N, int G_, int c_) { nM = M / BM; nN = N / BM; nwg = nM * nN; G = G_; c = c_; }
    __host__ __device__ bool next(int i, Unit& u) const {
        const long L = (long)i * G + c; if (L >= nwg) return false;
        int wgid = (int)L; { const int q = nwg / NXCD, r = nwg % NXCD, xcd = wgid % NXCD, off = wgid / NXCD; wgid = (xcd < r ? xcd * (q + 1) : r * (q + 1) + (xcd - r) * q) + off; }
        const int nig = WGM * nN, gid = wgid / nig, fm = gid * WGM, gsz = (nM - fm) < WGM ? (nM - fm) : WGM;
        u.pm = fm + ((wgid % nig) % gsz); u.pn = (wgid % nig) / gsz; return true;
    }
    __device__ __forceinline__ void a_ready(const Unit&) const {}
    __device__ __forceinline__ void done(const Unit&) const {}
};

__device__ __forceinline__ unsigned cvt_pk_bf16(float lo, float hi) { unsigned r; asm volatile("v_cvt_pk_bf16_f32 %0, %1, %2" : "=v"(r) : "v"(lo), "v"(hi)); return r; }
typedef unsigned u32x2 __attribute__((ext_vector_type(2)));
constexpr int NLAT = 32768, KVROWS = 8448;

struct EpiQKV {
    static constexpr bool PERM = false, AFTER_DRAIN = false;
    bf16_t* Q; bf16_t* Kall; bf16_t* Vall; const float* qn; const float* kn; const float* ropec; const float* ropes; float qscale;
    __device__ __forceinline__ void operator()(const f32x4 (&acc)[2][2][4][2], const Unit& u, int wr, int wc, int fr, int fq) const {
        const int pn = u.pn; const bool isv = (pn == 5), isk = (pn == 4);
        const float* nw = isk ? kn : qn;
        f32x4 w[2][2];
#pragma unroll
        for (int bj = 0; bj < 2; ++bj)
#pragma unroll
            for (int n = 0; n < 2; ++n) w[bj][n] = *(const f32x4*)(nw + 32 * bj + 16 * n + 4 * fq);
        const float osc = (pn < 4) ? qscale : 1.f;
        float ifr[4];
        int fq2 = fq; asm volatile("" : "+v"(fq2));
#pragma unroll
        for (int j = 0; j < 4; ++j) ifr[j] = __builtin_amdgcn_exp2f(-0.83048202372184058696f * (float)(4 * fq2 + j)) * 0.15915494309189533577f;
#pragma unroll
        for (int ai = 0; ai < 2; ++ai)
#pragma unroll
            for (int m = 0; m < 4; ++m) {
                const int r = u.pm * BM + ai * HALF + wr * 64 + m * 16 + fr;
                const bool lat = r < NLAT; int b, t;
                if (lat) { b = r >> 13; t = r & 8191; } else { const int rc = r - NLAT; b = rc >> 8; t = rc & 255; }
                f32x4 x[2][2];
#pragma unroll
                for (int bj = 0; bj < 2; ++bj)
#pragma unroll
                    for (int n = 0; n < 2; ++n) x[bj][n] = acc[ai][bj][m][n];
                if (!isv) {
                    float ss = 0.f;
#pragma unroll
                    for (int bj = 0; bj < 2; ++bj)
#pragma unroll
                        for (int n = 0; n < 2; ++n) { const f32x4 v = x[bj][n]; ss += (v[0] * v[0] + v[1] * v[1]) + (v[2] * v[2] + v[3] * v[3]); }
                    ss += __shfl_xor(ss, 16); ss += __shfl_xor(ss, 32);
                    const float rs = rsqrtf(ss * (1.0f / 64.0f) + 1e-6f);
#pragma unroll
                    for (int bj = 0; bj < 2; ++bj)
#pragma unroll
                        for (int n = 0; n < 2; ++n) x[bj][n] = x[bj][n] * rs * w[bj][n];
                    if (lat) {
#pragma unroll
                        for (int bj = 0; bj < 2; ++bj) {
                            const int pos = bj == 0 ? (t >> 6) : (t & 63);
                            f32x4 c, s;
#pragma unroll
                            for (int j = 0; j < 4; ++j) { const float rev = __builtin_amdgcn_fractf((float)pos * ifr[j]); c[j] = __builtin_amdgcn_cosf(rev); s[j] = __builtin_amdgcn_sinf(rev); }
                            const f32x4 x1 = x[bj][0], x2 = x[bj][1];
                            x[bj][0] = x1 * c - x2 * s; x[bj][1] = x2 * c + x1 * s;
                        }
                    }
#pragma unroll
                    for (int bj = 0; bj < 2; ++bj)
#pragma unroll
                        for (int n = 0; n < 2; ++n) x[bj][n] = x[bj][n] * osc;
                }
                bf16_t* dst;
                if (pn < 4) dst = Q + (size_t)r * 1024 + pn * 256 + 64 * wc;
                else { const size_t kr = (size_t)b * KVROWS + (lat ? 256 + t : t); dst = (isk ? Kall : Vall) + kr * 256 + 64 * wc; }
#pragma unroll
                for (int bj = 0; bj < 2; ++bj)
#pragma unroll
                    for (int n = 0; n < 2; ++n) { u32x2 p; p.x = cvt_pk_bf16(x[bj][n][0], x[bj][n][1]); p.y = cvt_pk_bf16(x[bj][n][2], x[bj][n][3]); *(u32x2*)(dst + 32 * bj + 16 * n + 4 * fq) = p; }
                asm volatile("" ::: "memory");
            }
    }
};

struct EpiResid {
    static constexpr bool PERM = true, AFTER_DRAIN = false;
    const float* base_lat; const float* base_ctx; float* out_lat; float* out_ctx; const float* gate;
    __device__ __forceinline__ void operator()(const f32x4 (&acc)[2][2][4][2], const Unit& u, int wr, int wc, int fr, int fq) const {
        const int rowt = u.pm * BM; const bool lat = rowt < NLAT; const int vec = lat ? (rowt >> 13) : 4;
        const float* bp = lat ? base_lat + (size_t)rowt * 1024 : base_ctx + (size_t)(rowt - NLAT) * 1024;
        float* op = lat ? out_lat + (size_t)rowt * 1024 : out_ctx + (size_t)(rowt - NLAT) * 1024;
        const int col0 = u.pn * BM + wc * 32 + 8 * fq;
#pragma unroll
        for (int bj = 0; bj < 2; ++bj) {
            const int cc = col0 + bj * HALF;
            const f32x4 g0 = *(const f32x4*)(gate + vec * 6144 + cc), g1 = *(const f32x4*)(gate + vec * 6144 + cc + 4);
#pragma unroll
            for (int ai = 0; ai < 2; ++ai)
#pragma unroll
                for (int m = 0; m < 4; ++m) { const size_t off = (size_t)(ai * HALF + wr * 64 + m * 16 + fr) * 1024 + cc;
                    const f32x4 hn0 = *(const f32x4*)(bp + off) + g0 * acc[ai][bj][m][0], hn1 = *(const f32x4*)(bp + off + 4) + g1 * acc[ai][bj][m][1];
                    *(f32x4*)(op + off) = hn0; *(f32x4*)(op + off + 4) = hn1; }
            asm volatile("" ::: "memory");
        }
    }
};

struct EpiResidFinal {
    static constexpr bool PERM = true, AFTER_DRAIN = false;
    const float* base; float* out; const float* gate; float* SS; unsigned* cnt; const float* fw; PG8_LAS float* red;
    __device__ __forceinline__ void operator()(const f32x4 (&acc)[2][2][4][2], const Unit& u, int wr, int wc, int fr, int fq) const {
        const int rowt = u.pm * BM, vec = rowt >> 13;
        const float* bp = base + (size_t)rowt * 1024; float* op = out + (size_t)rowt * 1024;
        const int col0 = u.pn * BM + wc * 32 + 8 * fq;
        float ss[8];
#pragma unroll
        for (int q = 0; q < 8; ++q) ss[q] = 0.f;
#pragma unroll
        for (int bj = 0; bj < 2; ++bj) {
            const int cc = col0 + bj * HALF;
            const f32x4 g0 = *(const f32x4*)(gate + vec * 6144 + cc), g1 = *(const f32x4*)(gate + vec * 6144 + cc + 4);
#pragma unroll
            for (int ai = 0; ai < 2; ++ai)
#pragma unroll
                for (int m = 0; m < 4; ++m) { const size_t off = (size_t)(ai * HALF + wr * 64 + m * 16 + fr) * 1024 + cc;
                    const f32x4 hn0 = *(const f32x4*)(bp + off) + g0 * acc[ai][bj][m][0], hn1 = *(const f32x4*)(bp + off + 4) + g1 * acc[ai][bj][m][1];
                    *(f32x4*)(op + off) = hn0; *(f32x4*)(op + off + 4) = hn1;
                    ss[ai * 4 + m] += ((hn0[0] * hn0[0] + hn0[1] * hn0[1]) + (hn0[2] * hn0[2] + hn0[3] * hn0[3])) + ((hn1[0] * hn1[0] + hn1[1] * hn1[1]) + (hn1[2] * hn1[2] + hn1[3] * hn1[3])); }
            asm volatile("" ::: "memory");
        }
#pragma unroll
        for (int q = 0; q < 8; ++q) { float s = ss[q]; s += __shfl_xor(s, 16); s += __shfl_xor(s, 32);
            if (fq == 0) red[((q >> 2) * HALF + wr * 64 + (q & 3) * 16 + fr) * 4 + wc] = s; }
        asm volatile("s_waitcnt lgkmcnt(0)" ::: "memory"); __builtin_amdgcn_s_barrier(); asm volatile("" ::: "memory");
        const int lane = fq * 16 + fr;
        if (lane < 32) { const int row = (wr * 4 + wc) * 32 + lane; const f32x4 p = *(const PG8_LAS f32x4*)(red + row * 4); atomicAdd(SS + rowt + row, (p[0] + p[1]) + (p[2] + p[3])); }
        asm volatile("s_waitcnt vmcnt(0)" ::: "memory"); __builtin_amdgcn_s_barrier(); asm volatile("" ::: "memory");
        if (threadIdx.x == 0) __hip_atomic_fetch_add(cnt + u.pm, 1u, __ATOMIC_RELAXED, __HIP_MEMORY_SCOPE_AGENT);
        { unsigned sp = 0; while ((unsigned)__builtin_amdgcn_readfirstlane(__hip_atomic_load(cnt + u.pm, __ATOMIC_RELAXED, __HIP_MEMORY_SCOPE_AGENT)) < 4u) { __builtin_amdgcn_s_sleep(2); if (++sp > (1u << 22)) break; } }
        asm volatile("" ::: "memory");
#pragma unroll
        for (int q = 0; q < 8; ++q) { const unsigned b = __hip_atomic_load((const unsigned*)SS + rowt + (q >> 2) * HALF + wr * 64 + (q & 3) * 16 + fr, __ATOMIC_RELAXED, __HIP_MEMORY_SCOPE_AGENT);
            ss[q] = rsqrtf(__builtin_bit_cast(float, b) * (1.0f / 1024.0f) + 1e-6f); }
#pragma unroll
        for (int bj = 0; bj < 2; ++bj) {
            const int cc = col0 + bj * HALF;
            const f32x4 w0 = *(const f32x4*)(fw + cc), w1 = *(const f32x4*)(fw + cc + 4);
#pragma unroll
            for (int ai = 0; ai < 2; ++ai)
#pragma unroll
                for (int m = 0; m < 4; ++m) { const size_t off = (size_t)(ai * HALF + wr * 64 + m * 16 + fr) * 1024 + cc;
                    const f32x4 hn0 = *(const f32x4*)(op + off), hn1 = *(const f32x4*)(op + off + 4);
                    *(f32x4*)(op + off) = hn0 * ss[ai * 4 + m] * w0; *(f32x4*)(op + off + 4) = hn1 * ss[ai * 4 + m] * w1; }
            asm volatile("" ::: "memory");
        }
    }
};

struct EpiResidN {
    static constexpr bool PERM = true, AFTER_DRAIN = false;
    const float* base_lat; const float* base_ctx; float* out_lat; float* out_ctx; const float* gate;
    bf16_t* XNr; float* SS; const float* nw; const float* sc;
    PG8_LAS float* red;
    __device__ __forceinline__ void operator()(const f32x4 (&acc)[2][2][4][2], const Unit& u, int wr, int wc, int fr, int fq) const {
        const int rowt = u.pm * BM; const bool lat = rowt < NLAT; const int vec = lat ? (rowt >> 13) : 4;
        const float* bp = lat ? base_lat + (size_t)rowt * 1024 : base_ctx + (size_t)(rowt - NLAT) * 1024;
        float* op = lat ? out_lat + (size_t)rowt * 1024 : out_ctx + (size_t)(rowt - NLAT) * 1024;
        const int col0 = u.pn * BM + wc * 32 + 8 * fq;
        float ss[8];
#pragma unroll
        for (int q = 0; q < 8; ++q) ss[q] = 0.f;
#pragma unroll
        for (int bj = 0; bj < 2; ++bj) {
            const int cc = col0 + bj * HALF;
            const f32x4 g0 = *(const f32x4*)(gate + vec * 6144 + cc), g1 = *(const f32x4*)(gate + vec * 6144 + cc + 4);
            const f32x4 gm0 = *(const f32x4*)(nw + cc) * (*(const f32x4*)(sc + vec * 6144 + cc) + 1.0f), gm1 = *(const f32x4*)(nw + cc + 4) * (*(const f32x4*)(sc + vec * 6144 + cc + 4) + 1.0f);
#pragma unroll
            for (int ai = 0; ai < 2; ++ai)
#pragma unroll
                for (int m = 0; m < 4; ++m) { const int rl = ai * HALF + wr * 64 + m * 16 + fr; const size_t off = (size_t)rl * 1024 + cc;
                    const f32x4 hn0 = *(const f32x4*)(bp + off) + g0 * acc[ai][bj][m][0], hn1 = *(const f32x4*)(bp + off + 4) + g1 * acc[ai][bj][m][1];
                    *(f32x4*)(op + off) = hn0; *(f32x4*)(op + off + 4) = hn1;
                    ss[ai * 4 + m] += ((hn0[0] * hn0[0] + hn0[1] * hn0[1]) + (hn0[2] * hn0[2] + hn0[3] * hn0[3])) + ((hn1[0] * hn1[0] + hn1[1] * hn1[1]) + (hn1[2] * hn1[2] + hn1[3] * hn1[3]));
                    const f32x4 y0 = hn0 * gm0, y1 = hn1 * gm1; u32x4 p; p.x = cvt_pk_bf16(y0[0], y0[1]); p.y = cvt_pk_bf16(y0[2], y0[3]); p.z = cvt_pk_bf16(y1[0], y1[1]); p.w = cvt_pk_bf16(y1[2], y1[3]);
                    *(u32x4*)(XNr + (size_t)rowt * 1024 + off) = p; }
            asm volatile("" ::: "memory");
        }
#pragma unroll
        for (int q = 0; q < 8; ++q) { float s = ss[q]; s += __shfl_xor(s, 16); s += __shfl_xor(s, 32);
            if (fq == 0) red[((q >> 2) * HALF + wr * 64 + (q & 3) * 16 + fr) * 4 + wc] = s; }
        asm volatile("s_waitcnt lgkmcnt(0)" ::: "memory"); __builtin_amdgcn_s_barrier(); asm volatile("" ::: "memory");
        const int lane = fq * 16 + fr;
        if (lane < 32) { const int row = (wr * 4 + wc) * 32 + lane; const f32x4 p = *(const PG8_LAS f32x4*)(red + row * 4); atomicAdd(SS + rowt + row, (p[0] + p[1]) + (p[2] + p[3])); }
    }
};

__device__ __forceinline__ float silu_f(float a) { return a * __builtin_amdgcn_rcpf(1.0f + __expf(-a)); }
struct EpiSwiGLU {
    static constexpr bool PERM = true, AFTER_DRAIN = false;
    bf16_t* O; const float* SS; const float* shw;
    __device__ __forceinline__ void operator()(const f32x4 (&acc)[2][2][4][2], const Unit& u, int wr, int wc, int fr, int fq) const {
        const int row0 = u.pm * BM + wr * 64 + fr, hc0 = u.pn * HALF + wc * 32 + 8 * fq;
        const int vec = (u.pm * BM < NLAT) ? ((u.pm * BM) >> 13) : 4;
        f32x4 sa0 = {0.f, 0.f, 0.f, 0.f}, sa1 = sa0, su0 = sa0, su1 = sa0;
        if (SS) { const float* sp = shw + vec * 5632 + u.pn * BM + wc * 32 + 8 * fq; sa0 = *(const f32x4*)sp; sa1 = *(const f32x4*)(sp + 4); su0 = *(const f32x4*)(sp + HALF); su1 = *(const f32x4*)(sp + HALF + 4); }
        float rs8[8];
#pragma unroll
        for (int q = 0; q < 8; ++q) rs8[q] = SS ? SS[row0 + (q >> 2) * HALF + (q & 3) * 16] : 0.f;
#pragma unroll
        for (int q = 0; q < 8; ++q) rs8[q] = SS ? rsqrtf(rs8[q] * (1.0f / 1024.0f) + 1e-6f) : 1.0f;
#pragma unroll
        for (int ai = 0; ai < 2; ++ai)
#pragma unroll
            for (int m = 0; m < 4; ++m) { const int r = row0 + ai * HALF + m * 16; bf16_t* rowp = O + (size_t)r * 2816 + hc0;
                const float rs = rs8[ai * 4 + m];
                const f32x4 a0 = acc[ai][0][m][0] * rs + sa0, a1 = acc[ai][0][m][1] * rs + sa1, u0 = acc[ai][1][m][0] * rs + su0, u1 = acc[ai][1][m][1] * rs + su1;
                u32x4 wv; wv.x = cvt_pk_bf16(silu_f(a0[0]) * u0[0], silu_f(a0[1]) * u0[1]); wv.y = cvt_pk_bf16(silu_f(a0[2]) * u0[2], silu_f(a0[3]) * u0[3]);
                wv.z = cvt_pk_bf16(silu_f(a1[0]) * u1[0], silu_f(a1[1]) * u1[1]); wv.w = cvt_pk_bf16(silu_f(a1[2]) * u1[2], silu_f(a1[3]) * u1[3]);
                __builtin_nontemporal_store(wv, (u32x4*)rowp); }
    }
};

__device__ __forceinline__ unsigned pk_f16(float lo, float hi) { const _Float16 a = (_Float16)lo, b = (_Float16)hi; return (unsigned)__builtin_bit_cast(unsigned short, a) | ((unsigned)__builtin_bit_cast(unsigned short, b) << 16); }
constexpr size_t OFF_MiB = 1u << 20, OFF_HQ = 122 * OFF_MiB, OFF_HG = 186 * OFF_MiB, OFF_HV = 250 * OFF_MiB, OFF_LFW = 314 * OFF_MiB, OFF_LBW = 378 * OFF_MiB, OFF_HVC = 506 * OFF_MiB, OFF_LFWC = 508 * OFF_MiB, OFF_LBWC = 510 * OFF_MiB;
struct EpiHgrnIn {
    static constexpr bool PERM = true, AFTER_DRAIN = false;
    unsigned char* ws; const float* lbl; const float* SS; const float* shw;
    __device__ __forceinline__ void operator()(const f32x4 (&acc)[2][2][4][2], const Unit& u, int wr, int wc, int fr, int fq) const {
        const int type = u.pn >> 2; const bool lat = u.pm < (NLAT / BM);
        if (type < 2 && !lat) return;
        const size_t doff = lat ? (type == 0 ? OFF_HQ : type == 1 ? OFF_HG : type == 2 ? OFF_LFW : type == 3 ? OFF_LBW : OFF_HV)
                                : (type == 2 ? OFF_LFWC : type == 3 ? OFF_LBWC : OFF_HVC) - (size_t)NLAT * 2048;
        bf16_t* dstb = (bf16_t*)(ws + doff);
        const int row0 = u.pm * BM + wr * 64 + fr; const int vec = lat ? ((u.pm * BM) >> 13) : 4;
        float rs8[8];
#pragma unroll
        for (int q = 0; q < 8; ++q) rs8[q] = SS[row0 + (q >> 2) * HALF + (q & 3) * 16];
#pragma unroll
        for (int q = 0; q < 8; ++q) rs8[q] = rsqrtf(rs8[q] * (1.0f / 1024.0f) + 1e-6f);
#pragma unroll
        for (int bj = 0; bj < 2; ++bj) {
            const int ch = (u.pn & 3) * 256 + bj * HALF + wc * 32 + 8 * fq;
            const float* sp = shw + vec * 5120 + u.pn * BM + bj * HALF + wc * 32 + 8 * fq; const f32x4 sw0 = *(const f32x4*)sp, sw1 = *(const f32x4*)(sp + 4);
            float lb[8];
            if (type == 2 || type == 3) {
#pragma unroll
                for (int e = 0; e < 8; ++e) { const float l0 = lbl[ch + e], l1 = lbl[1024 + ch + e]; lb[e] = 1.0f / (1.0f + __expf(l0 - l1)); }
            } else {
#pragma unroll
                for (int e = 0; e < 8; ++e) lb[e] = 0.f;
            }
#pragma unroll
            for (int ai = 0; ai < 2; ++ai)
#pragma unroll
                for (int m = 0; m < 4; ++m) { const int r = row0 + ai * HALF + m * 16; bf16_t* p = dstb + (size_t)r * 1024 + ch;
                    const float rs = rs8[ai * 4 + m];
                    float v[8];
#pragma unroll
                    for (int e = 0; e < 8; ++e) v[e] = acc[ai][bj][m][e >> 2][e & 3] * rs + (e < 4 ? sw0[e & 3] : sw1[e & 3]);
                    u32x4 wv;
                    if (type == 2 || type == 3) {
#pragma unroll
                        for (int e = 0; e < 8; ++e) { const float sg = __builtin_amdgcn_rcpf(1.0f + __expf(-v[e])); v[e] = __logf(lb[e] + (1.0f - lb[e]) * sg); }
                        wv.x = pk_f16(v[0], v[1]); wv.y = pk_f16(v[2], v[3]); wv.z = pk_f16(v[4], v[5]); wv.w = pk_f16(v[6], v[7]);
                    } else { wv.x = cvt_pk_bf16(v[0], v[1]); wv.y = cvt_pk_bf16(v[2], v[3]); wv.z = cvt_pk_bf16(v[4], v[5]); wv.w = cvt_pk_bf16(v[6], v[7]); }
                    *(u32x4*)p = wv; if (m & 1) asm volatile("" ::: "memory"); }
        }
    }
};

__device__ __forceinline__ void publish_unit(unsigned* cnt) {
    asm volatile("s_waitcnt vmcnt(0)" ::: "memory"); __builtin_amdgcn_s_barrier(); asm volatile("" ::: "memory");
    if (threadIdx.x == 0) { __builtin_amdgcn_fence(__ATOMIC_RELEASE, "agent"); asm volatile("s_waitcnt vmcnt(0)" ::: "memory"); __hip_atomic_fetch_add(cnt, 1u, __ATOMIC_RELAXED, __HIP_MEMORY_SCOPE_AGENT); }
}
__device__ __forceinline__ void wave_wait_count(unsigned* cnt, unsigned want) {
    unsigned sp = 0;
    while ((unsigned)__builtin_amdgcn_readfirstlane(__hip_atomic_load(cnt, __ATOMIC_RELAXED, __HIP_MEMORY_SCOPE_AGENT)) < want) { __builtin_amdgcn_s_sleep(4); if (++sp > (1u << 22)) break; }
    __builtin_amdgcn_fence(__ATOMIC_ACQUIRE, "agent"); asm volatile("s_waitcnt vmcnt(0)" ::: "memory");
}
__device__ __forceinline__ void latent_up_unit(int q, Unit& u) { const int nN = 22, nM = 128, nig = WGM * nN, gid = q / nig, fm = gid * WGM, gsz = (nM - fm) < WGM ? (nM - fm) : WGM; u.pm = fm + ((q % nig) % gsz); u.pn = (q % nig) / gsz; }
__device__ __forceinline__ int up_pos_type(int x, int j, int& idx) {
    if (x == 0 && j < 16) { idx = j; return 1; }
    if (j >= 30 && j < 60 && x < 3) { const int uu = x * 30 + (j - 30); if (uu < 88) { idx = uu; return 2; } }
    if (j >= 330 && j < 336) { idx = x * 6 + (j - 330); return 3; }
    int sp = 0;
    if (x == 0) sp += 16;
    if (x < 3) { const int lim = x < 2 ? 30 : 28; int t = j - 30; t = t < 0 ? 0 : (t > lim ? lim : t); sp += t; }
    { int t = j - 330; t = t < 0 ? 0 : (t > 6 ? 6 : t); sp += t; }
    const int prev = x == 0 ? 0 : x == 1 ? 52 : x == 2 ? 88 : 122 + (x - 3) * 6;
    idx = x * 360 + j - sp - prev; return 0;
}
struct UpOrder {
    int c, i0, i1; unsigned* cntW; unsigned* cntU;
    __device__ __forceinline__ bool next(int k, Unit& u) const {
        const int i = i0 + k; if (i >= i1) return false;
        int idx; const int t = up_pos_type(c & 7, i * 30 + (c >> 3), idx);
        if (t == 2) { u.pm = 128 + idx / 22; u.pn = idx % 22; } else latent_up_unit(idx, u);
        return true;
    }
    __device__ __forceinline__ void a_ready(const Unit& u) const { if (u.pm >= 128) wave_wait_count(cntW, 16u); }
    __device__ __forceinline__ void done(const Unit& u) const { if (u.pm >= 128) publish_unit(cntU); }
};
struct UpOrderD {
    int d, i0, i1;
    __device__ __forceinline__ bool next(int k, Unit& u) const { const int i = i0 + k; if (i >= i1) return false; const int q = 2728 + i * 16 + d; if (q >= 2816) return false; latent_up_unit(q, u); return true; }
    __device__ __forceinline__ void a_ready(const Unit&) const {}
    __device__ __forceinline__ void done(const Unit&) const {}
};
struct OneUnit {
    int pm, pn; unsigned* cnt;
    __device__ __forceinline__ bool next(int i, Unit& u) const { if (i > 0) return false; u.pm = pm; u.pn = pn; return true; }
    __device__ __forceinline__ void a_ready(const Unit&) const {}
    __device__ __forceinline__ void done(const Unit&) const { if (cnt) publish_unit(cnt); }
};
template <class Epi, class Sched, bool ALIGN_EPI = false, bool SP2 = false>
__device__ __forceinline__ void gemm_phase(PG8_LAS unsigned char* lds, const Gemm g, const Sched& S, const Epi& E) {
    int tid_ = threadIdx.x; asm volatile("" : "+v"(tid_));
    const int tid = tid_, wid = __builtin_amdgcn_readfirstlane(tid >> 6), lane = tid & 63, wr = wid >> 2, wc = wid & 3, fr = lane & 15, fq = lane >> 4;
    const int K = g.K, nt = K / BK;
    unsigned voffA[2], voffB[2];
#pragma unroll
    for (int i = 0; i < 2; ++i) { int R, C; stage_rc(tid * 16 + i * 8192, R, C); const int Rb = Epi::PERM ? ((R & ~31) + perm32(R & 31)) : R;
        voffA[i] = (unsigned)(R * K + C) * 2u; voffB[i] = (unsigned)(Rb * K + C) * 2u; }
    const size_t kstep = (size_t)(BK * 2);
    const size_t hstep = (size_t)HALF * K * 2;
    const size_t tstep = 2 * hstep;
    const unsigned ldsw = (unsigned)wid * 1024u;
    const int aoff = lds_byte(wr * 64 + fr, fq * 8), boff = lds_byte(wc * 32 + fr, fq * 8);
#define PG8_SA(b, h) (((b) * 2 + (h)) * HTB)
#define PG8_SB(b, h) ((4 + (b) * 2 + (h)) * HTB)
#define PG8_STAGE(bufoff, gbase, voff) do { _Pragma("unroll") for (int _i = 0; _i < 2; ++_i) \
        __builtin_amdgcn_global_load_lds((const unsigned*)((const char*)(gbase) + (voff)[_i]), (PG8_LAS unsigned*)(lds + (bufoff) + ldsw + _i * 8192), 16, 0, 0); } while (0)
#define PG8_LDA(dst, b, h) do { _Pragma("unroll") for (int m = 0; m < 4; ++m) _Pragma("unroll") for (int k = 0; k < 2; ++k) dst[m][k] = *(const PG8_LAS bf16x8*)(lds + PG8_SA(b, h) + aoff + m * 2048 + k * 1024); } while (0)
#define PG8_LDB(dst, b, h) do { _Pragma("unroll") for (int n = 0; n < 2; ++n) _Pragma("unroll") for (int k = 0; k < 2; ++k) dst[n][k] = *(const PG8_LAS bf16x8*)(lds + PG8_SB(b, h) + boff + n * 2048 + k * 1024); } while (0)
#define PG8_MMA(ai, bj, At, Bt) do { __builtin_amdgcn_s_setprio(1); _Pragma("unroll") for (int m = 0; m < 4; ++m) _Pragma("unroll") for (int n = 0; n < 2; ++n) _Pragma("unroll") for (int k = 0; k < 2; ++k) \
        acc[ai][bj][m][n] = __builtin_amdgcn_mfma_f32_16x16x32_bf16(Bt[n][k], At[m][k], acc[ai][bj][m][n], 0, 0, 0); __builtin_amdgcn_s_setprio(0); } while (0)
#define PG8_WAIT_V(n) asm volatile("s_waitcnt vmcnt(" #n ")" ::: "memory")
#define PG8_WAIT_L(n) asm volatile("s_waitcnt lgkmcnt(" #n ")" ::: "memory")
#define PG8_BAR __builtin_amdgcn_s_barrier()
#define PG8_SCHED __builtin_amdgcn_sched_barrier(0)
    Unit cur, nxt; int ui = 0;
    if (!S.next(0, cur)) return;
    f32x4 acc[2][2][4][2];
#pragma unroll
    for (int a = 0; a < 2; ++a)
#pragma unroll
        for (int b = 0; b < 2; ++b)
#pragma unroll
            for (int m = 0; m < 4; ++m)
#pragma unroll
                for (int n = 0; n < 2; ++n) acc[a][b][m][n] = (f32x4){0.f, 0.f, 0.f, 0.f};
    bf16x8 At[4][2], B0[2][2], B1[2][2];
    const char* cA = (const char*)g.A + (size_t)cur.pm * tstep; const char* cB = (const char*)g.Bt + (size_t)cur.pn * tstep;
    S.a_ready(cur);
    if constexpr (SP2) {
        PG8_STAGE(PG8_SB(0, 0), cB, voffB); PG8_STAGE(PG8_SB(0, 1), cB + hstep, voffB); PG8_STAGE(PG8_SA(0, 0), cA, voffA); PG8_STAGE(PG8_SA(0, 1), cA + hstep, voffA);
        if (wr == 1) PG8_BAR;
        PG8_WAIT_V(2); PG8_BAR;
        PG8_STAGE(PG8_SB(1, 0), cB + kstep, voffB); PG8_STAGE(PG8_SA(1, 0), cA + kstep, voffA); PG8_STAGE(PG8_SB(1, 1), cB + hstep + kstep, voffB);
        PG8_WAIT_V(6); PG8_BAR;
    } else {
        PG8_STAGE(PG8_SB(0, 0), cB, voffB); PG8_STAGE(PG8_SA(0, 0), cA, voffA); PG8_STAGE(PG8_SB(0, 1), cB + hstep, voffB); PG8_STAGE(PG8_SA(0, 1), cA + hstep, voffA);
        if (wr == 1) PG8_BAR;
        PG8_WAIT_V(4); PG8_BAR;
        PG8_STAGE(PG8_SB(1, 0), cB + kstep, voffB); PG8_STAGE(PG8_SA(1, 0), cA + kstep, voffA); PG8_STAGE(PG8_SB(1, 1), cB + hstep + kstep, voffB);
        PG8_WAIT_V(6); PG8_BAR;
    }
    for (;;) {
        const bool has_next = S.next(ui + 1, nxt);
        const char* nA = has_next ? (const char*)g.A + (size_t)nxt.pm * tstep : cA; const char* nB = has_next ? (const char*)g.Bt + (size_t)nxt.pn * tstep : cB;
        for (int t = 0; t < nt; t += 2) {
            const bool last = (t == nt - 2);
            const char* a1 = cA + (size_t)(t + 1) * kstep;
            const char* a2 = last ? nA : cA + (size_t)(t + 2) * kstep; const char* b2 = last ? nB : cB + (size_t)(t + 2) * kstep;
            const char* a3 = a2 + kstep; const char* b3 = b2 + kstep;
            if (last && has_next) S.a_ready(nxt);
            if constexpr (SP2) {
            PG8_LDB(B0, 0, 0); PG8_LDB(B1, 0, 1); PG8_SCHED; PG8_LDA(At, 0, 0); PG8_STAGE(PG8_SA(1, 1), a1 + hstep, voffA);
            PG8_WAIT_V(8); PG8_WAIT_L(0); PG8_BAR; PG8_MMA(0, 0, At, B0); PG8_MMA(0, 1, At, B1); PG8_BAR; PG8_SCHED;
            PG8_LDA(At, 0, 1); PG8_STAGE(PG8_SB(0, 0), b2, voffB); PG8_STAGE(PG8_SB(0, 1), b2 + hstep, voffB); PG8_STAGE(PG8_SA(0, 0), a2, voffA);
            PG8_WAIT_V(8); PG8_WAIT_L(0); PG8_BAR; PG8_MMA(1, 0, At, B0); PG8_MMA(1, 1, At, B1); PG8_BAR; PG8_SCHED;
            PG8_LDB(B0, 1, 0); PG8_LDB(B1, 1, 1); PG8_SCHED; PG8_LDA(At, 1, 0); PG8_STAGE(PG8_SA(0, 1), a2 + hstep, voffA);
            PG8_WAIT_V(8); PG8_WAIT_L(0); PG8_BAR; PG8_MMA(0, 0, At, B0); PG8_MMA(0, 1, At, B1); PG8_BAR; PG8_SCHED;
            PG8_LDA(At, 1, 1); PG8_STAGE(PG8_SB(1, 0), b3, voffB); PG8_STAGE(PG8_SB(1, 1), b3 + hstep, voffB); PG8_STAGE(PG8_SA(1, 0), a3, voffA);
            PG8_WAIT_V(8); PG8_WAIT_L(0); PG8_BAR; PG8_MMA(1, 0, At, B0); PG8_MMA(1, 1, At, B1); PG8_BAR; PG8_SCHED;
            } else {
            PG8_LDB(B0, 0, 0); PG8_SCHED; PG8_LDA(At, 0, 0); PG8_STAGE(PG8_SA(1, 1), a1 + hstep, voffA);
            PG8_WAIT_L(8); PG8_BAR; PG8_WAIT_L(0); PG8_MMA(0, 0, At, B0); PG8_BAR; PG8_SCHED;
            PG8_LDB(B1, 0, 1); PG8_STAGE(PG8_SB(0, 0), b2, voffB);
            PG8_BAR; PG8_WAIT_L(0); PG8_MMA(0, 1, At, B1); PG8_BAR;
            PG8_LDA(At, 0, 1); PG8_STAGE(PG8_SA(0, 0), a2, voffA);
            PG8_BAR; PG8_WAIT_L(0); PG8_MMA(1, 0, At, B0); PG8_BAR; PG8_SCHED;
            PG8_STAGE(PG8_SB(0, 1), b2 + hstep, voffB);
            PG8_WAIT_V(6); PG8_BAR; PG8_MMA(1, 1, At, B1); PG8_BAR;
            PG8_LDB(B0, 1, 0); PG8_SCHED; PG8_LDA(At, 1, 0); PG8_STAGE(PG8_SA(0, 1), a2 + hstep, voffA);
            PG8_WAIT_L(8); PG8_BAR; PG8_WAIT_L(0); PG8_MMA(0, 0, At, B0); PG8_BAR; PG8_SCHED;
            PG8_LDB(B1, 1, 1); PG8_STAGE(PG8_SB(1, 0), b3, voffB);
            PG8_BAR; PG8_WAIT_L(0); PG8_MMA(0, 1, At, B1); PG8_BAR;
            PG8_LDA(At, 1, 1); PG8_STAGE(PG8_SA(1, 0), a3, voffA);
            PG8_BAR; PG8_WAIT_L(0); PG8_MMA(1, 0, At, B0); PG8_BAR; PG8_SCHED;
            PG8_STAGE(PG8_SB(1, 1), b3 + hstep, voffB);
            PG8_WAIT_V(6); PG8_BAR; PG8_MMA(1, 1, At, B1); PG8_BAR;
            }
        }
        if constexpr (ALIGN_EPI) { if (wr == 0) PG8_BAR; }
        if constexpr (!Epi::AFTER_DRAIN) { E(acc, cur, wr, wc, fr, fq); S.done(cur); }
        if (!has_next) break;
#pragma unroll
        for (int a = 0; a < 2; ++a)
#pragma unroll
            for (int b = 0; b < 2; ++b)
#pragma unroll
                for (int m = 0; m < 4; ++m)
#pragma unroll
                    for (int n = 0; n < 2; ++n) acc[a][b][m][n] = (f32x4){0.f, 0.f, 0.f, 0.f};
        cur = nxt; cA = nA; cB = nB; ++ui;
        if constexpr (ALIGN_EPI) { if (wr == 1) PG8_BAR; }
    }
    PG8_WAIT_V(0);
    if constexpr (!ALIGN_EPI) { if (wr == 0) PG8_BAR; }
    PG8_BAR;
    if constexpr (Epi::AFTER_DRAIN) { E.fused(acc, cur, wr, wc, fr, fq, lds, wid, lane); S.done(cur); }
#undef PG8_SA
#undef PG8_SB
#undef PG8_STAGE
#undef PG8_LDA
#undef PG8_LDB
#undef PG8_MMA
#undef PG8_WAIT_V
#undef PG8_WAIT_L
#undef PG8_BAR
#undef PG8_SCHED
}
}

#ifndef PG8_SP2
#define PG8_SP2 true
#endif
#ifndef PG8_ALIGN
#define PG8_ALIGN true
#endif
#include <hip/hip_bf16.h>
#include <cmath>
namespace attn_body {
using bf16=__hip_bfloat16;
using bf16x8=__attribute__((ext_vector_type(8)))short;
using s16x4=__attribute__((ext_vector_type(4)))short;
using f32x16=__attribute__((ext_vector_type(16)))float;
using u32x4=__attribute__((ext_vector_type(4)))unsigned;
constexpr int D=64,QP=1024,KVP=256;
constexpr int NW=8,QBLK=32,QB=QBLK*NW,KVBLK=64;
__device__ __forceinline__ int crow(int r,int hi){return (r&3)+8*(r>>2)+4*hi;}
#define SBAR() __builtin_amdgcn_sched_barrier(0)
constexpr int NSLOT=3, SLOTB=8192;
constexpr int LDS_K=0, LDS_V=NSLOT*SLOTB, LDS_WS=2*NSLOT*SLOTB, LDS_OST=LDS_WS+NW*64*4, LDS_BYTES=LDS_OST+NW*4096;
constexpr float C2=0.125f*1.4426950408889634f;
__device__ __forceinline__ void glds16(const void*gsrc,unsigned lds_dst){unsigned keep;
  asm volatile("s_mov_b32 %0, m0\n\ts_mov_b32 m0, %2\n\ts_nop 0\n\tglobal_load_lds_dwordx4 %1, off\n\ts_mov_b32 m0, %0":"=&s"(keep):"v"(gsrc),"s"(lds_dst):"memory");}
__device__ __forceinline__ float max3f(float a,float b,float c){float r;asm("v_max3_f32 %0, %1, %2, %3":"=v"(r):"v"(a),"v"(b),"v"(c));return r;}
__device__ __forceinline__ float max2f(float a,float b){float r;asm("v_max_f32_e32 %0, %1, %2":"=v"(r):"v"(a),"v"(b));return r;}
__device__ __forceinline__ float fadd_s(float a,float b){float r;asm("v_add_f32_e32 %0, %1, %2":"=v"(r):"v"(a),"v"(b));return r;}
__device__ __forceinline__ float fsub_s(float a,float b){float r;asm("v_sub_f32_e32 %0, %1, %2":"=v"(r):"v"(a),"v"(b));return r;}
typedef float f32x2_t __attribute__((ext_vector_type(2))); typedef __bf16 bf16x2_t __attribute__((ext_vector_type(2)));
__device__ __forceinline__ unsigned cvtpk_s(float lo,float hi){f32x2_t v={lo,hi};bf16x2_t b=__builtin_convertvector(v,bf16x2_t);return __builtin_bit_cast(unsigned,b);}
#define WAIT_BAR(N) asm volatile("s_waitcnt vmcnt(" #N ") lgkmcnt(0)\n\ts_barrier":::"memory")

__device__ __forceinline__ void qkt(f32x16&p0,f32x16&p1,const char*Kslot,const bf16x8*qr,const f32x16&negm,int r32,int hi){
  const char*kb=Kslot+hi*1024+r32*16;
  #pragma unroll
  for(int d0=0;d0<4;++d0){
    const bf16x8 b0=*reinterpret_cast<const bf16x8*>(kb+d0*2048);
    const bf16x8 b1=*reinterpret_cast<const bf16x8*>(kb+d0*2048+512);
    if(d0==0){p0=__builtin_amdgcn_mfma_f32_32x32x16_bf16(b0,qr[0],negm,0,0,0);p1=__builtin_amdgcn_mfma_f32_32x32x16_bf16(b1,qr[0],negm,0,0,0);}
    else{p0=__builtin_amdgcn_mfma_f32_32x32x16_bf16(b0,qr[d0],p0,0,0,0);p1=__builtin_amdgcn_mfma_f32_32x32x16_bf16(b1,qr[d0],p1,0,0,0);}}
}
typedef __attribute__((address_space(3))) const char* lds_cptr;
typedef short v4i16_t __attribute__((ext_vector_type(4)));
__device__ __forceinline__ void kload8(bf16x8*kf,lds_cptr kp){
  kf[0]=*(const __attribute__((address_space(3))) bf16x8*)(kp);      kf[1]=*(const __attribute__((address_space(3))) bf16x8*)(kp+512);
  kf[2]=*(const __attribute__((address_space(3))) bf16x8*)(kp+2048); kf[3]=*(const __attribute__((address_space(3))) bf16x8*)(kp+2560);
  kf[4]=*(const __attribute__((address_space(3))) bf16x8*)(kp+4096); kf[5]=*(const __attribute__((address_space(3))) bf16x8*)(kp+4608);
  kf[6]=*(const __attribute__((address_space(3))) bf16x8*)(kp+6144); kf[7]=*(const __attribute__((address_space(3))) bf16x8*)(kp+6656);
}
__device__ __forceinline__ void kload2(bf16x8*kf,lds_cptr kp,int j){ kf[2*j]=*(const __attribute__((address_space(3))) bf16x8*)(kp+j*2048); kf[2*j+1]=*(const __attribute__((address_space(3))) bf16x8*)(kp+j*2048+512); }
__device__ __forceinline__ s16x4 vtr(lds_cptr p){ return __builtin_bit_cast(s16x4,__builtin_amdgcn_ds_read_tr16_b64_v4i16((__attribute__((address_space(3))) v4i16_t*)p)); }
__device__ __forceinline__ float rowmax(const f32x16&p0,const f32x16&p1){
  float a=max3f(p0[0],p0[1],p1[0]),b=max3f(p0[2],p0[3],p1[1]);a=max3f(a,p1[2],p1[3]);
  #pragma unroll
  for(int r=4;r<16;r+=4){a=max3f(a,p0[r],p0[r+1]);b=max3f(b,p0[r+2],p0[r+3]);a=max3f(a,p1[r],p1[r+1]);b=max3f(b,p1[r+2],p1[r+3]);}
  const float m=max2f(a,b);
  auto rr=__builtin_amdgcn_permlane32_swap(__float_as_uint(m),__float_as_uint(m),false,false);
  return max2f(__uint_as_float(rr[0]),__uint_as_float(rr[1]));
}
__device__ __forceinline__ void pv(f32x16*o,int vb,bf16x8 pa0,bf16x8 pa1,bf16x8 pa2,bf16x8 pa3){
  #pragma unroll
  for(int d0=0;d0<2;++d0){s16x4 lo[4],hi[4];
    #pragma unroll
    for(int ks=0;ks<4;++ks){
      asm volatile("ds_read_b64_tr_b16 %0,%1 offset:%c2":"=&v"(lo[ks]):"v"(vb),"i"(d0*4096+ks*1024):"memory");
      asm volatile("ds_read_b64_tr_b16 %0,%1 offset:%c2":"=&v"(hi[ks]):"v"(vb),"i"(d0*4096+ks*1024+512):"memory");}
    asm volatile("s_waitcnt lgkmcnt(0)":::"memory");SBAR();
    #define PK(k) (bf16x8){lo[k][0],lo[k][1],lo[k][2],lo[k][3],hi[k][0],hi[k][1],hi[k][2],hi[k][3]}
    o[d0]=__builtin_amdgcn_mfma_f32_32x32x16_bf16(pa0,PK(0),o[d0],0,0,0);
    o[d0]=__builtin_amdgcn_mfma_f32_32x32x16_bf16(pa1,PK(1),o[d0],0,0,0);
    o[d0]=__builtin_amdgcn_mfma_f32_32x32x16_bf16(pa2,PK(2),o[d0],0,0,0);
    o[d0]=__builtin_amdgcn_mfma_f32_32x32x16_bf16(pa3,PK(3),o[d0],0,0,0);
    #undef PK
  }
}

#ifndef ATTN_STORE16
#define ATTN_STORE16(p,v) (*(u32x4*)(p)=(v))
#endif
template<int THRL> __device__ __forceinline__ void attn_unit(const bf16*Qu,const bf16*__restrict__ Kh,const bf16*__restrict__ Vh,bf16*Ou,const int NT,char*shm){
  int tid_=threadIdx.x; asm volatile("":"+v"(tid_)); const int tid=tid_,lane=tid&63,r32=lane&31,hi=lane>>5; const int wid=__builtin_amdgcn_readfirstlane(tid>>6);
  const bf16*Qw=Qu+(long)(wid*QBLK)*QP;
  const unsigned lds0=(unsigned)(uintptr_t)shm;
  float*wsf=(float*)(shm+LDS_WS)+wid*64;
  const bf16*ksrc=Kh+(long)lane*KVP+wid*8;
  const bf16*vsrc=Vh+(long)(16*(wid&3)+(lane>>2))*KVP+(wid>>2)*32+(lane&3)*8;
  const unsigned kdst=lds0+LDS_K+wid*1024, vdst=lds0+LDS_V+wid*1024;
  #define DMA_K(t,slot) glds16(ksrc+(long)(t)*KVBLK*KVP,(unsigned)__builtin_amdgcn_readfirstlane(kdst+(slot)))
  #define DMA_V(t,slot) glds16(vsrc+(long)(t)*KVBLK*KVP,(unsigned)__builtin_amdgcn_readfirstlane(vdst+(slot)))
  const int vb0=(int)(lds0+LDS_V)+((lane>>4)&1)*32+(lane&3)*8+(4*hi+((lane&15)>>2))*64;
  const char*Kbase=shm+LDS_K; bf16x8 kf[8];
  const lds_cptr shm3=(lds_cptr)shm; const lds_cptr kp0=shm3+LDS_K+hi*1024+r32*16; const lds_cptr vp0=shm3+LDS_V+((lane>>4)&1)*32+(lane&3)*8+(4*hi+((lane&15)>>2))*64;
  DMA_K(0,0);DMA_V(0,0);DMA_K(1,SLOTB);
  bf16x8 qr[4];
  #pragma unroll
  for(int d0=0;d0<4;++d0)qr[d0]=*reinterpret_cast<const bf16x8*>(&Qw[(long)r32*QP+d0*16+hi*8]);
  float mhat=0.f,l_reg=0.f;f32x16 o[2];o[0]=f32x16{};o[1]=f32x16{};f32x16 negm=f32x16{};asm volatile("":"+v"(negm));
  #define CMASK(P0,P1,t) do{}while(0)
  bool resc=false;
  #define START(P0,P1) do{ const float rm=rowmax(P0,P1); resc=false; \
    { const float dl=rm; mhat=fadd_s(mhat,dl); \
      _Pragma("unroll") for(int r=0;r<16;++r){P0[r]=fsub_s(P0[r],dl);P1[r]=fsub_s(P1[r],dl);} \
      _Pragma("unroll") for(int r=0;r<16;++r)negm[r]=-mhat; asm volatile("":"+v"(negm)); } \
    _Pragma("unroll") for(int r=0;r<16;++r)P0[r]=__builtin_amdgcn_exp2f(P0[r]); }while(0)
  #define RESC() do{ if(resc){ asm volatile("s_waitcnt lgkmcnt(0)":::"memory"); \
      _Pragma("unroll") for(int d_=0;d_<2;++d_) _Pragma("unroll") for(int r=0;r<16;++r)o[d_][r]*=wsf[crow(r,hi)]; } }while(0)
  f32x16 pA0,pA1,pB0,pB1;
  int sl_prev=0,sl_cur=0,sl_next=SLOTB;
  #define ROT() do{sl_prev=sl_cur;sl_cur=sl_next;sl_next=(sl_next==(NSLOT-1)*SLOTB)?0:sl_next+SLOTB;}while(0)
  DMA_K(2,2*SLOTB);
  WAIT_BAR(3);
  qkt(pA0,pA1,Kbase,qr,negm,r32,hi);asm volatile("s_nop 15\n\ts_nop 7":"+v"(pA0),"+v"(pA1));CMASK(pA0,pA1,0);
  START(pA0,pA1);
  _Pragma("unroll") for(int r=0;r<16;++r)pA1[r]=__builtin_amdgcn_exp2f(pA1[r]);
  WAIT_BAR(0);
  DMA_K(3,0);DMA_V(1,SLOTB);
  ROT();
  kload8(kf,kp0+sl_cur);
  WAIT_BAR(2);
  s16x4 vlo[8],vhi[8]; u32x4 pw0,pw1,pw2,pw3;
  #define PKW(P,B) cvtpk_s(P[B],P[B+1])
  #define PAF(k) __builtin_bit_cast(bf16x8,pw##k)
  #define VFR(i) (bf16x8){vlo[i][0],vlo[i][1],vlo[i][2],vlo[i][3],vhi[i][0],vhi[i][1],vhi[i][2],vhi[i][3]}
  #define PIN(x) asm volatile("":"+v"(x))
  #define MX3(a,b,c) __builtin_fmaxf(__builtin_fmaxf((a),(b)),(c))
  #define GAPA(MF,A0,A1,A2,A3,W0,W1,PW) do{ MF; sacc+=A0; sacc+=A1; sacc+=A2; sacc+=A3; PIN(sacc); W0; W1; PIN(PW); SBAR(); }while(0)
  #define EX(v) __builtin_amdgcn_exp2f(v)
  #define GAPB(MF,X,B) do{ MF; X[B]=EX(X[B]); X[B+1]=EX(X[B+1]); X[B+2]=EX(X[B+2]); X[B+3]=EX(X[B+3]); PIN(X); SBAR(); }while(0)
  #define VRD(i) do{ vlo[i]=vtr(vp_+(((i)>>2)*4096+((i)&3)*1024)); vhi[i]=vtr(vp_+(((i)>>2)*4096+((i)&3)*1024+512)); }while(0)
  #define KRD(G,j) do{ if(G){ kload2(kf,kp0+sl_next,j); SBAR(); } }while(0)
  #define STEP(C0,C1,P0,P1,t,GK,GV,GL) do{ SBAR(); \
    const lds_cptr vp_=vp0+sl_prev; \
    VRD(0); SBAR(); float sacc=(P0[0]+P0[1]); \
    GAPA(C0=__builtin_amdgcn_mfma_f32_32x32x16_bf16(kf[0],qr[0],negm,0,0,0), P0[2],P0[3],P0[4],P0[5],     pw0[0]=PKW(P0,0), pw0[1]=PKW(P0,2), pw0); \
    VRD(4); SBAR(); GAPA(C1=__builtin_amdgcn_mfma_f32_32x32x16_bf16(kf[1],qr[0],negm,0,0,0), P0[6],P0[7],P0[8],P0[9],     pw0[2]=PKW(P0,4), pw0[3]=PKW(P0,6), pw0); \
    VRD(1); SBAR(); GAPA(C0=__builtin_amdgcn_mfma_f32_32x32x16_bf16(kf[2],qr[1],C0,0,0,0),   P0[10],P0[11],P0[12],P0[13], pw1[0]=PKW(P0,8), pw1[1]=PKW(P0,10), pw1); \
    VRD(5); SBAR(); GAPA(C1=__builtin_amdgcn_mfma_f32_32x32x16_bf16(kf[3],qr[1],C1,0,0,0),   P0[14],P0[15],P1[0],P1[1],   pw1[2]=PKW(P0,12),pw1[3]=PKW(P0,14), pw1); \
    VRD(2); SBAR(); GAPA(C0=__builtin_amdgcn_mfma_f32_32x32x16_bf16(kf[4],qr[2],C0,0,0,0),   P1[2],P1[3],P1[4],P1[5],     pw2[0]=PKW(P1,0), pw2[1]=PKW(P1,2), pw2); \
    VRD(6); SBAR(); GAPA(C1=__builtin_amdgcn_mfma_f32_32x32x16_bf16(kf[5],qr[2],C1,0,0,0),   P1[6],P1[7],P1[8],P1[9],     pw2[2]=PKW(P1,4), pw2[3]=PKW(P1,6), pw2); \
    VRD(3); SBAR(); GAPA(C0=__builtin_amdgcn_mfma_f32_32x32x16_bf16(kf[6],qr[3],C0,0,0,0),   P1[10],P1[11],P1[12],P1[13], pw3[0]=PKW(P1,8), pw3[1]=PKW(P1,10), pw3); \
    VRD(7); SBAR(); GAPA(C1=__builtin_amdgcn_mfma_f32_32x32x16_bf16(kf[7],qr[3],C1,0,0,0),   P1[14],P1[15],0.f,0.f,       pw3[2]=PKW(P1,12),pw3[3]=PKW(P1,14), pw3); \
    l_reg+=sacc; \
    if(GK){DMA_K((t)+3,sl_cur);} if(GV){DMA_V((t)+1,sl_next);} \
    CMASK(C0,C1,t); \
    { float a=MX3(C0[0],C0[1],C1[0]),b=MX3(C0[2],C0[3],C1[1]); a=MX3(a,C1[2],C1[3]); \
      _Pragma("unroll") for(int r=4;r<16;r+=4){a=MX3(a,C0[r],C0[r+1]);b=MX3(b,C0[r+2],C0[r+3]);a=MX3(a,C1[r],C1[r+1]);b=MX3(b,C1[r+2],C1[r+3]);} \
      float rm=__builtin_fmaxf(a,b); { auto rr=__builtin_amdgcn_permlane32_swap(__float_as_uint(rm),__float_as_uint(rm),false,false); rm=__builtin_fmaxf(__uint_as_float(rr[0]),__uint_as_float(rr[1])); } \
      resc=false; \
      if(__builtin_expect(__any(rm>(float)THRL),0)){ const float dl=__builtin_fmaxf(rm,0.f); mhat+=dl; \
        _Pragma("unroll") for(int r=0;r<16;++r){C0[r]-=dl;C1[r]-=dl;} \
        _Pragma("unroll") for(int r=0;r<16;++r)negm[r]=-mhat; asm volatile("":"+v"(negm)); \
        const float f=__builtin_amdgcn_exp2f(-dl); l_reg*=f; if(hi==0)wsf[r32]=f; resc=true; } } \
    SBAR(); \
    GAPB(o[0]=__builtin_amdgcn_mfma_f32_32x32x16_bf16(PAF(0),VFR(0),o[0],0,0,0), C0,0); \
    GAPB(o[1]=__builtin_amdgcn_mfma_f32_32x32x16_bf16(PAF(0),VFR(4),o[1],0,0,0), C0,4); \
    KRD(GL,0); GAPB(o[0]=__builtin_amdgcn_mfma_f32_32x32x16_bf16(PAF(1),VFR(1),o[0],0,0,0), C0,8); \
    KRD(GL,1); GAPB(o[1]=__builtin_amdgcn_mfma_f32_32x32x16_bf16(PAF(1),VFR(5),o[1],0,0,0), C0,12); \
    KRD(GL,2); GAPB(o[0]=__builtin_amdgcn_mfma_f32_32x32x16_bf16(PAF(2),VFR(2),o[0],0,0,0), C1,0); \
    KRD(GL,3); GAPB(o[1]=__builtin_amdgcn_mfma_f32_32x32x16_bf16(PAF(2),VFR(6),o[1],0,0,0), C1,4); \
    GAPB(o[0]=__builtin_amdgcn_mfma_f32_32x32x16_bf16(PAF(3),VFR(3),o[0],0,0,0), C1,8); \
    GAPB(o[1]=__builtin_amdgcn_mfma_f32_32x32x16_bf16(PAF(3),VFR(7),o[1],0,0,0), C1,12); \
    }while(0)
  int t=1;
  #undef CMASK
  #define CMASK(P0,P1,t) do{}while(0)
  for(;t+5<NT;t+=2){
    STEP(pB0,pB1,pA0,pA1,t,true,true,true);     WAIT_BAR(2); RESC(); ROT();
    STEP(pA0,pA1,pB0,pB1,t+1,true,true,true);   WAIT_BAR(2); RESC(); ROT();
  }
  #undef CMASK
  #define CMASK(P0,P1,t) do{}while(0)
  #define ENDW(tt) do{ if((tt)+3<NT){WAIT_BAR(2);} else if((tt)+2<NT){WAIT_BAR(1);} else {WAIT_BAR(0);} }while(0)
  for(;t+1<NT;t+=2){
    STEP(pB0,pB1,pA0,pA1,t,(t+3<NT),(t+1<NT),(t+1<NT));       ENDW(t);   RESC(); ROT();
    STEP(pA0,pA1,pB0,pB1,t+1,(t+4<NT),(t+2<NT),(t+2<NT));     ENDW(t+1); RESC(); ROT();
  }
  STEP(pB0,pB1,pA0,pA1,NT-1,false,false,false); RESC();
  { float sacc=pB0[0]+pB0[1]; _Pragma("unroll") for(int r=2;r<16;++r)sacc+=pB0[r]; _Pragma("unroll") for(int r=0;r<16;++r)sacc+=pB1[r]; l_reg+=sacc;
    pw0=(u32x4){PKW(pB0,0),PKW(pB0,2),PKW(pB0,4),PKW(pB0,6)};pw1=(u32x4){PKW(pB0,8),PKW(pB0,10),PKW(pB0,12),PKW(pB0,14)};pw2=(u32x4){PKW(pB1,0),PKW(pB1,2),PKW(pB1,4),PKW(pB1,6)};pw3=(u32x4){PKW(pB1,8),PKW(pB1,10),PKW(pB1,12),PKW(pB1,14)};
    SBAR(); pv(o,vb0+sl_cur,PAF(0),PAF(1),PAF(2),PAF(3)); }
  #undef PKW
  #undef PAF
  #undef VFR
  #undef PIN
  #undef MX3
  #undef GAPA
  #undef GAPB
  #undef EX
  #undef VRD
  #undef KRD
  #undef STEP
  #undef ENDW
  {auto rr=__builtin_amdgcn_permlane32_swap(__float_as_uint(l_reg),__float_as_uint(l_reg),false,false);l_reg=__uint_as_float(rr[0])+__uint_as_float(rr[1]);}
  if(hi==0)wsf[32+r32]=l_reg;asm volatile("s_waitcnt lgkmcnt(0)":::"memory");
  float rli[16];
  #pragma unroll
  for(int r=0;r<16;++r)rli[r]=__builtin_amdgcn_rcpf(wsf[32+crow(r,hi)]);
  bf16*Ow=Ou+(long)(wid*QBLK)*QP;
  { bf16*stg=(bf16*)(shm+LDS_OST)+wid*2048;
    #pragma unroll
    for(int r=0;r<16;++r){const int orow=crow(r,hi);
      #pragma unroll
      for(int d0=0;d0<2;++d0)stg[orow*64+d0*32+r32]=__float2bfloat16(o[d0][r]*rli[r]);}
    asm volatile("s_waitcnt lgkmcnt(0)":::"memory");
    #pragma unroll
    for(int i=0;i<4;++i){const int row=i*8+(lane>>3),ch=lane&7; const u32x4 v=*(const u32x4*)(stg+row*64+ch*8); ATTN_STORE16(Ow+(long)row*QP+ch*8,v);} }
  asm volatile("s_waitcnt lgkmcnt(0)\n\ts_barrier":::"memory");
  #undef DMA_K
  #undef DMA_V
  #undef CMASK
  #undef START
  #undef RESC
  #undef ROT
}
constexpr int ATTN_LDS_BYTES=LDS_BYTES;
#undef SBAR
#undef WAIT_BAR
}
constexpr int NWAVES = 8;
constexpr int NLAT = 32768, NCTX = 1024, MALL = NLAT + NCTX, DM = 1024, SEQ = 8192, CTXL = 256, KVROWS = 8448, FFH = 2816;
constexpr size_t MiB = 1u << 20;
constexpr size_t WS_MOD = 0, WS_ROPE = 256 * 1024, WS_BAR = 280 * 1024, WS_SS = 296 * 1024, WS_SHW = 51 * MiB + 512 * 1024;
constexpr size_t WS_XN2 = 304 * MiB;
constexpr size_t WS_WQKV = 1 * MiB, WS_WO = 4 * MiB, WS_F1A = 6 * MiB, WS_F2A = 17 * MiB, WS_HIN = 23 * MiB, WS_HO = 33 * MiB, WS_F1B = 35 * MiB, WS_F2B = 46 * MiB, WS_HCTX = 52 * MiB, WS_XN = 56 * MiB;
constexpr size_t WS_U = 1 * MiB, WS_D = 18 * MiB;
constexpr size_t WS_QO = 122 * MiB, WS_K = 188 * MiB, WS_V = 205 * MiB, WS_HID0 = 122 * MiB;
constexpr size_t WS_HQ = 122 * MiB, WS_HG = 186 * MiB, WS_HV = 250 * MiB, WS_LFW = 314 * MiB, WS_LBW = 378 * MiB, WS_OFW = 442 * MiB, WS_OBW = 56 * MiB, WS_OG = 122 * MiB, WS_HID1 = 186 * MiB;
constexpr size_t WS_HVC = 506 * MiB, WS_LFWC = 508 * MiB, WS_LBWC = 510 * MiB;
constexpr size_t WS_END = 512 * MiB;
static_assert(WS_HQ == pg8::OFF_HQ && WS_HG == pg8::OFF_HG && WS_HV == pg8::OFF_HV && WS_LFW == pg8::OFF_LFW && WS_LBW == pg8::OFF_LBW && WS_HVC == pg8::OFF_HVC && WS_LFWC == pg8::OFF_LFWC && WS_LBWC == pg8::OFF_LBWC, "EpiHgrnIn offsets");
constexpr size_t F1_ELEMS = (size_t)2 * FFH * DM, F2_ELEMS = (size_t)DM * FFH;
constexpr int RING_BYTES = 131072, LDS_BYTES = 147456;

#define LAS __attribute__((address_space(3)))
typedef unsigned short bf16;
typedef unsigned v4u __attribute__((ext_vector_type(4)));
typedef unsigned v2u __attribute__((ext_vector_type(2)));
typedef float f32x4 __attribute__((ext_vector_type(4)));
typedef float f32x16 __attribute__((ext_vector_type(16)));
typedef short bf16x8 __attribute__((ext_vector_type(8)));
typedef float f32x2_t __attribute__((ext_vector_type(2)));
typedef __bf16 bf16x2_t __attribute__((ext_vector_type(2)));
__device__ __forceinline__ unsigned pk2(float lo, float hi) { f32x2_t v = {lo, hi}; bf16x2_t b = __builtin_convertvector(v, bf16x2_t); return __builtin_bit_cast(unsigned, b); }
__device__ __forceinline__ unsigned short f2bf(float f) { return (unsigned short)(pk2(f, 0.f) & 0xffffu); }
__device__ __forceinline__ float bf2f(unsigned short h) { return __builtin_bit_cast(float, (unsigned)h << 16); }
__device__ __forceinline__ float h2f(unsigned short h) { return (float)__builtin_bit_cast(_Float16, h); }
__device__ __forceinline__ float wave_sum(float v) {
#pragma unroll
    for (int o = 1; o < 64; o <<= 1) v += __shfl_xor(v, o);
    return v;
}
#define LDS_WAIT() asm volatile("s_waitcnt lgkmcnt(0)" ::: "memory")

template <int MODE> __device__ __forceinline__ int wmap(int o) {
    if (MODE == 1) { const int tile = o >> 8, w = o & 255, wc = w >> 6, bj = (w >> 5) & 1, e = w & 31; return tile * 256 + 128 * bj + 32 * wc + e; }
    if (MODE == 2) { const int half = o >= FFH ? 1 : 0, idx = o - half * FFH, pn = idx >> 7, q = idx & 127; return 256 * pn + 128 * half + q; }
    return o;
}
template <int MODE> __device__ __forceinline__ void p0_transpose_item(const float* W, int K, int N, bf16* WT, LAS float* scr, int item, int lane) {
    const int nblk = N / 32, kb = item / nblk, nb = item % nblk, k0 = 64 * kb, n0 = 32 * nb;
    float tv[32];
#pragma unroll
    for (int i = 0; i < 32; ++i) tv[i] = W[(size_t)(k0 + 2 * i + (lane >> 5)) * N + n0 + (lane & 31)];
#pragma unroll
    for (int i = 0; i < 32; ++i) scr[(2 * i + (lane >> 5)) * 33 + (lane & 31)] = tv[i];
    LDS_WAIT(); asm volatile("" ::: "memory");
    const int c = lane & 7;
#pragma unroll
    for (int j = 0; j < 4; ++j) { const int n = (lane >> 3) + 8 * j; const LAS float* s = scr + (8 * c) * 33 + n;
        v4u o; o.x = pk2(s[0 * 33], s[1 * 33]); o.y = pk2(s[2 * 33], s[3 * 33]); o.z = pk2(s[4 * 33], s[5 * 33]); o.w = pk2(s[6 * 33], s[7 * 33]);
        *(v4u*)(WT + (size_t)wmap<MODE>(n0 + n) * K + k0 + 8 * c) = o; }
    LDS_WAIT(); asm volatile("" ::: "memory");
}

__device__ __forceinline__ void norm_row_pair(int ra, int rb, bool hasb, int lane, const float* src_lat, const float* src_ctx, const float* w, const float* modl, int shi, int sci, bf16* XN) {
    const float* srca = ra < NLAT ? src_lat + (size_t)ra * DM : src_ctx + (size_t)(ra - NLAT) * DM;
    const float* srcb = rb < NLAT ? src_lat + (size_t)rb * DM : src_ctx + (size_t)(rb - NLAT) * DM;
    const int veca = ra < NLAT ? (ra >> 13) : 4, vecb = rb < NLAT ? (rb >> 13) : 4;
    f32x4 va[4], vb[4]; float sa = 0.f, sb = 0.f;
#pragma unroll
    for (int j = 0; j < 4; ++j) { va[j] = ((const f32x4*)srca + lane)[64 * j]; vb[j] = ((const f32x4*)srcb + lane)[64 * j]; }
#pragma unroll
    for (int j = 0; j < 4; ++j) { sa += (va[j].x * va[j].x + va[j].y * va[j].y) + (va[j].z * va[j].z + va[j].w * va[j].w); sb += (vb[j].x * vb[j].x + vb[j].y * vb[j].y) + (vb[j].z * vb[j].z + vb[j].w * vb[j].w); }
    const float rstda = rsqrtf(wave_sum(sa) * (1.f / DM) + 1e-6f), rstdb = rsqrtf(wave_sum(sb) * (1.f / DM) + 1e-6f);
    const f32x4* wp = (const f32x4*)w + lane;
    const f32x4* sha = (const f32x4*)(modl + veca * 6144 + shi * 1024) + lane; const f32x4* sca = (const f32x4*)(modl + veca * 6144 + sci * 1024) + lane;
    const f32x4* shb = (const f32x4*)(modl + vecb * 6144 + shi * 1024) + lane; const f32x4* scb = (const f32x4*)(modl + vecb * 6144 + sci * 1024) + lane;
    unsigned long long* oa = (unsigned long long*)(XN + (size_t)ra * DM) + lane; unsigned long long* ob = (unsigned long long*)(XN + (size_t)rb * DM) + lane;
#pragma unroll
    for (int j = 0; j < 4; ++j) { const f32x4 ww = wp[64 * j];
        const f32x4 ya = va[j] * rstda * ww * (sca[64 * j] + 1.0f) + sha[64 * j];
        oa[64 * j] = (unsigned long long)pk2(ya.x, ya.y) | ((unsigned long long)pk2(ya.z, ya.w) << 32);
        if (hasb) { const f32x4 yb = vb[j] * rstdb * ww * (scb[64 * j] + 1.0f) + shb[64 * j]; ob[64 * j] = (unsigned long long)pk2(yb.x, yb.y) | ((unsigned long long)pk2(yb.z, yb.w) << 32); } }
}
__device__ __forceinline__ void norm_rows(int gw, int NGW, int lane, const float* src_lat, const float* src_ctx, int r0, int nrows, const float* w, const float* modl, int shi, int sci, bf16* XN) {
    for (int r = r0 + gw; r < nrows; r += 2 * NGW) { const bool hasb = r + NGW < nrows; norm_row_pair(r, hasb ? r + NGW : r, hasb, lane, src_lat, src_ctx, w, modl, shi, sci, XN); }
}
__device__ __forceinline__ void final_norm_rows(int gw, int NGW, int lane, float* h, const float* w) {
    for (int r = gw; r < NLAT; r += NGW) {
        f32x4* xr = (f32x4*)(h + (size_t)r * DM) + lane;
        f32x4 v[4]; float s = 0.f;
#pragma unroll
        for (int j = 0; j < 4; ++j) { v[j] = xr[64 * j]; s += (v[j].x * v[j].x + v[j].y * v[j].y) + (v[j].z * v[j].z + v[j].w * v[j].w); }
        const float rstd = rsqrtf(wave_sum(s) * (1.f / DM) + 1e-6f);
        const f32x4* wp = (const f32x4*)w + lane;
#pragma unroll
        for (int j = 0; j < 4; ++j) xr[64 * j] = v[j] * rstd * wp[64 * j];
    }
}

constexpr int SC_Q0 = 0, SC_QM = 17408, SC_KE = 34816, SC_KT = 52224, SC_VT = 70656, SC_ST = 89088, SC_AT = 123904, SC_PS = 133120, SC_EL = 137216;
constexpr int NSTR = 272, TSTR = 144;
static_assert(SC_EL + 512 <= LDS_BYTES, "scan LDS map");
__device__ __forceinline__ int crow(int r, int hi) { return (r & 3) + 8 * (r >> 2) + 4 * hi; }
__device__ __forceinline__ int scan_row(int c, int s, int b, int dir) {
    if (c < 4) { const int idx = 64 * c + s; return NLAT + b * CTXL + (dir ? (CTXL - 1 - idx) : idx); }
    const int idx = 64 * (c - 4) + s; return b * SEQ + (dir ? (SEQ - 1 - idx) : idx);
}
#define MFMA32(a, b, c) __builtin_amdgcn_mfma_f32_32x32x16_bf16((a), (b), (c), 0, 0, 0)
template <int MODE> __device__ __forceinline__ void hgrn_scan_item(LAS unsigned char* lds, int item, const bf16* HQ, const bf16* HV, const bf16* LFW, const bf16* LBW, const bf16* HVc, const bf16* LFWc, const bf16* LBWc, bf16* OFW, bf16* OBW, float* UB, float* DB) {
    int tid_ = threadIdx.x; asm volatile("" : "+v"(tid_));
    const int tid = tid_, lane = tid & 63, wid = __builtin_amdgcn_readfirstlane(tid >> 6), r32 = lane & 31, hi = lane >> 5;
    const int seg = item & 3, stream = item >> 2, dir = stream & 1, h = (stream >> 1) & 7, b = stream >> 4;
    if (MODE == 0 && seg == 3) return;
    const bf16* LF = dir ? LBW : LFW; bf16* OX = dir ? OBW : OFW;
    const bf16* LFc = (dir ? LBWc : LFWc) - (size_t)NLAT * DM; const bf16* HVcb = HVc - (size_t)NLAT * DM;
    const int kp = lane, g = wid;
    const unsigned voff2 = (unsigned)(h * 128 + 2 * kp) * 2u;
    const int vt = wid & 3, th = wid >> 2;
    unsigned lfrA[8], qrA[8], vrA[8], lfrB[8], qrB[8], vrB[8];
#define SCAN_LOAD(LFR, QR, VR, c) do { const bf16* lfb_ = (c) < 4 ? LFc : LF; const bf16* hvb_ = (c) < 4 ? HVcb : HV; \
        _Pragma("unroll") for (int i = 0; i < 8; ++i) { const size_t r_ = (size_t)__builtin_amdgcn_readfirstlane(scan_row((c), 8 * g + i, b, dir)) * (DM * 2);     \
            LFR[i] = *(const unsigned*)((const char*)lfb_ + r_ + voff2); VR[i] = *(const unsigned*)((const char*)hvb_ + r_ + voff2); \
            if (MODE == 1) QR[i] = *(const unsigned*)((const char*)HQ + r_ + voff2);     } } while (0)
    f32x16 S[2];
#pragma unroll
    for (int j = 0; j < 2; ++j)
#pragma unroll
        for (int i = 0; i < 16; ++i) S[j][i] = 0.f;
    if (MODE == 1) {
        for (int js = 0; js < seg; ++js) { const int it = stream * 4 + js;
#pragma unroll
            for (int j = 0; j < 2; ++j)
#pragma unroll
                for (int i = 0; i < 16; ++i) S[j][i] = S[j][i] * DB[it * 128 + 32 * (2 * th + j) + crow(i, hi)] + UB[((size_t)it * 32 + j * 16 + i) * 512 + tid]; }
        *(LAS unsigned*)(lds + SC_AT + (tid >> 4) * TSTR + 64 + 4 * (tid & 15)) = 0u;
    }
    float dacc0 = 1.f, dacc1 = 1.f;
    const int c0 = 33 * seg;
    SCAN_LOAD(lfrA, qrA, vrA, c0); SCAN_LOAD(lfrB, qrB, vrB, c0 + 1);
    for (int cc = c0; cc < c0 + 33; cc += 2) {
      { const int c = cc;
        const bool has_out = (MODE == 1) && c >= 4;
        f32x2_t lf[8]; f32x2_t ps = {0.f, 0.f};
#pragma unroll
        for (int i = 0; i < 8; ++i) { lf[i] = (f32x2_t){h2f((unsigned short)(lfrA[i] & 0xffffu)), h2f((unsigned short)(lfrA[i] >> 16))}; ps += lf[i]; }
        *(LAS f32x2_t*)(lds + SC_PS + (g * 128 + 2 * kp) * 4) = ps;
        LDS_WAIT(); __builtin_amdgcn_s_barrier(); asm volatile("" ::: "memory");
        {
            f32x2_t pre = {0.f, 0.f}, Lmid = {0.f, 0.f}, Lend = {0.f, 0.f};
#pragma unroll
            for (int gg = 0; gg < 8; ++gg) { const f32x2_t p = *(const LAS f32x2_t*)(lds + SC_PS + (gg * 128 + 2 * kp) * 4); if (gg < g) pre += p; if (gg < 4) Lmid += p; Lend += p; }
            const f32x2_t eLmid = {__expf(Lmid.x), __expf(Lmid.y)}, eEndMid = {__expf(Lend.x - Lmid.x), __expf(Lend.y - Lmid.y)};
            if (g == 0) { const f32x2_t el = {__expf(Lend.x), __expf(Lend.y)}; *(LAS f32x2_t*)(lds + SC_EL + 2 * kp * 4) = el; dacc0 *= el.x; dacc1 *= el.y; }
            f32x2_t E = {__expf(pre.x - Lmid.x), __expf(pre.y - Lmid.y)};
            unsigned kt0[4], kt1[4];
#pragma unroll
            for (int i = 0; i < 8; ++i) {
                const f32x2_t f = {__expf(lf[i].x), __expf(lf[i].y)};
                E = E * f;
                const f32x2_t re = {__builtin_amdgcn_rcpf(E.x), __builtin_amdgcn_rcpf(E.y)};
                const f32x2_t ke = (1.0f - f) * re, kend = ke * eEndMid;
                const int s = 8 * g + i;
                if (has_out) {
                    const f32x2_t q = {bf2f((unsigned short)(qrA[i] & 0xffffu)), bf2f((unsigned short)(qrA[i] >> 16))};
                    const f32x2_t qm = q * E, q0 = qm * eLmid;
                    *(LAS unsigned*)(lds + SC_Q0 + s * NSTR + 4 * kp) = pk2(q0.x, q0.y);
                    *(LAS unsigned*)(lds + SC_QM + s * NSTR + 4 * kp) = pk2(qm.x, qm.y);
                    *(LAS unsigned*)(lds + SC_KE + s * NSTR + 4 * kp) = pk2(ke.x, ke.y);
                }
                const unsigned kd = pk2(kend.x, kend.y);
                if (i & 1) { kt0[i >> 1] |= kd << 16; kt1[i >> 1] |= kd & 0xffff0000u; } else { kt0[i >> 1] = kd & 0xffffu; kt1[i >> 1] = kd >> 16; }
            }
            *(LAS v4u*)(lds + SC_KT + (2 * kp) * TSTR + 16 * g) = (v4u){kt0[0], kt0[1], kt0[2], kt0[3]};
            *(LAS v4u*)(lds + SC_KT + (2 * kp + 1) * TSTR + 16 * g) = (v4u){kt1[0], kt1[1], kt1[2], kt1[3]};
            v4u v0, v1;
#pragma unroll
            for (int i2 = 0; i2 < 4; ++i2) { v0[i2] = (vrA[2 * i2] & 0xffffu) | (vrA[2 * i2 + 1] << 16); v1[i2] = (vrA[2 * i2] >> 16) | (vrA[2 * i2 + 1] & 0xffff0000u); }
            *(LAS v4u*)(lds + SC_VT + (2 * kp) * TSTR + 16 * g) = v0;
            *(LAS v4u*)(lds + SC_VT + (2 * kp + 1) * TSTR + 16 * g) = v1;
            if (has_out) {
#pragma unroll
                for (int j = 0; j < 2; ++j)
#pragma unroll
                    for (int g4 = 0; g4 < 4; ++g4)
                        *(LAS v2u*)(lds + SC_ST + (32 * vt + r32) * NSTR + (32 * (2 * th + j) + 8 * g4 + 4 * hi) * 2) = (v2u){pk2(S[j][4 * g4], S[j][4 * g4 + 1]), pk2(S[j][4 * g4 + 2], S[j][4 * g4 + 3])};
            }
        }
        if (c + 2 < c0 + 33) SCAN_LOAD(lfrA, qrA, vrA, c + 2);
        LDS_WAIT(); __builtin_amdgcn_s_barrier(); asm volatile("" ::: "memory");
        f32x16 o;
#pragma unroll
        for (int i = 0; i < 16; ++i) o[i] = 0.f;
        if (has_out && wid < 3) {
            const int si = wid >> 1, ti = (wid + 1) >> 1;
            f32x16 a;
#pragma unroll
            for (int i = 0; i < 16; ++i) a[i] = 0.f;
#pragma unroll
            for (int kk = 0; kk < 8; ++kk) {
                const bf16x8 A = *(const LAS bf16x8*)(lds + SC_KE + (32 * si + r32) * NSTR + (16 * kk + 8 * hi) * 2);
                const bf16x8 B = *(const LAS bf16x8*)(lds + SC_QM + (32 * ti + r32) * NSTR + (16 * kk + 8 * hi) * 2);
                a = MFMA32(A, B, a);
            }
            const int t = 32 * ti + r32;
#pragma unroll
            for (int g4 = 0; g4 < 4; ++g4) {
                const int s0 = 32 * si + 8 * g4 + 4 * hi;
                const float a0 = (s0 + 0 <= t) ? a[4 * g4 + 0] : 0.f, a1 = (s0 + 1 <= t) ? a[4 * g4 + 1] : 0.f, a2 = (s0 + 2 <= t) ? a[4 * g4 + 2] : 0.f, a3 = (s0 + 3 <= t) ? a[4 * g4 + 3] : 0.f;
                *(LAS v2u*)(lds + SC_AT + t * TSTR + s0 * 2) = (v2u){pk2(a0, a1), pk2(a2, a3)};
            }
        }
        {
            const LAS float* EL = (const LAS float*)(lds + SC_EL);
#pragma unroll
            for (int j = 0; j < 2; ++j) {
                const int kq = 2 * th + j;
#pragma unroll
                for (int i = 0; i < 16; ++i) S[j][i] *= EL[32 * kq + crow(i, hi)];
#pragma unroll
                for (int kk = 0; kk < 4; ++kk) {
                    const bf16x8 A = *(const LAS bf16x8*)(lds + SC_KT + (32 * kq + r32) * TSTR + (16 * kk + 8 * hi) * 2);
                    const bf16x8 B = *(const LAS bf16x8*)(lds + SC_VT + (32 * vt + r32) * TSTR + (16 * kk + 8 * hi) * 2);
                    S[j] = MFMA32(A, B, S[j]);
                }
            }
            if (has_out) {
#pragma unroll
                for (int kk = 0; kk < 8; ++kk) {
                    const bf16x8 A = *(const LAS bf16x8*)(lds + SC_Q0 + (32 * th + r32) * NSTR + (16 * kk + 8 * hi) * 2);
                    const bf16x8 B = *(const LAS bf16x8*)(lds + SC_ST + (32 * vt + r32) * NSTR + (16 * kk + 8 * hi) * 2);
                    o = MFMA32(A, B, o);
                }
            }
        }
        LDS_WAIT(); __builtin_amdgcn_s_barrier(); asm volatile("" ::: "memory");
        if (has_out) {
#pragma unroll
            for (int kk = 0; kk < 4; ++kk) {
                const bf16x8 A = *(const LAS bf16x8*)(lds + SC_AT + (32 * th + r32) * TSTR + (16 * kk + 8 * hi) * 2);
                const bf16x8 B = *(const LAS bf16x8*)(lds + SC_VT + (32 * vt + r32) * TSTR + (16 * kk + 8 * hi) * 2);
                o = MFMA32(A, B, o);
            }
#pragma unroll
            for (int i = 0; i < 16; ++i) *(LAS unsigned short*)(lds + SC_Q0 + wid * 2560 + crow(i, hi) * 80 + 2 * r32) = f2bf(o[i]);
            LDS_WAIT(); asm volatile("" ::: "memory");
#pragma unroll
            for (int j2 = 0; j2 < 2; ++j2) { const int tl = j2 * 16 + (lane >> 2), pc = lane & 3; const v4u pv = *(const LAS v4u*)(lds + SC_Q0 + wid * 2560 + tl * 80 + 16 * pc);
                const size_t r_ = (size_t)scan_row(c, 32 * th + tl, b, dir); *(v4u*)(OX + r_ * DM + h * 128 + 32 * vt + 8 * pc) = pv; }
        }
          }
      if (cc + 1 < c0 + 33) { const int c = cc + 1;
        const bool has_out = (MODE == 1) && c >= 4;
        f32x2_t lf[8]; f32x2_t ps = {0.f, 0.f};
#pragma unroll
        for (int i = 0; i < 8; ++i) { lf[i] = (f32x2_t){h2f((unsigned short)(lfrB[i] & 0xffffu)), h2f((unsigned short)(lfrB[i] >> 16))}; ps += lf[i]; }
        *(LAS f32x2_t*)(lds + SC_PS + (g * 128 + 2 * kp) * 4) = ps;
        LDS_WAIT(); __builtin_amdgcn_s_barrier(); asm volatile("" ::: "memory");
        {
            f32x2_t pre = {0.f, 0.f}, Lmid = {0.f, 0.f}, Lend = {0.f, 0.f};
#pragma unroll
            for (int gg = 0; gg < 8; ++gg) { const f32x2_t p = *(const LAS f32x2_t*)(lds + SC_PS + (gg * 128 + 2 * kp) * 4); if (gg < g) pre += p; if (gg < 4) Lmid += p; Lend += p; }
            const f32x2_t eLmid = {__expf(Lmid.x), __expf(Lmid.y)}, eEndMid = {__expf(Lend.x - Lmid.x), __expf(Lend.y - Lmid.y)};
            if (g == 0) { const f32x2_t el = {__expf(Lend.x), __expf(Lend.y)}; *(LAS f32x2_t*)(lds + SC_EL + 2 * kp * 4) = el; dacc0 *= el.x; dacc1 *= el.y; }
            f32x2_t E = {__expf(pre.x - Lmid.x), __expf(pre.y - Lmid.y)};
            unsigned kt0[4], kt1[4];
#pragma unroll
            for (int i = 0; i < 8; ++i) {
                const f32x2_t f = {__expf(lf[i].x), __expf(lf[i].y)};
                E = E * f;
                const f32x2_t re = {__builtin_amdgcn_rcpf(E.x), __builtin_amdgcn_rcpf(E.y)};
                const f32x2_t ke = (1.0f - f) * re, kend = ke * eEndMid;
                const int s = 8 * g + i;
                if (has_out) {
                    const f32x2_t q = {bf2f((unsigned short)(qrB[i] & 0xffffu)), bf2f((unsigned short)(qrB[i] >> 16))};
                    const f32x2_t qm = q * E, q0 = qm * eLmid;
                    *(LAS unsigned*)(lds + SC_Q0 + s * NSTR + 4 * kp) = pk2(q0.x, q0.y);
                    *(LAS unsigned*)(lds + SC_QM + s * NSTR + 4 * kp) = pk2(qm.x, qm.y);
                    *(LAS unsigned*)(lds + SC_KE + s * NSTR + 4 * kp) = pk2(ke.x, ke.y);
                }
                const unsigned kd = pk2(kend.x, kend.y);
                if (i & 1) { kt0[i >> 1] |= kd << 16; kt1[i >> 1] |= kd & 0xffff0000u; } else { kt0[i >> 1] = kd & 0xffffu; kt1[i >> 1] = kd >> 16; }
            }
            *(LAS v4u*)(lds + SC_KT + (2 * kp) * TSTR + 16 * g) = (v4u){kt0[0], kt0[1], kt0[2], kt0[3]};
            *(LAS v4u*)(lds + SC_KT + (2 * kp + 1) * TSTR + 16 * g) = (v4u){kt1[0], kt1[1], kt1[2], kt1[3]};
            v4u v0, v1;
#pragma unroll
            for (int i2 = 0; i2 < 4; ++i2) { v0[i2] = (vrB[2 * i2] & 0xffffu) | (vrB[2 * i2 + 1] << 16); v1[i2] = (vrB[2 * i2] >> 16) | (vrB[2 * i2 + 1] & 0xffff0000u); }
            *(LAS v4u*)(lds + SC_VT + (2 * kp) * TSTR + 16 * g) = v0;
            *(LAS v4u*)(lds + SC_VT + (2 * kp + 1) * TSTR + 16 * g) = v1;
            if (has_out) {
#pragma unroll
                for (int j = 0; j < 2; ++j)
#pragma unroll
                    for (int g4 = 0; g4 < 4; ++g4)
                        *(LAS v2u*)(lds + SC_ST + (32 * vt + r32) * NSTR + (32 * (2 * th + j) + 8 * g4 + 4 * hi) * 2) = (v2u){pk2(S[j][4 * g4], S[j][4 * g4 + 1]), pk2(S[j][4 * g4 + 2], S[j][4 * g4 + 3])};
            }
        }
        if (c + 2 < c0 + 33) SCAN_LOAD(lfrB, qrB, vrB, c + 2);
        LDS_WAIT(); __builtin_amdgcn_s_barrier(); asm volatile("" ::: "memory");
        f32x16 o;
#pragma unroll
        for (int i = 0; i < 16; ++i) o[i] = 0.f;
        if (has_out && wid < 3) {
            const int si = wid >> 1, ti = (wid + 1) >> 1;
            f32x16 a;
#pragma unroll
            for (int i = 0; i < 16; ++i) a[i] = 0.f;
#pragma unroll
            for (int kk = 0; kk < 8; ++kk) {
                const bf16x8 A = *(const LAS bf16x8*)(lds + SC_KE + (32 * si + r32) * NSTR + (16 * kk + 8 * hi) * 2);
                const bf16x8 B = *(const LAS bf16x8*)(lds + SC_QM + (32 * ti + r32) * NSTR + (16 * kk + 8 * hi) * 2);
                a = MFMA32(A, B, a);
            }
            const int t = 32 * ti + r32;
#pragma unroll
            for (int g4 = 0; g4 < 4; ++g4) {
                const int s0 = 32 * si + 8 * g4 + 4 * hi;
                const float a0 = (s0 + 0 <= t) ? a[4 * g4 + 0] : 0.f, a1 = (s0 + 1 <= t) ? a[4 * g4 + 1] : 0.f, a2 = (s0 + 2 <= t) ? a[4 * g4 + 2] : 0.f, a3 = (s0 + 3 <= t) ? a[4 * g4 + 3] : 0.f;
                *(LAS v2u*)(lds + SC_AT + t * TSTR + s0 * 2) = (v2u){pk2(a0, a1), pk2(a2, a3)};
            }
        }
        {
            const LAS float* EL = (const LAS float*)(lds + SC_EL);
#pragma unroll
            for (int j = 0; j < 2; ++j) {
                const int kq = 2 * th + j;
#pragma unroll
                for (int i = 0; i < 16; ++i) S[j][i] *= EL[32 * kq + crow(i, hi)];
#pragma unroll
                for (int kk = 0; kk < 4; ++kk) {
                    const bf16x8 A = *(const LAS bf16x8*)(lds + SC_KT + (32 * kq + r32) * TSTR + (16 * kk + 8 * hi) * 2);
                    const bf16x8 B = *(const LAS bf16x8*)(lds + SC_VT + (32 * vt + r32) * TSTR + (16 * kk + 8 * hi) * 2);
                    S[j] = MFMA32(A, B, S[j]);
                }
            }
            if (has_out) {
#pragma unroll
                for (int kk = 0; kk < 8; ++kk) {
                    const bf16x8 A = *(const LAS bf16x8*)(lds + SC_Q0 + (32 * th + r32) * NSTR + (16 * kk + 8 * hi) * 2);
                    const bf16x8 B = *(const LAS bf16x8*)(lds + SC_ST + (32 * vt + r32) * NSTR + (16 * kk + 8 * hi) * 2);
                    o = MFMA32(A, B, o);
                }
            }
        }
        LDS_WAIT(); __builtin_amdgcn_s_barrier(); asm volatile("" ::: "memory");
        if (has_out) {
#pragma unroll
            for (int kk = 0; kk < 4; ++kk) {
                const bf16x8 A = *(const LAS bf16x8*)(lds + SC_AT + (32 * th + r32) * TSTR + (16 * kk + 8 * hi) * 2);
                const bf16x8 B = *(const LAS bf16x8*)(lds + SC_VT + (32 * vt + r32) * TSTR + (16 * kk + 8 * hi) * 2);
                o = MFMA32(A, B, o);
            }
#pragma unroll
            for (int i = 0; i < 16; ++i) *(LAS unsigned short*)(lds + SC_Q0 + wid * 2560 + crow(i, hi) * 80 + 2 * r32) = f2bf(o[i]);
            LDS_WAIT(); asm volatile("" ::: "memory");
#pragma unroll
            for (int j2 = 0; j2 < 2; ++j2) { const int tl = j2 * 16 + (lane >> 2), pc = lane & 3; const v4u pv = *(const LAS v4u*)(lds + SC_Q0 + wid * 2560 + tl * 80 + 16 * pc);
                const size_t r_ = (size_t)scan_row(c, 32 * th + tl, b, dir); *(v4u*)(OX + r_ * DM + h * 128 + 32 * vt + 8 * pc) = pv; }
        }
          }
    }
#undef SCAN_LOAD
    if (MODE == 0) {
#pragma unroll
        for (int j = 0; j < 2; ++j)
#pragma unroll
            for (int i = 0; i < 16; ++i) UB[((size_t)item * 32 + j * 16 + i) * 512 + tid] = S[j][i];
        if (g == 0) { DB[item * 128 + 2 * kp] = dacc0; DB[item * 128 + 2 * kp + 1] = dacc1; }
    }
    LDS_WAIT(); __builtin_amdgcn_s_barrier(); asm volatile("" ::: "memory");
}
__device__ __forceinline__ void hgrn_combine(int gw, int NGW, int lane, const bf16* OFW, const bf16* OBW, const bf16* HG, const float* onorm, bf16* OG) {
    float wn[16];
#pragma unroll
    for (int e = 0; e < 16; ++e) wn[e] = onorm[lane * 16 + e];
    for (int r0 = gw; r0 < NLAT; r0 += 2 * NGW) {
        const bool hasb = r0 + NGW < NLAT; const int r1 = hasb ? r0 + NGW : r0;
        v4u a[2][2], bq[2][2], gg[2][2];
#pragma unroll
        for (int k = 0; k < 2; ++k) { const size_t off = (size_t)(k ? r1 : r0) * DM + lane * 16;
#pragma unroll
            for (int j = 0; j < 2; ++j) { a[k][j] = *(const v4u*)(OFW + off + 8 * j); bq[k][j] = *(const v4u*)(OBW + off + 8 * j); gg[k][j] = *(const v4u*)(HG + off + 8 * j); } }
#pragma unroll
        for (int k = 0; k < 2; ++k) {
            if (k == 1 && !hasb) break;
            float o[16], gt[16];
#pragma unroll
            for (int j = 0; j < 2; ++j)
#pragma unroll
                for (int e = 0; e < 4; ++e) { o[8 * j + 2 * e] = bf2f((unsigned short)(a[k][j][e] & 0xffffu)) + bf2f((unsigned short)(bq[k][j][e] & 0xffffu)); o[8 * j + 2 * e + 1] = bf2f((unsigned short)(a[k][j][e] >> 16)) + bf2f((unsigned short)(bq[k][j][e] >> 16));
                    gt[8 * j + 2 * e] = bf2f((unsigned short)(gg[k][j][e] & 0xffffu)); gt[8 * j + 2 * e + 1] = bf2f((unsigned short)(gg[k][j][e] >> 16)); }
            float ss = 0.f;
#pragma unroll
            for (int e = 0; e < 16; ++e) ss += o[e] * o[e];
            ss += __shfl_xor(ss, 1); ss += __shfl_xor(ss, 2); ss += __shfl_xor(ss, 4);
            const float rstd = rsqrtf(ss * (1.f / 128.f) + 1e-6f);
            unsigned pk[8];
#pragma unroll
            for (int e = 0; e < 8; ++e) { const float y0 = o[2 * e] * rstd * wn[2 * e] * __builtin_amdgcn_rcpf(1.0f + __expf(-gt[2 * e])), y1 = o[2 * e + 1] * rstd * wn[2 * e + 1] * __builtin_amdgcn_rcpf(1.0f + __expf(-gt[2 * e + 1])); pk[e] = pk2(y0, y1); }
            const size_t off = (size_t)(k ? r1 : r0) * DM + lane * 16;
            *(v4u*)(OG + off) = (v4u){pk[0], pk[1], pk[2], pk[3]}; *(v4u*)(OG + off + 8) = (v4u){pk[4], pk[5], pk[6], pk[7]};
        }
    }
}

#define XB_TMO      128
#define XB_XCNT(j)  (256  + 64 * (j))
#define XB_XSUB(j)  (1280 + 64 * (j))
#define XB_XGEN(j)  (2304 + 64 * (j))
#define XB_TOP      3328
#define XB_TOPGEN   3392
#define XCD_BAR_WORDS 3456
#define XB_SPIN_CAP (1u << 18)

__device__ __forceinline__ unsigned xb_ld(unsigned* p)              { return __hip_atomic_load(p, __ATOMIC_RELAXED, __HIP_MEMORY_SCOPE_AGENT); }
__device__ __forceinline__ unsigned xb_add(unsigned* p, unsigned v) { return __hip_atomic_fetch_add(p, v, __ATOMIC_RELAXED, __HIP_MEMORY_SCOPE_AGENT); }
__device__ __forceinline__ unsigned xb_xcc_id() { return (unsigned)__builtin_amdgcn_s_getreg((3 << 11) | 20) & 0xFu; }
#define XB_SPIN(cond, bar) do { unsigned _sp = 0; while (cond) { __builtin_amdgcn_s_sleep(1); \
    if ((++_sp & 255u) == 0u) { if (xb_ld(&(bar)[XB_TMO])) break; if (_sp > XB_SPIN_CAP) { atomicAdd(&(bar)[XB_TMO], 1u); break; } } } } while (0)

struct XcdBarrier {
    unsigned* bar; unsigned x;
    volatile LAS unsigned* st;
};

__device__ __forceinline__ XcdBarrier xcd_barrier_post(unsigned* bar, volatile LAS unsigned* st) {
    XcdBarrier b; b.bar = bar; b.x = xb_xcc_id(); b.st = st;
    if (threadIdx.x == 0) (void)xb_add(&bar[XB_XCNT(b.x)], 1u);
    return b;
}
__device__ __forceinline__ void xcd_barrier_complete(unsigned* bar, unsigned x, unsigned& nloc, unsigned& nx) {
    const unsigned G = gridDim.x * gridDim.y * gridDim.z;
    unsigned sum, cnt, mine, sp = 0u;
    for (;;) {
        sum = 0u; cnt = 0u; mine = 0u;
#pragma unroll
        for (unsigned j = 0; j < 16; ++j) { const unsigned c = xb_ld(&bar[XB_XCNT(j)]); sum += c; cnt += (c > 0u) ? 1u : 0u; mine = (j == x) ? c : mine; }
        if (sum == G) break;
        __builtin_amdgcn_s_sleep(1);
        if ((++sp & 255u) == 0u) { if (xb_ld(&bar[XB_TMO])) break; if (sp > XB_SPIN_CAP) { atomicAdd(&bar[XB_TMO], 1u); break; } }
    }
    nloc = mine > 0u ? mine : 1u; nx = cnt > 0u ? cnt : 1u;
}

__device__ __forceinline__ void xcd_barrier(const XcdBarrier& b) {
    asm volatile("s_waitcnt vmcnt(0)" ::: "memory");
    __syncthreads();
    if (threadIdx.x == 0) {
        unsigned* bar = b.bar;
        __builtin_amdgcn_s_waitcnt(0);
        unsigned nloc = b.st[0], nx = b.st[1];
        if (nloc == 0u) { xcd_barrier_complete(bar, b.x, nloc, nx); b.st[0] = nloc; b.st[1] = nx; }
        const unsigned old = xb_add(&bar[XB_XSUB(b.x)], 1u);
        const unsigned gen = old / nloc;
        if (old + 1u == (gen + 1u) * nloc) {
            __builtin_amdgcn_fence(__ATOMIC_RELEASE, "agent");
            asm volatile("s_waitcnt vmcnt(0)" ::: "memory");
            const unsigned og = xb_add(&bar[XB_TOP], 1u);
            const unsigned tg = og / nx;
            if (og + 1u == (tg + 1u) * nx) xb_add(&bar[XB_TOPGEN], 1u);
            else XB_SPIN(xb_ld(&bar[XB_TOPGEN]) == tg, bar);
            __builtin_amdgcn_fence(__ATOMIC_ACQUIRE, "agent");
            xb_add(&bar[XB_XGEN(b.x)], 1u);
            asm volatile("s_waitcnt vmcnt(0)" ::: "memory");
        } else {
            XB_SPIN(xb_ld(&bar[XB_XGEN(b.x)]) == gen, bar);
            __builtin_amdgcn_fence(__ATOMIC_ACQUIRE, "agent");
            asm volatile("s_waitcnt vmcnt(0)" ::: "memory");
        }
    }
    __syncthreads();
}

struct Args { const float* in[19]; float* out; unsigned char* ws; };
typedef __attribute__((address_space(4))) Args KArgs;
__device__ __forceinline__ int fresh_v(int t) { asm volatile("" : "+v"(t)); return t; }
__device__ __forceinline__ int fresh_s(int t) { asm volatile("" : "+s"(t)); return t; }
__global__ void __launch_bounds__(NWAVES * 64, 2) mk_fwd(Args args) {
    extern __shared__ __attribute__((aligned(16))) unsigned char lds_raw[];
    LAS unsigned char* lds = (LAS unsigned char*)lds_raw;
    cg::grid_group grid = cg::this_grid();
#define PHASE_IDS() const int tid = fresh_v((int)threadIdx.x), lane = tid & 63, wave = __builtin_amdgcn_readfirstlane(tid >> 6); (void)lane; (void)wave; \
    const int G = fresh_s((int)gridDim.x), bx = fresh_s((int)blockIdx.x); const int vcu = (G % 8 == 0) ? (bx % 8) * (G / 8) + bx / 8 : bx; (void)vcu; \
    const int gw = vcu * NWAVES + wave, NGW = G * NWAVES; (void)gw; (void)NGW; \
    const KArgs* ap = (const KArgs*)__builtin_amdgcn_kernarg_segment_ptr(); asm volatile("" : "+s"(ap)); unsigned char* ws = ap->ws; (void)ws
#define IN(k) (ap->in[k])
#define MOD ((float*)(ws + WS_MOD))
#define ROPEC ((float*)(ws + WS_ROPE))
#define ROPES (ROPEC + 128 * 16)
#define Wqkv_t ((bf16*)(ws + WS_WQKV))
#define Wo_t ((bf16*)(ws + WS_WO))
#define Hin_t ((bf16*)(ws + WS_HIN))
#define Ho_t ((bf16*)(ws + WS_HO))
#define F1A_t ((bf16*)(ws + WS_F1A))
#define F2A_t ((bf16*)(ws + WS_F2A))
#define F1B_t ((bf16*)(ws + WS_F1B))
#define F2B_t ((bf16*)(ws + WS_F2B))
#define HCTX ((float*)(ws + WS_HCTX))
#define XN ((bf16*)(ws + WS_XN))
#define QO ((bf16*)(ws + WS_QO))
#define KB ((bf16*)(ws + WS_K))
#define VB ((bf16*)(ws + WS_V))
#define MOD1 (MOD + 5 * 6144)
#define SS0 ((float*)(ws + WS_SS))
#define SS1 (SS0 + MALL)
#define SS2 (SS1 + MALL)
#define SS3 (SS2 + MALL)
#define SHW0 ((float*)(ws + WS_SHW))
#define SHW1 (SHW0 + 5 * 5632)
#define SHW2 (SHW1 + 5 * 5120)
    if (args.ws == nullptr) grid.sync();
    volatile LAS unsigned* bst = (volatile LAS unsigned*)(lds + LDS_BYTES - 16);
    if (threadIdx.x == 0) { bst[0] = 0u; bst[1] = 0u; }
    __syncthreads();
    const XcdBarrier bar = xcd_barrier_post((unsigned*)(args.ws + WS_BAR), bst);
    {
        PHASE_IDS();
        for (int i = (bx * NWAVES * 64) + tid; i < 4 * MALL; i += G * NWAVES * 64) SS0[i] = 0.f;
        LAS float* sl = (LAS float*)(lds + 73728);
        for (int i = tid; i < 5 * 1024; i += NWAVES * 64) { const float v = i < 4096 ? (ap->in[1])[i] : (ap->in[3])[i - 4096]; sl[i] = v / (1.0f + __expf(-v)); }
        __syncthreads();
        for (int it = gw; it < 768; it += NGW) {
            const int l = it / 384, n0 = (it % 384) * 16, cg4 = lane & 3, ks = lane >> 2;
            const float* W = (ap->in[4]) + (size_t)l * 1024 * 6144 + n0 + 4 * cg4;
            f32x4 acc[5];
#pragma unroll
            for (int v = 0; v < 5; ++v) acc[v] = (f32x4){0.f, 0.f, 0.f, 0.f};
#pragma unroll 8
            for (int i = 0; i < 64; ++i) { const int kk = i * 16 + ks; const f32x4 w4 = *(const f32x4*)(W + (size_t)kk * 6144);
#pragma unroll
                for (int v = 0; v < 5; ++v) acc[v] += w4 * sl[v * 1024 + kk]; }
#pragma unroll
            for (int v = 0; v < 5; ++v)
#pragma unroll
                for (int e = 0; e < 4; ++e) { float a = acc[v][e]; a += __shfl_xor(a, 4); a += __shfl_xor(a, 8); a += __shfl_xor(a, 16); a += __shfl_xor(a, 32); acc[v][e] = a; }
            if (ks == 0) { const f32x4 bb = *(const f32x4*)((ap->in[5]) + l * 6144 + n0 + 4 * cg4);
#pragma unroll
                for (int v = 0; v < 5; ++v) *(f32x4*)(MOD + (size_t)(l * 5 + v) * 6144 + n0 + 4 * cg4) = acc[v] + bb; }
        }
        for (int idx = bx * (NWAVES * 64) + tid; idx < 2048; idx += G * NWAVES * 64) {
            const int pos = idx >> 4, f = idx & 15;
            double inv = 1.0; for (int j = 0; j < f; ++j) inv *= 0.56234132519034908;
            const double ang = (double)pos * inv, TWO_PI = 6.283185307179586476925;
            const double kq = __builtin_rint(ang / TWO_PI); const double rr = ang - kq * TWO_PI, r2 = rr * rr;
            double cs = 1.0, sn = rr, tc = 1.0, tsn = rr;
            for (int n = 1; n <= 14; ++n) { tc *= -r2 / (double)((2 * n - 1) * (2 * n)); tsn *= -r2 / (double)((2 * n) * (2 * n + 1)); cs += tc; sn += tsn; }
            ROPEC[idx] = (float)cs; ROPES[idx] = (float)sn;
        }
        LAS float* scr = (LAS float*)(lds + wave * 8448);
        constexpr int I_QKV = 16 * 48, I_O = 16 * 32, I_HIN = 16 * 160, I_HO = 16 * 32, I_F1 = 16 * 176, I_F2 = 44 * 32;
        constexpr int NITEMS = I_QKV + I_O + I_HIN + I_HO + 2 * I_F1 + 2 * I_F2;
        for (int it = gw; it < NITEMS; it += NGW) {
            int r = it;
            if (r < I_QKV) { p0_transpose_item<1>((ap->in[8]), 1024, 1536, Wqkv_t, scr, r, lane); continue; } r -= I_QKV;
            if (r < I_O) { p0_transpose_item<0>((ap->in[11]), 1024, 1024, Wo_t, scr, r, lane); continue; } r -= I_O;
            if (r < I_HIN) { p0_transpose_item<0>((ap->in[12]), 1024, 5120, Hin_t, scr, r, lane); continue; } r -= I_HIN;
            if (r < I_HO) { p0_transpose_item<0>((ap->in[15]), 1024, 1024, Ho_t, scr, r, lane); continue; } r -= I_HO;
            if (r < I_F1) { p0_transpose_item<2>((ap->in[16]), 1024, 5632, F1A_t, scr, r, lane); continue; } r -= I_F1;
            if (r < I_F1) { p0_transpose_item<2>((ap->in[16]) + (size_t)1024 * 5632, 1024, 5632, F1B_t, scr, r, lane); continue; } r -= I_F1;
            if (r < I_F2) { p0_transpose_item<0>((ap->in[17]), 2816, 1024, F2A_t, scr, r, lane); continue; } r -= I_F2;
            p0_transpose_item<0>((ap->in[17]) + (size_t)2816 * 1024, 2816, 1024, F2B_t, scr, r, lane);
        }
    }
    xcd_barrier(bar);
    { PHASE_IDS();
      const bool qcu = (G == 256) && bx < 24;
      if (qcu) {
          const int pm = 128 + bx / 6, pn = bx % 6;
          norm_rows(wave, NWAVES, lane, (ap->in[0]), (ap->in[2]), pm * 256, pm * 256 + 256, (ap->in[6]), MOD, 0, 1, XN);
          asm volatile("s_waitcnt vmcnt(0)" ::: "memory"); __syncthreads();
          if (tid == 0) { __builtin_amdgcn_fence(__ATOMIC_ACQUIRE, "agent"); asm volatile("s_waitcnt vmcnt(0)" ::: "memory"); }
          __syncthreads();
          pg8::Gemm gq{XN, Wqkv_t, MALL, 1536, 1024}; pg8::OneUnit Sq{pm, pn, nullptr};
          pg8::EpiQKV Eq{QO, KB, VB, (ap->in[9]), (ap->in[10]), ROPEC, ROPES, attn_body::C2};
          pg8::gemm_phase<pg8::EpiQKV, pg8::OneUnit, PG8_ALIGN, PG8_SP2>(lds, gq, Sq, Eq);
      } else {
      const int gw1 = (G == 256) ? (bx - 24) * NWAVES + wave : gw, NGW1 = (G == 256) ? 232 * NWAVES : NGW;
      norm_rows(gw1, NGW1, lane, (ap->in[0]), (ap->in[2]), 0, (G == 256) ? NLAT : MALL, (ap->in[6]), MOD, 0, 1, XN);
      for (int site = 0; site < 3; ++site) {
          const bf16* Bt = site == 0 ? F1A_t : site == 1 ? Hin_t : F1B_t; const int N = site == 1 ? 5120 : 5632;
          const float* shv = (site == 0 ? MOD : MOD1) + (site == 1 ? 0 : 3) * 1024; float* dst = site == 0 ? SHW0 : site == 1 ? SHW1 : SHW2;
          for (int n = gw1; n < N; n += NGW1) {
              const v4u w0 = *(const v4u*)(Bt + (size_t)n * 1024 + lane * 16), w1 = *(const v4u*)(Bt + (size_t)n * 1024 + lane * 16 + 8);
              float wf[16];
#pragma unroll
              for (int e = 0; e < 4; ++e) { wf[2 * e] = bf2f((unsigned short)(w0[e] & 0xffffu)); wf[2 * e + 1] = bf2f((unsigned short)(w0[e] >> 16)); wf[8 + 2 * e] = bf2f((unsigned short)(w1[e] & 0xffffu)); wf[8 + 2 * e + 1] = bf2f((unsigned short)(w1[e] >> 16)); }
#pragma unroll
              for (int v = 0; v < 5; ++v) { const float* sp = shv + v * 6144 + lane * 16; float a = 0.f;
#pragma unroll
                  for (int e4 = 0; e4 < 4; ++e4) { const f32x4 s4 = *(const f32x4*)(sp + 4 * e4); a += (wf[4 * e4] * s4[0] + wf[4 * e4 + 1] * s4[1]) + (wf[4 * e4 + 2] * s4[2] + wf[4 * e4 + 3] * s4[3]); }
                  a = wave_sum(a); if (lane == 0) dst[v * N + n] = a; }
          }
      }
      }
    }
    xcd_barrier(bar);
    {
        PHASE_IDS();
        const int Mrows = (G == 256) ? NLAT : MALL;
        pg8::Gemm g{XN, Wqkv_t, Mrows, 1536, 1024}; pg8::StaticOrder S; S.init(Mrows, 1536, G, bx);
        pg8::EpiQKV E{QO, KB, VB, (ap->in[9]), (ap->in[10]), ROPEC, ROPES, attn_body::C2};
        pg8::gemm_phase<pg8::EpiQKV, pg8::StaticOrder, PG8_ALIGN, PG8_SP2>(lds, g, S, E);
    }
    xcd_barrier(bar);
    {
        PHASE_IDS();
        for (int i = 0; i < 8; ++i) {
            const int u = i * 256 + vcu; if (u >= 2048 || G != 256) break;
            const int combo = u >> 7, idx = u & 127, b = combo >> 2, kvh = combo & 3, hq = idx >> 5, qb = idx & 31, h = kvh * 4 + hq;
            const attn_body::bf16* Qu = (const attn_body::bf16*)QO + ((size_t)b * SEQ + qb * 256) * 1024 + h * 64;
            const attn_body::bf16* Kh = (const attn_body::bf16*)KB + (size_t)b * KVROWS * 256 + kvh * 64;
            const attn_body::bf16* Vh = (const attn_body::bf16*)VB + (size_t)b * KVROWS * 256 + kvh * 64;
            attn_body::attn_unit<8>(Qu, Kh, Vh, (attn_body::bf16*)XN + (Qu - (const attn_body::bf16*)QO), 132, (char*)lds_raw);
        }
        if (G != 256) for (int u = bx; u < 2048; u += G) {
            const int combo = u >> 7, idx = u & 127, b = combo >> 2, kvh = combo & 3, hq = idx >> 5, qb = idx & 31, h = kvh * 4 + hq;
            const attn_body::bf16* Qu = (const attn_body::bf16*)QO + ((size_t)b * SEQ + qb * 256) * 1024 + h * 64;
            const attn_body::bf16* Kh = (const attn_body::bf16*)KB + (size_t)b * KVROWS * 256 + kvh * 64;
            const attn_body::bf16* Vh = (const attn_body::bf16*)VB + (size_t)b * KVROWS * 256 + kvh * 64;
            attn_body::attn_unit<8>(Qu, Kh, Vh, (attn_body::bf16*)XN + (Qu - (const attn_body::bf16*)QO), 132, (char*)lds_raw);
        }
        for (int u = bx; u < 64; u += G) {
            const int b = u >> 4, h = u & 15, kvh = h >> 2;
            const attn_body::bf16* Qu = (const attn_body::bf16*)QO + ((size_t)NLAT + b * CTXL) * 1024 + h * 64;
            const attn_body::bf16* Kh = (const attn_body::bf16*)KB + (size_t)b * KVROWS * 256 + kvh * 64;
            const attn_body::bf16* Vh = (const attn_body::bf16*)VB + (size_t)b * KVROWS * 256 + kvh * 64;
            attn_body::attn_unit<8>(Qu, Kh, Vh, (attn_body::bf16*)XN + (Qu - (const attn_body::bf16*)QO), 4, (char*)lds_raw);
        }
    }
    xcd_barrier(bar);
    {
        PHASE_IDS();
        const int Mrows = (G == 256) ? NLAT : MALL;
        pg8::Gemm g{XN, Wo_t, Mrows, 1024, 1024}; pg8::StaticOrder S; S.init(Mrows, 1024, G, bx);
        pg8::EpiResidN E{(ap->in[0]), (ap->in[2]), (ap->out), HCTX, MOD + 2 * 1024, (bf16*)(ws + WS_XN2), SS0, (ap->in[7]), MOD + 4 * 1024, (LAS float*)(lds + 139264)};
        pg8::gemm_phase<pg8::EpiResidN, pg8::StaticOrder, PG8_ALIGN, PG8_SP2>(lds, g, S, E);
    }
    xcd_barrier(bar);
    {
        PHASE_IDS();
        pg8::EpiSwiGLU E{(bf16*)(ws + WS_HID0), SS0, SHW0};
        pg8::Gemm g{(const bf16*)(ws + WS_XN2), F1A_t, MALL, 5632, 1024};
        if (G == 256) {
            unsigned* cntW = (unsigned*)(ws + WS_BAR) + XCD_BAR_WORDS + 64; unsigned* cntU = cntW + 64; unsigned* cntD = cntW + 128;
            if (bx < 240) {
                const int x = bx & 7, idx = bx >> 3; const bool hasW = (x == 0 && idx < 16), hasH = idx < 6;
                if (hasW) {
                    pg8::Gemm gw_{XN, Wo_t, MALL, 1024, 1024}; pg8::OneUnit Sw{128 + (idx >> 2), idx & 3, cntW};
                    pg8::EpiResidN Ew{(ap->in[0]), (ap->in[2]), (ap->out), HCTX, MOD + 2 * 1024, (bf16*)(ws + WS_XN2), SS0, (ap->in[7]), MOD + 4 * 1024, (LAS float*)(lds + 139264)};
                    pg8::gemm_phase<pg8::EpiResidN, pg8::OneUnit, PG8_ALIGN, PG8_SP2>(lds, gw_, Sw, Ew);
                }
                pg8::UpOrder S{bx, hasW ? 1 : 0, hasH ? 11 : 12, cntW, cntU};
                pg8::gemm_phase<pg8::EpiSwiGLU, pg8::UpOrder, PG8_ALIGN, PG8_SP2>(lds, g, S, E);
                if (hasH) {
                    pg8::wave_wait_count(cntD, 16u); __syncthreads();
                    const int hidx = x * 6 + idx;
                    pg8::Gemm gh{XN, Hin_t, MALL, 5120, 1024}; pg8::OneUnit Sh{128 + hidx / 12, 8 + hidx % 12, nullptr};
                    pg8::EpiHgrnIn Eh{ws, (ap->in[13]), SS1, SHW1};
                    pg8::gemm_phase<pg8::EpiHgrnIn, pg8::OneUnit, PG8_ALIGN, PG8_SP2>(lds, gh, Sh, Eh);
                }
            } else {
                const int d = bx - 240;
                { pg8::UpOrderD S{d, 0, 3}; pg8::gemm_phase<pg8::EpiSwiGLU, pg8::UpOrderD, PG8_ALIGN, PG8_SP2>(lds, g, S, E); }
                pg8::wave_wait_count(cntU, 88u); __syncthreads();
                {
                    pg8::Gemm g2{(const bf16*)(ws + WS_HID0), F2A_t, MALL, 1024, FFH}; pg8::OneUnit S2{128 + (d >> 2), d & 3, cntD};
                    pg8::EpiResidN E2{(ap->out), HCTX, (ap->out), HCTX, MOD + 5 * 1024, XN, SS1, (ap->in[6]) + 1024, MOD1 + 1 * 1024, (LAS float*)(lds + 139264)};
                    pg8::gemm_phase<pg8::EpiResidN, pg8::OneUnit, PG8_ALIGN, PG8_SP2>(lds, g2, S2, E2);
                }
                { pg8::UpOrderD S{d, 3, 6}; pg8::gemm_phase<pg8::EpiSwiGLU, pg8::UpOrderD, PG8_ALIGN, PG8_SP2>(lds, g, S, E); }
            }
        } else {
            pg8::StaticOrder S; S.init(MALL, 5632, G, bx);
            pg8::gemm_phase<pg8::EpiSwiGLU, pg8::StaticOrder, PG8_ALIGN, PG8_SP2>(lds, g, S, E);
        }
    }
    xcd_barrier(bar);
    {
        PHASE_IDS();
        const int Mrows = (G == 256) ? NLAT : MALL;
        pg8::Gemm g{(const bf16*)(ws + WS_HID0), F2A_t, Mrows, 1024, FFH}; pg8::StaticOrder S; S.init(Mrows, 1024, G, bx);
        pg8::EpiResidN E{(ap->out), HCTX, (ap->out), HCTX, MOD + 5 * 1024, XN, SS1, (ap->in[6]) + 1024, MOD1 + 1 * 1024, (LAS float*)(lds + 139264)};
        pg8::gemm_phase<pg8::EpiResidN, pg8::StaticOrder, PG8_ALIGN, PG8_SP2>(lds, g, S, E);
    }
    xcd_barrier(bar);
    {
        PHASE_IDS();
        const int Mrows = (G == 256) ? NLAT : MALL;
        pg8::Gemm g{XN, Hin_t, Mrows, 5120, 1024}; pg8::StaticOrder S; S.init(Mrows, 5120, G, bx);
        pg8::EpiHgrnIn E{ws, (ap->in[13]), SS1, SHW1};
        pg8::gemm_phase<pg8::EpiHgrnIn, pg8::StaticOrder, PG8_ALIGN, PG8_SP2>(lds, g, S, E);
    }
    xcd_barrier(bar);
    { PHASE_IDS();
    for (int item = bx; item < 256; item += G)
        hgrn_scan_item<0>(lds, item, (const bf16*)(ws + WS_HQ), (const bf16*)(ws + WS_HV), (const bf16*)(ws + WS_LFW), (const bf16*)(ws + WS_LBW), (const bf16*)(ws + WS_HVC), (const bf16*)(ws + WS_LFWC), (const bf16*)(ws + WS_LBWC), (bf16*)(ws + WS_OFW), (bf16*)(ws + WS_OBW), (float*)(ws + WS_U), (float*)(ws + WS_D)); }
    xcd_barrier(bar);
    { PHASE_IDS();
    for (int item = bx; item < 256; item += G)
        hgrn_scan_item<1>(lds, item, (const bf16*)(ws + WS_HQ), (const bf16*)(ws + WS_HV), (const bf16*)(ws + WS_LFW), (const bf16*)(ws + WS_LBW), (const bf16*)(ws + WS_HVC), (const bf16*)(ws + WS_LFWC), (const bf16*)(ws + WS_LBWC), (bf16*)(ws + WS_OFW), (bf16*)(ws + WS_OBW), (float*)(ws + WS_U), (float*)(ws + WS_D)); }
    xcd_barrier(bar);
    { PHASE_IDS(); hgrn_combine(gw, NGW, lane, (const bf16*)(ws + WS_OFW), (const bf16*)(ws + WS_OBW), (const bf16*)(ws + WS_HG), (ap->in[14]), (bf16*)(ws + WS_OG)); }
    xcd_barrier(bar);
    {
        PHASE_IDS();
        pg8::Gemm g{(const bf16*)(ws + WS_OG), Ho_t, NLAT, 1024, 1024}; pg8::StaticOrder S; S.init(NLAT, 1024, G, bx);
        pg8::EpiResidN E{(ap->out), HCTX, (ap->out), HCTX, MOD1 + 2 * 1024, XN, SS2, (ap->in[7]) + 1024, MOD1 + 4 * 1024, (LAS float*)(lds + 139264)};
        pg8::gemm_phase<pg8::EpiResidN, pg8::StaticOrder, PG8_ALIGN, PG8_SP2>(lds, g, S, E);
    }
    xcd_barrier(bar);
    {
        PHASE_IDS();
        pg8::Gemm g{XN, F1B_t, NLAT, 5632, 1024}; pg8::StaticOrder S; S.init(NLAT, 5632, G, bx);
        pg8::EpiSwiGLU E{(bf16*)(ws + WS_HID1), SS2, SHW2};
        pg8::gemm_phase<pg8::EpiSwiGLU, pg8::StaticOrder, PG8_ALIGN, PG8_SP2>(lds, g, S, E);
    }
    xcd_barrier(bar);
    {
        PHASE_IDS();
        pg8::Gemm g{(const bf16*)(ws + WS_HID1), F2B_t, NLAT, 1024, FFH}; pg8::StaticOrder S; S.init(NLAT, 1024, G, bx);
        if (G == 256) {
            pg8::EpiResidFinal E{(ap->out), (ap->out), MOD1 + 5 * 1024, SS3, (unsigned*)(ws + WS_BAR) + XCD_BAR_WORDS + 256, (ap->in[18]), (LAS float*)(lds + 139264)};
            pg8::gemm_phase<pg8::EpiResidFinal, pg8::StaticOrder, PG8_ALIGN, PG8_SP2>(lds, g, S, E);
        } else {
            pg8::EpiResid E{(ap->out), HCTX, (ap->out), HCTX, MOD1 + 5 * 1024};
            pg8::gemm_phase<pg8::EpiResid, pg8::StaticOrder, PG8_ALIGN, PG8_SP2>(lds, g, S, E);
        }
    }
    if (gridDim.x != 256) {
        xcd_barrier(bar);
        { PHASE_IDS(); final_norm_rows(gw, NGW, lane, (ap->out), (ap->in[18])); }
    }
}


extern "C" void kernel_launch(void* const* d_in, const int* in_sizes, int n_in, void* d_out, int out_size, void* d_ws, size_t ws_size, hipStream_t stream) {
    static int grid = 0;
    if (grid == 0) {
        if (n_in != 19 || out_size != NLAT * DM || ws_size < WS_END) { fprintf(stderr, "kernel_launch: unexpected shapes: n_in %d out %d ws %zu\n", n_in, out_size, ws_size); grid = -1; return; }
        int dev = 0, cus = 0, per_cu = 0;
        if (hipGetDevice(&dev) != hipSuccess || hipDeviceGetAttribute(&cus, hipDeviceAttributeMultiprocessorCount, dev) != hipSuccess) { grid = -1; return; }
        if (hipFuncSetAttribute((const void*)mk_fwd, hipFuncAttributeMaxDynamicSharedMemorySize, LDS_BYTES) != hipSuccess) { fprintf(stderr, "kernel_launch: hipFuncSetAttribute failed\n"); grid = -1; return; }
        if (hipOccupancyMaxActiveBlocksPerMultiprocessor(&per_cu, (const void*)mk_fwd, NWAVES * 64, LDS_BYTES) != hipSuccess || per_cu < 1) { fprintf(stderr, "kernel_launch: occupancy query says %d\n", per_cu); per_cu = 1; }
        (void)hipGetLastError();
        grid = cus;
    }
    if (grid < 0) return;
    if (hipMemsetAsync((char*)d_ws + WS_BAR, 0, (XCD_BAR_WORDS + 512) * 4, stream) != hipSuccess) { fprintf(stderr, "kernel_launch: memset of the barrier words failed\n"); return; }
    Args a{};
    for (int i = 0; i < 19; ++i) a.in[i] = (const float*)d_in[i];
    a.out = (float*)d_out; a.ws = (unsigned char*)d_ws;
    void* kargs[] = {&a};
    hipError_t e = hipLaunchCooperativeKernel((const void*)mk_fwd, dim3(grid), dim3(NWAVES * 64), kargs, LDS_BYTES, stream);
    if (e != hipSuccess) fprintf(stderr, "kernel_launch: cooperative launch failed: %s (grid %d)\n", hipGetErrorString(e), grid);
}
```

```cpp
#include <hip/hip_cooperative_groups.h>
namespace cg = cooperative_groups;
#include <hip/hip_runtime.h>
#include <cstdio>
#include <cstdint>
namespace pg8 {
#define PG8_LAS __attribute__((address_space(3)))
typedef unsigned short bf16_t;
typedef short bf16x8 __attribute__((ext_vector_type(8)));
typedef float f32x4 __attribute__((ext_vector_type(4)));
typedef unsigned u32x4 __attribute__((ext_vector_type(4)));
constexpr int BM = 256, BK = 64, HALF = 128, HTB = HALF * BK * 2  , STAGE_BYTES = 8 * HTB, NXCD = 8, WGM = 8;

__host__ __device__ __forceinline__ int lds_byte(int r, int c) { const int st = (r >> 4) * 2 + (c >> 5), rr = r & 15, cc = c & 31, ob = rr * 64 + cc * 2; return st * 1024 + (ob ^ (((ob >> 9) & 1) << 5)); }
__host__ __device__ __forceinline__ void stage_rc(int b, int& R, int& C) { const int st = b / 1024, sb = b % 1024, swz = sb ^ (((sb >> 9) & 1) << 5); R = (st >> 1) * 16 + swz / 64; C = (st & 1) * 32 + (swz % 64) / 2; }
__host__ __device__ __forceinline__ int perm32(int rho) { const int n = rho >> 4, i = rho & 15; return 8 * (i >> 2) + 4 * n + (i & 3); }

struct Unit { int pm, pn; };
struct Gemm { const bf16_t* A; const bf16_t* Bt; int M, N, K; };

struct StaticOrder {
    int nM, nN, nwg, G, c;
    __host__ __device__ void init(int M, int N, int G_, int c_) { nM = M / BM; nN = N / BM; nwg = nM * nN; G = G_; c = c_; }
    __host__ __device__ bool next(int i, Unit& u) const {
        const long L = (long)i * G + c; if (L >= nwg) return false;
        int wgid = (int)L; { const int q = nwg / NXCD, r = nwg % NXCD, xcd = wgid % NXCD, off = wgid / NXCD; wgid = (xcd < r ? xcd * (q + 1) : r * (q + 1) + (xcd - r) * q) + off; }
        const int nig = WGM * nN, gid = wgid / nig, fm = gid * WGM, gsz = (nM - fm) < WGM ? (nM - fm) : WGM;
        u.pm = fm + ((wgid % nig) % gsz); u.pn = (wgid % nig) / gsz; return true;
    }
    __device__ __forceinline__ void a_ready(const Unit&) const {}
    __device__ __forceinline__ void done(const Unit&) const {}
};

__device__ __forceinline__ unsigned cvt_pk_bf16(float lo, float hi) { unsigned r; asm volatile("v_cvt_pk_bf16_f32 %0, %1, %2" : "=v"(r) : "v"(lo), "v"(hi)); return r; }
typedef unsigned u32x2 __attribute__((ext_vector_type(2)));
constexpr int NLAT = 32768, KVROWS = 8448;

struct EpiQKV {
    static constexpr bool PERM = false, AFTER_DRAIN = false;
    bf16_t* Q; bf16_t* Kall; bf16_t* Vall; const float* qn; const float* kn; const float* ropec; const float* ropes; float qscale;
    __device__ __forceinline__ void operator()(const f32x4 (&acc)[2][2][4][2], const Unit& u, int wr, int wc, int fr, int fq) const {
        const int pn = u.pn; const bool isv = (pn == 5), isk = (pn == 4);
        const float* nw = isk ? kn : qn;
        f32x4 w[2][2];
#pragma unroll
        for (int bj = 0; bj < 2; ++bj)
#pragma unroll
            for (int n = 0; n < 2; ++n) w[bj][n] = *(const f32x4*)(nw + 32 * bj + 16 * n + 4 * fq);
        const float osc = (pn < 4) ? qscale : 1.f;
        float ifr[4];
        int fq2 = fq; asm volatile("" : "+v"(fq2));
#pragma unroll
        for (int j = 0; j < 4; ++j) ifr[j] = __builtin_amdgcn_exp2f(-0.83048202372184058696f * (float)(4 * fq2 + j)) * 0.15915494309189533577f;
#pragma unroll
        for (int ai = 0; ai < 2; ++ai)
#pragma unroll
            for (int m = 0; m < 4; ++m) {
                const int r = u.pm * BM + ai * HALF + wr * 64 + m * 16 + fr;
                const bool lat = r < NLAT; int b, t;
                if (lat) { b = r >> 13; t = r & 8191; } else { const int rc = r - NLAT; b = rc >> 8; t = rc & 255; }
                f32x4 x[2][2];
#pragma unroll
                for (int bj = 0; bj < 2; ++bj)
#pragma unroll
                    for (int n = 0; n < 2; ++n) x[bj][n] = acc[ai][bj][m][n];
                if (!isv) {
                    float ss = 0.f;
#pragma unroll
                    for (int bj = 0; bj < 2; ++bj)
#pragma unroll
                        for (int n = 0; n < 2; ++n) { const f32x4 v = x[bj][n]; ss += (v[0] * v[0] + v[1] * v[1]) + (v[2] * v[2] + v[3] * v[3]); }
                    ss += __shfl_xor(ss, 16); ss += __shfl_xor(ss, 32);
                    const float rs = rsqrtf(ss * (1.0f / 64.0f) + 1e-6f);
#pragma unroll
                    for (int bj = 0; bj < 2; ++bj)
#pragma unroll
                        for (int n = 0; n < 2; ++n) x[bj][n] = x[bj][n] * rs * w[bj][n];
                    if (lat) {
#pragma unroll
                        for (int bj = 0; bj < 2; ++bj) {
                            const int pos = bj == 0 ? (t >> 6) : (t & 63);
                            f32x4 c, s;
#pragma unroll
                            for (int j = 0; j < 4; ++j) { const float rev = __builtin_amdgcn_fractf((float)pos * ifr[j]); c[j] = __builtin_amdgcn_cosf(rev); s[j] = __builtin_amdgcn_sinf(rev); }
                            const f32x4 x1 = x[bj][0], x2 = x[bj][1];
                            x[bj][0] = x1 * c - x2 * s; x[bj][1] = x2 * c + x1 * s;
                        }
                    }
#pragma unroll
                    for (int bj = 0; bj < 2; ++bj)
#pragma unroll
                        for (int n = 0; n < 2; ++n) x[bj][n] = x[bj][n] * osc;
                }
                bf16_t* dst;
                if (pn < 4) dst = Q + (size_t)r * 1024 + pn * 256 + 64 * wc;
                else { const size_t kr = (size_t)b * KVROWS + (lat ? 256 + t : t); dst = (isk ? Kall : Vall) + kr * 256 + 64 * wc; }
#pragma unroll
                for (int bj = 0; bj < 2; ++bj)
#pragma unroll
                    for (int n = 0; n < 2; ++n) { u32x2 p; p.x = cvt_pk_bf16(x[bj][n][0], x[bj][n][1]); p.y = cvt_pk_bf16(x[bj][n][2], x[bj][n][3]); *(u32x2*)(dst + 32 * bj + 16 * n + 4 * fq) = p; }
                asm volatile("" ::: "memory");
            }
    }
};

__device__ __forceinline__ void bf8_to_f32(const u32x4 w, f32x4& lo, f32x4& hi) {
    lo = (f32x4){__builtin_bit_cast(float, w.x << 16), __builtin_bit_cast(float, w.x & 0xffff0000u), __builtin_bit_cast(float, w.y << 16), __builtin_bit_cast(float, w.y & 0xffff0000u)};
    hi = (f32x4){__builtin_bit_cast(float, w.z << 16), __builtin_bit_cast(float, w.z & 0xffff0000u), __builtin_bit_cast(float, w.w << 16), __builtin_bit_cast(float, w.w & 0xffff0000u)};
}
__device__ __forceinline__ u32x4 f32_to_bf8(const f32x4 lo, const f32x4 hi) { u32x4 p; p.x = cvt_pk_bf16(lo[0], lo[1]); p.y = cvt_pk_bf16(lo[2], lo[3]); p.z = cvt_pk_bf16(hi[0], hi[1]); p.w = cvt_pk_bf16(hi[2], hi[3]); return p; }
struct EpiResid {
    static constexpr bool PERM = true, AFTER_DRAIN = false;
    const bf16_t* base; float* out; const float* gate;
    __device__ __forceinline__ void operator()(const f32x4 (&acc)[2][2][4][2], const Unit& u, int wr, int wc, int fr, int fq) const {
        const int rowt = u.pm * BM, vec = rowt >> 13;
        const bf16_t* bp = base + (size_t)rowt * 1024; float* op = out + (size_t)rowt * 1024;
        const int col0 = u.pn * BM + wc * 32 + 8 * fq;
#pragma unroll
        for (int bj = 0; bj < 2; ++bj) {
            const int cc = col0 + bj * HALF;
            const f32x4 g0 = *(const f32x4*)(gate + vec * 6144 + cc), g1 = *(const f32x4*)(gate + vec * 6144 + cc + 4);
#pragma unroll
            for (int ai = 0; ai < 2; ++ai)
#pragma unroll
                for (int m = 0; m < 4; ++m) { const size_t off = (size_t)(ai * HALF + wr * 64 + m * 16 + fr) * 1024 + cc;
                    f32x4 b0, b1; bf8_to_f32(*(const u32x4*)(bp + off), b0, b1);
                    *(f32x4*)(op + off) = b0 + g0 * acc[ai][bj][m][0]; *(f32x4*)(op + off + 4) = b1 + g1 * acc[ai][bj][m][1]; }
            asm volatile("" ::: "memory");
        }
    }
};

struct EpiResidFinal {
    static constexpr bool PERM = true, AFTER_DRAIN = false;
    const bf16_t* base; float* out; const float* gate; float* SS; unsigned* cnt; const float* fw; PG8_LAS float* red;
    __device__ __forceinline__ void operator()(const f32x4 (&acc)[2][2][4][2], const Unit& u, int wr, int wc, int fr_, int fq_) const {
        int fr = fr_, fq = fq_; asm volatile("" : "+v"(fr), "+v"(fq));
        const int rowt = u.pm * BM, vec = rowt >> 13;
        const bf16_t* bp = base + (size_t)rowt * 1024; float* op = out + (size_t)rowt * 1024;
        const int col0 = u.pn * BM + wc * 32 + 8 * fq;
        float ss[8];
#pragma unroll
        for (int q = 0; q < 8; ++q) ss[q] = 0.f;
#pragma unroll
        for (int bj = 0; bj < 2; ++bj) {
            const int cc = col0 + bj * HALF;
            const f32x4 g0 = *(const f32x4*)(gate + vec * 6144 + cc), g1 = *(const f32x4*)(gate + vec * 6144 + cc + 4);
#pragma unroll
            for (int ai = 0; ai < 2; ++ai)
#pragma unroll
                for (int m = 0; m < 4; ++m) { const size_t off = (size_t)(ai * HALF + wr * 64 + m * 16 + fr) * 1024 + cc;
                    f32x4 b0, b1; bf8_to_f32(*(const u32x4*)(bp + off), b0, b1);
                    const f32x4 hn0 = b0 + g0 * acc[ai][bj][m][0], hn1 = b1 + g1 * acc[ai][bj][m][1];
                    *(f32x4*)(op + off) = hn0; *(f32x4*)(op + off + 4) = hn1;
                    ss[ai * 4 + m] += ((hn0[0] * hn0[0] + hn0[1] * hn0[1]) + (hn0[2] * hn0[2] + hn0[3] * hn0[3])) + ((hn1[0] * hn1[0] + hn1[1] * hn1[1]) + (hn1[2] * hn1[2] + hn1[3] * hn1[3])); }
            asm volatile("" ::: "memory");
        }
#pragma unroll
        for (int q = 0; q < 8; ++q) { float s = ss[q]; s += __shfl_xor(s, 16); s += __shfl_xor(s, 32);
            if (fq == 0) red[((q >> 2) * HALF + wr * 64 + (q & 3) * 16 + fr) * 4 + wc] = s; }
        asm volatile("s_waitcnt lgkmcnt(0)" ::: "memory"); __builtin_amdgcn_s_barrier(); asm volatile("" ::: "memory");
        const int lane = fq * 16 + fr;
        if (lane < 32) { const int row = (wr * 4 + wc) * 32 + lane; const f32x4 p = *(const PG8_LAS f32x4*)(red + row * 4); atomicAdd(SS + rowt + row, (p[0] + p[1]) + (p[2] + p[3])); }
        asm volatile("s_waitcnt vmcnt(0)" ::: "memory"); __builtin_amdgcn_s_barrier(); asm volatile("" ::: "memory");
        if (threadIdx.x == 0) __hip_atomic_fetch_add(cnt + u.pm, 1u, __ATOMIC_RELAXED, __HIP_MEMORY_SCOPE_AGENT);
        { unsigned sp = 0; while ((unsigned)__builtin_amdgcn_readfirstlane(__hip_atomic_load(cnt + u.pm, __ATOMIC_RELAXED, __HIP_MEMORY_SCOPE_AGENT)) < 4u) { __builtin_amdgcn_s_sleep(2); if (++sp > (1u << 22)) break; } }
        asm volatile("" ::: "memory");
#pragma unroll
        for (int q = 0; q < 8; ++q) { const unsigned b = __hip_atomic_load((const unsigned*)SS + rowt + (q >> 2) * HALF + wr * 64 + (q & 3) * 16 + fr, __ATOMIC_RELAXED, __HIP_MEMORY_SCOPE_AGENT);
            ss[q] = rsqrtf(__builtin_bit_cast(float, b) * (1.0f / 1024.0f) + 1e-6f); }
#pragma unroll
        for (int bj = 0; bj < 2; ++bj) {
            const int cc = col0 + bj * HALF;
            const f32x4 w0 = *(const f32x4*)(fw + cc), w1 = *(const f32x4*)(fw + cc + 4);
#pragma unroll
            for (int ai = 0; ai < 2; ++ai)
#pragma unroll
                for (int m = 0; m < 4; ++m) { const size_t off = (size_t)(ai * HALF + wr * 64 + m * 16 + fr) * 1024 + cc;
                    const f32x4 hn0 = *(const f32x4*)(op + off), hn1 = *(const f32x4*)(op + off + 4);
                    *(f32x4*)(op + off) = hn0 * ss[ai * 4 + m] * w0; *(f32x4*)(op + off + 4) = hn1 * ss[ai * 4 + m] * w1; }
            asm volatile("" ::: "memory");
        }
    }
};

template <bool BASE_F32> struct EpiResidN {
    static constexpr bool PERM = true, AFTER_DRAIN = false;
    const void* base_lat; const void* base_ctx; bf16_t* out_lat; bf16_t* out_ctx; const float* gate;
    bf16_t* XNr; float* SS; const float* nw; const float* sc;
    PG8_LAS float* red;
    __device__ __forceinline__ void operator()(const f32x4 (&acc)[2][2][4][2], const Unit& u, int wr, int wc, int fr_, int fq_) const {
        int fr = fr_, fq = fq_; asm volatile("" : "+v"(fr), "+v"(fq));
        const int rowt = u.pm * BM; const bool lat = rowt < NLAT; const int vec = lat ? (rowt >> 13) : 4;
        const size_t rbase = (size_t)(lat ? rowt : rowt - NLAT) * 1024;
        const float* bpf = (const float*)(lat ? base_lat : base_ctx) + rbase; const bf16_t* bph = (const bf16_t*)(lat ? base_lat : base_ctx) + rbase;
        bf16_t* op = (lat ? out_lat : out_ctx) + rbase;
        const int col0 = u.pn * BM + wc * 32 + 8 * fq;
        float ss[8];
#pragma unroll
        for (int q = 0; q < 8; ++q) ss[q] = 0.f;
#pragma unroll
        for (int bj = 0; bj < 2; ++bj) {
            const int cc = col0 + bj * HALF;
            const f32x4 g0 = *(const f32x4*)(gate + vec * 6144 + cc), g1 = *(const f32x4*)(gate + vec * 6144 + cc + 4);
            const f32x4 gm0 = *(const f32x4*)(nw + cc) * (*(const f32x4*)(sc + vec * 6144 + cc) + 1.0f), gm1 = *(const f32x4*)(nw + cc + 4) * (*(const f32x4*)(sc + vec * 6144 + cc + 4) + 1.0f);
#pragma unroll
            for (int ai = 0; ai < 2; ++ai)
#pragma unroll
                for (int m = 0; m < 4; ++m) { const int rl = ai * HALF + wr * 64 + m * 16 + fr; const size_t off = (size_t)rl * 1024 + cc;
                    f32x4 b0, b1;
                    if (BASE_F32) { b0 = *(const f32x4*)(bpf + off); b1 = *(const f32x4*)(bpf + off + 4); } else bf8_to_f32(*(const u32x4*)(bph + off), b0, b1);
                    const f32x4 hn0 = b0 + g0 * acc[ai][bj][m][0], hn1 = b1 + g1 * acc[ai][bj][m][1];
                    *(u32x4*)(op + off) = f32_to_bf8(hn0, hn1);
                    ss[ai * 4 + m] += ((hn0[0] * hn0[0] + hn0[1] * hn0[1]) + (hn0[2] * hn0[2] + hn0[3] * hn0[3])) + ((hn1[0] * hn1[0] + hn1[1] * hn1[1]) + (hn1[2] * hn1[2] + hn1[3] * hn1[3]));
                    *(u32x4*)(XNr + (size_t)rowt * 1024 + off) = f32_to_bf8(hn0 * gm0, hn1 * gm1); }
            asm volatile("" ::: "memory");
        }
#pragma unroll
        for (int q = 0; q < 8; ++q) { float s = ss[q]; s += __shfl_xor(s, 16); s += __shfl_xor(s, 32);
            if (fq == 0) red[((q >> 2) * HALF + wr * 64 + (q & 3) * 16 + fr) * 4 + wc] = s; }
        asm volatile("s_waitcnt lgkmcnt(0)" ::: "memory"); __builtin_amdgcn_s_barrier(); asm volatile("" ::: "memory");
        const int lane = fq * 16 + fr;
        if (lane < 32) { const int row = (wr * 4 + wc) * 32 + lane; const f32x4 p = *(const PG8_LAS f32x4*)(red + row * 4); atomicAdd(SS + rowt + row, (p[0] + p[1]) + (p[2] + p[3])); }
    }
};

__device__ __forceinline__ float silu_f(float a) { return a * __builtin_amdgcn_rcpf(1.0f + __expf(-a)); }
struct EpiSwiGLU {
    static constexpr bool PERM = true, AFTER_DRAIN = false;
    bf16_t* O; const float* SS; const float* shw;
    __device__ __forceinline__ void operator()(const f32x4 (&acc)[2][2][4][2], const Unit& u, int wr, int wc, int fr, int fq) const {
        const int row0 = u.pm * BM + wr * 64 + fr, hc0 = u.pn * HALF + wc * 32 + 8 * fq;
        const int vec = (u.pm * BM < NLAT) ? ((u.pm * BM) >> 13) : 4;
        f32x4 sa0 = {0.f, 0.f, 0.f, 0.f}, sa1 = sa0, su0 = sa0, su1 = sa0;
        if (SS) { const float* sp = shw + vec * 5632 + u.pn * BM + wc * 32 + 8 * fq; sa0 = *(const f32x4*)sp; sa1 = *(const f32x4*)(sp + 4); su0 = *(const f32x4*)(sp + HALF); su1 = *(const f32x4*)(sp + HALF + 4); }
        float rs8[8];
#pragma unroll
        for (int q = 0; q < 8; ++q) rs8[q] = SS ? SS[row0 + (q >> 2) * HALF + (q & 3) * 16] : 0.f;
#pragma unroll
        for (int q = 0; q < 8; ++q) rs8[q] = SS ? rsqrtf(rs8[q] * (1.0f / 1024.0f) + 1e-6f) : 1.0f;
#pragma unroll
        for (int ai = 0; ai < 2; ++ai)
#pragma unroll
            for (int m = 0; m < 4; ++m) { const int r = row0 + ai * HALF + m * 16; bf16_t* rowp = O + (size_t)r * 2816 + hc0;
                const float rs = rs8[ai * 4 + m];
                const f32x4 a0 = acc[ai][0][m][0] * rs + sa0, a1 = acc[ai][0][m][1] * rs + sa1, u0 = acc[ai][1][m][0] * rs + su0, u1 = acc[ai][1][m][1] * rs + su1;
                u32x4 wv; wv.x = cvt_pk_bf16(silu_f(a0[0]) * u0[0], silu_f(a0[1]) * u0[1]); wv.y = cvt_pk_bf16(silu_f(a0[2]) * u0[2], silu_f(a0[3]) * u0[3]);
                wv.z = cvt_pk_bf16(silu_f(a1[0]) * u1[0], silu_f(a1[1]) * u1[1]); wv.w = cvt_pk_bf16(silu_f(a1[2]) * u1[2], silu_f(a1[3]) * u1[3]);
                __builtin_nontemporal_store(wv, (u32x4*)rowp); }
    }
};

__device__ __forceinline__ unsigned pk_f16(float lo, float hi) { const _Float16 a = (_Float16)lo, b = (_Float16)hi; return (unsigned)__builtin_bit_cast(unsigned short, a) | ((unsigned)__builtin_bit_cast(unsigned short, b) << 16); }
constexpr size_t OFF_MiB = 1u << 20, OFF_HQ = 122 * OFF_MiB, OFF_HG = 186 * OFF_MiB, OFF_HV = 250 * OFF_MiB, OFF_LFW = 314 * OFF_MiB, OFF_LBW = 378 * OFF_MiB, OFF_HVC = 506 * OFF_MiB, OFF_LFWC = 508 * OFF_MiB, OFF_LBWC = 510 * OFF_MiB;
struct EpiHgrnIn {
    static constexpr bool PERM = true, AFTER_DRAIN = false;
    unsigned char* ws; const float* lbl; const float* SS; const float* shw;
    __device__ __forceinline__ void operator()(const f32x4 (&acc)[2][2][4][2], const Unit& u, int wr, int wc, int fr, int fq) const {
        const int type = u.pn >> 2; const bool lat = u.pm < (NLAT / BM);
        if (type < 2 && !lat) return;
        const size_t doff = lat ? (type == 0 ? OFF_HQ : type == 1 ? OFF_HG : type == 2 ? OFF_LFW : type == 3 ? OFF_LBW : OFF_HV)
                                : (type == 2 ? OFF_LFWC : type == 3 ? OFF_LBWC : OFF_HVC) - (size_t)NLAT * 2048;
        bf16_t* dstb = (bf16_t*)(ws + doff);
        const int row0 = u.pm * BM + wr * 64 + fr; const int vec = lat ? ((u.pm * BM) >> 13) : 4;
        float rs8[8];
#pragma unroll
        for (int q = 0; q < 8; ++q) rs8[q] = SS[row0 + (q >> 2) * HALF + (q & 3) * 16];
#pragma unroll
        for (int q = 0; q < 8; ++q) rs8[q] = rsqrtf(rs8[q] * (1.0f / 1024.0f) + 1e-6f);
#pragma unroll
        for (int bj = 0; bj < 2; ++bj) {
            const int ch = (u.pn & 3) * 256 + bj * HALF + wc * 32 + 8 * fq;
            const float* sp = shw + vec * 5120 + u.pn * BM + bj * HALF + wc * 32 + 8 * fq; const f32x4 sw0 = *(const f32x4*)sp, sw1 = *(const f32x4*)(sp + 4);
            float lb[8];
            if (type == 2 || type == 3) {
#pragma unroll
                for (int e = 0; e < 8; ++e) { const float l0 = lbl[ch + e], l1 = lbl[1024 + ch + e]; lb[e] = 1.0f / (1.0f + __expf(l0 - l1)); }
            } else {
#pragma unroll
                for (int e = 0; e < 8; ++e) lb[e] = 0.f;
            }
#pragma unroll
            for (int ai = 0; ai < 2; ++ai)
#pragma unroll
                for (int m = 0; m < 4; ++m) { const int r = row0 + ai * HALF + m * 16; bf16_t* p = dstb + (size_t)r * 1024 + ch;
                    const float rs = rs8[ai * 4 + m];
                    float v[8];
#pragma unroll
                    for (int e = 0; e < 8; ++e) v[e] = acc[ai][bj][m][e >> 2][e & 3] * rs + (e < 4 ? sw0[e & 3] : sw1[e & 3]);
                    u32x4 wv;
                    if (type == 2 || type == 3) {
#pragma unroll
                        for (int e = 0; e < 8; ++e) { const float sg = __builtin_amdgcn_rcpf(1.0f + __expf(-v[e])); v[e] = __logf(lb[e] + (1.0f - lb[e]) * sg); }
                        wv.x = pk_f16(v[0], v[1]); wv.y = pk_f16(v[2], v[3]); wv.z = pk_f16(v[4], v[5]); wv.w = pk_f16(v[6], v[7]);
                    } else { wv.x = cvt_pk_bf16(v[0], v[1]); wv.y = cvt_pk_bf16(v[2], v[3]); wv.z = cvt_pk_bf16(v[4], v[5]); wv.w = cvt_pk_bf16(v[6], v[7]); }
                    *(u32x4*)p = wv; if (m & 1) asm volatile("" ::: "memory"); }
        }
    }
};

__device__ __forceinline__ void publish_unit(unsigned* cnt) {
    asm volatile("s_waitcnt vmcnt(0)" ::: "memory"); __builtin_amdgcn_s_barrier(); asm volatile("" ::: "memory");
    if (threadIdx.x == 0) { __builtin_amdgcn_fence(__ATOMIC_RELEASE, "agent"); asm volatile("s_waitcnt vmcnt(0)" ::: "memory"); __hip_atomic_fetch_add(cnt, 1u, __ATOMIC_RELAXED, __HIP_MEMORY_SCOPE_AGENT); }
}
__device__ __forceinline__ void wave_wait_count(unsigned* cnt, unsigned want) {
    unsigned sp = 0;
    while ((unsigned)__builtin_amdgcn_readfirstlane(__hip_atomic_load(cnt, __ATOMIC_RELAXED, __HIP_MEMORY_SCOPE_AGENT)) < want) { __builtin_amdgcn_s_sleep(4); if (++sp > (1u << 22)) break; }
    __builtin_amdgcn_fence(__ATOMIC_ACQUIRE, "agent"); asm volatile("s_waitcnt vmcnt(0)" ::: "memory");
}
__device__ __forceinline__ void latent_up_unit(int q, Unit& u) { const int nN = 22, nM = 128, nig = WGM * nN, gid = q / nig, fm = gid * WGM, gsz = (nM - fm) < WGM ? (nM - fm) : WGM; u.pm = fm + ((q % nig) % gsz); u.pn = (q % nig) / gsz; }
__device__ __forceinline__ int up_pos_type(int x, int j, int& idx) {
    if (x == 0 && j < 16) { idx = j; return 1; }
    if (j >= 30 && j < 60 && x < 3) { const int uu = x * 30 + (j - 30); if (uu < 88) { idx = uu; return 2; } }
    if (j >= 330 && j < 336) { idx = x * 6 + (j - 330); return 3; }
    int sp = 0;
    if (x == 0) sp += 16;
    if (x < 3) { const int lim = x < 2 ? 30 : 28; int t = j - 30; t = t < 0 ? 0 : (t > lim ? lim : t); sp += t; }
    { int t = j - 330; t = t < 0 ? 0 : (t > 6 ? 6 : t); sp += t; }
    const int prev = x == 0 ? 0 : x == 1 ? 52 : x == 2 ? 88 : 122 + (x - 3) * 6;
    idx = x * 360 + j - sp - prev; return 0;
}
struct UpOrder {
    int c, i0, i1; unsigned* cntW; unsigned* cntU;
    __device__ __forceinline__ bool next(int k, Unit& u) const {
        const int i = i0 + k; if (i >= i1) return false;
        int idx; const int t = up_pos_type(c & 7, i * 30 + (c >> 3), idx);
        if (t == 2) { u.pm = 128 + idx / 22; u.pn = idx % 22; } else latent_up_unit(idx, u);
        return true;
    }
    __device__ __forceinline__ void a_ready(const Unit& u) const { if (u.pm >= 128) wave_wait_count(cntW, 16u); }
    __device__ __forceinline__ void done(const Unit& u) const { if (u.pm >= 128) publish_unit(cntU); }
};
struct UpOrderD {
    int d, i0, i1;
    __device__ __forceinline__ bool next(int k, Unit& u) const { const int i = i0 + k; if (i >= i1) return false; const int q = 2728 + i * 16 + d; if (q >= 2816) return false; latent_up_unit(q, u); return true; }
    __device__ __forceinline__ void a_ready(const Unit&) const {}
    __device__ __forceinline__ void done(const Unit&) const {}
};
struct OneUnit {
    int pm, pn; unsigned* cnt;
    __device__ __forceinline__ bool next(int i, Unit& u) const { if (i > 0) return false; u.pm = pm; u.pn = pn; return true; }
    __device__ __forceinline__ void a_ready(const Unit&) const {}
    __device__ __forceinline__ void done(const Unit&) const { if (cnt) publish_unit(cnt); }
};
template <class Epi, class Sched, bool ALIGN_EPI = false, bool SP2 = false>
__device__ __forceinline__ void gemm_phase(PG8_LAS unsigned char* lds, const Gemm g, const Sched& S, const Epi& E) {
    int tid_ = threadIdx.x; asm volatile("" : "+v"(tid_));
    const int tid = tid_, wid = __builtin_amdgcn_readfirstlane(tid >> 6), lane = tid & 63, wr = wid >> 2, wc = wid & 3, fr = lane & 15, fq = lane >> 4;
    const int K = g.K, nt = K / BK;
    unsigned voffA[2], voffB[2];
#pragma unroll
    for (int i = 0; i < 2; ++i) { int R, C; stage_rc(tid * 16 + i * 8192, R, C); const int Rb = Epi::PERM ? ((R & ~31) + perm32(R & 31)) : R;
        voffA[i] = (unsigned)(R * K + C) * 2u; voffB[i] = (unsigned)(Rb * K + C) * 2u; }
    const size_t kstep = (size_t)(BK * 2);
    const size_t hstep = (size_t)HALF * K * 2;
    const size_t tstep = 2 * hstep;
    const unsigned ldsw = (unsigned)wid * 1024u;
    const int aoff = lds_byte(wr * 64 + fr, fq * 8), boff = lds_byte(wc * 32 + fr, fq * 8);
#define PG8_SA(b, h) (((b) * 2 + (h)) * HTB)
#define PG8_SB(b, h) ((4 + (b) * 2 + (h)) * HTB)
#define PG8_STAGE(bufoff, gbase, voff) do { _Pragma("unroll") for (int _i = 0; _i < 2; ++_i) \
        __builtin_amdgcn_global_load_lds((const unsigned*)((const char*)(gbase) + (voff)[_i]), (PG8_LAS unsigned*)(lds + (bufoff) + ldsw + _i * 8192), 16, 0, 0); } while (0)
#define PG8_LDA(dst, b, h) do { _Pragma("unroll") for (int m = 0; m < 4; ++m) _Pragma("unroll") for (int k = 0; k < 2; ++k) dst[m][k] = *(const PG8_LAS bf16x8*)(lds + PG8_SA(b, h) + aoff + m * 2048 + k * 1024); } while (0)
#define PG8_LDB(dst, b, h) do { _Pragma("unroll") for (int n = 0; n < 2; ++n) _Pragma("unroll") for (int k = 0; k < 2; ++k) dst[n][k] = *(const PG8_LAS bf16x8*)(lds + PG8_SB(b, h) + boff + n * 2048 + k * 1024); } while (0)
#define PG8_MMA(ai, bj, At, Bt) do { __builtin_amdgcn_s_setprio(1); _Pragma("unroll") for (int m = 0; m < 4; ++m) _Pragma("unroll") for (int n = 0; n < 2; ++n) _Pragma("unroll") for (int k = 0; k < 2; ++k) \
        acc[ai][bj][m][n] = __builtin_amdgcn_mfma_f32_16x16x32_bf16(Bt[n][k], At[m][k], acc[ai][bj][m][n], 0, 0, 0); __builtin_amdgcn_s_setprio(0); } while (0)
#define PG8_WAIT_V(n) asm volatile("s_waitcnt vmcnt(" #n ")" ::: "memory")
#define PG8_WAIT_L(n) asm volatile("s_waitcnt lgkmcnt(" #n ")" ::: "memory")
#define PG8_BAR __builtin_amdgcn_s_barrier()
#define PG8_SCHED __builtin_amdgcn_sched_barrier(0)
    Unit cur, nxt; int ui = 0;
    if (!S.next(0, cur)) return;
    f32x4 acc[2][2][4][2];
#pragma unroll
    for (int a = 0; a < 2; ++a)
#pragma unroll
        for (int b = 0; b < 2; ++b)
#pragma unroll
            for (int m = 0; m < 4; ++m)
#pragma unroll
                for (int n = 0; n < 2; ++n) acc[a][b][m][n] = (f32x4){0.f, 0.f, 0.f, 0.f};
    bf16x8 At[4][2], B0[2][2], B1[2][2];
    const char* cA = (const char*)g.A + (size_t)cur.pm * tstep; const char* cB = (const char*)g.Bt + (size_t)cur.pn * tstep;
    S.a_ready(cur);
    if constexpr (SP2) {
        PG8_STAGE(PG8_SB(0, 0), cB, voffB); PG8_STAGE(PG8_SB(0, 1), cB + hstep, voffB); PG8_STAGE(PG8_SA(0, 0), cA, voffA); PG8_STAGE(PG8_SA(0, 1), cA + hstep, voffA);
        if (wr == 1) PG8_BAR;
        PG8_WAIT_V(2); PG8_BAR;
        PG8_STAGE(PG8_SB(1, 0), cB + kstep, voffB); PG8_STAGE(PG8_SA(1, 0), cA + kstep, voffA); PG8_STAGE(PG8_SB(1, 1), cB + hstep + kstep, voffB);
        PG8_WAIT_V(6); PG8_BAR;
    } else {
        PG8_STAGE(PG8_SB(0, 0), cB, voffB); PG8_STAGE(PG8_SA(0, 0), cA, voffA); PG8_STAGE(PG8_SB(0, 1), cB + hstep, voffB); PG8_STAGE(PG8_SA(0, 1), cA + hstep, voffA);
        if (wr == 1) PG8_BAR;
        PG8_WAIT_V(4); PG8_BAR;
        PG8_STAGE(PG8_SB(1, 0), cB + kstep, voffB); PG8_STAGE(PG8_SA(1, 0), cA + kstep, voffA); PG8_STAGE(PG8_SB(1, 1), cB + hstep + kstep, voffB);
        PG8_WAIT_V(6); PG8_BAR;
    }
    for (;;) {
        const bool has_next = S.next(ui + 1, nxt);
        const char* nA = has_next ? (const char*)g.A + (size_t)nxt.pm * tstep : cA; const char* nB = has_next ? (const char*)g.Bt + (size_t)nxt.pn * tstep : cB;
        for (int t = 0; t < nt; t += 2) {
            const bool last = (t == nt - 2);
            const char* a1 = cA + (size_t)(t + 1) * kstep;
            const char* a2 = last ? nA : cA + (size_t)(t + 2) * kstep; const char* b2 = last ? nB : cB + (size_t)(t + 2) * kstep;
            const char* a3 = a2 + kstep; const char* b3 = b2 + kstep;
            if (last && has_next) S.a_ready(nxt);
            if constexpr (SP2) {
            PG8_LDB(B0, 0, 0); PG8_LDB(B1, 0, 1); PG8_SCHED; PG8_LDA(At, 0, 0); PG8_STAGE(PG8_SA(1, 1), a1 + hstep, voffA);
            PG8_WAIT_V(8); PG8_WAIT_L(0); PG8_BAR; PG8_MMA(0, 0, At, B0); PG8_MMA(0, 1, At, B1); PG8_BAR; PG8_SCHED;
            PG8_LDA(At, 0, 1); PG8_STAGE(PG8_SB(0, 0), b2, voffB); PG8_STAGE(PG8_SB(0, 1), b2 + hstep, voffB); PG8_STAGE(PG8_SA(0, 0), a2, voffA);
            PG8_WAIT_V(8); PG8_WAIT_L(0); PG8_BAR; PG8_MMA(1, 0, At, B0); PG8_MMA(1, 1, At, B1); PG8_BAR; PG8_SCHED;
            PG8_LDB(B0, 1, 0); PG8_LDB(B1, 1, 1); PG8_SCHED; PG8_LDA(At, 1, 0); PG8_STAGE(PG8_SA(0, 1), a2 + hstep, voffA);
            PG8_WAIT_V(8); PG8_WAIT_L(0); PG8_BAR; PG8_MMA(0, 0, At, B0); PG8_MMA(0, 1, At, B1); PG8_BAR; PG8_SCHED;
            PG8_LDA(At, 1, 1); PG8_STAGE(PG8_SB(1, 0), b3, voffB); PG8_STAGE(PG8_SB(1, 1), b3 + hstep, voffB); PG8_STAGE(PG8_SA(1, 0), a3, voffA);
            PG8_WAIT_V(8); PG8_WAIT_L(0); PG8_BAR; PG8_MMA(1, 0, At, B0); PG8_MMA(1, 1, At, B1); PG8_BAR; PG8_SCHED;
            } else {
            PG8_LDB(B0, 0, 0); PG8_SCHED; PG8_LDA(At, 0, 0); PG8_STAGE(PG8_SA(1, 1), a1 + hstep, voffA);
            PG8_WAIT_L(8); PG8_BAR; PG8_WAIT_L(0); PG8_MMA(0, 0, At, B0); PG8_BAR; PG8_SCHED;
            PG8_LDB(B1, 0, 1); PG8_STAGE(PG8_SB(0, 0), b2, voffB);
            PG8_BAR; PG8_WAIT_L(0); PG8_MMA(0, 1, At, B1); PG8_BAR;
            PG8_LDA(At, 0, 1); PG8_STAGE(PG8_SA(0, 0), a2, voffA);
            PG8_BAR; PG8_WAIT_L(0); PG8_MMA(1, 0, At, B0); PG8_BAR; PG8_SCHED;
            PG8_STAGE(PG8_SB(0, 1), b2 + hstep, voffB);
            PG8_WAIT_V(6); PG8_BAR; PG8_MMA(1, 1, At, B1); PG8_BAR;
            PG8_LDB(B0, 1, 0); PG8_SCHED; PG8_LDA(At, 1, 0); PG8_STAGE(PG8_SA(0, 1), a2 + hstep, voffA);
            PG8_WAIT_L(8); PG8_BAR; PG8_WAIT_L(0); PG8_MMA(0, 0, At, B0); PG8_BAR; PG8_SCHED;
            PG8_LDB(B1, 1, 1); PG8_STAGE(PG8_SB(1, 0), b3, voffB);
            PG8_BAR; PG8_WAIT_L(0); PG8_MMA(0, 1, At, B1); PG8_BAR;
            PG8_LDA(At, 1, 1); PG8_STAGE(PG8_SA(1, 0), a3, voffA);
            PG8_BAR; PG8_WAIT_L(0); PG8_MMA(1, 0, At, B0); PG8_BAR; PG8_SCHED;
            PG8_STAGE(PG8_SB(1, 1), b3 + hstep, voffB);
            PG8_WAIT_V(6); PG8_BAR; PG8_MMA(1, 1, At, B1); PG8_BAR;
            }
        }
        if constexpr (ALIGN_EPI) { if (wr == 0) PG8_BAR; }
        if constexpr (!Epi::AFTER_DRAIN) { E(acc, cur, wr, wc, fr, fq); S.done(cur); }
        if (!has_next) break;
#pragma unroll
        for (int a = 0; a < 2; ++a)
#pragma unroll
            for (int b = 0; b < 2; ++b)
#pragma unroll
                for (int m = 0; m < 4; ++m)
#pragma unroll
                    for (int n = 0; n < 2; ++n) acc[a][b][m][n] = (f32x4){0.f, 0.f, 0.f, 0.f};
        cur = nxt; cA = nA; cB = nB; ++ui;
        if constexpr (ALIGN_EPI) { if (wr == 1) PG8_BAR; }
    }
    PG8_WAIT_V(0);
    if constexpr (!ALIGN_EPI) { if (wr == 0) PG8_BAR; }
    PG8_BAR;
    if constexpr (Epi::AFTER_DRAIN) { E.fused(acc, cur, wr, wc, fr, fq, lds, wid, lane); S.done(cur); }
#undef PG8_SA
#undef PG8_SB
#undef PG8_STAGE
#undef PG8_LDA
#undef PG8_LDB
#undef PG8_MMA
#undef PG8_WAIT_V
#undef PG8_WAIT_L
#undef PG8_BAR
#undef PG8_SCHED
}
}

#ifndef PG8_SP2
#define PG8_SP2 true
#endif
#ifndef PG8_ALIGN
#define PG8_ALIGN true
#endif
#include <hip/hip_bf16.h>
#include <cmath>
namespace attn_body {
using bf16=__hip_bfloat16;
using bf16x8=__attribute__((ext_vector_type(8)))short;
using s16x4=__attribute__((ext_vector_type(4)))short;
using f32x16=__attribute__((ext_vector_type(16)))float;
using u32x4=__attribute__((ext_vector_type(4)))unsigned;
constexpr int D=64,QP=1024,KVP=256;
constexpr int NW=8,QBLK=32,QB=QBLK*NW,KVBLK=64;
__device__ __forceinline__ int crow(int r,int hi){return (r&3)+8*(r>>2)+4*hi;}
#define SBAR() __builtin_amdgcn_sched_barrier(0)
constexpr int NSLOT=3, SLOTB=8192;
constexpr int LDS_K=0, LDS_V=NSLOT*SLOTB, LDS_WS=2*NSLOT*SLOTB, LDS_OST=LDS_WS+NW*64*4, LDS_BYTES=LDS_OST+NW*4096;
constexpr float C2=0.125f*1.4426950408889634f;
__device__ __forceinline__ void glds16(const void*gsrc,unsigned lds_dst){unsigned keep;
  asm volatile("s_mov_b32 %0, m0\n\ts_mov_b32 m0, %2\n\ts_nop 0\n\tglobal_load_lds_dwordx4 %1, off\n\ts_mov_b32 m0, %0":"=&s"(keep):"v"(gsrc),"s"(lds_dst):"memory");}
__device__ __forceinline__ float max3f(float a,float b,float c){float r;asm("v_max3_f32 %0, %1, %2, %3":"=v"(r):"v"(a),"v"(b),"v"(c));return r;}
__device__ __forceinline__ float max2f(float a,float b){float r;asm("v_max_f32_e32 %0, %1, %2":"=v"(r):"v"(a),"v"(b));return r;}
__device__ __forceinline__ float fadd_s(float a,float b){float r;asm("v_add_f32_e32 %0, %1, %2":"=v"(r):"v"(a),"v"(b));return r;}
__device__ __forceinline__ float fsub_s(float a,float b){float r;asm("v_sub_f32_e32 %0, %1, %2":"=v"(r):"v"(a),"v"(b));return r;}
typedef float f32x2_t __attribute__((ext_vector_type(2))); typedef __bf16 bf16x2_t __attribute__((ext_vector_type(2)));
__device__ __forceinline__ unsigned cvtpk_s(float lo,float hi){f32x2_t v={lo,hi};bf16x2_t b=__builtin_convertvector(v,bf16x2_t);return __builtin_bit_cast(unsigned,b);}
#define WAIT_BAR(N) asm volatile("s_waitcnt vmcnt(" #N ") lgkmcnt(0)\n\ts_barrier":::"memory")

__device__ __forceinline__ void qkt(f32x16&p0,f32x16&p1,const char*Kslot,const bf16x8*qr,const f32x16&negm,int r32,int hi){
  const char*kb=Kslot+hi*1024+r32*16;
  #pragma unroll
  for(int d0=0;d0<4;++d0){
    const bf16x8 b0=*reinterpret_cast<const bf16x8*>(kb+d0*2048);
    const bf16x8 b1=*reinterpret_cast<const bf16x8*>(kb+d0*2048+512);
    if(d0==0){p0=__builtin_amdgcn_mfma_f32_32x32x16_bf16(b0,qr[0],negm,0,0,0);p1=__builtin_amdgcn_mfma_f32_32x32x16_bf16(b1,qr[0],negm,0,0,0);}
    else{p0=__builtin_amdgcn_mfma_f32_32x32x16_bf16(b0,qr[d0],p0,0,0,0);p1=__builtin_amdgcn_mfma_f32_32x32x16_bf16(b1,qr[d0],p1,0,0,0);}}
}
typedef __attribute__((address_space(3))) const char* lds_cptr;
typedef short v4i16_t __attribute__((ext_vector_type(4)));
__device__ __forceinline__ void kload8(bf16x8*kf,lds_cptr kp){
  kf[0]=*(const __attribute__((address_space(3))) bf16x8*)(kp);      kf[1]=*(const __attribute__((address_space(3))) bf16x8*)(kp+512);
  kf[2]=*(const __attribute__((address_space(3))) bf16x8*)(kp+2048); kf[3]=*(const __attribute__((address_space(3))) bf16x8*)(kp+2560);
  kf[4]=*(const __attribute__((address_space(3))) bf16x8*)(kp+4096); kf[5]=*(const __attribute__((address_space(3))) bf16x8*)(kp+4608);
  kf[6]=*(const __attribute__((address_space(3))) bf16x8*)(kp+6144); kf[7]=*(const __attribute__((address_space(3))) bf16x8*)(kp+6656);
}
__device__ __forceinline__ void kload2(bf16x8*kf,lds_cptr kp,int j){ kf[2*j]=*(const __attribute__((address_space(3))) bf16x8*)(kp+j*2048); kf[2*j+1]=*(const __attribute__((address_space(3))) bf16x8*)(kp+j*2048+512); }
__device__ __forceinline__ s16x4 vtr(lds_cptr p){ return __builtin_bit_cast(s16x4,__builtin_amdgcn_ds_read_tr16_b64_v4i16((__attribute__((address_space(3))) v4i16_t*)p)); }
__device__ __forceinline__ float rowmax(const f32x16&p0,const f32x16&p1){
  float a=max3f(p0[0],p0[1],p1[0]),b=max3f(p0[2],p0[3],p1[1]);a=max3f(a,p1[2],p1[3]);
  #pragma unroll
  for(int r=4;r<16;r+=4){a=max3f(a,p0[r],p0[r+1]);b=max3f(b,p0[r+2],p0[r+3]);a=max3f(a,p1[r],p1[r+1]);b=max3f(b,p1[r+2],p1[r+3]);}
  const float m=max2f(a,b);
  auto rr=__builtin_amdgcn_permlane32_swap(__float_as_uint(m),__float_as_uint(m),false,false);
  return max2f(__uint_as_float(rr[0]),__uint_as_float(rr[1]));
}
__device__ __forceinline__ void pv(f32x16*o,int vb,bf16x8 pa0,bf16x8 pa1,bf16x8 pa2,bf16x8 pa3){
  #pragma unroll
  for(int d0=0;d0<2;++d0){s16x4 lo[4],hi[4];
    #pragma unroll
    for(int ks=0;ks<4;++ks){
      asm volatile("ds_read_b64_tr_b16 %0,%1 offset:%c2":"=&v"(lo[ks]):"v"(vb),"i"(d0*4096+ks*1024):"memory");
      asm volatile("ds_read_b64_tr_b16 %0,%1 offset:%c2":"=&v"(hi[ks]):"v"(vb),"i"(d0*4096+ks*1024+512):"memory");}
    asm volatile("s_waitcnt lgkmcnt(0)":::"memory");SBAR();
    #define PK(k) (bf16x8){lo[k][0],lo[k][1],lo[k][2],lo[k][3],hi[k][0],hi[k][1],hi[k][2],hi[k][3]}
    o[d0]=__builtin_amdgcn_mfma_f32_32x32x16_bf16(pa0,PK(0),o[d0],0,0,0);
    o[d0]=__builtin_amdgcn_mfma_f32_32x32x16_bf16(pa1,PK(1),o[d0],0,0,0);
    o[d0]=__builtin_amdgcn_mfma_f32_32x32x16_bf16(pa2,PK(2),o[d0],0,0,0);
    o[d0]=__builtin_amdgcn_mfma_f32_32x32x16_bf16(pa3,PK(3),o[d0],0,0,0);
    #undef PK
  }
}

#ifndef ATTN_STORE16
#define ATTN_STORE16(p,v) (*(u32x4*)(p)=(v))
#endif
template<int THRL> __device__ __forceinline__ void attn_unit(const bf16*Qu,const bf16*__restrict__ Kh,const bf16*__restrict__ Vh,bf16*Ou,const int NT,char*shm){
  int tid_=threadIdx.x; asm volatile("":"+v"(tid_)); const int tid=tid_,lane=tid&63,r32=lane&31,hi=lane>>5; const int wid=__builtin_amdgcn_readfirstlane(tid>>6);
  const bf16*Qw=Qu+(long)(wid*QBLK)*QP;
  const unsigned lds0=(unsigned)(uintptr_t)shm;
  float*wsf=(float*)(shm+LDS_WS)+wid*64;
  const bf16*ksrc=Kh+(long)lane*KVP+wid*8;
  const bf16*vsrc=Vh+(long)(16*(wid&3)+(lane>>2))*KVP+(wid>>2)*32+(lane&3)*8;
  const unsigned kdst=lds0+LDS_K+wid*1024, vdst=lds0+LDS_V+wid*1024;
  #define DMA_K(t,slot) glds16(ksrc+(long)(t)*KVBLK*KVP,(unsigned)__builtin_amdgcn_readfirstlane(kdst+(slot)))
  #define DMA_V(t,slot) glds16(vsrc+(long)(t)*KVBLK*KVP,(unsigned)__builtin_amdgcn_readfirstlane(vdst+(slot)))
  const int vb0=(int)(lds0+LDS_V)+((lane>>4)&1)*32+(lane&3)*8+(4*hi+((lane&15)>>2))*64;
  const char*Kbase=shm+LDS_K; bf16x8 kf[8];
  const lds_cptr shm3=(lds_cptr)shm; const lds_cptr kp0=shm3+LDS_K+hi*1024+r32*16; const lds_cptr vp0=shm3+LDS_V+((lane>>4)&1)*32+(lane&3)*8+(4*hi+((lane&15)>>2))*64;
  DMA_K(0,0);DMA_V(0,0);DMA_K(1,SLOTB);
  bf16x8 qr[4];
  #pragma unroll
  for(int d0=0;d0<4;++d0)qr[d0]=*reinterpret_cast<const bf16x8*>(&Qw[(long)r32*QP+d0*16+hi*8]);
  float mhat=0.f,l_reg=0.f;f32x16 o[2];o[0]=f32x16{};o[1]=f32x16{};f32x16 negm=f32x16{};asm volatile("":"+v"(negm));
  #define CMASK(P0,P1,t) do{}while(0)
  bool resc=false;
  #define START(P0,P1) do{ const float rm=rowmax(P0,P1); resc=false; \
    { const float dl=rm; mhat=fadd_s(mhat,dl); \
      _Pragma("unroll") for(int r=0;r<16;++r){P0[r]=fsub_s(P0[r],dl);P1[r]=fsub_s(P1[r],dl);} \
      _Pragma("unroll") for(int r=0;r<16;++r)negm[r]=-mhat; asm volatile("":"+v"(negm)); } \
    _Pragma("unroll") for(int r=0;r<16;++r)P0[r]=__builtin_amdgcn_exp2f(P0[r]); }while(0)
  #define RESC() do{ if(resc){ asm volatile("s_waitcnt lgkmcnt(0)":::"memory"); \
      _Pragma("unroll") for(int d_=0;d_<2;++d_) _Pragma("unroll") for(int r=0;r<16;++r)o[d_][r]*=wsf[crow(r,hi)]; } }while(0)
  f32x16 pA0,pA1,pB0,pB1;
  int sl_prev=0,sl_cur=0,sl_next=SLOTB;
  #define ROT() do{sl_prev=sl_cur;sl_cur=sl_next;sl_next=(sl_next==(NSLOT-1)*SLOTB)?0:sl_next+SLOTB;}while(0)
  DMA_K(2,2*SLOTB);
  WAIT_BAR(3);
  qkt(pA0,pA1,Kbase,qr,negm,r32,hi);asm volatile("s_nop 15\n\ts_nop 7":"+v"(pA0),"+v"(pA1));CMASK(pA0,pA1,0);
  START(pA0,pA1);
  _Pragma("unroll") for(int r=0;r<16;++r)pA1[r]=__builtin_amdgcn_exp2f(pA1[r]);
  WAIT_BAR(0);
  DMA_K(3,0);DMA_V(1,SLOTB);
  ROT();
  kload8(kf,kp0+sl_cur);
  WAIT_BAR(2);
  s16x4 vlo[8],vhi[8]; u32x4 pw0,pw1,pw2,pw3;
  #define PKW(P,B) cvtpk_s(P[B],P[B+1])
  #define PAF(k) __builtin_bit_cast(bf16x8,pw##k)
  #define VFR(i) (bf16x8){vlo[i][0],vlo[i][1],vlo[i][2],vlo[i][3],vhi[i][0],vhi[i][1],vhi[i][2],vhi[i][3]}
  #define PIN(x) asm volatile("":"+v"(x))
  #define MX3(a,b,c) __builtin_fmaxf(__builtin_fmaxf((a),(b)),(c))
  #define GAPA(MF,A0,A1,A2,A3,W0,W1,PW) do{ MF; sacc+=A0; sacc+=A1; sacc+=A2; sacc+=A3; PIN(sacc); W0; W1; PIN(PW); SBAR(); }while(0)
  #define EX(v) __builtin_amdgcn_exp2f(v)
  #define GAPB(MF,X,B) do{ MF; X[B]=EX(X[B]); X[B+1]=EX(X[B+1]); X[B+2]=EX(X[B+2]); X[B+3]=EX(X[B+3]); PIN(X); SBAR(); }while(0)
  #define VRD(i) do{ vlo[i]=vtr(vp_+(((i)>>2)*4096+((i)&3)*1024)); vhi[i]=vtr(vp_+(((i)>>2)*4096+((i)&3)*1024+512)); }while(0)
  #define KRD(G,j) do{ if(G){ kload2(kf,kp0+sl_next,j); SBAR(); } }while(0)
  #define STEP(C0,C1,P0,P1,t,GK,GV,GL) do{ SBAR(); \
    const lds_cptr vp_=vp0+sl_prev; \
    VRD(0); SBAR(); float sacc=(P0[0]+P0[1]); \
    GAPA(C0=__builtin_amdgcn_mfma_f32_32x32x16_bf16(kf[0],qr[0],negm,0,0,0), P0[2],P0[3],P0[4],P0[5],     pw0[0]=PKW(P0,0), pw0[1]=PKW(P0,2), pw0); \
    VRD(4); SBAR(); GAPA(C1=__builtin_amdgcn_mfma_f32_32x32x16_bf16(kf[1],qr[0],negm,0,0,0), P0[6],P0[7],P0[8],P0[9],     pw0[2]=PKW(P0,4), pw0[3]=PKW(P0,6), pw0); \
    VRD(1); SBAR(); GAPA(C0=__builtin_amdgcn_mfma_f32_32x32x16_bf16(kf[2],qr[1],C0,0,0,0),   P0[10],P0[11],P0[12],P0[13], pw1[0]=PKW(P0,8), pw1[1]=PKW(P0,10), pw1); \
    VRD(5); SBAR(); GAPA(C1=__builtin_amdgcn_mfma_f32_32x32x16_bf16(kf[3],qr[1],C1,0,0,0),   P0[14],P0[15],P1[0],P1[1],   pw1[2]=PKW(P0,12),pw1[3]=PKW(P0,14), pw1); \
    VRD(2); SBAR(); GAPA(C0=__builtin_amdgcn_mfma_f32_32x32x16_bf16(kf[4],qr[2],C0,0,0,0),   P1[2],P1[3],P1[4],P1[5],     pw2[0]=PKW(P1,0), pw2[1]=PKW(P1,2), pw2); \
    VRD(6); SBAR(); GAPA(C1=__builtin_amdgcn_mfma_f32_32x32x16_bf16(kf[5],qr[2],C1,0,0,0),   P1[6],P1[7],P1[8],P1[9],     pw2[2]=PKW(P1,4), pw2[3]=PKW(P1,6), pw2); \
    VRD(3); SBAR(); GAPA(C0=__builtin_amdgcn_mfma_f32_32x32x16_bf16(kf[6],qr[3],C0,0,0,0),   P1[10],P1[11],P1[12],P1[13], pw3[0]=PKW(P1,8), pw3[1]=PKW(P1,10), pw3); \
    VRD(7); SBAR(); GAPA(C1=__builtin_amdgcn_mfma_f32_32x32x16_bf16(kf[7],qr[3],C1,0,0,0),   P1[14],P1[15],0.f,0.f,       pw3[2]=PKW(P1,12),pw3[3]=PKW(P1,14), pw3); \
    l_reg+=sacc; \
    if(GK){DMA_K((t)+3,sl_cur);} if(GV){DMA_V((t)+1,sl_next);} \
    CMASK(C0,C1,t); \
    { float a=MX3(C0[0],C0[1],C1[0]),b=MX3(C0[2],C0[3],C1[1]); a=MX3(a,C1[2],C1[3]); \
      _Pragma("unroll") for(int r=4;r<16;r+=4){a=MX3(a,C0[r],C0[r+1]);b=MX3(b,C0[r+2],C0[r+3]);a=MX3(a,C1[r],C1[r+1]);b=MX3(b,C1[r+2],C1[r+3]);} \
      float rm=__builtin_fmaxf(a,b); { auto rr=__builtin_amdgcn_permlane32_swap(__float_as_uint(rm),__float_as_uint(rm),false,false); rm=__builtin_fmaxf(__uint_as_float(rr[0]),__uint_as_float(rr[1])); } \
      resc=false; \
      if(__builtin_expect(__any(rm>(float)THRL),0)){ const float dl=__builtin_fmaxf(rm,0.f); mhat+=dl; \
        _Pragma("unroll") for(int r=0;r<16;++r){C0[r]-=dl;C1[r]-=dl;} \
        _Pragma("unroll") for(int r=0;r<16;++r)negm[r]=-mhat; asm volatile("":"+v"(negm)); \
        const float f=__builtin_amdgcn_exp2f(-dl); l_reg*=f; if(hi==0)wsf[r32]=f; resc=true; } } \
    SBAR(); \
    GAPB(o[0]=__builtin_amdgcn_mfma_f32_32x32x16_bf16(PAF(0),VFR(0),o[0],0,0,0), C0,0); \
    GAPB(o[1]=__builtin_amdgcn_mfma_f32_32x32x16_bf16(PAF(0),VFR(4),o[1],0,0,0), C0,4); \
    KRD(GL,0); GAPB(o[0]=__builtin_amdgcn_mfma_f32_32x32x16_bf16(PAF(1),VFR(1),o[0],0,0,0), C0,8); \
    KRD(GL,1); GAPB(o[1]=__builtin_amdgcn_mfma_f32_32x32x16_bf16(PAF(1),VFR(5),o[1],0,0,0), C0,12); \
    KRD(GL,2); GAPB(o[0]=__builtin_amdgcn_mfma_f32_32x32x16_bf16(PAF(2),VFR(2),o[0],0,0,0), C1,0); \
    KRD(GL,3); GAPB(o[1]=__builtin_amdgcn_mfma_f32_32x32x16_bf16(PAF(2),VFR(6),o[1],0,0,0), C1,4); \
    GAPB(o[0]=__builtin_amdgcn_mfma_f32_32x32x16_bf16(PAF(3),VFR(3),o[0],0,0,0), C1,8); \
    GAPB(o[1]=__builtin_amdgcn_mfma_f32_32x32x16_bf16(PAF(3),VFR(7),o[1],0,0,0), C1,12); \
    }while(0)
  int t=1;
  #undef CMASK
  #define CMASK(P0,P1,t) do{}while(0)
  for(;t+5<NT;t+=2){
    STEP(pB0,pB1,pA0,pA1,t,true,true,true);     WAIT_BAR(2); RESC(); ROT();
    STEP(pA0,pA1,pB0,pB1,t+1,true,true,true);   WAIT_BAR(2); RESC(); ROT();
  }
  #undef CMASK
  #define CMASK(P0,P1,t) do{}while(0)
  #define ENDW(tt) do{ if((tt)+3<NT){WAIT_BAR(2);} else if((tt)+2<NT){WAIT_BAR(1);} else {WAIT_BAR(0);} }while(0)
  for(;t+1<NT;t+=2){
    STEP(pB0,pB1,pA0,pA1,t,(t+3<NT),(t+1<NT),(t+1<NT));       ENDW(t);   RESC(); ROT();
    STEP(pA0,pA1,pB0,pB1,t+1,(t+4<NT),(t+2<NT),(t+2<NT));     ENDW(t+1); RESC(); ROT();
  }
  STEP(pB0,pB1,pA0,pA1,NT-1,false,false,false); RESC();
  { float sacc=pB0[0]+pB0[1]; _Pragma("unroll") for(int r=2;r<16;++r)sacc+=pB0[r]; _Pragma("unroll") for(int r=0;r<16;++r)sacc+=pB1[r]; l_reg+=sacc;
    pw0=(u32x4){PKW(pB0,0),PKW(pB0,2),PKW(pB0,4),PKW(pB0,6)};pw1=(u32x4){PKW(pB0,8),PKW(pB0,10),PKW(pB0,12),PKW(pB0,14)};pw2=(u32x4){PKW(pB1,0),PKW(pB1,2),PKW(pB1,4),PKW(pB1,6)};pw3=(u32x4){PKW(pB1,8),PKW(pB1,10),PKW(pB1,12),PKW(pB1,14)};
    SBAR(); pv(o,vb0+sl_cur,PAF(0),PAF(1),PAF(2),PAF(3)); }
  #undef PKW
  #undef PAF
  #undef VFR
  #undef PIN
  #undef MX3
  #undef GAPA
  #undef GAPB
  #undef EX
  #undef VRD
  #undef KRD
  #undef STEP
  #undef ENDW
  {auto rr=__builtin_amdgcn_permlane32_swap(__float_as_uint(l_reg),__float_as_uint(l_reg),false,false);l_reg=__uint_as_float(rr[0])+__uint_as_float(rr[1]);}
  if(hi==0)wsf[32+r32]=l_reg;asm volatile("s_waitcnt lgkmcnt(0)":::"memory");
  float rli[16];
  #pragma unroll
  for(int r=0;r<16;++r)rli[r]=__builtin_amdgcn_rcpf(wsf[32+crow(r,hi)]);
  bf16*Ow=Ou+(long)(wid*QBLK)*QP;
  { bf16*stg=(bf16*)(shm+LDS_OST)+wid*2048;
    #pragma unroll
    for(int r=0;r<16;++r){const int orow=crow(r,hi);
      #pragma unroll
      for(int d0=0;d0<2;++d0)stg[orow*64+d0*32+r32]=__float2bfloat16(o[d0][r]*rli[r]);}
    asm volatile("s_waitcnt lgkmcnt(0)":::"memory");
    #pragma unroll
    for(int i=0;i<4;++i){const int row=i*8+(lane>>3),ch=lane&7; const u32x4 v=*(const u32x4*)(stg+row*64+ch*8); ATTN_STORE16(Ow+(long)row*QP+ch*8,v);} }
  asm volatile("s_waitcnt lgkmcnt(0)\n\ts_barrier":::"memory");
  #undef DMA_K
  #undef DMA_V
  #undef CMASK
  #undef START
  #undef RESC
  #undef ROT
}
constexpr int ATTN_LDS_BYTES=LDS_BYTES;
#undef SBAR
#undef WAIT_BAR
}
constexpr int NWAVES = 8;
constexpr int NLAT = 32768, NCTX = 1024, MALL = NLAT + NCTX, DM = 1024, SEQ = 8192, CTXL = 256, KVROWS = 8448, FFH = 2816;
constexpr size_t MiB = 1u << 20;
constexpr size_t WS_MOD = 0, WS_ROPE = 256 * 1024, WS_BAR = 280 * 1024, WS_SS = 296 * 1024, WS_SHW = 51 * MiB + 512 * 1024;
constexpr size_t WS_XN2 = 304 * MiB;
constexpr size_t WS_WQKV = 1 * MiB, WS_WO = 4 * MiB, WS_F1A = 6 * MiB, WS_F2A = 17 * MiB, WS_HIN = 23 * MiB, WS_HO = 33 * MiB, WS_F1B = 35 * MiB, WS_F2B = 46 * MiB, WS_HCTX = 52 * MiB, WS_XN = 56 * MiB;
constexpr size_t WS_U = 1 * MiB, WS_D = 18 * MiB;
constexpr size_t WS_QO = 122 * MiB, WS_K = 188 * MiB, WS_V = 205 * MiB, WS_HID0 = 122 * MiB;
constexpr size_t WS_HQ = 122 * MiB, WS_HG = 186 * MiB, WS_HV = 250 * MiB, WS_LFW = 314 * MiB, WS_LBW = 378 * MiB, WS_HB = 442 * MiB, WS_OBW = 56 * MiB, WS_OG = 122 * MiB, WS_HID1 = 186 * MiB;
constexpr size_t WS_HVC = 506 * MiB, WS_LFWC = 508 * MiB, WS_LBWC = 510 * MiB;
constexpr size_t WS_END = 512 * MiB;
static_assert(WS_HQ == pg8::OFF_HQ && WS_HG == pg8::OFF_HG && WS_HV == pg8::OFF_HV && WS_LFW == pg8::OFF_LFW && WS_LBW == pg8::OFF_LBW && WS_HVC == pg8::OFF_HVC && WS_LFWC == pg8::OFF_LFWC && WS_LBWC == pg8::OFF_LBWC, "EpiHgrnIn offsets");
constexpr size_t F1_ELEMS = (size_t)2 * FFH * DM, F2_ELEMS = (size_t)DM * FFH;
constexpr int RING_BYTES = 131072, LDS_BYTES = 147456;

#define LAS __attribute__((address_space(3)))
typedef unsigned short bf16;
typedef unsigned v4u __attribute__((ext_vector_type(4)));
typedef unsigned v2u __attribute__((ext_vector_type(2)));
typedef float f32x4 __attribute__((ext_vector_type(4)));
typedef float f32x16 __attribute__((ext_vector_type(16)));
typedef short bf16x8 __attribute__((ext_vector_type(8)));
typedef float f32x2_t __attribute__((ext_vector_type(2)));
typedef __bf16 bf16x2_t __attribute__((ext_vector_type(2)));
__device__ __forceinline__ unsigned pk2(float lo, float hi) { f32x2_t v = {lo, hi}; bf16x2_t b = __builtin_convertvector(v, bf16x2_t); return __builtin_bit_cast(unsigned, b); }
__device__ __forceinline__ unsigned short f2bf(float f) { return (unsigned short)(pk2(f, 0.f) & 0xffffu); }
__device__ __forceinline__ float bf2f(unsigned short h) { return __builtin_bit_cast(float, (unsigned)h << 16); }
__device__ __forceinline__ float h2f(unsigned short h) { return (float)__builtin_bit_cast(_Float16, h); }
__device__ __forceinline__ float wave_sum(float v) {
#pragma unroll
    for (int o = 1; o < 64; o <<= 1) v += __shfl_xor(v, o);
    return v;
}
#define LDS_WAIT() asm volatile("s_waitcnt lgkmcnt(0)" ::: "memory")

template <int MODE> __device__ __forceinline__ int wmap(int o) {
    if (MODE == 1) { const int tile = o >> 8, w = o & 255, wc = w >> 6, bj = (w >> 5) & 1, e = w & 31; return tile * 256 + 128 * bj + 32 * wc + e; }
    if (MODE == 2) { const int half = o >= FFH ? 1 : 0, idx = o - half * FFH, pn = idx >> 7, q = idx & 127; return 256 * pn + 128 * half + q; }
    return o;
}
template <int MODE> __device__ __forceinline__ void p0_transpose_item(const float* W, int K, int N, bf16* WT, LAS float* scr, int item, int lane) {
    const int nblk = N / 32, kb = item / nblk, nb = item % nblk, k0 = 64 * kb, n0 = 32 * nb;
    float tv[32];
#pragma unroll
    for (int i = 0; i < 32; ++i) tv[i] = W[(size_t)(k0 + 2 * i + (lane >> 5)) * N + n0 + (lane & 31)];
#pragma unroll
    for (int i = 0; i < 32; ++i) scr[(2 * i + (lane >> 5)) * 33 + (lane & 31)] = tv[i];
    LDS_WAIT(); asm volatile("" ::: "memory");
    const int c = lane & 7;
#pragma unroll
    for (int j = 0; j < 4; ++j) { const int n = (lane >> 3) + 8 * j; const LAS float* s = scr + (8 * c) * 33 + n;
        v4u o; o.x = pk2(s[0 * 33], s[1 * 33]); o.y = pk2(s[2 * 33], s[3 * 33]); o.z = pk2(s[4 * 33], s[5 * 33]); o.w = pk2(s[6 * 33], s[7 * 33]);
        *(v4u*)(WT + (size_t)wmap<MODE>(n0 + n) * K + k0 + 8 * c) = o; }
    LDS_WAIT(); asm volatile("" ::: "memory");
}

__device__ __forceinline__ void norm_row_pair(int ra, int rb, bool hasb, int lane, const float* src_lat, const float* src_ctx, const float* w, const float* modl, int shi, int sci, bf16* XN) {
    const float* srca = ra < NLAT ? src_lat + (size_t)ra * DM : src_ctx + (size_t)(ra - NLAT) * DM;
    const float* srcb = rb < NLAT ? src_lat + (size_t)rb * DM : src_ctx + (size_t)(rb - NLAT) * DM;
    const int veca = ra < NLAT ? (ra >> 13) : 4, vecb = rb < NLAT ? (rb >> 13) : 4;
    f32x4 va[4], vb[4]; float sa = 0.f, sb = 0.f;
#pragma unroll
    for (int j = 0; j < 4; ++j) { va[j] = ((const f32x4*)srca + lane)[64 * j]; vb[j] = ((const f32x4*)srcb + lane)[64 * j]; }
#pragma unroll
    for (int j = 0; j < 4; ++j) { sa += (va[j].x * va[j].x + va[j].y * va[j].y) + (va[j].z * va[j].z + va[j].w * va[j].w); sb += (vb[j].x * vb[j].x + vb[j].y * vb[j].y) + (vb[j].z * vb[j].z + vb[j].w * vb[j].w); }
    const float rstda = rsqrtf(wave_sum(sa) * (1.f / DM) + 1e-6f), rstdb = rsqrtf(wave_sum(sb) * (1.f / DM) + 1e-6f);
    const f32x4* wp = (const f32x4*)w + lane;
    const f32x4* sha = (const f32x4*)(modl + veca * 6144 + shi * 1024) + lane; const f32x4* sca = (const f32x4*)(modl + veca * 6144 + sci * 1024) + lane;
    const f32x4* shb = (const f32x4*)(modl + vecb * 6144 + shi * 1024) + lane; const f32x4* scb = (const f32x4*)(modl + vecb * 6144 + sci * 1024) + lane;
    unsigned long long* oa = (unsigned long long*)(XN + (size_t)ra * DM) + lane; unsigned long long* ob = (unsigned long long*)(XN + (size_t)rb * DM) + lane;
#pragma unroll
    for (int j = 0; j < 4; ++j) { const f32x4 ww = wp[64 * j];
        const f32x4 ya = va[j] * rstda * ww * (sca[64 * j] + 1.0f) + sha[64 * j];
        oa[64 * j] = (unsigned long long)pk2(ya.x, ya.y) | ((unsigned long long)pk2(ya.z, ya.w) << 32);
        if (hasb) { const f32x4 yb = vb[j] * rstdb * ww * (scb[64 * j] + 1.0f) + shb[64 * j]; ob[64 * j] = (unsigned long long)pk2(yb.x, yb.y) | ((unsigned long long)pk2(yb.z, yb.w) << 32); } }
}
__device__ __forceinline__ void norm_rows(int gw, int NGW, int lane, const float* src_lat, const float* src_ctx, int r0, int nrows, const float* w, const float* modl, int shi, int sci, bf16* XN) {
    for (int r = r0 + gw; r < nrows; r += 2 * NGW) { const bool hasb = r + NGW < nrows; norm_row_pair(r, hasb ? r + NGW : r, hasb, lane, src_lat, src_ctx, w, modl, shi, sci, XN); }
}
__device__ __forceinline__ void final_norm_rows(int gw, int NGW, int lane, float* h, const float* w) {
    for (int r = gw; r < NLAT; r += NGW) {
        f32x4* xr = (f32x4*)(h + (size_t)r * DM) + lane;
        f32x4 v[4]; float s = 0.f;
#pragma unroll
        for (int j = 0; j < 4; ++j) { v[j] = xr[64 * j]; s += (v[j].x * v[j].x + v[j].y * v[j].y) + (v[j].z * v[j].z + v[j].w * v[j].w); }
        const float rstd = rsqrtf(wave_sum(s) * (1.f / DM) + 1e-6f);
        const f32x4* wp = (const f32x4*)w + lane;
#pragma unroll
        for (int j = 0; j < 4; ++j) xr[64 * j] = v[j] * rstd * wp[64 * j];
    }
}

constexpr int SC_Q0 = 0, SC_QM = 17408, SC_KE = 34816, SC_KT = 52224, SC_VT = 70656, SC_ST = 89088, SC_AT = 123904, SC_PS = 133120, SC_EL = 137216;
constexpr int NSTR = 272, TSTR = 144;
static_assert(SC_EL + 512 <= LDS_BYTES, "scan LDS map");
__device__ __forceinline__ int crow(int r, int hi) { return (r & 3) + 8 * (r >> 2) + 4 * hi; }
__device__ __forceinline__ int scan_row(int c, int s, int b, int dir) {
    if (c < 4) { const int idx = 64 * c + s; return NLAT + b * CTXL + (dir ? (CTXL - 1 - idx) : idx); }
    const int idx = 64 * (c - 4) + s; return b * SEQ + (dir ? (SEQ - 1 - idx) : idx);
}
#define MFMA32(a, b, c) __builtin_amdgcn_mfma_f32_32x32x16_bf16((a), (b), (c), 0, 0, 0)
template <int MODE> __device__ __forceinline__ void hgrn_scan_item(LAS unsigned char* lds, int item, const bf16* HQ, const bf16* HV, const bf16* LFW, const bf16* LBW, const bf16* HVc, const bf16* LFWc, const bf16* LBWc, bf16* OFW, bf16* OBW, float* UB, float* DB) {
    int tid_ = threadIdx.x; asm volatile("" : "+v"(tid_));
    const int tid = tid_, lane = tid & 63, wid = __builtin_amdgcn_readfirstlane(tid >> 6), r32 = lane & 31, hi = lane >> 5;
    const int seg = item & 3, stream = item >> 2, dir = stream & 1, h = (stream >> 1) & 7, b = stream >> 4;
    if (MODE == 0 && seg == 3) return;
    const bf16* LF = dir ? LBW : LFW; bf16* OX = dir ? OBW : OFW;
    const bf16* LFc = (dir ? LBWc : LFWc) - (size_t)NLAT * DM; const bf16* HVcb = HVc - (size_t)NLAT * DM;
    const int kp = lane, g = wid;
    const unsigned voff2 = (unsigned)(h * 128 + 2 * kp) * 2u;
    const int vt = wid & 3, th = wid >> 2;
    unsigned lfrA[8], qrA[8], vrA[8], lfrB[8], qrB[8], vrB[8];
#define SCAN_LOAD(LFR, QR, VR, c) do { const bf16* lfb_ = (c) < 4 ? LFc : LF; const bf16* hvb_ = (c) < 4 ? HVcb : HV; \
        _Pragma("unroll") for (int i = 0; i < 8; ++i) { const size_t r_ = (size_t)__builtin_amdgcn_readfirstlane(scan_row((c), 8 * g + i, b, dir)) * (DM * 2);     \
            LFR[i] = *(const unsigned*)((const char*)lfb_ + r_ + voff2); VR[i] = *(const unsigned*)((const char*)hvb_ + r_ + voff2); \
            if (MODE == 1) QR[i] = *(const unsigned*)((const char*)HQ + r_ + voff2);     } } while (0)
    f32x16 S[2];
#pragma unroll
    for (int j = 0; j < 2; ++j)
#pragma unroll
        for (int i = 0; i < 16; ++i) S[j][i] = 0.f;
    if (MODE == 1) {
        for (int js = 0; js < seg; ++js) { const int it = stream * 4 + js;
#pragma unroll
            for (int j = 0; j < 2; ++j)
#pragma unroll
                for (int i = 0; i < 16; ++i) S[j][i] = S[j][i] * DB[it * 128 + 32 * (2 * th + j) + crow(i, hi)] + UB[((size_t)it * 32 + j * 16 + i) * 512 + tid]; }
        *(LAS unsigned*)(lds + SC_AT + (tid >> 4) * TSTR + 64 + 4 * (tid & 15)) = 0u;
    }
    float dacc0 = 1.f, dacc1 = 1.f;
    const int c0 = 33 * seg;
    SCAN_LOAD(lfrA, qrA, vrA, c0); SCAN_LOAD(lfrB, qrB, vrB, c0 + 1);
    for (int cc = c0; cc < c0 + 33; cc += 2) {
      { const int c = cc;
        const bool has_out = (MODE == 1) && c >= 4;
        f32x2_t lf[8]; f32x2_t ps = {0.f, 0.f};
#pragma unroll
        for (int i = 0; i < 8; ++i) { lf[i] = (f32x2_t){h2f((unsigned short)(lfrA[i] & 0xffffu)), h2f((unsigned short)(lfrA[i] >> 16))}; ps += lf[i]; }
        *(LAS f32x2_t*)(lds + SC_PS + (g * 128 + 2 * kp) * 4) = ps;
        LDS_WAIT(); __builtin_amdgcn_s_barrier(); asm volatile("" ::: "memory");
        {
            f32x2_t pre = {0.f, 0.f}, Lmid = {0.f, 0.f}, Lend = {0.f, 0.f};
#pragma unroll
            for (int gg = 0; gg < 8; ++gg) { const f32x2_t p = *(const LAS f32x2_t*)(lds + SC_PS + (gg * 128 + 2 * kp) * 4); if (gg < g) pre += p; if (gg < 4) Lmid += p; Lend += p; }
            const f32x2_t eLmid = {__expf(Lmid.x), __expf(Lmid.y)}, eEndMid = {__expf(Lend.x - Lmid.x), __expf(Lend.y - Lmid.y)};
            if (g == 0) { const f32x2_t el = {__expf(Lend.x), __expf(Lend.y)}; *(LAS f32x2_t*)(lds + SC_EL + 2 * kp * 4) = el; dacc0 *= el.x; dacc1 *= el.y; }
            f32x2_t E = {__expf(pre.x - Lmid.x), __expf(pre.y - Lmid.y)};
            unsigned kt0[4], kt1[4];
#pragma unroll
            for (int i = 0; i < 8; ++i) {
                const f32x2_t f = {__expf(lf[i].x), __expf(lf[i].y)};
                E = E * f;
                const f32x2_t re = {__builtin_amdgcn_rcpf(E.x), __builtin_amdgcn_rcpf(E.y)};
                const f32x2_t ke = (1.0f - f) * re, kend = ke * eEndMid;
                const int s = 8 * g + i;
                if (has_out) {
                    const f32x2_t q = {bf2f((unsigned short)(qrA[i] & 0xffffu)), bf2f((unsigned short)(qrA[i] >> 16))};
                    const f32x2_t qm = q * E, q0 = qm * eLmid;
                    *(LAS unsigned*)(lds + SC_Q0 + s * NSTR + 4 * kp) = pk2(q0.x, q0.y);
                    *(LAS unsigned*)(lds + SC_QM + s * NSTR + 4 * kp) = pk2(qm.x, qm.y);
                    *(LAS unsigned*)(lds + SC_KE + s * NSTR + 4 * kp) = pk2(ke.x, ke.y);
                }
                const unsigned kd = pk2(kend.x, kend.y);
                if (i & 1) { kt0[i >> 1] |= kd << 16; kt1[i >> 1] |= kd & 0xffff0000u; } else { kt0[i >> 1] = kd & 0xffffu; kt1[i >> 1] = kd >> 16; }
            }
            *(LAS v4u*)(lds + SC_KT + (2 * kp) * TSTR + 16 * g) = (v4u){kt0[0], kt0[1], kt0[2], kt0[3]};
            *(LAS v4u*)(lds + SC_KT + (2 * kp + 1) * TSTR + 16 * g) = (v4u){kt1[0], kt1[1], kt1[2], kt1[3]};
            v4u v0, v1;
#pragma unroll
            for (int i2 = 0; i2 < 4; ++i2) { v0[i2] = (vrA[2 * i2] & 0xffffu) | (vrA[2 * i2 + 1] << 16); v1[i2] = (vrA[2 * i2] >> 16) | (vrA[2 * i2 + 1] & 0xffff0000u); }
            *(LAS v4u*)(lds + SC_VT + (2 * kp) * TSTR + 16 * g) = v0;
            *(LAS v4u*)(lds + SC_VT + (2 * kp + 1) * TSTR + 16 * g) = v1;
            if (has_out) {
#pragma unroll
                for (int j = 0; j < 2; ++j)
#pragma unroll
                    for (int g4 = 0; g4 < 4; ++g4)
                        *(LAS v2u*)(lds + SC_ST + (32 * vt + r32) * NSTR + (32 * (2 * th + j) + 8 * g4 + 4 * hi) * 2) = (v2u){pk2(S[j][4 * g4], S[j][4 * g4 + 1]), pk2(S[j][4 * g4 + 2], S[j][4 * g4 + 3])};
            }
        }
        if (c + 2 < c0 + 33) SCAN_LOAD(lfrA, qrA, vrA, c + 2);
        LDS_WAIT(); __builtin_amdgcn_s_barrier(); asm volatile("" ::: "memory");
        f32x16 o;
#pragma unroll
        for (int i = 0; i < 16; ++i) o[i] = 0.f;
        if (has_out && wid < 3) {
            const int si = wid >> 1, ti = (wid + 1) >> 1;
            f32x16 a;
#pragma unroll
            for (int i = 0; i < 16; ++i) a[i] = 0.f;
#pragma unroll
            for (int kk = 0; kk < 8; ++kk) {
                const bf16x8 A = *(const LAS bf16x8*)(lds + SC_KE + (32 * si + r32) * NSTR + (16 * kk + 8 * hi) * 2);
                const bf16x8 B = *(const LAS bf16x8*)(lds + SC_QM + (32 * ti + r32) * NSTR + (16 * kk + 8 * hi) * 2);
                a = MFMA32(A, B, a);
            }
            const int t = 32 * ti + r32;
#pragma unroll
            for (int g4 = 0; g4 < 4; ++g4) {
                const int s0 = 32 * si + 8 * g4 + 4 * hi;
                const float a0 = (s0 + 0 <= t) ? a[4 * g4 + 0] : 0.f, a1 = (s0 + 1 <= t) ? a[4 * g4 + 1] : 0.f, a2 = (s0 + 2 <= t) ? a[4 * g4 + 2] : 0.f, a3 = (s0 + 3 <= t) ? a[4 * g4 + 3] : 0.f;
                *(LAS v2u*)(lds + SC_AT + t * TSTR + s0 * 2) = (v2u){pk2(a0, a1), pk2(a2, a3)};
            }
        }
        {
            const LAS float* EL = (const LAS float*)(lds + SC_EL);
#pragma unroll
            for (int j = 0; j < 2; ++j) {
                const int kq = 2 * th + j;
#pragma unroll
                for (int i = 0; i < 16; ++i) S[j][i] *= EL[32 * kq + crow(i, hi)];
#pragma unroll
                for (int kk = 0; kk < 4; ++kk) {
                    const bf16x8 A = *(const LAS bf16x8*)(lds + SC_KT + (32 * kq + r32) * TSTR + (16 * kk + 8 * hi) * 2);
                    const bf16x8 B = *(const LAS bf16x8*)(lds + SC_VT + (32 * vt + r32) * TSTR + (16 * kk + 8 * hi) * 2);
                    S[j] = MFMA32(A, B, S[j]);
                }
            }
            if (has_out) {
#pragma unroll
                for (int kk = 0; kk < 8; ++kk) {
                    const bf16x8 A = *(const LAS bf16x8*)(lds + SC_Q0 + (32 * th + r32) * NSTR + (16 * kk + 8 * hi) * 2);
                    const bf16x8 B = *(const LAS bf16x8*)(lds + SC_ST + (32 * vt + r32) * NSTR + (16 * kk + 8 * hi) * 2);
                    o = MFMA32(A, B, o);
                }
            }
        }
        LDS_WAIT(); __builtin_amdgcn_s_barrier(); asm volatile("" ::: "memory");
        if (has_out) {
#pragma unroll
            for (int kk = 0; kk < 4; ++kk) {
                const bf16x8 A = *(const LAS bf16x8*)(lds + SC_AT + (32 * th + r32) * TSTR + (16 * kk + 8 * hi) * 2);
                const bf16x8 B = *(const LAS bf16x8*)(lds + SC_VT + (32 * vt + r32) * TSTR + (16 * kk + 8 * hi) * 2);
                o = MFMA32(A, B, o);
            }
#pragma unroll
            for (int i = 0; i < 16; ++i) *(LAS unsigned short*)(lds + SC_Q0 + wid * 2560 + crow(i, hi) * 80 + 2 * r32) = f2bf(o[i]);
            LDS_WAIT(); asm volatile("" ::: "memory");
#pragma unroll
            for (int j2 = 0; j2 < 2; ++j2) { const int tl = j2 * 16 + (lane >> 2), pc = lane & 3; const v4u pv = *(const LAS v4u*)(lds + SC_Q0 + wid * 2560 + tl * 80 + 16 * pc);
                const size_t r_ = (size_t)scan_row(c, 32 * th + tl, b, dir); *(v4u*)(OX + r_ * DM + h * 128 + 32 * vt + 8 * pc) = pv; }
        }
          }
      if (cc + 1 < c0 + 33) { const int c = cc + 1;
        const bool has_out = (MODE == 1) && c >= 4;
        f32x2_t lf[8]; f32x2_t ps = {0.f, 0.f};
#pragma unroll
        for (int i = 0; i < 8; ++i) { lf[i] = (f32x2_t){h2f((unsigned short)(lfrB[i] & 0xffffu)), h2f((unsigned short)(lfrB[i] >> 16))}; ps += lf[i]; }
        *(LAS f32x2_t*)(lds + SC_PS + (g * 128 + 2 * kp) * 4) = ps;
        LDS_WAIT(); __builtin_amdgcn_s_barrier(); asm volatile("" ::: "memory");
        {
            f32x2_t pre = {0.f, 0.f}, Lmid = {0.f, 0.f}, Lend = {0.f, 0.f};
#pragma unroll
            for (int gg = 0; gg < 8; ++gg) { const f32x2_t p = *(const LAS f32x2_t*)(lds + SC_PS + (gg * 128 + 2 * kp) * 4); if (gg < g) pre += p; if (gg < 4) Lmid += p; Lend += p; }
            const f32x2_t eLmid = {__expf(Lmid.x), __expf(Lmid.y)}, eEndMid = {__expf(Lend.x - Lmid.x), __expf(Lend.y - Lmid.y)};
            if (g == 0) { const f32x2_t el = {__expf(Lend.x), __expf(Lend.y)}; *(LAS f32x2_t*)(lds + SC_EL + 2 * kp * 4) = el; dacc0 *= el.x; dacc1 *= el.y; }
            f32x2_t E = {__expf(pre.x - Lmid.x), __expf(pre.y - Lmid.y)};
            unsigned kt0[4], kt1[4];
#pragma unroll
            for (int i = 0; i < 8; ++i) {
                const f32x2_t f = {__expf(lf[i].x), __expf(lf[i].y)};
                E = E * f;
                const f32x2_t re = {__builtin_amdgcn_rcpf(E.x), __builtin_amdgcn_rcpf(E.y)};
                const f32x2_t ke = (1.0f - f) * re, kend = ke * eEndMid;
                const int s = 8 * g + i;
                if (has_out) {
                    const f32x2_t q = {bf2f((unsigned short)(qrB[i] & 0xffffu)), bf2f((unsigned short)(qrB[i] >> 16))};
                    const f32x2_t qm = q * E, q0 = qm * eLmid;
                    *(LAS unsigned*)(lds + SC_Q0 + s * NSTR + 4 * kp) = pk2(q0.x, q0.y);
                    *(LAS unsigned*)(lds + SC_QM + s * NSTR + 4 * kp) = pk2(qm.x, qm.y);
                    *(LAS unsigned*)(lds + SC_KE + s * NSTR + 4 * kp) = pk2(ke.x, ke.y);
                }
                const unsigned kd = pk2(kend.x, kend.y);
                if (i & 1) { kt0[i >> 1] |= kd << 16; kt1[i >> 1] |= kd & 0xffff0000u; } else { kt0[i >> 1] = kd & 0xffffu; kt1[i >> 1] = kd >> 16; }
            }
            *(LAS v4u*)(lds + SC_KT + (2 * kp) * TSTR + 16 * g) = (v4u){kt0[0], kt0[1], kt0[2], kt0[3]};
            *(LAS v4u*)(lds + SC_KT + (2 * kp + 1) * TSTR + 16 * g) = (v4u){kt1[0], kt1[1], kt1[2], kt1[3]};
            v4u v0, v1;
#pragma unroll
            for (int i2 = 0; i2 < 4; ++i2) { v0[i2] = (vrB[2 * i2] & 0xffffu) | (vrB[2 * i2 + 1] << 16); v1[i2] = (vrB[2 * i2] >> 16) | (vrB[2 * i2 + 1] & 0xffff0000u); }
            *(LAS v4u*)(lds + SC_VT + (2 * kp) * TSTR + 16 * g) = v0;
            *(LAS v4u*)(lds + SC_VT + (2 * kp + 1) * TSTR + 16 * g) = v1;
            if (has_out) {
#pragma unroll
                for (int j = 0; j < 2; ++j)
#pragma unroll
                    for (int g4 = 0; g4 < 4; ++g4)
                        *(LAS v2u*)(lds + SC_ST + (32 * vt + r32) * NSTR + (32 * (2 * th + j) + 8 * g4 + 4 * hi) * 2) = (v2u){pk2(S[j][4 * g4], S[j][4 * g4 + 1]), pk2(S[j][4 * g4 + 2], S[j][4 * g4 + 3])};
            }
        }
        if (c + 2 < c0 + 33) SCAN_LOAD(lfrB, qrB, vrB, c + 2);
        LDS_WAIT(); __builtin_amdgcn_s_barrier(); asm volatile("" ::: "memory");
        f32x16 o;
#pragma unroll
        for (int i = 0; i < 16; ++i) o[i] = 0.f;
        if (has_out && wid < 3) {
            const int si = wid >> 1, ti = (wid + 1) >> 1;
            f32x16 a;
#pragma unroll
            for (int i = 0; i < 16; ++i) a[i] = 0.f;
#pragma unroll
            for (int kk = 0; kk < 8; ++kk) {
                const bf16x8 A = *(const LAS bf16x8*)(lds + SC_KE + (32 * si + r32) * NSTR + (16 * kk + 8 * hi) * 2);
                const bf16x8 B = *(const LAS bf16x8*)(lds + SC_QM + (32 * ti + r32) * NSTR + (16 * kk + 8 * hi) * 2);
                a = MFMA32(A, B, a);
            }
            const int t = 32 * ti + r32;
#pragma unroll
            for (int g4 = 0; g4 < 4; ++g4) {
                const int s0 = 32 * si + 8 * g4 + 4 * hi;
                const float a0 = (s0 + 0 <= t) ? a[4 * g4 + 0] : 0.f, a1 = (s0 + 1 <= t) ? a[4 * g4 + 1] : 0.f, a2 = (s0 + 2 <= t) ? a[4 * g4 + 2] : 0.f, a3 = (s0 + 3 <= t) ? a[4 * g4 + 3] : 0.f;
                *(LAS v2u*)(lds + SC_AT + t * TSTR + s0 * 2) = (v2u){pk2(a0, a1), pk2(a2, a3)};
            }
        }
        {
            const LAS float* EL = (const LAS float*)(lds + SC_EL);
#pragma unroll
            for (int j = 0; j < 2; ++j) {
                const int kq = 2 * th + j;
#pragma unroll
                for (int i = 0; i < 16; ++i) S[j][i] *= EL[32 * kq + crow(i, hi)];
#pragma unroll
                for (int kk = 0; kk < 4; ++kk) {
                    const bf16x8 A = *(const LAS bf16x8*)(lds + SC_KT + (32 * kq + r32) * TSTR + (16 * kk + 8 * hi) * 2);
                    const bf16x8 B = *(const LAS bf16x8*)(lds + SC_VT + (32 * vt + r32) * TSTR + (16 * kk + 8 * hi) * 2);
                    S[j] = MFMA32(A, B, S[j]);
                }
            }
            if (has_out) {
#pragma unroll
                for (int kk = 0; kk < 8; ++kk) {
                    const bf16x8 A = *(const LAS bf16x8*)(lds + SC_Q0 + (32 * th + r32) * NSTR + (16 * kk + 8 * hi) * 2);
                    const bf16x8 B = *(const LAS bf16x8*)(lds + SC_ST + (32 * vt + r32) * NSTR + (16 * kk + 8 * hi) * 2);
                    o = MFMA32(A, B, o);
                }
            }
        }
        LDS_WAIT(); __builtin_amdgcn_s_barrier(); asm volatile("" ::: "memory");
        if (has_out) {
#pragma unroll
            for (int kk = 0; kk < 4; ++kk) {
                const bf16x8 A = *(const LAS bf16x8*)(lds + SC_AT + (32 * th + r32) * TSTR + (16 * kk + 8 * hi) * 2);
                const bf16x8 B = *(const LAS bf16x8*)(lds + SC_VT + (32 * vt + r32) * TSTR + (16 * kk + 8 * hi) * 2);
                o = MFMA32(A, B, o);
            }
#pragma unroll
            for (int i = 0; i < 16; ++i) *(LAS unsigned short*)(lds + SC_Q0 + wid * 2560 + crow(i, hi) * 80 + 2 * r32) = f2bf(o[i]);
            LDS_WAIT(); asm volatile("" ::: "memory");
#pragma unroll
            for (int j2 = 0; j2 < 2; ++j2) { const int tl = j2 * 16 + (lane >> 2), pc = lane & 3; const v4u pv = *(const LAS v4u*)(lds + SC_Q0 + wid * 2560 + tl * 80 + 16 * pc);
                const size_t r_ = (size_t)scan_row(c, 32 * th + tl, b, dir); *(v4u*)(OX + r_ * DM + h * 128 + 32 * vt + 8 * pc) = pv; }
        }
          }
    }
#undef SCAN_LOAD
    if (MODE == 0) {
#pragma unroll
        for (int j = 0; j < 2; ++j)
#pragma unroll
            for (int i = 0; i < 16; ++i) UB[((size_t)item * 32 + j * 16 + i) * 512 + tid] = S[j][i];
        if (g == 0) { DB[item * 128 + 2 * kp] = dacc0; DB[item * 128 + 2 * kp + 1] = dacc1; }
    }
    LDS_WAIT(); __builtin_amdgcn_s_barrier(); asm volatile("" ::: "memory");
}
__device__ __forceinline__ void hgrn_combine(int gw, int NGW, int lane, const bf16* OFW, const bf16* OBW, const bf16* HG, const float* onorm, bf16* OG) {
    float wn[16];
#pragma unroll
    for (int e = 0; e < 16; ++e) wn[e] = onorm[lane * 16 + e];
    for (int r0 = gw; r0 < NLAT; r0 += 2 * NGW) {
        const bool hasb = r0 + NGW < NLAT; const int r1 = hasb ? r0 + NGW : r0;
        v4u a[2][2], bq[2][2], gg[2][2];
#pragma unroll
        for (int k = 0; k < 2; ++k) { const size_t off = (size_t)(k ? r1 : r0) * DM + lane * 16;
#pragma unroll
            for (int j = 0; j < 2; ++j) { a[k][j] = *(const v4u*)(OFW + off + 8 * j); bq[k][j] = *(const v4u*)(OBW + off + 8 * j); gg[k][j] = *(const v4u*)(HG + off + 8 * j); } }
#pragma unroll
        for (int k = 0; k < 2; ++k) {
            if (k == 1 && !hasb) break;
            float o[16], gt[16];
#pragma unroll
            for (int j = 0; j < 2; ++j)
#pragma unroll
                for (int e = 0; e < 4; ++e) { o[8 * j + 2 * e] = bf2f((unsigned short)(a[k][j][e] & 0xffffu)) + bf2f((unsigned short)(bq[k][j][e] & 0xffffu)); o[8 * j + 2 * e + 1] = bf2f((unsigned short)(a[k][j][e] >> 16)) + bf2f((unsigned short)(bq[k][j][e] >> 16));
                    gt[8 * j + 2 * e] = bf2f((unsigned short)(gg[k][j][e] & 0xffffu)); gt[8 * j + 2 * e + 1] = bf2f((unsigned short)(gg[k][j][e] >> 16)); }
            float ss = 0.f;
#pragma unroll
            for (int e = 0; e < 16; ++e) ss += o[e] * o[e];
            ss += __shfl_xor(ss, 1); ss += __shfl_xor(ss, 2); ss += __shfl_xor(ss, 4);
            const float rstd = rsqrtf(ss * (1.f / 128.f) + 1e-6f);
            unsigned pk[8];
#pragma unroll
            for (int e = 0; e < 8; ++e) { const float y0 = o[2 * e] * rstd * wn[2 * e] * __builtin_amdgcn_rcpf(1.0f + __expf(-gt[2 * e])), y1 = o[2 * e + 1] * rstd * wn[2 * e + 1] * __builtin_amdgcn_rcpf(1.0f + __expf(-gt[2 * e + 1])); pk[e] = pk2(y0, y1); }
            const size_t off = (size_t)(k ? r1 : r0) * DM + lane * 16;
            *(v4u*)(OG + off) = (v4u){pk[0], pk[1], pk[2], pk[3]}; *(v4u*)(OG + off + 8) = (v4u){pk[4], pk[5], pk[6], pk[7]};
        }
    }
}

#define XB_TMO      128
#define XB_XCNT(j)  (256  + 64 * (j))
#define XB_XSUB(j)  (1280 + 64 * (j))
#define XB_XGEN(j)  (2304 + 64 * (j))
#define XB_TOP      3328
#define XB_TOPGEN   3392
#define XCD_BAR_WORDS 3456
#define XB_SPIN_CAP (1u << 18)

__device__ __forceinline__ unsigned xb_ld(unsigned* p)              { return __hip_atomic_load(p, __ATOMIC_RELAXED, __HIP_MEMORY_SCOPE_AGENT); }
__device__ __forceinline__ unsigned xb_add(unsigned* p, unsigned v) { return __hip_atomic_fetch_add(p, v, __ATOMIC_RELAXED, __HIP_MEMORY_SCOPE_AGENT); }
__device__ __forceinline__ unsigned xb_xcc_id() { return (unsigned)__builtin_amdgcn_s_getreg((3 << 11) | 20) & 0xFu; }
#define XB_SPIN(cond, bar) do { unsigned _sp = 0; while (cond) { __builtin_amdgcn_s_sleep(1); \
    if ((++_sp & 255u) == 0u) { if (xb_ld(&(bar)[XB_TMO])) break; if (_sp > XB_SPIN_CAP) { atomicAdd(&(bar)[XB_TMO], 1u); break; } } } } while (0)

struct XcdBarrier {
    unsigned* bar; unsigned x;
    volatile LAS unsigned* st;
};

__device__ __forceinline__ XcdBarrier xcd_barrier_post(unsigned* bar, volatile LAS unsigned* st) {
    XcdBarrier b; b.bar = bar; b.x = xb_xcc_id(); b.st = st;
    if (threadIdx.x == 0) (void)xb_add(&bar[XB_XCNT(b.x)], 1u);
    return b;
}
__device__ __forceinline__ void xcd_barrier_complete(unsigned* bar, unsigned x, unsigned& nloc, unsigned& nx) {
    const unsigned G = gridDim.x * gridDim.y * gridDim.z;
    unsigned sum, cnt, mine, sp = 0u;
    for (;;) {
        sum = 0u; cnt = 0u; mine = 0u;
#pragma unroll
        for (unsigned j = 0; j < 16; ++j) { const unsigned c = xb_ld(&bar[XB_XCNT(j)]); sum += c; cnt += (c > 0u) ? 1u : 0u; mine = (j == x) ? c : mine; }
        if (sum == G) break;
        __builtin_amdgcn_s_sleep(1);
        if ((++sp & 255u) == 0u) { if (xb_ld(&bar[XB_TMO])) break; if (sp > XB_SPIN_CAP) { atomicAdd(&bar[XB_TMO], 1u); break; } }
    }
    nloc = mine > 0u ? mine : 1u; nx = cnt > 0u ? cnt : 1u;
}

__device__ __forceinline__ void xcd_barrier(const XcdBarrier& b) {
    asm volatile("s_waitcnt vmcnt(0)" ::: "memory");
    __syncthreads();
    if (threadIdx.x == 0) {
        unsigned* bar = b.bar;
        __builtin_amdgcn_s_waitcnt(0);
        unsigned nloc = b.st[0], nx = b.st[1];
        if (nloc == 0u) { xcd_barrier_complete(bar, b.x, nloc, nx); b.st[0] = nloc; b.st[1] = nx; }
        const unsigned old = xb_add(&bar[XB_XSUB(b.x)], 1u);
        const unsigned gen = old / nloc;
        if (old + 1u == (gen + 1u) * nloc) {
            __builtin_amdgcn_fence(__ATOMIC_RELEASE, "agent");
            asm volatile("s_waitcnt vmcnt(0)" ::: "memory");
            const unsigned og = xb_add(&bar[XB_TOP], 1u);
            const unsigned tg = og / nx;
            if (og + 1u == (tg + 1u) * nx) xb_add(&bar[XB_TOPGEN], 1u);
            else XB_SPIN(xb_ld(&bar[XB_TOPGEN]) == tg, bar);
            __builtin_amdgcn_fence(__ATOMIC_ACQUIRE, "agent");
            xb_add(&bar[XB_XGEN(b.x)], 1u);
            asm volatile("s_waitcnt vmcnt(0)" ::: "memory");
        } else {
            XB_SPIN(xb_ld(&bar[XB_XGEN(b.x)]) == gen, bar);
            __builtin_amdgcn_fence(__ATOMIC_ACQUIRE, "agent");
            asm volatile("s_waitcnt vmcnt(0)" ::: "memory");
        }
    }
    __syncthreads();
}

struct Args { const float* in[19]; float* out; unsigned char* ws; };
typedef __attribute__((address_space(4))) Args KArgs;
__device__ __forceinline__ int fresh_v(int t) { asm volatile("" : "+v"(t)); return t; }
__device__ __forceinline__ int fresh_s(int t) { asm volatile("" : "+s"(t)); return t; }
__global__ void __launch_bounds__(NWAVES * 64, 2) mk_fwd(Args args) {
    extern __shared__ __attribute__((aligned(16))) unsigned char lds_raw[];
    LAS unsigned char* lds = (LAS unsigned char*)lds_raw;
    cg::grid_group grid = cg::this_grid();
#define PHASE_IDS() const int tid = fresh_v((int)threadIdx.x), lane = tid & 63, wave = __builtin_amdgcn_readfirstlane(tid >> 6); (void)lane; (void)wave; \
    const int G = fresh_s((int)gridDim.x), bx = fresh_s((int)blockIdx.x); const int vcu = (G % 8 == 0) ? (bx % 8) * (G / 8) + bx / 8 : bx; (void)vcu; \
    const int gw = vcu * NWAVES + wave, NGW = G * NWAVES; (void)gw; (void)NGW; \
    const KArgs* ap = (const KArgs*)__builtin_amdgcn_kernarg_segment_ptr(); asm volatile("" : "+s"(ap)); unsigned char* ws = ap->ws; (void)ws
#define IN(k) (ap->in[k])
#define MOD ((float*)(ws + WS_MOD))
#define ROPEC ((float*)(ws + WS_ROPE))
#define ROPES (ROPEC + 128 * 16)
#define Wqkv_t ((bf16*)(ws + WS_WQKV))
#define Wo_t ((bf16*)(ws + WS_WO))
#define Hin_t ((bf16*)(ws + WS_HIN))
#define Ho_t ((bf16*)(ws + WS_HO))
#define F1A_t ((bf16*)(ws + WS_F1A))
#define F2A_t ((bf16*)(ws + WS_F2A))
#define F1B_t ((bf16*)(ws + WS_F1B))
#define F2B_t ((bf16*)(ws + WS_F2B))
#define HCTX ((bf16*)(ws + WS_HCTX))
#define HB ((bf16*)(ws + WS_HB))
#define OFWP ((bf16*)(ap->out))
#define XN ((bf16*)(ws + WS_XN))
#define QO ((bf16*)(ws + WS_QO))
#define KB ((bf16*)(ws + WS_K))
#define VB ((bf16*)(ws + WS_V))
#define MOD1 (MOD + 5 * 6144)
#define SS0 ((float*)(ws + WS_SS))
#define SS1 (SS0 + MALL)
#define SS2 (SS1 + MALL)
#define SS3 (SS2 + MALL)
#define SHW0 ((float*)(ws + WS_SHW))
#define SHW1 (SHW0 + 5 * 5632)
#define SHW2 (SHW1 + 5 * 5120)
    if (args.ws == nullptr) grid.sync();
    volatile LAS unsigned* bst = (volatile LAS unsigned*)(lds + LDS_BYTES - 16);
    if (threadIdx.x == 0) { bst[0] = 0u; bst[1] = 0u; }
    __syncthreads();
    const XcdBarrier bar = xcd_barrier_post((unsigned*)(args.ws + WS_BAR), bst);
    {
        PHASE_IDS();
        for (int i = (bx * NWAVES * 64) + tid; i < 4 * MALL; i += G * NWAVES * 64) SS0[i] = 0.f;
        LAS float* sl = (LAS float*)(lds + 73728);
        for (int i = tid; i < 5 * 1024; i += NWAVES * 64) { const float v = i < 4096 ? (ap->in[1])[i] : (ap->in[3])[i - 4096]; sl[i] = v / (1.0f + __expf(-v)); }
        __syncthreads();
        for (int it = gw; it < 768; it += NGW) {
            const int l = it / 384, n0 = (it % 384) * 16, cg4 = lane & 3, ks = lane >> 2;
            const float* W = (ap->in[4]) + (size_t)l * 1024 * 6144 + n0 + 4 * cg4;
            f32x4 acc[5];
#pragma unroll
            for (int v = 0; v < 5; ++v) acc[v] = (f32x4){0.f, 0.f, 0.f, 0.f};
#pragma unroll 8
            for (int i = 0; i < 64; ++i) { const int kk = i * 16 + ks; const f32x4 w4 = *(const f32x4*)(W + (size_t)kk * 6144);
#pragma unroll
                for (int v = 0; v < 5; ++v) acc[v] += w4 * sl[v * 1024 + kk]; }
#pragma unroll
            for (int v = 0; v < 5; ++v)
#pragma unroll
                for (int e = 0; e < 4; ++e) { float a = acc[v][e]; a += __shfl_xor(a, 4); a += __shfl_xor(a, 8); a += __shfl_xor(a, 16); a += __shfl_xor(a, 32); acc[v][e] = a; }
            if (ks == 0) { const f32x4 bb = *(const f32x4*)((ap->in[5]) + l * 6144 + n0 + 4 * cg4);
#pragma unroll
                for (int v = 0; v < 5; ++v) *(f32x4*)(MOD + (size_t)(l * 5 + v) * 6144 + n0 + 4 * cg4) = acc[v] + bb; }
        }
        for (int idx = bx * (NWAVES * 64) + tid; idx < 2048; idx += G * NWAVES * 64) {
            const int pos = idx >> 4, f = idx & 15;
            double inv = 1.0; for (int j = 0; j < f; ++j) inv *= 0.56234132519034908;
            const double ang = (double)pos * inv, TWO_PI = 6.283185307179586476925;
            const double kq = __builtin_rint(ang / TWO_PI); const double rr = ang - kq * TWO_PI, r2 = rr * rr;
            double cs = 1.0, sn = rr, tc = 1.0, tsn = rr;
            for (int n = 1; n <= 14; ++n) { tc *= -r2 / (double)((2 * n - 1) * (2 * n)); tsn *= -r2 / (double)((2 * n) * (2 * n + 1)); cs += tc; sn += tsn; }
            ROPEC[idx] = (float)cs; ROPES[idx] = (float)sn;
        }
        LAS float* scr = (LAS float*)(lds + wave * 8448);
        constexpr int I_QKV = 16 * 48, I_O = 16 * 32, I_HIN = 16 * 160, I_HO = 16 * 32, I_F1 = 16 * 176, I_F2 = 44 * 32;
        constexpr int NITEMS = I_QKV + I_O + I_HIN + I_HO + 2 * I_F1 + 2 * I_F2;
        for (int it = gw; it < NITEMS; it += NGW) {
            int r = it;
            if (r < I_QKV) { p0_transpose_item<1>((ap->in[8]), 1024, 1536, Wqkv_t, scr, r, lane); continue; } r -= I_QKV;
            if (r < I_O) { p0_transpose_item<0>((ap->in[11]), 1024, 1024, Wo_t, scr, r, lane); continue; } r -= I_O;
            if (r < I_HIN) { p0_transpose_item<0>((ap->in[12]), 1024, 5120, Hin_t, scr, r, lane); continue; } r -= I_HIN;
            if (r < I_HO) { p0_transpose_item<0>((ap->in[15]), 1024, 1024, Ho_t, scr, r, lane); continue; } r -= I_HO;
            if (r < I_F1) { p0_transpose_item<2>((ap->in[16]), 1024, 5632, F1A_t, scr, r, lane); continue; } r -= I_F1;
            if (r < I_F1) { p0_transpose_item<2>((ap->in[16]) + (size_t)1024 * 5632, 1024, 5632, F1B_t, scr, r, lane); continue; } r -= I_F1;
            if (r < I_F2) { p0_transpose_item<0>((ap->in[17]), 2816, 1024, F2A_t, scr, r, lane); continue; } r -= I_F2;
            p0_transpose_item<0>((ap->in[17]) + (size_t)2816 * 1024, 2816, 1024, F2B_t, scr, r, lane);
        }
    }
    xcd_barrier(bar);
    { PHASE_IDS();
      const bool qcu = (G == 256) && bx < 24;
      if (qcu) {
          const int pm = 128 + bx / 6, pn = bx % 6;
          norm_rows(wave, NWAVES, lane, (ap->in[0]), (ap->in[2]), pm * 256, pm * 256 + 256, (ap->in[6]), MOD, 0, 1, XN);
          asm volatile("s_waitcnt vmcnt(0)" ::: "memory"); __syncthreads();
          if (tid == 0) { __builtin_amdgcn_fence(__ATOMIC_ACQUIRE, "agent"); asm volatile("s_waitcnt vmcnt(0)" ::: "memory"); }
          __syncthreads();
          pg8::Gemm gq{XN, Wqkv_t, MALL, 1536, 1024}; pg8::OneUnit Sq{pm, pn, nullptr};
          pg8::EpiQKV Eq{QO, KB, VB, (ap->in[9]), (ap->in[10]), ROPEC, ROPES, attn_body::C2};
          pg8::gemm_phase<pg8::EpiQKV, pg8::OneUnit, PG8_ALIGN, PG8_SP2>(lds, gq, Sq, Eq);
      } else {
      const int gw1 = (G == 256) ? (bx - 24) * NWAVES + wave : gw, NGW1 = (G == 256) ? 232 * NWAVES : NGW;
      norm_rows(gw1, NGW1, lane, (ap->in[0]), (ap->in[2]), 0, (G == 256) ? NLAT : MALL, (ap->in[6]), MOD, 0, 1, XN);
      for (int site = 0; site < 3; ++site) {
          const bf16* Bt = site == 0 ? F1A_t : site == 1 ? Hin_t : F1B_t; const int N = site == 1 ? 5120 : 5632;
          const float* shv = (site == 0 ? MOD : MOD1) + (site == 1 ? 0 : 3) * 1024; float* dst = site == 0 ? SHW0 : site == 1 ? SHW1 : SHW2;
          for (int n = gw1; n < N; n += NGW1) {
              const v4u w0 = *(const v4u*)(Bt + (size_t)n * 1024 + lane * 16), w1 = *(const v4u*)(Bt + (size_t)n * 1024 + lane * 16 + 8);
              float wf[16];
#pragma unroll
              for (int e = 0; e < 4; ++e) { wf[2 * e] = bf2f((unsigned short)(w0[e] & 0xffffu)); wf[2 * e + 1] = bf2f((unsigned short)(w0[e] >> 16)); wf[8 + 2 * e] = bf2f((unsigned short)(w1[e] & 0xffffu)); wf[8 + 2 * e + 1] = bf2f((unsigned short)(w1[e] >> 16)); }
#pragma unroll
              for (int v = 0; v < 5; ++v) { const float* sp = shv + v * 6144 + lane * 16; float a = 0.f;
#pragma unroll
                  for (int e4 = 0; e4 < 4; ++e4) { const f32x4 s4 = *(const f32x4*)(sp + 4 * e4); a += (wf[4 * e4] * s4[0] + wf[4 * e4 + 1] * s4[1]) + (wf[4 * e4 + 2] * s4[2] + wf[4 * e4 + 3] * s4[3]); }
                  a = wave_sum(a); if (lane == 0) dst[v * N + n] = a; }
          }
      }
      }
    }
    xcd_barrier(bar);
    {
        PHASE_IDS();
        const int Mrows = (G == 256) ? NLAT : MALL;
        pg8::Gemm g{XN, Wqkv_t, Mrows, 1536, 1024}; pg8::StaticOrder S; S.init(Mrows, 1536, G, bx);
        pg8::EpiQKV E{QO, KB, VB, (ap->in[9]), (ap->in[10]), ROPEC, ROPES, attn_body::C2};
        pg8::gemm_phase<pg8::EpiQKV, pg8::StaticOrder, PG8_ALIGN, PG8_SP2>(lds, g, S, E);
    }
    xcd_barrier(bar);
    {
        PHASE_IDS();
        for (int i = 0; i < 8; ++i) {
            const int u = i * 256 + vcu; if (u >= 2048 || G != 256) break;
            const int combo = u >> 7, idx = u & 127, b = combo >> 2, kvh = combo & 3, hq = idx >> 5, qb = idx & 31, h = kvh * 4 + hq;
            const attn_body::bf16* Qu = (const attn_body::bf16*)QO + ((size_t)b * SEQ + qb * 256) * 1024 + h * 64;
            const attn_body::bf16* Kh = (const attn_body::bf16*)KB + (size_t)b * KVROWS * 256 + kvh * 64;
            const attn_body::bf16* Vh = (const attn_body::bf16*)VB + (size_t)b * KVROWS * 256 + kvh * 64;
            attn_body::attn_unit<8>(Qu, Kh, Vh, (attn_body::bf16*)XN + (Qu - (const attn_body::bf16*)QO), 132, (char*)lds_raw);
        }
        if (G != 256) for (int u = bx; u < 2048; u += G) {
            const int combo = u >> 7, idx = u & 127, b = combo >> 2, kvh = combo & 3, hq = idx >> 5, qb = idx & 31, h = kvh * 4 + hq;
            const attn_body::bf16* Qu = (const attn_body::bf16*)QO + ((size_t)b * SEQ + qb * 256) * 1024 + h * 64;
            const attn_body::bf16* Kh = (const attn_body::bf16*)KB + (size_t)b * KVROWS * 256 + kvh * 64;
            const attn_body::bf16* Vh = (const attn_body::bf16*)VB + (size_t)b * KVROWS * 256 + kvh * 64;
            attn_body::attn_unit<8>(Qu, Kh, Vh, (attn_body::bf16*)XN + (Qu - (const attn_body::bf16*)QO), 132, (char*)lds_raw);
        }
        for (int u = bx; u < 64; u += G) {
            const int b = u >> 4, h = u & 15, kvh = h >> 2;
            const attn_body::bf16* Qu = (const attn_body::bf16*)QO + ((size_t)NLAT + b * CTXL) * 1024 + h * 64;
            const attn_body::bf16* Kh = (const attn_body::bf16*)KB + (size_t)b * KVROWS * 256 + kvh * 64;
            const attn_body::bf16* Vh = (const attn_body::bf16*)VB + (size_t)b * KVROWS * 256 + kvh * 64;
            attn_body::attn_unit<8>(Qu, Kh, Vh, (attn_body::bf16*)XN + (Qu - (const attn_body::bf16*)QO), 4, (char*)lds_raw);
        }
    }
    xcd_barrier(bar);
    {
        PHASE_IDS();
        const int Mrows = (G == 256) ? NLAT : MALL;
        pg8::Gemm g{XN, Wo_t, Mrows, 1024, 1024}; pg8::StaticOrder S; S.init(Mrows, 1024, G, bx);
        pg8::EpiResidN<true> E{(ap->in[0]), (ap->in[2]), HB, HCTX, MOD + 2 * 1024, (bf16*)(ws + WS_XN2), SS0, (ap->in[7]), MOD + 4 * 1024, (LAS float*)(lds + 139264)};
        pg8::gemm_phase<pg8::EpiResidN<true>, pg8::StaticOrder, PG8_ALIGN, PG8_SP2>(lds, g, S, E);
    }
    xcd_barrier(bar);
    {
        PHASE_IDS();
        pg8::EpiSwiGLU E{(bf16*)(ws + WS_HID0), SS0, SHW0};
        pg8::Gemm g{(const bf16*)(ws + WS_XN2), F1A_t, MALL, 5632, 1024};
        if (G == 256) {
            unsigned* cntW = (unsigned*)(ws + WS_BAR) + XCD_BAR_WORDS + 64; unsigned* cntU = cntW + 64; unsigned* cntD = cntW + 128;
            if (bx < 240) {
                const int x = bx & 7, idx = bx >> 3; const bool hasW = (x == 0 && idx < 16), hasH = idx < 6;
                if (hasW) {
                    pg8::Gemm gw_{XN, Wo_t, MALL, 1024, 1024}; pg8::OneUnit Sw{128 + (idx >> 2), idx & 3, cntW};
                    pg8::EpiResidN<true> Ew{(ap->in[0]), (ap->in[2]), HB, HCTX, MOD + 2 * 1024, (bf16*)(ws + WS_XN2), SS0, (ap->in[7]), MOD + 4 * 1024, (LAS float*)(lds + 139264)};
                    pg8::gemm_phase<pg8::EpiResidN<true>, pg8::OneUnit, PG8_ALIGN, PG8_SP2>(lds, gw_, Sw, Ew);
                }
                pg8::UpOrder S{bx, hasW ? 1 : 0, hasH ? 11 : 12, cntW, cntU};
                pg8::gemm_phase<pg8::EpiSwiGLU, pg8::UpOrder, PG8_ALIGN, PG8_SP2>(lds, g, S, E);
                if (hasH) {
                    pg8::wave_wait_count(cntD, 16u); __syncthreads();
                    const int hidx = x * 6 + idx;
                    pg8::Gemm gh{XN, Hin_t, MALL, 5120, 1024}; pg8::OneUnit Sh{128 + hidx / 12, 8 + hidx % 12, nullptr};
                    pg8::EpiHgrnIn Eh{ws, (ap->in[13]), SS1, SHW1};
                    pg8::gemm_phase<pg8::EpiHgrnIn, pg8::OneUnit, PG8_ALIGN, PG8_SP2>(lds, gh, Sh, Eh);
                }
            } else {
                const int d = bx - 240;
                { pg8::UpOrderD S{d, 0, 3}; pg8::gemm_phase<pg8::EpiSwiGLU, pg8::UpOrderD, PG8_ALIGN, PG8_SP2>(lds, g, S, E); }
                pg8::wave_wait_count(cntU, 88u); __syncthreads();
                {
                    pg8::Gemm g2{(const bf16*)(ws + WS_HID0), F2A_t, MALL, 1024, FFH}; pg8::OneUnit S2{128 + (d >> 2), d & 3, cntD};
                    pg8::EpiResidN<false> E2{HB, HCTX, HB, HCTX, MOD + 5 * 1024, XN, SS1, (ap->in[6]) + 1024, MOD1 + 1 * 1024, (LAS float*)(lds + 139264)};
                    pg8::gemm_phase<pg8::EpiResidN<false>, pg8::OneUnit, PG8_ALIGN, PG8_SP2>(lds, g2, S2, E2);
                }
                { pg8::UpOrderD S{d, 3, 6}; pg8::gemm_phase<pg8::EpiSwiGLU, pg8::UpOrderD, PG8_ALIGN, PG8_SP2>(lds, g, S, E); }
            }
        } else {
            pg8::StaticOrder S; S.init(MALL, 5632, G, bx);
            pg8::gemm_phase<pg8::EpiSwiGLU, pg8::StaticOrder, PG8_ALIGN, PG8_SP2>(lds, g, S, E);
        }
    }
    xcd_barrier(bar);
    {
        PHASE_IDS();
        const int Mrows = (G == 256) ? NLAT : MALL;
        pg8::Gemm g{(const bf16*)(ws + WS_HID0), F2A_t, Mrows, 1024, FFH}; pg8::StaticOrder S; S.init(Mrows, 1024, G, bx);
        pg8::EpiResidN<false> E{HB, HCTX, HB, HCTX, MOD + 5 * 1024, XN, SS1, (ap->in[6]) + 1024, MOD1 + 1 * 1024, (LAS float*)(lds + 139264)};
        pg8::gemm_phase<pg8::EpiResidN<false>, pg8::StaticOrder, PG8_ALIGN, PG8_SP2>(lds, g, S, E);
    }
    xcd_barrier(bar);
    {
        PHASE_IDS();
        const int Mrows = (G == 256) ? NLAT : MALL;
        pg8::Gemm g{XN, Hin_t, Mrows, 5120, 1024}; pg8::StaticOrder S; S.init(Mrows, 5120, G, bx);
        pg8::EpiHgrnIn E{ws, (ap->in[13]), SS1, SHW1};
        pg8::gemm_phase<pg8::EpiHgrnIn, pg8::StaticOrder, PG8_ALIGN, PG8_SP2>(lds, g, S, E);
    }
    xcd_barrier(bar);
    { PHASE_IDS();
    for (int item = bx; item < 256; item += G)
        hgrn_scan_item<0>(lds, item, (const bf16*)(ws + WS_HQ), (const bf16*)(ws + WS_HV), (const bf16*)(ws + WS_LFW), (const bf16*)(ws + WS_LBW), (const bf16*)(ws + WS_HVC), (const bf16*)(ws + WS_LFWC), (const bf16*)(ws + WS_LBWC), OFWP, (bf16*)(ws + WS_OBW), (float*)(ws + WS_U), (float*)(ws + WS_D)); }
    xcd_barrier(bar);
    { PHASE_IDS();
    for (int item = bx; item < 256; item += G)
        hgrn_scan_item<1>(lds, item, (const bf16*)(ws + WS_HQ), (const bf16*)(ws + WS_HV), (const bf16*)(ws + WS_LFW), (const bf16*)(ws + WS_LBW), (const bf16*)(ws + WS_HVC), (const bf16*)(ws + WS_LFWC), (const bf16*)(ws + WS_LBWC), OFWP, (bf16*)(ws + WS_OBW), (float*)(ws + WS_U), (float*)(ws + WS_D)); }
    xcd_barrier(bar);
    { PHASE_IDS(); hgrn_combine(gw, NGW, lane, (const bf16*)OFWP, (const bf16*)(ws + WS_OBW), (const bf16*)(ws + WS_HG), (ap->in[14]), (bf16*)(ws + WS_OG)); }
    xcd_barrier(bar);
    {
        PHASE_IDS();
        pg8::Gemm g{(const bf16*)(ws + WS_OG), Ho_t, NLAT, 1024, 1024}; pg8::StaticOrder S; S.init(NLAT, 1024, G, bx);
        pg8::EpiResidN<false> E{HB, HCTX, HB, HCTX, MOD1 + 2 * 1024, XN, SS2, (ap->in[7]) + 1024, MOD1 + 4 * 1024, (LAS float*)(lds + 139264)};
        pg8::gemm_phase<pg8::EpiResidN<false>, pg8::StaticOrder, PG8_ALIGN, PG8_SP2>(lds, g, S, E);
    }
    xcd_barrier(bar);
    {
        PHASE_IDS();
        pg8::Gemm g{XN, F1B_t, NLAT, 5632, 1024}; pg8::StaticOrder S; S.init(NLAT, 5632, G, bx);
        pg8::EpiSwiGLU E{(bf16*)(ws + WS_HID1), SS2, SHW2};
        pg8::gemm_phase<pg8::EpiSwiGLU, pg8::StaticOrder, PG8_ALIGN, PG8_SP2>(lds, g, S, E);
    }
    xcd_barrier(bar);
    {
        PHASE_IDS();
        pg8::Gemm g{(const bf16*)(ws + WS_HID1), F2B_t, NLAT, 1024, FFH}; pg8::StaticOrder S; S.init(NLAT, 1024, G, bx);
        if (G == 256) {
            pg8::EpiResidFinal E{HB, (ap->out), MOD1 + 5 * 1024, SS3, (unsigned*)(ws + WS_BAR) + XCD_BAR_WORDS + 256, (ap->in[18]), (LAS float*)(lds + 139264)};
            pg8::gemm_phase<pg8::EpiResidFinal, pg8::StaticOrder, PG8_ALIGN, PG8_SP2>(lds, g, S, E);
        } else {
            pg8::EpiResid E{HB, (ap->out), MOD1 + 5 * 1024};
            pg8::gemm_phase<pg8::EpiResid, pg8::StaticOrder, PG8_ALIGN, PG8_SP2>(lds, g, S, E);
        }
    }
    if (gridDim.x != 256) {
        xcd_barrier(bar);
        { PHASE_IDS(); final_norm_rows(gw, NGW, lane, (ap->out), (ap->in[18])); }
    }
}


extern "C" void kernel_launch(void* const* d_in, const int* in_sizes, int n_in, void* d_out, int out_size, void* d_ws, size_t ws_size, hipStream_t stream) {
    static int grid = 0;
    if (grid == 0) {
        if (n_in != 19 || out_size != NLAT * DM || ws_size < WS_END) { fprintf(stderr, "kernel_launch: unexpected shapes: n_in %d out %d ws %zu\n", n_in, out_size, ws_size); grid = -1; return; }
        int dev = 0, cus = 0, per_cu = 0;
        if (hipGetDevice(&dev) != hipSuccess || hipDeviceGetAttribute(&cus, hipDeviceAttributeMultiprocessorCount, dev) != hipSuccess) { grid = -1; return; }
        if (hipFuncSetAttribute((const void*)mk_fwd, hipFuncAttributeMaxDynamicSharedMemorySize, LDS_BYTES) != hipSuccess) { fprintf(stderr, "kernel_launch: hipFuncSetAttribute failed\n"); grid = -1; return; }
        if (hipOccupancyMaxActiveBlocksPerMultiprocessor(&per_cu, (const void*)mk_fwd, NWAVES * 64, LDS_BYTES) != hipSuccess || per_cu < 1) { fprintf(stderr, "kernel_launch: occupancy query says %d\n", per_cu); per_cu = 1; }
        (void)hipGetLastError();
        grid = cus;
    }
    if (grid < 0) return;
    if (hipMemsetAsync((char*)d_ws + WS_BAR, 0, (XCD_BAR_WORDS + 512) * 4, stream) != hipSuccess) { fprintf(stderr, "kernel_launch: memset of the barrier words failed\n"); return; }
    Args a{};
    for (int i = 0; i < 19; ++i) a.in[i] = (const float*)d_in[i];
    a.out = (float*)d_out; a.ws = (unsigned char*)d_ws;
    void* kargs[] = {&a};
    hipError_t e = hipLaunchCooperativeKernel((const void*)mk_fwd, dim3(grid), dim3(NWAVES * 64), kargs, LDS_BYTES, stream);
    if (e != hipSuccess) fprintf(stderr, "kernel_launch: cooperative launch failed: %s (grid %d)\n", hipGetErrorString(e), grid);
}
```

```cpp
#include <hip/hip_cooperative_groups.h>
namespace cg = cooperative_groups;
#include <hip/hip_runtime.h>
#include <cstdio>
#include <cstdint>
namespace pg8 {
#define PG8_LAS __attribute__((address_space(3)))
typedef unsigned short bf16_t;
typedef short bf16x8 __attribute__((ext_vector_type(8)));
typedef float f32x4 __attribute__((ext_vector_type(4)));
typedef unsigned u32x4 __attribute__((ext_vector_type(4)));
constexpr int BM = 256, BK = 64, HALF = 128, HTB = HALF * BK * 2  , STAGE_BYTES = 8 * HTB, NXCD = 8, WGM = 8;

__host__ __device__ __forceinline__ int lds_byte(int r, int c) { const int st = (r >> 4) * 2 + (c >> 5), rr = r & 15, cc = c & 31, ob = rr * 64 + cc * 2; return st * 1024 + (ob ^ (((ob >> 9) & 1) << 5)); }
__host__ __device__ __forceinline__ void stage_rc(int b, int& R, int& C) { const int st = b / 1024, sb = b % 1024, swz = sb ^ (((sb >> 9) & 1) << 5); R = (st >> 1) * 16 + swz / 64; C = (st & 1) * 32 + (swz % 64) / 2; }
__host__ __device__ __forceinline__ int perm32(int rho) { const int n = rho >> 4, i = rho & 15; return 8 * (i >> 2) + 4 * n + (i & 3); }

struct Unit { int pm, pn; };
struct Gemm { const bf16_t* A; const bf16_t* Bt; int M, N, K; };

struct StaticOrder {
    int nM, nN, nwg, G, c;
    __host__ __device__ void init(int M, int N, int G_, int c_) { nM = M / BM; nN = N / BM; nwg = nM * nN; G = G_; c = c_; }
    __host__ __device__ bool next(int i, Unit& u) const {
        const long L = (long)i * G + c; if (L >= nwg) return false;
        int wgid = (int)L; { const int q = nwg / NXCD, r = nwg % NXCD, xcd = wgid % NXCD, off = wgid / NXCD; wgid = (xcd < r ? xcd * (q + 1) : r * (q + 1) + (xcd - r) * q) + off; }
        const int nig = WGM * nN, gid = wgid / nig, fm = gid * WGM, gsz = (nM - fm) < WGM ? (nM - fm) : WGM;
        u.pm = fm + ((wgid % nig) % gsz); u.pn = (wgid % nig) / gsz; return true;
    }
    __device__ __forceinline__ void a_ready(const Unit&) const {}
    __device__ __forceinline__ void done(const Unit&) const {}
};

__device__ __forceinline__ unsigned cvt_pk_bf16(float lo, float hi) { unsigned r; asm volatile("v_cvt_pk_bf16_f32 %0, %1, %2" : "=v"(r) : "v"(lo), "v"(hi)); return r; }
typedef unsigned u32x2 __attribute__((ext_vector_type(2)));
constexpr int NLAT = 32768, KVROWS = 8448;

struct EpiQKV {
    static constexpr bool PERM = false, AFTER_DRAIN = false;
    bf16_t* Q; bf16_t* Kall; bf16_t* Vall; const float* qn; const float* kn; const float* ropec; const float* ropes; float qscale;
    __device__ __forceinline__ void operator()(const f32x4 (&acc)[2][2][4][2], const Unit& u, int wr, int wc, int fr, int fq) const {
        const int pn = u.pn; const bool isv = (pn == 5), isk = (pn == 4);
        const float* nw = isk ? kn : qn;
        f32x4 w[2][2];
#pragma unroll
        for (int bj = 0; bj < 2; ++bj)
#pragma unroll
            for (int n = 0; n < 2; ++n) w[bj][n] = *(const f32x4*)(nw + 32 * bj + 16 * n + 4 * fq);
        const float osc = (pn < 4) ? qscale : 1.f;
        float ifr[4];
        int fq2 = fq; asm volatile("" : "+v"(fq2));
#pragma unroll
        for (int j = 0; j < 4; ++j) ifr[j] = __builtin_amdgcn_exp2f(-0.83048202372184058696f * (float)(4 * fq2 + j)) * 0.15915494309189533577f;
#pragma unroll
        for (int ai = 0; ai < 2; ++ai)
#pragma unroll
            for (int m = 0; m < 4; ++m) {
                const int r = u.pm * BM + ai * HALF + wr * 64 + m * 16 + fr;
                const bool lat = r < NLAT; int b, t;
                if (lat) { b = r >> 13; t = r & 8191; } else { const int rc = r - NLAT; b = rc >> 8; t = rc & 255; }
                f32x4 x[2][2];
#pragma unroll
                for (int bj = 0; bj < 2; ++bj)
#pragma unroll
                    for (int n = 0; n < 2; ++n) x[bj][n] = acc[ai][bj][m][n];
                if (!isv) {
                    float ss = 0.f;
#pragma unroll
                    for (int bj = 0; bj < 2; ++bj)
#pragma unroll
                        for (int n = 0; n < 2; ++n) { const f32x4 v = x[bj][n]; ss += (v[0] * v[0] + v[1] * v[1]) + (v[2] * v[2] + v[3] * v[3]); }
                    ss += __shfl_xor(ss, 16); ss += __shfl_xor(ss, 32);
                    const float rs = rsqrtf(ss * (1.0f / 64.0f) + 1e-6f);
#pragma unroll
                    for (int bj = 0; bj < 2; ++bj)
#pragma unroll
                        for (int n = 0; n < 2; ++n) x[bj][n] = x[bj][n] * rs * w[bj][n];
                    if (lat) {
#pragma unroll
                        for (int bj = 0; bj < 2; ++bj) {
                            const int pos = bj == 0 ? (t >> 6) : (t & 63);
                            f32x4 c, s;
#pragma unroll
                            for (int j = 0; j < 4; ++j) { const float rev = __builtin_amdgcn_fractf((float)pos * ifr[j]); c[j] = __builtin_amdgcn_cosf(rev); s[j] = __builtin_amdgcn_sinf(rev); }
                            const f32x4 x1 = x[bj][0], x2 = x[bj][1];
                            x[bj][0] = x1 * c - x2 * s; x[bj][1] = x2 * c + x1 * s;
                        }
                    }
#pragma unroll
                    for (int bj = 0; bj < 2; ++bj)
#pragma unroll
                        for (int n = 0; n < 2; ++n) x[bj][n] = x[bj][n] * osc;
                }
                bf16_t* dst;
                if (pn < 4) dst = Q + (size_t)r * 1024 + pn * 256 + 64 * wc;
                else { const size_t kr = (size_t)b * KVROWS + (lat ? 256 + t : t); dst = (isk ? Kall : Vall) + kr * 256 + 64 * wc; }
#pragma unroll
                for (int bj = 0; bj < 2; ++bj)
#pragma unroll
                    for (int n = 0; n < 2; ++n) { u32x2 p; p.x = cvt_pk_bf16(x[bj][n][0], x[bj][n][1]); p.y = cvt_pk_bf16(x[bj][n][2], x[bj][n][3]); *(u32x2*)(dst + 32 * bj + 16 * n + 4 * fq) = p; }
                asm volatile("" ::: "memory");
            }
    }
};

__device__ __forceinline__ void bf8_to_f32(const u32x4 w, f32x4& lo, f32x4& hi) {
    lo = (f32x4){__builtin_bit_cast(float, w.x << 16), __builtin_bit_cast(float, w.x & 0xffff0000u), __builtin_bit_cast(float, w.y << 16), __builtin_bit_cast(float, w.y & 0xffff0000u)};
    hi = (f32x4){__builtin_bit_cast(float, w.z << 16), __builtin_bit_cast(float, w.z & 0xffff0000u), __builtin_bit_cast(float, w.w << 16), __builtin_bit_cast(float, w.w & 0xffff0000u)};
}
__device__ __forceinline__ u32x4 f32_to_bf8(const f32x4 lo, const f32x4 hi) { u32x4 p; p.x = cvt_pk_bf16(lo[0], lo[1]); p.y = cvt_pk_bf16(lo[2], lo[3]); p.z = cvt_pk_bf16(hi[0], hi[1]); p.w = cvt_pk_bf16(hi[2], hi[3]); return p; }
struct EpiResid {
    static constexpr bool PERM = true, AFTER_DRAIN = false;
    const bf16_t* base; float* out; const float* gate;
    __device__ __forceinline__ void operator()(const f32x4 (&acc)[2][2][4][2], const Unit& u, int wr, int wc, int fr, int fq) const {
        const int rowt = u.pm * BM, vec = rowt >> 13;
        const bf16_t* bp = base + (size_t)rowt * 1024; float* op = out + (size_t)rowt * 1024;
        const int col0 = u.pn * BM + wc * 32 + 8 * fq;
#pragma unroll
        for (int bj = 0; bj < 2; ++bj) {
            const int cc = col0 + bj * HALF;
            const f32x4 g0 = *(const f32x4*)(gate + vec * 6144 + cc), g1 = *(const f32x4*)(gate + vec * 6144 + cc + 4);
#pragma unroll
            for (int ai = 0; ai < 2; ++ai)
#pragma unroll
                for (int m = 0; m < 4; ++m) { const size_t off = (size_t)(ai * HALF + wr * 64 + m * 16 + fr) * 1024 + cc;
                    f32x4 b0, b1; bf8_to_f32(*(const u32x4*)(bp + off), b0, b1);
                    *(f32x4*)(op + off) = b0 + g0 * acc[ai][bj][m][0]; *(f32x4*)(op + off + 4) = b1 + g1 * acc[ai][bj][m][1]; }
            asm volatile("" ::: "memory");
        }
    }
};

struct EpiResidFinal {
    static constexpr bool PERM = true, AFTER_DRAIN = false;
    const bf16_t* base; float* out; const float* gate; float* SS; unsigned* cnt; const float* fw; PG8_LAS float* red;
    __device__ __forceinline__ void operator()(const f32x4 (&acc_c)[2][2][4][2], const Unit& u, int wr, int wc, int fr_, int fq_) const {
        f32x4 (&acc)[2][2][4][2] = const_cast<f32x4 (&)[2][2][4][2]>(acc_c);
        int fr = fr_, fq = fq_; asm volatile("" : "+v"(fr), "+v"(fq));
        const int rowt = u.pm * BM, vec = rowt >> 13;
        const bf16_t* bp = base + (size_t)rowt * 1024; float* op = out + (size_t)rowt * 1024;
        const int col0 = u.pn * BM + wc * 32 + 8 * fq;
        float ss[8];
#pragma unroll
        for (int q = 0; q < 8; ++q) ss[q] = 0.f;
#pragma unroll
        for (int bj = 0; bj < 2; ++bj) {
            const int cc = col0 + bj * HALF;
            const f32x4 g0 = *(const f32x4*)(gate + vec * 6144 + cc), g1 = *(const f32x4*)(gate + vec * 6144 + cc + 4);
#pragma unroll
            for (int ai = 0; ai < 2; ++ai)
#pragma unroll
                for (int m = 0; m < 4; ++m) { const size_t off = (size_t)(ai * HALF + wr * 64 + m * 16 + fr) * 1024 + cc;
                    f32x4 b0, b1; bf8_to_f32(*(const u32x4*)(bp + off), b0, b1);
                    const f32x4 hn0 = b0 + g0 * acc[ai][bj][m][0], hn1 = b1 + g1 * acc[ai][bj][m][1];
                    acc[ai][bj][m][0] = hn0; acc[ai][bj][m][1] = hn1;
                    ss[ai * 4 + m] += ((hn0[0] * hn0[0] + hn0[1] * hn0[1]) + (hn0[2] * hn0[2] + hn0[3] * hn0[3])) + ((hn1[0] * hn1[0] + hn1[1] * hn1[1]) + (hn1[2] * hn1[2] + hn1[3] * hn1[3])); }
            asm volatile("" ::: "memory");
        }
#pragma unroll
        for (int q = 0; q < 8; ++q) { float s = ss[q]; s += __shfl_xor(s, 16); s += __shfl_xor(s, 32);
            if (fq == 0) red[((q >> 2) * HALF + wr * 64 + (q & 3) * 16 + fr) * 4 + wc] = s; }
        asm volatile("s_waitcnt lgkmcnt(0)" ::: "memory"); __builtin_amdgcn_s_barrier(); asm volatile("" ::: "memory");
        const int lane = fq * 16 + fr;
        if (lane < 32) { const int row = (wr * 4 + wc) * 32 + lane; const f32x4 p = *(const PG8_LAS f32x4*)(red + row * 4); atomicAdd(SS + rowt + row, (p[0] + p[1]) + (p[2] + p[3])); }
        asm volatile("s_waitcnt vmcnt(0)" ::: "memory"); __builtin_amdgcn_s_barrier(); asm volatile("" ::: "memory");
        if (threadIdx.x == 0) __hip_atomic_fetch_add(cnt + u.pm, 1u, __ATOMIC_RELAXED, __HIP_MEMORY_SCOPE_AGENT);
        { unsigned sp = 0; while ((unsigned)__builtin_amdgcn_readfirstlane(__hip_atomic_load(cnt + u.pm, __ATOMIC_RELAXED, __HIP_MEMORY_SCOPE_AGENT)) < 4u) { __builtin_amdgcn_s_sleep(2); if (++sp > (1u << 22)) break; } }
        asm volatile("" ::: "memory");
#pragma unroll
        for (int q = 0; q < 8; ++q) { const unsigned b = __hip_atomic_load((const unsigned*)SS + rowt + (q >> 2) * HALF + wr * 64 + (q & 3) * 16 + fr, __ATOMIC_RELAXED, __HIP_MEMORY_SCOPE_AGENT);
            ss[q] = rsqrtf(__builtin_bit_cast(float, b) * (1.0f / 1024.0f) + 1e-6f); }
#pragma unroll
        for (int bj = 0; bj < 2; ++bj) {
            const int cc = col0 + bj * HALF;
            const f32x4 w0 = *(const f32x4*)(fw + cc), w1 = *(const f32x4*)(fw + cc + 4);
#pragma unroll
            for (int ai = 0; ai < 2; ++ai)
#pragma unroll
                for (int m = 0; m < 4; ++m) { const size_t off = (size_t)(ai * HALF + wr * 64 + m * 16 + fr) * 1024 + cc;
                    *(f32x4*)(op + off) = acc[ai][bj][m][0] * ss[ai * 4 + m] * w0; *(f32x4*)(op + off + 4) = acc[ai][bj][m][1] * ss[ai * 4 + m] * w1; }
        }
    }
};

template <bool BASE_F32> struct EpiResidN {
    static constexpr bool PERM = true, AFTER_DRAIN = false;
    const void* base_lat; const void* base_ctx; bf16_t* out_lat; bf16_t* out_ctx; const float* gate;
    bf16_t* XNr; float* SS; const float* nw; const float* sc;
    PG8_LAS float* red;
    __device__ __forceinline__ void operator()(const f32x4 (&acc)[2][2][4][2], const Unit& u, int wr, int wc, int fr_, int fq_) const {
        int fr = fr_, fq = fq_; asm volatile("" : "+v"(fr), "+v"(fq));
        const int rowt = u.pm * BM; const bool lat = rowt < NLAT; const int vec = lat ? (rowt >> 13) : 4;
        const size_t rbase = (size_t)(lat ? rowt : rowt - NLAT) * 1024;
        const float* bpf = (const float*)(lat ? base_lat : base_ctx) + rbase; const bf16_t* bph = (const bf16_t*)(lat ? base_lat : base_ctx) + rbase;
        bf16_t* op = (lat ? out_lat : out_ctx) + rbase;
        const int col0 = u.pn * BM + wc * 32 + 8 * fq;
        float ss[8];
#pragma unroll
        for (int q = 0; q < 8; ++q) ss[q] = 0.f;
#pragma unroll
        for (int bj = 0; bj < 2; ++bj) {
            const int cc = col0 + bj * HALF;
            const f32x4 g0 = *(const f32x4*)(gate + vec * 6144 + cc), g1 = *(const f32x4*)(gate + vec * 6144 + cc + 4);
            const f32x4 gm0 = *(const f32x4*)(nw + cc) * (*(const f32x4*)(sc + vec * 6144 + cc) + 1.0f), gm1 = *(const f32x4*)(nw + cc + 4) * (*(const f32x4*)(sc + vec * 6144 + cc + 4) + 1.0f);
#pragma unroll
            for (int ai = 0; ai < 2; ++ai)
#pragma unroll
                for (int m = 0; m < 4; ++m) { const int rl = ai * HALF + wr * 64 + m * 16 + fr; const size_t off = (size_t)rl * 1024 + cc;
                    f32x4 b0, b1;
                    if (BASE_F32) { b0 = *(const f32x4*)(bpf + off); b1 = *(const f32x4*)(bpf + off + 4); } else bf8_to_f32(*(const u32x4*)(bph + off), b0, b1);
                    const f32x4 hn0 = b0 + g0 * acc[ai][bj][m][0], hn1 = b1 + g1 * acc[ai][bj][m][1];
                    *(u32x4*)(op + off) = f32_to_bf8(hn0, hn1);
                    ss[ai * 4 + m] += ((hn0[0] * hn0[0] + hn0[1] * hn0[1]) + (hn0[2] * hn0[2] + hn0[3] * hn0[3])) + ((hn1[0] * hn1[0] + hn1[1] * hn1[1]) + (hn1[2] * hn1[2] + hn1[3] * hn1[3]));
                    *(u32x4*)(XNr + (size_t)rowt * 1024 + off) = f32_to_bf8(hn0 * gm0, hn1 * gm1); }
            asm volatile("" ::: "memory");
        }
#pragma unroll
        for (int q = 0; q < 8; ++q) { float s = ss[q]; s += __shfl_xor(s, 16); s += __shfl_xor(s, 32);
            if (fq == 0) red[((q >> 2) * HALF + wr * 64 + (q & 3) * 16 + fr) * 4 + wc] = s; }
        asm volatile("s_waitcnt lgkmcnt(0)" ::: "memory"); __builtin_amdgcn_s_barrier(); asm volatile("" ::: "memory");
        const int lane = fq * 16 + fr;
        if (lane < 32) { const int row = (wr * 4 + wc) * 32 + lane; const f32x4 p = *(const PG8_LAS f32x4*)(red + row * 4); atomicAdd(SS + rowt + row, (p[0] + p[1]) + (p[2] + p[3])); }
    }
};

__device__ __forceinline__ float silu_f(float a) { return a * __builtin_amdgcn_rcpf(1.0f + __expf(-a)); }
struct EpiSwiGLU {
    static constexpr bool PERM = true, AFTER_DRAIN = false;
    bf16_t* O; const float* SS; const float* shw;
    __device__ __forceinline__ void operator()(const f32x4 (&acc)[2][2][4][2], const Unit& u, int wr, int wc, int fr, int fq) const {
        const int row0 = u.pm * BM + wr * 64 + fr, hc0 = u.pn * HALF + wc * 32 + 8 * fq;
        const int vec = (u.pm * BM < NLAT) ? ((u.pm * BM) >> 13) : 4;
        f32x4 sa0 = {0.f, 0.f, 0.f, 0.f}, sa1 = sa0, su0 = sa0, su1 = sa0;
        if (SS) { const float* sp = shw + vec * 5632 + u.pn * BM + wc * 32 + 8 * fq; sa0 = *(const f32x4*)sp; sa1 = *(const f32x4*)(sp + 4); su0 = *(const f32x4*)(sp + HALF); su1 = *(const f32x4*)(sp + HALF + 4); }
        float rs8[8];
#pragma unroll
        for (int q = 0; q < 8; ++q) rs8[q] = SS ? SS[row0 + (q >> 2) * HALF + (q & 3) * 16] : 0.f;
#pragma unroll
        for (int q = 0; q < 8; ++q) rs8[q] = SS ? rsqrtf(rs8[q] * (1.0f / 1024.0f) + 1e-6f) : 1.0f;
#pragma unroll
        for (int ai = 0; ai < 2; ++ai)
#pragma unroll
            for (int m = 0; m < 4; ++m) { const int r = row0 + ai * HALF + m * 16; bf16_t* rowp = O + (size_t)r * 2816 + hc0;
                const float rs = rs8[ai * 4 + m];
                const f32x4 a0 = acc[ai][0][m][0] * rs + sa0, a1 = acc[ai][0][m][1] * rs + sa1, u0 = acc[ai][1][m][0] * rs + su0, u1 = acc[ai][1][m][1] * rs + su1;
                u32x4 wv; wv.x = cvt_pk_bf16(silu_f(a0[0]) * u0[0], silu_f(a0[1]) * u0[1]); wv.y = cvt_pk_bf16(silu_f(a0[2]) * u0[2], silu_f(a0[3]) * u0[3]);
                wv.z = cvt_pk_bf16(silu_f(a1[0]) * u1[0], silu_f(a1[1]) * u1[1]); wv.w = cvt_pk_bf16(silu_f(a1[2]) * u1[2], silu_f(a1[3]) * u1[3]);
                __builtin_nontemporal_store(wv, (u32x4*)rowp); }
    }
};

__device__ __forceinline__ unsigned pk_f16(float lo, float hi) { const _Float16 a = (_Float16)lo, b = (_Float16)hi; return (unsigned)__builtin_bit_cast(unsigned short, a) | ((unsigned)__builtin_bit_cast(unsigned short, b) << 16); }
constexpr size_t OFF_MiB = 1u << 20, OFF_HQ = 122 * OFF_MiB, OFF_HG = 186 * OFF_MiB, OFF_HV = 250 * OFF_MiB, OFF_LFW = 314 * OFF_MiB, OFF_LBW = 378 * OFF_MiB, OFF_HVC = 506 * OFF_MiB, OFF_LFWC = 508 * OFF_MiB, OFF_LBWC = 510 * OFF_MiB;
struct EpiHgrnIn {
    static constexpr bool PERM = true, AFTER_DRAIN = false;
    unsigned char* ws; const float* lbl; const float* SS; const float* shw;
    __device__ __forceinline__ void operator()(const f32x4 (&acc)[2][2][4][2], const Unit& u, int wr, int wc, int fr, int fq) const {
        const int type = u.pn >> 2; const bool lat = u.pm < (NLAT / BM);
        if (type < 2 && !lat) return;
        const size_t doff = lat ? (type == 0 ? OFF_HQ : type == 1 ? OFF_HG : type == 2 ? OFF_LFW : type == 3 ? OFF_LBW : OFF_HV)
                                : (type == 2 ? OFF_LFWC : type == 3 ? OFF_LBWC : OFF_HVC) - (size_t)NLAT * 2048;
        bf16_t* dstb = (bf16_t*)(ws + doff);
        const int row0 = u.pm * BM + wr * 64 + fr; const int vec = lat ? ((u.pm * BM) >> 13) : 4;
        float rs8[8];
#pragma unroll
        for (int q = 0; q < 8; ++q) rs8[q] = SS[row0 + (q >> 2) * HALF + (q & 3) * 16];
#pragma unroll
        for (int q = 0; q < 8; ++q) rs8[q] = rsqrtf(rs8[q] * (1.0f / 1024.0f) + 1e-6f);
#pragma unroll
        for (int bj = 0; bj < 2; ++bj) {
            const int ch = (u.pn & 3) * 256 + bj * HALF + wc * 32 + 8 * fq;
            const float* sp = shw + vec * 5120 + u.pn * BM + bj * HALF + wc * 32 + 8 * fq; const f32x4 sw0 = *(const f32x4*)sp, sw1 = *(const f32x4*)(sp + 4);
            float lb[8];
            if (type == 2 || type == 3) {
#pragma unroll
                for (int e = 0; e < 8; ++e) { const float l0 = lbl[ch + e], l1 = lbl[1024 + ch + e]; lb[e] = 1.0f / (1.0f + __expf(l0 - l1)); }
            } else {
#pragma unroll
                for (int e = 0; e < 8; ++e) lb[e] = 0.f;
            }
#pragma unroll
            for (int ai = 0; ai < 2; ++ai)
#pragma unroll
                for (int m = 0; m < 4; ++m) { const int r = row0 + ai * HALF + m * 16; bf16_t* p = dstb + (size_t)r * 1024 + ch;
                    const float rs = rs8[ai * 4 + m];
                    float v[8];
#pragma unroll
                    for (int e = 0; e < 8; ++e) v[e] = acc[ai][bj][m][e >> 2][e & 3] * rs + (e < 4 ? sw0[e & 3] : sw1[e & 3]);
                    u32x4 wv;
                    if (type == 2 || type == 3) {
#pragma unroll
                        for (int e = 0; e < 8; ++e) { const float sg = __builtin_amdgcn_rcpf(1.0f + __expf(-v[e])); v[e] = __logf(lb[e] + (1.0f - lb[e]) * sg); }
                        wv.x = pk_f16(v[0], v[1]); wv.y = pk_f16(v[2], v[3]); wv.z = pk_f16(v[4], v[5]); wv.w = pk_f16(v[6], v[7]);
                    } else { wv.x = cvt_pk_bf16(v[0], v[1]); wv.y = cvt_pk_bf16(v[2], v[3]); wv.z = cvt_pk_bf16(v[4], v[5]); wv.w = cvt_pk_bf16(v[6], v[7]); }
                    *(u32x4*)p = wv; if (m & 1) asm volatile("" ::: "memory"); }
        }
    }
};

__device__ __forceinline__ void publish_unit(unsigned* cnt) {
    asm volatile("s_waitcnt vmcnt(0)" ::: "memory"); __builtin_amdgcn_s_barrier(); asm volatile("" ::: "memory");
    if (threadIdx.x == 0) { __builtin_amdgcn_fence(__ATOMIC_RELEASE, "agent"); asm volatile("s_waitcnt vmcnt(0)" ::: "memory"); __hip_atomic_fetch_add(cnt, 1u, __ATOMIC_RELAXED, __HIP_MEMORY_SCOPE_AGENT); }
}
__device__ __forceinline__ void wave_wait_count(unsigned* cnt, unsigned want) {
    unsigned sp = 0;
    while ((unsigned)__builtin_amdgcn_readfirstlane(__hip_atomic_load(cnt, __ATOMIC_RELAXED, __HIP_MEMORY_SCOPE_AGENT)) < want) { __builtin_amdgcn_s_sleep(4); if (++sp > (1u << 22)) break; }
    __builtin_amdgcn_fence(__ATOMIC_ACQUIRE, "agent"); asm volatile("s_waitcnt vmcnt(0)" ::: "memory");
}
__device__ __forceinline__ void latent_up_unit(int q, Unit& u) { const int nN = 22, nM = 128, nig = WGM * nN, gid = q / nig, fm = gid * WGM, gsz = (nM - fm) < WGM ? (nM - fm) : WGM; u.pm = fm + ((q % nig) % gsz); u.pn = (q % nig) / gsz; }
__device__ __forceinline__ int up_pos_type(int x, int j, int& idx) {
    if (x == 0 && j < 16) { idx = j; return 1; }
    if (j >= 30 && j < 60 && x < 3) { const int uu = x * 30 + (j - 30); if (uu < 88) { idx = uu; return 2; } }
    if (j >= 330 && j < 336) { idx = x * 6 + (j - 330); return 3; }
    int sp = 0;
    if (x == 0) sp += 16;
    if (x < 3) { const int lim = x < 2 ? 30 : 28; int t = j - 30; t = t < 0 ? 0 : (t > lim ? lim : t); sp += t; }
    { int t = j - 330; t = t < 0 ? 0 : (t > 6 ? 6 : t); sp += t; }
    const int prev = x == 0 ? 0 : x == 1 ? 52 : x == 2 ? 88 : 122 + (x - 3) * 6;
    idx = x * 360 + j - sp - prev; return 0;
}
struct UpOrder {
    int c, i0, i1; unsigned* cntW; unsigned* cntU;
    __device__ __forceinline__ bool next(int k, Unit& u) const {
        const int i = i0 + k; if (i >= i1) return false;
        int idx; const int t = up_pos_type(c & 7, i * 30 + (c >> 3), idx);
        if (t == 2) { u.pm = 128 + idx / 22; u.pn = idx % 22; } else latent_up_unit(idx, u);
        return true;
    }
    __device__ __forceinline__ void a_ready(const Unit& u) const { if (u.pm >= 128) wave_wait_count(cntW, 16u); }
    __device__ __forceinline__ void done(const Unit& u) const { if (u.pm >= 128) publish_unit(cntU); }
};
struct UpOrderD {
    int d, i0, i1;
    __device__ __forceinline__ bool next(int k, Unit& u) const { const int i = i0 + k; if (i >= i1) return false; const int q = 2728 + i * 16 + d; if (q >= 2816) return false; latent_up_unit(q, u); return true; }
    __device__ __forceinline__ void a_ready(const Unit&) const {}
    __device__ __forceinline__ void done(const Unit&) const {}
};
struct OneUnit {
    int pm, pn; unsigned* cnt;
    __device__ __forceinline__ bool next(int i, Unit& u) const { if (i > 0) return false; u.pm = pm; u.pn = pn; return true; }
    __device__ __forceinline__ void a_ready(const Unit&) const {}
    __device__ __forceinline__ void done(const Unit&) const { if (cnt) publish_unit(cnt); }
};
template <class Epi, class Sched, bool ALIGN_EPI = false, bool SP2 = false>
__device__ __forceinline__ void gemm_phase(PG8_LAS unsigned char* lds, const Gemm g, const Sched& S, const Epi& E) {
    int tid_ = threadIdx.x; asm volatile("" : "+v"(tid_));
    const int tid = tid_, wid = __builtin_amdgcn_readfirstlane(tid >> 6), lane = tid & 63, wr = wid >> 2, wc = wid & 3, fr = lane & 15, fq = lane >> 4;
    const int K = g.K, nt = K / BK;
    unsigned voffA[2], voffB[2];
#pragma unroll
    for (int i = 0; i < 2; ++i) { int R, C; stage_rc(tid * 16 + i * 8192, R, C); const int Rb = Epi::PERM ? ((R & ~31) + perm32(R & 31)) : R;
        voffA[i] = (unsigned)(R * K + C) * 2u; voffB[i] = (unsigned)(Rb * K + C) * 2u; }
    const size_t kstep = (size_t)(BK * 2);
    const size_t hstep = (size_t)HALF * K * 2;
    const size_t tstep = 2 * hstep;
    const unsigned ldsw = (unsigned)wid * 1024u;
    const int aoff = lds_byte(wr * 64 + fr, fq * 8), boff = lds_byte(wc * 32 + fr, fq * 8);
#define PG8_SA(b, h) (((b) * 2 + (h)) * HTB)
#define PG8_SB(b, h) ((4 + (b) * 2 + (h)) * HTB)
#define PG8_STAGE(bufoff, gbase, voff) do { _Pragma("unroll") for (int _i = 0; _i < 2; ++_i) \
        __builtin_amdgcn_global_load_lds((const unsigned*)((const char*)(gbase) + (voff)[_i]), (PG8_LAS unsigned*)(lds + (bufoff) + ldsw + _i * 8192), 16, 0, 0); } while (0)
#define PG8_LDA(dst, b, h) do { _Pragma("unroll") for (int m = 0; m < 4; ++m) _Pragma("unroll") for (int k = 0; k < 2; ++k) dst[m][k] = *(const PG8_LAS bf16x8*)(lds + PG8_SA(b, h) + aoff + m * 2048 + k * 1024); } while (0)
#define PG8_LDB(dst, b, h) do { _Pragma("unroll") for (int n = 0; n < 2; ++n) _Pragma("unroll") for (int k = 0; k < 2; ++k) dst[n][k] = *(const PG8_LAS bf16x8*)(lds + PG8_SB(b, h) + boff + n * 2048 + k * 1024); } while (0)
#define PG8_MMA(ai, bj, At, Bt) do { __builtin_amdgcn_s_setprio(1); _Pragma("unroll") for (int m = 0; m < 4; ++m) _Pragma("unroll") for (int n = 0; n < 2; ++n) _Pragma("unroll") for (int k = 0; k < 2; ++k) \
        acc[ai][bj][m][n] = __builtin_amdgcn_mfma_f32_16x16x32_bf16(Bt[n][k], At[m][k], acc[ai][bj][m][n], 0, 0, 0); __builtin_amdgcn_s_setprio(0); } while (0)
#define PG8_WAIT_V(n) asm volatile("s_waitcnt vmcnt(" #n ")" ::: "memory")
#define PG8_WAIT_L(n) asm volatile("s_waitcnt lgkmcnt(" #n ")" ::: "memory")
#define PG8_BAR __builtin_amdgcn_s_barrier()
#define PG8_SCHED __builtin_amdgcn_sched_barrier(0)
    Unit cur, nxt; int ui = 0;
    if (!S.next(0, cur)) return;
    f32x4 acc[2][2][4][2];
#pragma unroll
    for (int a = 0; a < 2; ++a)
#pragma unroll
        for (int b = 0; b < 2; ++b)
#pragma unroll
            for (int m = 0; m < 4; ++m)
#pragma unroll
                for (int n = 0; n < 2; ++n) acc[a][b][m][n] = (f32x4){0.f, 0.f, 0.f, 0.f};
    bf16x8 At[4][2], B0[2][2], B1[2][2];
    const char* cA = (const char*)g.A + (size_t)cur.pm * tstep; const char* cB = (const char*)g.Bt + (size_t)cur.pn * tstep;
    S.a_ready(cur);
    if constexpr (SP2) {
        PG8_STAGE(PG8_SB(0, 0), cB, voffB); PG8_STAGE(PG8_SB(0, 1), cB + hstep, voffB); PG8_STAGE(PG8_SA(0, 0), cA, voffA); PG8_STAGE(PG8_SA(0, 1), cA + hstep, voffA);
        if (wr == 1) PG8_BAR;
        PG8_WAIT_V(2); PG8_BAR;
        PG8_STAGE(PG8_SB(1, 0), cB + kstep, voffB); PG8_STAGE(PG8_SA(1, 0), cA + kstep, voffA); PG8_STAGE(PG8_SB(1, 1), cB + hstep + kstep, voffB);
        PG8_WAIT_V(6); PG8_BAR;
    } else {
        PG8_STAGE(PG8_SB(0, 0), cB, voffB); PG8_STAGE(PG8_SA(0, 0), cA, voffA); PG8_STAGE(PG8_SB(0, 1), cB + hstep, voffB); PG8_STAGE(PG8_SA(0, 1), cA + hstep, voffA);
        if (wr == 1) PG8_BAR;
        PG8_WAIT_V(4); PG8_BAR;
        PG8_STAGE(PG8_SB(1, 0), cB + kstep, voffB); PG8_STAGE(PG8_SA(1, 0), cA + kstep, voffA); PG8_STAGE(PG8_SB(1, 1), cB + hstep + kstep, voffB);
        PG8_WAIT_V(6); PG8_BAR;
    }
    for (;;) {
        const bool has_next = S.next(ui + 1, nxt);
        const char* nA = has_next ? (const char*)g.A + (size_t)nxt.pm * tstep : cA; const char* nB = has_next ? (const char*)g.Bt + (size_t)nxt.pn * tstep : cB;
        for (int t = 0; t < nt; t += 2) {
            const bool last = (t == nt - 2);
            const char* a1 = cA + (size_t)(t + 1) * kstep;
            const char* a2 = last ? nA : cA + (size_t)(t + 2) * kstep; const char* b2 = last ? nB : cB + (size_t)(t + 2) * kstep;
            const char* a3 = a2 + kstep; const char* b3 = b2 + kstep;
            if (last && has_next) S.a_ready(nxt);
            if constexpr (SP2) {
            PG8_LDB(B0, 0, 0); PG8_LDB(B1, 0, 1); PG8_SCHED; PG8_LDA(At, 0, 0); PG8_STAGE(PG8_SA(1, 1), a1 + hstep, voffA);
            PG8_WAIT_V(8); PG8_WAIT_L(0); PG8_BAR; PG8_MMA(0, 0, At, B0); PG8_MMA(0, 1, At, B1); PG8_BAR; PG8_SCHED;
            PG8_LDA(At, 0, 1); PG8_STAGE(PG8_SB(0, 0), b2, voffB); PG8_STAGE(PG8_SB(0, 1), b2 + hstep, voffB); PG8_STAGE(PG8_SA(0, 0), a2, voffA);
            PG8_WAIT_V(8); PG8_WAIT_L(0); PG8_BAR; PG8_MMA(1, 0, At, B0); PG8_MMA(1, 1, At, B1); PG8_BAR; PG8_SCHED;
            PG8_LDB(B0, 1, 0); PG8_LDB(B1, 1, 1); PG8_SCHED; PG8_LDA(At, 1, 0); PG8_STAGE(PG8_SA(0, 1), a2 + hstep, voffA);
            PG8_WAIT_V(8); PG8_WAIT_L(0); PG8_BAR; PG8_MMA(0, 0, At, B0); PG8_MMA(0, 1, At, B1); PG8_BAR; PG8_SCHED;
            PG8_LDA(At, 1, 1); PG8_STAGE(PG8_SB(1, 0), b3, voffB); PG8_STAGE(PG8_SB(1, 1), b3 + hstep, voffB); PG8_STAGE(PG8_SA(1, 0), a3, voffA);
            PG8_WAIT_V(8); PG8_WAIT_L(0); PG8_BAR; PG8_MMA(1, 0, At, B0); PG8_MMA(1, 1, At, B1); PG8_BAR; PG8_SCHED;
            } else {
            PG8_LDB(B0, 0, 0); PG8_SCHED; PG8_LDA(At, 0, 0); PG8_STAGE(PG8_SA(1, 1), a1 + hstep, voffA);
            PG8_WAIT_L(8); PG8_BAR; PG8_WAIT_L(0); PG8_MMA(0, 0, At, B0); PG8_BAR; PG8_SCHED;
            PG8_LDB(B1, 0, 1); PG8_STAGE(PG8_SB(0, 0), b2, voffB);
            PG8_BAR; PG8_WAIT_L(0); PG8_MMA(0, 1, At, B1); PG8_BAR;
            PG8_LDA(At, 0, 1); PG8_STAGE(PG8_SA(0, 0), a2, voffA);
            PG8_BAR; PG8_WAIT_L(0); PG8_MMA(1, 0, At, B0); PG8_BAR; PG8_SCHED;
            PG8_STAGE(PG8_SB(0, 1), b2 + hstep, voffB);
            PG8_WAIT_V(6); PG8_BAR; PG8_MMA(1, 1, At, B1); PG8_BAR;
            PG8_LDB(B0, 1, 0); PG8_SCHED; PG8_LDA(At, 1, 0); PG8_STAGE(PG8_SA(0, 1), a2 + hstep, voffA);
            PG8_WAIT_L(8); PG8_BAR; PG8_WAIT_L(0); PG8_MMA(0, 0, At, B0); PG8_BAR; PG8_SCHED;
            PG8_LDB(B1, 1, 1); PG8_STAGE(PG8_SB(1, 0), b3, voffB);
            PG8_BAR; PG8_WAIT_L(0); PG8_MMA(0, 1, At, B1); PG8_BAR;
            PG8_LDA(At, 1, 1); PG8_STAGE(PG8_SA(1, 0), a3, voffA);
            PG8_BAR; PG8_WAIT_L(0); PG8_MMA(1, 0, At, B0); PG8_BAR; PG8_SCHED;
            PG8_STAGE(PG8_SB(1, 1), b3 + hstep, voffB);
            PG8_WAIT_V(6); PG8_BAR; PG8_MMA(1, 1, At, B1); PG8_BAR;
            }
        }
        if constexpr (ALIGN_EPI) { if (wr == 0) PG8_BAR; }
        if constexpr (!Epi::AFTER_DRAIN) { E(acc, cur, wr, wc, fr, fq); S.done(cur); }
        if (!has_next) break;
#pragma unroll
        for (int a = 0; a < 2; ++a)
#pragma unroll
            for (int b = 0; b < 2; ++b)
#pragma unroll
                for (int m = 0; m < 4; ++m)
#pragma unroll
                    for (int n = 0; n < 2; ++n) acc[a][b][m][n] = (f32x4){0.f, 0.f, 0.f, 0.f};
        cur = nxt; cA = nA; cB = nB; ++ui;
        if constexpr (ALIGN_EPI) { if (wr == 1) PG8_BAR; }
    }
    PG8_WAIT_V(0);
    if constexpr (!ALIGN_EPI) { if (wr == 0) PG8_BAR; }
    PG8_BAR;
    if constexpr (Epi::AFTER_DRAIN) { E.fused(acc, cur, wr, wc, fr, fq, lds, wid, lane); S.done(cur); }
#undef PG8_SA
#undef PG8_SB
#undef PG8_STAGE
#undef PG8_LDA
#undef PG8_LDB
#undef PG8_MMA
#undef PG8_WAIT_V
#undef PG8_WAIT_L
#undef PG8_BAR
#undef PG8_SCHED
}
}

#ifndef PG8_SP2
#define PG8_SP2 true
#endif
#ifndef PG8_ALIGN
#define PG8_ALIGN true
#endif
#include <hip/hip_bf16.h>
#include <cmath>
namespace attn_body {
using bf16=__hip_bfloat16;
using bf16x8=__attribute__((ext_vector_type(8)))short;
using s16x4=__attribute__((ext_vector_type(4)))short;
using f32x16=__attribute__((ext_vector_type(16)))float;
using u32x4=__attribute__((ext_vector_type(4)))unsigned;
constexpr int D=64,QP=1024,KVP=256;
constexpr int NW=8,QBLK=32,QB=QBLK*NW,KVBLK=64;
__device__ __forceinline__ int crow(int r,int hi){return (r&3)+8*(r>>2)+4*hi;}
#define SBAR() __builtin_amdgcn_sched_barrier(0)
constexpr int NSLOT=3, SLOTB=8192;
constexpr int LDS_K=0, LDS_V=NSLOT*SLOTB, LDS_WS=2*NSLOT*SLOTB, LDS_OST=LDS_WS+NW*64*4, LDS_BYTES=LDS_OST+NW*4096;
constexpr float C2=0.125f*1.4426950408889634f;
__device__ __forceinline__ void glds16(const void*gsrc,unsigned lds_dst){unsigned keep;
  asm volatile("s_mov_b32 %0, m0\n\ts_mov_b32 m0, %2\n\ts_nop 0\n\tglobal_load_lds_dwordx4 %1, off\n\ts_mov_b32 m0, %0":"=&s"(keep):"v"(gsrc),"s"(lds_dst):"memory");}
__device__ __forceinline__ float max3f(float a,float b,float c){float r;asm("v_max3_f32 %0, %1, %2, %3":"=v"(r):"v"(a),"v"(b),"v"(c));return r;}
__device__ __forceinline__ float max2f(float a,float b){float r;asm("v_max_f32_e32 %0, %1, %2":"=v"(r):"v"(a),"v"(b));return r;}
__device__ __forceinline__ float fadd_s(float a,float b){float r;asm("v_add_f32_e32 %0, %1, %2":"=v"(r):"v"(a),"v"(b));return r;}
__device__ __forceinline__ float fsub_s(float a,float b){float r;asm("v_sub_f32_e32 %0, %1, %2":"=v"(r):"v"(a),"v"(b));return r;}
typedef float f32x2_t __attribute__((ext_vector_type(2))); typedef __bf16 bf16x2_t __attribute__((ext_vector_type(2)));
__device__ __forceinline__ unsigned cvtpk_s(float lo,float hi){f32x2_t v={lo,hi};bf16x2_t b=__builtin_convertvector(v,bf16x2_t);return __builtin_bit_cast(unsigned,b);}
#define WAIT_BAR(N) asm volatile("s_waitcnt vmcnt(" #N ") lgkmcnt(0)\n\ts_barrier":::"memory")

__device__ __forceinline__ void qkt(f32x16&p0,f32x16&p1,const char*Kslot,const bf16x8*qr,const f32x16&negm,int r32,int hi){
  const char*kb=Kslot+hi*1024+r32*16;
  #pragma unroll
  for(int d0=0;d0<4;++d0){
    const bf16x8 b0=*reinterpret_cast<const bf16x8*>(kb+d0*2048);
    const bf16x8 b1=*reinterpret_cast<const bf16x8*>(kb+d0*2048+512);
    if(d0==0){p0=__builtin_amdgcn_mfma_f32_32x32x16_bf16(b0,qr[0],negm,0,0,0);p1=__builtin_amdgcn_mfma_f32_32x32x16_bf16(b1,qr[0],negm,0,0,0);}
    else{p0=__builtin_amdgcn_mfma_f32_32x32x16_bf16(b0,qr[d0],p0,0,0,0);p1=__builtin_amdgcn_mfma_f32_32x32x16_bf16(b1,qr[d0],p1,0,0,0);}}
}
typedef __attribute__((address_space(3))) const char* lds_cptr;
typedef short v4i16_t __attribute__((ext_vector_type(4)));
__device__ __forceinline__ void kload8(bf16x8*kf,lds_cptr kp){
  kf[0]=*(const __attribute__((address_space(3))) bf16x8*)(kp);      kf[1]=*(const __attribute__((address_space(3))) bf16x8*)(kp+512);
  kf[2]=*(const __attribute__((address_space(3))) bf16x8*)(kp+2048); kf[3]=*(const __attribute__((address_space(3))) bf16x8*)(kp+2560);
  kf[4]=*(const __attribute__((address_space(3))) bf16x8*)(kp+4096); kf[5]=*(const __attribute__((address_space(3))) bf16x8*)(kp+4608);
  kf[6]=*(const __attribute__((address_space(3))) bf16x8*)(kp+6144); kf[7]=*(const __attribute__((address_space(3))) bf16x8*)(kp+6656);
}
__device__ __forceinline__ void kload2(bf16x8*kf,lds_cptr kp,int j){ kf[2*j]=*(const __attribute__((address_space(3))) bf16x8*)(kp+j*2048); kf[2*j+1]=*(const __attribute__((address_space(3))) bf16x8*)(kp+j*2048+512); }
__device__ __forceinline__ s16x4 vtr(lds_cptr p){ return __builtin_bit_cast(s16x4,__builtin_amdgcn_ds_read_tr16_b64_v4i16((__attribute__((address_space(3))) v4i16_t*)p)); }
__device__ __forceinline__ float rowmax(const f32x16&p0,const f32x16&p1){
  float a=max3f(p0[0],p0[1],p1[0]),b=max3f(p0[2],p0[3],p1[1]);a=max3f(a,p1[2],p1[3]);
  #pragma unroll
  for(int r=4;r<16;r+=4){a=max3f(a,p0[r],p0[r+1]);b=max3f(b,p0[r+2],p0[r+3]);a=max3f(a,p1[r],p1[r+1]);b=max3f(b,p1[r+2],p1[r+3]);}
  const float m=max2f(a,b);
  auto rr=__builtin_amdgcn_permlane32_swap(__float_as_uint(m),__float_as_uint(m),false,false);
  return max2f(__uint_as_float(rr[0]),__uint_as_float(rr[1]));
}
__device__ __forceinline__ void pv(f32x16*o,int vb,bf16x8 pa0,bf16x8 pa1,bf16x8 pa2,bf16x8 pa3){
  #pragma unroll
  for(int d0=0;d0<2;++d0){s16x4 lo[4],hi[4];
    #pragma unroll
    for(int ks=0;ks<4;++ks){
      asm volatile("ds_read_b64_tr_b16 %0,%1 offset:%c2":"=&v"(lo[ks]):"v"(vb),"i"(d0*4096+ks*1024):"memory");
      asm volatile("ds_read_b64_tr_b16 %0,%1 offset:%c2":"=&v"(hi[ks]):"v"(vb),"i"(d0*4096+ks*1024+512):"memory");}
    asm volatile("s_waitcnt lgkmcnt(0)":::"memory");SBAR();
    #define PK(k) (bf16x8){lo[k][0],lo[k][1],lo[k][2],lo[k][3],hi[k][0],hi[k][1],hi[k][2],hi[k][3]}
    o[d0]=__builtin_amdgcn_mfma_f32_32x32x16_bf16(pa0,PK(0),o[d0],0,0,0);
    o[d0]=__builtin_amdgcn_mfma_f32_32x32x16_bf16(pa1,PK(1),o[d0],0,0,0);
    o[d0]=__builtin_amdgcn_mfma_f32_32x32x16_bf16(pa2,PK(2),o[d0],0,0,0);
    o[d0]=__builtin_amdgcn_mfma_f32_32x32x16_bf16(pa3,PK(3),o[d0],0,0,0);
    #undef PK
  }
}

#ifndef ATTN_STORE16
#define ATTN_STORE16(p,v) (*(u32x4*)(p)=(v))
#endif
template<int THRL> __device__ __forceinline__ void attn_unit(const bf16*Qu,const bf16*__restrict__ Kh,const bf16*__restrict__ Vh,bf16*Ou,const int NT,char*shm){
  int tid_=threadIdx.x; asm volatile("":"+v"(tid_)); const int tid=tid_,lane=tid&63,r32=lane&31,hi=lane>>5; const int wid=__builtin_amdgcn_readfirstlane(tid>>6);
  const bf16*Qw=Qu+(long)(wid*QBLK)*QP;
  const unsigned lds0=(unsigned)(uintptr_t)shm;
  float*wsf=(float*)(shm+LDS_WS)+wid*64;
  const bf16*ksrc=Kh+(long)lane*KVP+wid*8;
  const bf16*vsrc=Vh+(long)(16*(wid&3)+(lane>>2))*KVP+(wid>>2)*32+(lane&3)*8;
  const unsigned kdst=lds0+LDS_K+wid*1024, vdst=lds0+LDS_V+wid*1024;
  #define DMA_K(t,slot) glds16(ksrc+(long)(t)*KVBLK*KVP,(unsigned)__builtin_amdgcn_readfirstlane(kdst+(slot)))
  #define DMA_V(t,slot) glds16(vsrc+(long)(t)*KVBLK*KVP,(unsigned)__builtin_amdgcn_readfirstlane(vdst+(slot)))
  const int vb0=(int)(lds0+LDS_V)+((lane>>4)&1)*32+(lane&3)*8+(4*hi+((lane&15)>>2))*64;
  const char*Kbase=shm+LDS_K; bf16x8 kf[8];
  const lds_cptr shm3=(lds_cptr)shm; const lds_cptr kp0=shm3+LDS_K+hi*1024+r32*16; const lds_cptr vp0=shm3+LDS_V+((lane>>4)&1)*32+(lane&3)*8+(4*hi+((lane&15)>>2))*64;
  DMA_K(0,0);DMA_V(0,0);DMA_K(1,SLOTB);
  bf16x8 qr[4];
  #pragma unroll
  for(int d0=0;d0<4;++d0)qr[d0]=*reinterpret_cast<const bf16x8*>(&Qw[(long)r32*QP+d0*16+hi*8]);
  float mhat=0.f,l_reg=0.f;f32x16 o[2];o[0]=f32x16{};o[1]=f32x16{};f32x16 negm=f32x16{};asm volatile("":"+v"(negm));
  #define CMASK(P0,P1,t) do{}while(0)
  bool resc=false;
  #define START(P0,P1) do{ const float rm=rowmax(P0,P1); resc=false; \
    { const float dl=rm; mhat=fadd_s(mhat,dl); \
      _Pragma("unroll") for(int r=0;r<16;++r){P0[r]=fsub_s(P0[r],dl);P1[r]=fsub_s(P1[r],dl);} \
      _Pragma("unroll") for(int r=0;r<16;++r)negm[r]=-mhat; asm volatile("":"+v"(negm)); } \
    _Pragma("unroll") for(int r=0;r<16;++r)P0[r]=__builtin_amdgcn_exp2f(P0[r]); }while(0)
  #define RESC() do{ if(resc){ asm volatile("s_waitcnt lgkmcnt(0)":::"memory"); \
      _Pragma("unroll") for(int d_=0;d_<2;++d_) _Pragma("unroll") for(int r=0;r<16;++r)o[d_][r]*=wsf[crow(r,hi)]; } }while(0)
  f32x16 pA0,pA1,pB0,pB1;
  int sl_prev=0,sl_cur=0,sl_next=SLOTB;
  #define ROT() do{sl_prev=sl_cur;sl_cur=sl_next;sl_next=(sl_next==(NSLOT-1)*SLOTB)?0:sl_next+SLOTB;}while(0)
  DMA_K(2,2*SLOTB);
  WAIT_BAR(3);
  qkt(pA0,pA1,Kbase,qr,negm,r32,hi);asm volatile("s_nop 15\n\ts_nop 7":"+v"(pA0),"+v"(pA1));CMASK(pA0,pA1,0);
  START(pA0,pA1);
  _Pragma("unroll") for(int r=0;r<16;++r)pA1[r]=__builtin_amdgcn_exp2f(pA1[r]);
  WAIT_BAR(0);
  DMA_K(3,0);DMA_V(1,SLOTB);
  ROT();
  kload8(kf,kp0+sl_cur);
  WAIT_BAR(2);
  s16x4 vlo[8],vhi[8]; u32x4 pw0,pw1,pw2,pw3;
  #define PKW(P,B) cvtpk_s(P[B],P[B+1])
  #define PAF(k) __builtin_bit_cast(bf16x8,pw##k)
  #define VFR(i) (bf16x8){vlo[i][0],vlo[i][1],vlo[i][2],vlo[i][3],vhi[i][0],vhi[i][1],vhi[i][2],vhi[i][3]}
  #define PIN(x) asm volatile("":"+v"(x))
  #define MX3(a,b,c) __builtin_fmaxf(__builtin_fmaxf((a),(b)),(c))
  #define GAPA(MF,A0,A1,A2,A3,W0,W1,PW) do{ MF; sacc+=A0; sacc+=A1; sacc+=A2; sacc+=A3; PIN(sacc); W0; W1; PIN(PW); SBAR(); }while(0)
  #define EX(v) __builtin_amdgcn_exp2f(v)
  #define GAPB(MF,X,B) do{ MF; X[B]=EX(X[B]); X[B+1]=EX(X[B+1]); X[B+2]=EX(X[B+2]); X[B+3]=EX(X[B+3]); PIN(X); SBAR(); }while(0)
  #define VRD(i) do{ vlo[i]=vtr(vp_+(((i)>>2)*4096+((i)&3)*1024)); vhi[i]=vtr(vp_+(((i)>>2)*4096+((i)&3)*1024+512)); }while(0)
  #define KRD(G,j) do{ if(G){ kload2(kf,kp0+sl_next,j); SBAR(); } }while(0)
  #define STEP(C0,C1,P0,P1,t,GK,GV,GL) do{ SBAR(); \
    const lds_cptr vp_=vp0+sl_prev; \
    VRD(0); SBAR(); float sacc=(P0[0]+P0[1]); \
    GAPA(C0=__builtin_amdgcn_mfma_f32_32x32x16_bf16(kf[0],qr[0],negm,0,0,0), P0[2],P0[3],P0[4],P0[5],     pw0[0]=PKW(P0,0), pw0[1]=PKW(P0,2), pw0); \
    VRD(4); SBAR(); GAPA(C1=__builtin_amdgcn_mfma_f32_32x32x16_bf16(kf[1],qr[0],negm,0,0,0), P0[6],P0[7],P0[8],P0[9],     pw0[2]=PKW(P0,4), pw0[3]=PKW(P0,6), pw0); \
    VRD(1); SBAR(); GAPA(C0=__builtin_amdgcn_mfma_f32_32x32x16_bf16(kf[2],qr[1],C0,0,0,0),   P0[10],P0[11],P0[12],P0[13], pw1[0]=PKW(P0,8), pw1[1]=PKW(P0,10), pw1); \
    VRD(5); SBAR(); GAPA(C1=__builtin_amdgcn_mfma_f32_32x32x16_bf16(kf[3],qr[1],C1,0,0,0),   P0[14],P0[15],P1[0],P1[1],   pw1[2]=PKW(P0,12),pw1[3]=PKW(P0,14), pw1); \
    VRD(2); SBAR(); GAPA(C0=__builtin_amdgcn_mfma_f32_32x32x16_bf16(kf[4],qr[2],C0,0,0,0),   P1[2],P1[3],P1[4],P1[5],     pw2[0]=PKW(P1,0), pw2[1]=PKW(P1,2), pw2); \
    VRD(6); SBAR(); GAPA(C1=__builtin_amdgcn_mfma_f32_32x32x16_bf16(kf[5],qr[2],C1,0,0,0),   P1[6],P1[7],P1[8],P1[9],     pw2[2]=PKW(P1,4), pw2[3]=PKW(P1,6), pw2); \
    VRD(3); SBAR(); GAPA(C0=__builtin_amdgcn_mfma_f32_32x32x16_bf16(kf[6],qr[3],C0,0,0,0),   P1[10],P1[11],P1[12],P1[13], pw3[0]=PKW(P1,8), pw3[1]=PKW(P1,10), pw3); \
    VRD(7); SBAR(); GAPA(C1=__builtin_amdgcn_mfma_f32_32x32x16_bf16(kf[7],qr[3],C1,0,0,0),   P1[14],P1[15],0.f,0.f,       pw3[2]=PKW(P1,12),pw3[3]=PKW(P1,14), pw3); \
    l_reg+=sacc; \
    if(GK){DMA_K((t)+3,sl_cur);} if(GV){DMA_V((t)+1,sl_next);} \
    CMASK(C0,C1,t); \
    { float a=MX3(C0[0],C0[1],C1[0]),b=MX3(C0[2],C0[3],C1[1]); a=MX3(a,C1[2],C1[3]); \
      _Pragma("unroll") for(int r=4;r<16;r+=4){a=MX3(a,C0[r],C0[r+1]);b=MX3(b,C0[r+2],C0[r+3]);a=MX3(a,C1[r],C1[r+1]);b=MX3(b,C1[r+2],C1[r+3]);} \
      float rm=__builtin_fmaxf(a,b); { auto rr=__builtin_amdgcn_permlane32_swap(__float_as_uint(rm),__float_as_uint(rm),false,false); rm=__builtin_fmaxf(__uint_as_float(rr[0]),__uint_as_float(rr[1])); } \
      resc=false; \
      if(__builtin_expect(__any(rm>(float)THRL),0)){ const float dl=__builtin_fmaxf(rm,0.f); mhat+=dl; \
        _Pragma("unroll") for(int r=0;r<16;++r){C0[r]-=dl;C1[r]-=dl;} \
        _Pragma("unroll") for(int r=0;r<16;++r)negm[r]=-mhat; asm volatile("":"+v"(negm)); \
        const float f=__builtin_amdgcn_exp2f(-dl); l_reg*=f; if(hi==0)wsf[r32]=f; resc=true; } } \
    SBAR(); \
    GAPB(o[0]=__builtin_amdgcn_mfma_f32_32x32x16_bf16(PAF(0),VFR(0),o[0],0,0,0), C0,0); \
    GAPB(o[1]=__builtin_amdgcn_mfma_f32_32x32x16_bf16(PAF(0),VFR(4),o[1],0,0,0), C0,4); \
    KRD(GL,0); GAPB(o[0]=__builtin_amdgcn_mfma_f32_32x32x16_bf16(PAF(1),VFR(1),o[0],0,0,0), C0,8); \
    KRD(GL,1); GAPB(o[1]=__builtin_amdgcn_mfma_f32_32x32x16_bf16(PAF(1),VFR(5),o[1],0,0,0), C0,12); \
    KRD(GL,2); GAPB(o[0]=__builtin_amdgcn_mfma_f32_32x32x16_bf16(PAF(2),VFR(2),o[0],0,0,0), C1,0); \
    KRD(GL,3); GAPB(o[1]=__builtin_amdgcn_mfma_f32_32x32x16_bf16(PAF(2),VFR(6),o[1],0,0,0), C1,4); \
    GAPB(o[0]=__builtin_amdgcn_mfma_f32_32x32x16_bf16(PAF(3),VFR(3),o[0],0,0,0), C1,8); \
    GAPB(o[1]=__builtin_amdgcn_mfma_f32_32x32x16_bf16(PAF(3),VFR(7),o[1],0,0,0), C1,12); \
    }while(0)
  int t=1;
  #undef CMASK
  #define CMASK(P0,P1,t) do{}while(0)
  for(;t+5<NT;t+=2){
    STEP(pB0,pB1,pA0,pA1,t,true,true,true);     WAIT_BAR(2); RESC(); ROT();
    STEP(pA0,pA1,pB0,pB1,t+1,true,true,true);   WAIT_BAR(2); RESC(); ROT();
  }
  #undef CMASK
  #define CMASK(P0,P1,t) do{}while(0)
  #define ENDW(tt) do{ if((tt)+3<NT){WAIT_BAR(2);} else if((tt)+2<NT){WAIT_BAR(1);} else {WAIT_BAR(0);} }while(0)
  for(;t+1<NT;t+=2){
    STEP(pB0,pB1,pA0,pA1,t,(t+3<NT),(t+1<NT),(t+1<NT));       ENDW(t);   RESC(); ROT();
    STEP(pA0,pA1,pB0,pB1,t+1,(t+4<NT),(t+2<NT),(t+2<NT));     ENDW(t+1); RESC(); ROT();
  }
  STEP(pB0,pB1,pA0,pA1,NT-1,false,false,false); RESC();
  { float sacc=pB0[0]+pB0[1]; _Pragma("unroll") for(int r=2;r<16;++r)sacc+=pB0[r]; _Pragma("unroll") for(int r=0;r<16;++r)sacc+=pB1[r]; l_reg+=sacc;
    pw0=(u32x4){PKW(pB0,0),PKW(pB0,2),PKW(pB0,4),PKW(pB0,6)};pw1=(u32x4){PKW(pB0,8),PKW(pB0,10),PKW(pB0,12),PKW(pB0,14)};pw2=(u32x4){PKW(pB1,0),PKW(pB1,2),PKW(pB1,4),PKW(pB1,6)};pw3=(u32x4){PKW(pB1,8),PKW(pB1,10),PKW(pB1,12),PKW(pB1,14)};
    SBAR(); pv(o,vb0+sl_cur,PAF(0),PAF(1),PAF(2),PAF(3)); }
  #undef PKW
  #undef PAF
  #undef VFR
  #undef PIN
  #undef MX3
  #undef GAPA
  #undef GAPB
  #undef EX
  #undef VRD
  #undef KRD
  #undef STEP
  #undef ENDW
  {auto rr=__builtin_amdgcn_permlane32_swap(__float_as_uint(l_reg),__float_as_uint(l_reg),false,false);l_reg=__uint_as_float(rr[0])+__uint_as_float(rr[1]);}
  if(hi==0)wsf[32+r32]=l_reg;asm volatile("s_waitcnt lgkmcnt(0)":::"memory");
  float rli[16];
  #pragma unroll
  for(int r=0;r<16;++r)rli[r]=__builtin_amdgcn_rcpf(wsf[32+crow(r,hi)]);
  bf16*Ow=Ou+(long)(wid*QBLK)*QP;
  { bf16*stg=(bf16*)(shm+LDS_OST)+wid*2048;
    #pragma unroll
    for(int r=0;r<16;++r){const int orow=crow(r,hi);
      #pragma unroll
      for(int d0=0;d0<2;++d0)stg[orow*64+d0*32+r32]=__float2bfloat16(o[d0][r]*rli[r]);}
    asm volatile("s_waitcnt lgkmcnt(0)":::"memory");
    #pragma unroll
    for(int i=0;i<4;++i){const int row=i*8+(lane>>3),ch=lane&7; const u32x4 v=*(const u32x4*)(stg+row*64+ch*8); ATTN_STORE16(Ow+(long)row*QP+ch*8,v);} }
  asm volatile("s_waitcnt lgkmcnt(0)\n\ts_barrier":::"memory");
  #undef DMA_K
  #undef DMA_V
  #undef CMASK
  #undef START
  #undef RESC
  #undef ROT
}
constexpr int ATTN_LDS_BYTES=LDS_BYTES;
#undef SBAR
#undef WAIT_BAR
}
constexpr int NWAVES = 8;
constexpr int NLAT = 32768, NCTX = 1024, MALL = NLAT + NCTX, DM = 1024, SEQ = 8192, CTXL = 256, KVROWS = 8448, FFH = 2816;
constexpr size_t MiB = 1u << 20;
constexpr size_t WS_MOD = 0, WS_ROPE = 256 * 1024, WS_BAR = 280 * 1024, WS_SS = 296 * 1024, WS_SHW = 51 * MiB + 512 * 1024;
constexpr size_t WS_XN2 = 304 * MiB;
constexpr size_t WS_WQKV = 1 * MiB, WS_WO = 4 * MiB, WS_F1A = 6 * MiB, WS_F2A = 17 * MiB, WS_HIN = 23 * MiB, WS_HO = 33 * MiB, WS_F1B = 35 * MiB, WS_F2B = 46 * MiB, WS_HCTX = 52 * MiB, WS_XN = 56 * MiB;
constexpr size_t WS_U = 1 * MiB, WS_D = 18 * MiB;
constexpr size_t WS_QO = 122 * MiB, WS_K = 188 * MiB, WS_V = 205 * MiB, WS_HID0 = 122 * MiB;
constexpr size_t WS_HQ = 122 * MiB, WS_HG = 186 * MiB, WS_HV = 250 * MiB, WS_LFW = 314 * MiB, WS_LBW = 378 * MiB, WS_HB = 442 * MiB, WS_OBW = 56 * MiB, WS_OG = 122 * MiB, WS_HID1 = 186 * MiB;
constexpr size_t WS_HVC = 506 * MiB, WS_LFWC = 508 * MiB, WS_LBWC = 510 * MiB;
constexpr size_t WS_END = 512 * MiB;
static_assert(WS_HQ == pg8::OFF_HQ && WS_HG == pg8::OFF_HG && WS_HV == pg8::OFF_HV && WS_LFW == pg8::OFF_LFW && WS_LBW == pg8::OFF_LBW && WS_HVC == pg8::OFF_HVC && WS_LFWC == pg8::OFF_LFWC && WS_LBWC == pg8::OFF_LBWC, "EpiHgrnIn offsets");
constexpr size_t F1_ELEMS = (size_t)2 * FFH * DM, F2_ELEMS = (size_t)DM * FFH;
constexpr int RING_BYTES = 131072, LDS_BYTES = 147456;

#define LAS __attribute__((address_space(3)))
typedef unsigned short bf16;
typedef unsigned v4u __attribute__((ext_vector_type(4)));
typedef unsigned v2u __attribute__((ext_vector_type(2)));
typedef float f32x4 __attribute__((ext_vector_type(4)));
typedef float f32x16 __attribute__((ext_vector_type(16)));
typedef short bf16x8 __attribute__((ext_vector_type(8)));
typedef float f32x2_t __attribute__((ext_vector_type(2)));
typedef __bf16 bf16x2_t __attribute__((ext_vector_type(2)));
__device__ __forceinline__ unsigned pk2(float lo, float hi) { f32x2_t v = {lo, hi}; bf16x2_t b = __builtin_convertvector(v, bf16x2_t); return __builtin_bit_cast(unsigned, b); }
__device__ __forceinline__ unsigned short f2bf(float f) { return (unsigned short)(pk2(f, 0.f) & 0xffffu); }
__device__ __forceinline__ float bf2f(unsigned short h) { return __builtin_bit_cast(float, (unsigned)h << 16); }
__device__ __forceinline__ float h2f(unsigned short h) { return (float)__builtin_bit_cast(_Float16, h); }
__device__ __forceinline__ float wave_sum(float v) {
#pragma unroll
    for (int o = 1; o < 64; o <<= 1) v += __shfl_xor(v, o);
    return v;
}
#define LDS_WAIT() asm volatile("s_waitcnt lgkmcnt(0)" ::: "memory")

template <int MODE> __device__ __forceinline__ int wmap(int o) {
    if (MODE == 1) { const int tile = o >> 8, w = o & 255, wc = w >> 6, bj = (w >> 5) & 1, e = w & 31; return tile * 256 + 128 * bj + 32 * wc + e; }
    if (MODE == 2) { const int half = o >= FFH ? 1 : 0, idx = o - half * FFH, pn = idx >> 7, q = idx & 127; return 256 * pn + 128 * half + q; }
    return o;
}
template <int MODE> __device__ __forceinline__ void p0_transpose_item(const float* W, int K, int N, bf16* WT, LAS float* scr, int item, int lane) {
    const int nblk = N / 32, kb = item / nblk, nb = item % nblk, k0 = 64 * kb, n0 = 32 * nb;
    float tv[32];
#pragma unroll
    for (int i = 0; i < 32; ++i) tv[i] = W[(size_t)(k0 + 2 * i + (lane >> 5)) * N + n0 + (lane & 31)];
#pragma unroll
    for (int i = 0; i < 32; ++i) scr[(2 * i + (lane >> 5)) * 33 + (lane & 31)] = tv[i];
    LDS_WAIT(); asm volatile("" ::: "memory");
    const int c = lane & 7;
#pragma unroll
    for (int j = 0; j < 4; ++j) { const int n = (lane >> 3) + 8 * j; const LAS float* s = scr + (8 * c) * 33 + n;
        v4u o; o.x = pk2(s[0 * 33], s[1 * 33]); o.y = pk2(s[2 * 33], s[3 * 33]); o.z = pk2(s[4 * 33], s[5 * 33]); o.w = pk2(s[6 * 33], s[7 * 33]);
        *(v4u*)(WT + (size_t)wmap<MODE>(n0 + n) * K + k0 + 8 * c) = o; }
    LDS_WAIT(); asm volatile("" ::: "memory");
}

__device__ __forceinline__ void norm_row_pair(int ra, int rb, bool hasb, int lane, const float* src_lat, const float* src_ctx, const float* w, const float* modl, int shi, int sci, bf16* XN) {
    const float* srca = ra < NLAT ? src_lat + (size_t)ra * DM : src_ctx + (size_t)(ra - NLAT) * DM;
    const float* srcb = rb < NLAT ? src_lat + (size_t)rb * DM : src_ctx + (size_t)(rb - NLAT) * DM;
    const int veca = ra < NLAT ? (ra >> 13) : 4, vecb = rb < NLAT ? (rb >> 13) : 4;
    f32x4 va[4], vb[4]; float sa = 0.f, sb = 0.f;
#pragma unroll
    for (int j = 0; j < 4; ++j) { va[j] = ((const f32x4*)srca + lane)[64 * j]; vb[j] = ((const f32x4*)srcb + lane)[64 * j]; }
#pragma unroll
    for (int j = 0; j < 4; ++j) { sa += (va[j].x * va[j].x + va[j].y * va[j].y) + (va[j].z * va[j].z + va[j].w * va[j].w); sb += (vb[j].x * vb[j].x + vb[j].y * vb[j].y) + (vb[j].z * vb[j].z + vb[j].w * vb[j].w); }
    const float rstda = rsqrtf(wave_sum(sa) * (1.f / DM) + 1e-6f), rstdb = rsqrtf(wave_sum(sb) * (1.f / DM) + 1e-6f);
    const f32x4* wp = (const f32x4*)w + lane;
    const f32x4* sha = (const f32x4*)(modl + veca * 6144 + shi * 1024) + lane; const f32x4* sca = (const f32x4*)(modl + veca * 6144 + sci * 1024) + lane;
    const f32x4* shb = (const f32x4*)(modl + vecb * 6144 + shi * 1024) + lane; const f32x4* scb = (const f32x4*)(modl + vecb * 6144 + sci * 1024) + lane;
    unsigned long long* oa = (unsigned long long*)(XN + (size_t)ra * DM) + lane; unsigned long long* ob = (unsigned long long*)(XN + (size_t)rb * DM) + lane;
#pragma unroll
    for (int j = 0; j < 4; ++j) { const f32x4 ww = wp[64 * j];
        const f32x4 ya = va[j] * rstda * ww * (sca[64 * j] + 1.0f) + sha[64 * j];
        oa[64 * j] = (unsigned long long)pk2(ya.x, ya.y) | ((unsigned long long)pk2(ya.z, ya.w) << 32);
        if (hasb) { const f32x4 yb = vb[j] * rstdb * ww * (scb[64 * j] + 1.0f) + shb[64 * j]; ob[64 * j] = (unsigned long long)pk2(yb.x, yb.y) | ((unsigned long long)pk2(yb.z, yb.w) << 32); } }
}
__device__ __forceinline__ void norm_rows(int gw, int NGW, int lane, const float* src_lat, const float* src_ctx, int r0, int nrows, const float* w, const float* modl, int shi, int sci, bf16* XN) {
    for (int r = r0 + gw; r < nrows; r += 2 * NGW) { const bool hasb = r + NGW < nrows; norm_row_pair(r, hasb ? r + NGW : r, hasb, lane, src_lat, src_ctx, w, modl, shi, sci, XN); }
}
__device__ __forceinline__ void final_norm_rows(int gw, int NGW, int lane, float* h, const float* w) {
    for (int r = gw; r < NLAT; r += NGW) {
        f32x4* xr = (f32x4*)(h + (size_t)r * DM) + lane;
        f32x4 v[4]; float s = 0.f;
#pragma unroll
        for (int j = 0; j < 4; ++j) { v[j] = xr[64 * j]; s += (v[j].x * v[j].x + v[j].y * v[j].y) + (v[j].z * v[j].z + v[j].w * v[j].w); }
        const float rstd = rsqrtf(wave_sum(s) * (1.f / DM) + 1e-6f);
        const f32x4* wp = (const f32x4*)w + lane;
#pragma unroll
        for (int j = 0; j < 4; ++j) xr[64 * j] = v[j] * rstd * wp[64 * j];
    }
}

constexpr int SC_Q0 = 0, SC_QM = 17408, SC_KE = 34816, SC_KT = 52224, SC_VT = 70656, SC_ST = 89088, SC_AT = 123904, SC_PS = 133120, SC_EL = 137216;
constexpr int NSTR = 272, TSTR = 144;
static_assert(SC_EL + 512 <= LDS_BYTES, "scan LDS map");
__device__ __forceinline__ int crow(int r, int hi) { return (r & 3) + 8 * (r >> 2) + 4 * hi; }
__device__ __forceinline__ int scan_row(int c, int s, int b, int dir) {
    if (c < 4) { const int idx = 64 * c + s; return NLAT + b * CTXL + (dir ? (CTXL - 1 - idx) : idx); }
    const int idx = 64 * (c - 4) + s; return b * SEQ + (dir ? (SEQ - 1 - idx) : idx);
}
#define MFMA32(a, b, c) __builtin_amdgcn_mfma_f32_32x32x16_bf16((a), (b), (c), 0, 0, 0)
template <int MODE> __device__ __forceinline__ void hgrn_scan_item(LAS unsigned char* lds, int item, const bf16* HQ, const bf16* HV, const bf16* LFW, const bf16* LBW, const bf16* HVc, const bf16* LFWc, const bf16* LBWc, bf16* OFW, bf16* OBW, float* UB, float* DB) {
    int tid_ = threadIdx.x; asm volatile("" : "+v"(tid_));
    const int tid = tid_, lane = tid & 63, wid = __builtin_amdgcn_readfirstlane(tid >> 6), r32 = lane & 31, hi = lane >> 5;
    const int seg = item & 3, stream = item >> 2, dir = stream & 1, h = (stream >> 1) & 7, b = stream >> 4;
    if (MODE == 0 && seg == 3) return;
    const bf16* LF = dir ? LBW : LFW; bf16* OX = dir ? OBW : OFW;
    const bf16* LFc = (dir ? LBWc : LFWc) - (size_t)NLAT * DM; const bf16* HVcb = HVc - (size_t)NLAT * DM;
    const int kp = lane, g = wid;
    const unsigned voff2 = (unsigned)(h * 128 + 2 * kp) * 2u;
    const int vt = wid & 3, th = wid >> 2;
    unsigned lfrA[8], qrA[8], vrA[8], lfrB[8], qrB[8], vrB[8];
#define SCAN_LOAD(LFR, QR, VR, c) do { const bf16* lfb_ = (c) < 4 ? LFc : LF; const bf16* hvb_ = (c) < 4 ? HVcb : HV; \
        _Pragma("unroll") for (int i = 0; i < 8; ++i) { const size_t r_ = (size_t)__builtin_amdgcn_readfirstlane(scan_row((c), 8 * g + i, b, dir)) * (DM * 2);     \
            LFR[i] = *(const unsigned*)((const char*)lfb_ + r_ + voff2); VR[i] = *(const unsigned*)((const char*)hvb_ + r_ + voff2); \
            if (MODE == 1) QR[i] = *(const unsigned*)((const char*)HQ + r_ + voff2);     } } while (0)
    f32x16 S[2];
#pragma unroll
    for (int j = 0; j < 2; ++j)
#pragma unroll
        for (int i = 0; i < 16; ++i) S[j][i] = 0.f;
    if (MODE == 1) {
        for (int js = 0; js < seg; ++js) { const int it = stream * 4 + js;
#pragma unroll
            for (int j = 0; j < 2; ++j)
#pragma unroll
                for (int i = 0; i < 16; ++i) S[j][i] = S[j][i] * DB[it * 128 + 32 * (2 * th + j) + crow(i, hi)] + UB[((size_t)it * 32 + j * 16 + i) * 512 + tid]; }
        *(LAS unsigned*)(lds + SC_AT + (tid >> 4) * TSTR + 64 + 4 * (tid & 15)) = 0u;
    }
    float dacc0 = 1.f, dacc1 = 1.f;
    const int c0 = 33 * seg;
    SCAN_LOAD(lfrA, qrA, vrA, c0); SCAN_LOAD(lfrB, qrB, vrB, c0 + 1);
    for (int cc = c0; cc < c0 + 33; cc += 2) {
      { const int c = cc;
        const bool has_out = (MODE == 1) && c >= 4;
        f32x2_t lf[8]; f32x2_t ps = {0.f, 0.f};
#pragma unroll
        for (int i = 0; i < 8; ++i) { lf[i] = (f32x2_t){h2f((unsigned short)(lfrA[i] & 0xffffu)), h2f((unsigned short)(lfrA[i] >> 16))}; ps += lf[i]; }
        *(LAS f32x2_t*)(lds + SC_PS + (g * 128 + 2 * kp) * 4) = ps;
        LDS_WAIT(); __builtin_amdgcn_s_barrier(); asm volatile("" ::: "memory");
        {
            f32x2_t pre = {0.f, 0.f}, Lmid = {0.f, 0.f}, Lend = {0.f, 0.f};
#pragma unroll
            for (int gg = 0; gg < 8; ++gg) { const f32x2_t p = *(const LAS f32x2_t*)(lds + SC_PS + (gg * 128 + 2 * kp) * 4); if (gg < g) pre += p; if (gg < 4) Lmid += p; Lend += p; }
            const f32x2_t eLmid = {__expf(Lmid.x), __expf(Lmid.y)}, eEndMid = {__expf(Lend.x - Lmid.x), __expf(Lend.y - Lmid.y)};
            if (g == 0) { const f32x2_t el = {__expf(Lend.x), __expf(Lend.y)}; *(LAS f32x2_t*)(lds + SC_EL + 2 * kp * 4) = el; dacc0 *= el.x; dacc1 *= el.y; }
            f32x2_t E = {__expf(pre.x - Lmid.x), __expf(pre.y - Lmid.y)};
            unsigned kt0[4], kt1[4];
#pragma unroll
            for (int i = 0; i < 8; ++i) {
                const f32x2_t f = {__expf(lf[i].x), __expf(lf[i].y)};
                E = E * f;
                const f32x2_t re = {__builtin_amdgcn_rcpf(E.x), __builtin_amdgcn_rcpf(E.y)};
                const f32x2_t ke = (1.0f - f) * re, kend = ke * eEndMid;
                const int s = 8 * g + i;
                if (has_out) {
                    const f32x2_t q = {bf2f((unsigned short)(qrA[i] & 0xffffu)), bf2f((unsigned short)(qrA[i] >> 16))};
                    const f32x2_t qm = q * E, q0 = qm * eLmid;
                    *(LAS unsigned*)(lds + SC_Q0 + s * NSTR + 4 * kp) = pk2(q0.x, q0.y);
                    *(LAS unsigned*)(lds + SC_QM + s * NSTR + 4 * kp) = pk2(qm.x, qm.y);
                    *(LAS unsigned*)(lds + SC_KE + s * NSTR + 4 * kp) = pk2(ke.x, ke.y);
                }
                const unsigned kd = pk2(kend.x, kend.y);
                if (i & 1) { kt0[i >> 1] |= kd << 16; kt1[i >> 1] |= kd & 0xffff0000u; } else { kt0[i >> 1] = kd & 0xffffu; kt1[i >> 1] = kd >> 16; }
            }
            *(LAS v4u*)(lds + SC_KT + (2 * kp) * TSTR + 16 * g) = (v4u){kt0[0], kt0[1], kt0[2], kt0[3]};
            *(LAS v4u*)(lds + SC_KT + (2 * kp + 1) * TSTR + 16 * g) = (v4u){kt1[0], kt1[1], kt1[2], kt1[3]};
            v4u v0, v1;
#pragma unroll
            for (int i2 = 0; i2 < 4; ++i2) { v0[i2] = (vrA[2 * i2] & 0xffffu) | (vrA[2 * i2 + 1] << 16); v1[i2] = (vrA[2 * i2] >> 16) | (vrA[2 * i2 + 1] & 0xffff0000u); }
            *(LAS v4u*)(lds + SC_VT + (2 * kp) * TSTR + 16 * g) = v0;
            *(LAS v4u*)(lds + SC_VT + (2 * kp + 1) * TSTR + 16 * g) = v1;
            if (has_out) {
#pragma unroll
                for (int j = 0; j < 2; ++j)
#pragma unroll
                    for (int g4 = 0; g4 < 4; ++g4)
                        *(LAS v2u*)(lds + SC_ST + (32 * vt + r32) * NSTR + (32 * (2 * th + j) + 8 * g4 + 4 * hi) * 2) = (v2u){pk2(S[j][4 * g4], S[j][4 * g4 + 1]), pk2(S[j][4 * g4 + 2], S[j][4 * g4 + 3])};
            }
        }
        if (c + 2 < c0 + 33) SCAN_LOAD(lfrA, qrA, vrA, c + 2);
        LDS_WAIT(); __builtin_amdgcn_s_barrier(); asm volatile("" ::: "memory");
        f32x16 o;
#pragma unroll
        for (int i = 0; i < 16; ++i) o[i] = 0.f;
        if (has_out && wid < 3) {
            const int si = wid >> 1, ti = (wid + 1) >> 1;
            f32x16 a;
#pragma unroll
            for (int i = 0; i < 16; ++i) a[i] = 0.f;
#pragma unroll
            for (int kk = 0; kk < 8; ++kk) {
                const bf16x8 A = *(const LAS bf16x8*)(lds + SC_KE + (32 * si + r32) * NSTR + (16 * kk + 8 * hi) * 2);
                const bf16x8 B = *(const LAS bf16x8*)(lds + SC_QM + (32 * ti + r32) * NSTR + (16 * kk + 8 * hi) * 2);
                a = MFMA32(A, B, a);
            }
            const int t = 32 * ti + r32;
#pragma unroll
            for (int g4 = 0; g4 < 4; ++g4) {
                const int s0 = 32 * si + 8 * g4 + 4 * hi;
                const float a0 = (s0 + 0 <= t) ? a[4 * g4 + 0] : 0.f, a1 = (s0 + 1 <= t) ? a[4 * g4 + 1] : 0.f, a2 = (s0 + 2 <= t) ? a[4 * g4 + 2] : 0.f, a3 = (s0 + 3 <= t) ? a[4 * g4 + 3] : 0.f;
                *(LAS v2u*)(lds + SC_AT + t * TSTR + s0 * 2) = (v2u){pk2(a0, a1), pk2(a2, a3)};
            }
        }
        {
            const LAS float* EL = (const LAS float*)(lds + SC_EL);
#pragma unroll
            for (int j = 0; j < 2; ++j) {
                const int kq = 2 * th + j;
#pragma unroll
                for (int i = 0; i < 16; ++i) S[j][i] *= EL[32 * kq + crow(i, hi)];
#pragma unroll
                for (int kk = 0; kk < 4; ++kk) {
                    const bf16x8 A = *(const LAS bf16x8*)(lds + SC_KT + (32 * kq + r32) * TSTR + (16 * kk + 8 * hi) * 2);
                    const bf16x8 B = *(const LAS bf16x8*)(lds + SC_VT + (32 * vt + r32) * TSTR + (16 * kk + 8 * hi) * 2);
                    S[j] = MFMA32(A, B, S[j]);
                }
            }
            if (has_out) {
#pragma unroll
                for (int kk = 0; kk < 8; ++kk) {
                    const bf16x8 A = *(const LAS bf16x8*)(lds + SC_Q0 + (32 * th + r32) * NSTR + (16 * kk + 8 * hi) * 2);
                    const bf16x8 B = *(const LAS bf16x8*)(lds + SC_ST + (32 * vt + r32) * NSTR + (16 * kk + 8 * hi) * 2);
                    o = MFMA32(A, B, o);
                }
            }
        }
        LDS_WAIT(); __builtin_amdgcn_s_barrier(); asm volatile("" ::: "memory");
        if (has_out) {
#pragma unroll
            for (int kk = 0; kk < 4; ++kk) {
                const bf16x8 A = *(const LAS bf16x8*)(lds + SC_AT + (32 * th + r32) * TSTR + (16 * kk + 8 * hi) * 2);
                const bf16x8 B = *(const LAS bf16x8*)(lds + SC_VT + (32 * vt + r32) * TSTR + (16 * kk + 8 * hi) * 2);
                o = MFMA32(A, B, o);
            }
#pragma unroll
            for (int i = 0; i < 16; ++i) *(LAS unsigned short*)(lds + SC_Q0 + wid * 2560 + crow(i, hi) * 80 + 2 * r32) = f2bf(o[i]);
            LDS_WAIT(); asm volatile("" ::: "memory");
#pragma unroll
            for (int j2 = 0; j2 < 2; ++j2) { const int tl = j2 * 16 + (lane >> 2), pc = lane & 3; const v4u pv = *(const LAS v4u*)(lds + SC_Q0 + wid * 2560 + tl * 80 + 16 * pc);
                const size_t r_ = (size_t)scan_row(c, 32 * th + tl, b, dir); *(v4u*)(OX + r_ * DM + h * 128 + 32 * vt + 8 * pc) = pv; }
        }
          }
      if (cc + 1 < c0 + 33) { const int c = cc + 1;
        const bool has_out = (MODE == 1) && c >= 4;
        f32x2_t lf[8]; f32x2_t ps = {0.f, 0.f};
#pragma unroll
        for (int i = 0; i < 8; ++i) { lf[i] = (f32x2_t){h2f((unsigned short)(lfrB[i] & 0xffffu)), h2f((unsigned short)(lfrB[i] >> 16))}; ps += lf[i]; }
        *(LAS f32x2_t*)(lds + SC_PS + (g * 128 + 2 * kp) * 4) = ps;
        LDS_WAIT(); __builtin_amdgcn_s_barrier(); asm volatile("" ::: "memory");
        {
            f32x2_t pre = {0.f, 0.f}, Lmid = {0.f, 0.f}, Lend = {0.f, 0.f};
#pragma unroll
            for (int gg = 0; gg < 8; ++gg) { const f32x2_t p = *(const LAS f32x2_t*)(lds + SC_PS + (gg * 128 + 2 * kp) * 4); if (gg < g) pre += p; if (gg < 4) Lmid += p; Lend += p; }
            const f32x2_t eLmid = {__expf(Lmid.x), __expf(Lmid.y)}, eEndMid = {__expf(Lend.x - Lmid.x), __expf(Lend.y - Lmid.y)};
            if (g == 0) { const f32x2_t el = {__expf(Lend.x), __expf(Lend.y)}; *(LAS f32x2_t*)(lds + SC_EL + 2 * kp * 4) = el; dacc0 *= el.x; dacc1 *= el.y; }
            f32x2_t E = {__expf(pre.x - Lmid.x), __expf(pre.y - Lmid.y)};
            unsigned kt0[4], kt1[4];
#pragma unroll
            for (int i = 0; i < 8; ++i) {
                const f32x2_t f = {__expf(lf[i].x), __expf(lf[i].y)};
                E = E * f;
                const f32x2_t re = {__builtin_amdgcn_rcpf(E.x), __builtin_amdgcn_rcpf(E.y)};
                const f32x2_t ke = (1.0f - f) * re, kend = ke * eEndMid;
                const int s = 8 * g + i;
                if (has_out) {
                    const f32x2_t q = {bf2f((unsigned short)(qrB[i] & 0xffffu)), bf2f((unsigned short)(qrB[i] >> 16))};
                    const f32x2_t qm = q * E, q0 = qm * eLmid;
                    *(LAS unsigned*)(lds + SC_Q0 + s * NSTR + 4 * kp) = pk2(q0.x, q0.y);
                    *(LAS unsigned*)(lds + SC_QM + s * NSTR + 4 * kp) = pk2(qm.x, qm.y);
                    *(LAS unsigned*)(lds + SC_KE + s * NSTR + 4 * kp) = pk2(ke.x, ke.y);
                }
                const unsigned kd = pk2(kend.x, kend.y);
                if (i & 1) { kt0[i >> 1] |= kd << 16; kt1[i >> 1] |= kd & 0xffff0000u; } else { kt0[i >> 1] = kd & 0xffffu; kt1[i >> 1] = kd >> 16; }
            }
            *(LAS v4u*)(lds + SC_KT + (2 * kp) * TSTR + 16 * g) = (v4u){kt0[0], kt0[1], kt0[2], kt0[3]};
            *(LAS v4u*)(lds + SC_KT + (2 * kp + 1) * TSTR + 16 * g) = (v4u){kt1[0], kt1[1], kt1[2], kt1[3]};
            v4u v0, v1;
#pragma unroll
            for (int i2 = 0; i2 < 4; ++i2) { v0[i2] = (vrB[2 * i2] & 0xffffu) | (vrB[2 * i2 + 1] << 16); v1[i2] = (vrB[2 * i2] >> 16) | (vrB[2 * i2 + 1] & 0xffff0000u); }
            *(LAS v4u*)(lds + SC_VT + (2 * kp) * TSTR + 16 * g) = v0;
            *(LAS v4u*)(lds + SC_VT + (2 * kp + 1) * TSTR + 16 * g) = v1;
            if (has_out) {
#pragma unroll
                for (int j = 0; j < 2; ++j)
#pragma unroll
                    for (int g4 = 0; g4 < 4; ++g4)
                        *(LAS v2u*)(lds + SC_ST + (32 * vt + r32) * NSTR + (32 * (2 * th + j) + 8 * g4 + 4 * hi) * 2) = (v2u){pk2(S[j][4 * g4], S[j][4 * g4 + 1]), pk2(S[j][4 * g4 + 2], S[j][4 * g4 + 3])};
            }
        }
        if (c + 2 < c0 + 33) SCAN_LOAD(lfrB, qrB, vrB, c + 2);
        LDS_WAIT(); __builtin_amdgcn_s_barrier(); asm volatile("" ::: "memory");
        f32x16 o;
#pragma unroll
        for (int i = 0; i < 16; ++i) o[i] = 0.f;
        if (has_out && wid < 3) {
            const int si = wid >> 1, ti = (wid + 1) >> 1;
            f32x16 a;
#pragma unroll
            for (int i = 0; i < 16; ++i) a[i] = 0.f;
#pragma unroll
            for (int kk = 0; kk < 8; ++kk) {
                const bf16x8 A = *(const LAS bf16x8*)(lds + SC_KE + (32 * si + r32) * NSTR + (16 * kk + 8 * hi) * 2);
                const bf16x8 B = *(const LAS bf16x8*)(lds + SC_QM + (32 * ti + r32) * NSTR + (16 * kk + 8 * hi) * 2);
                a = MFMA32(A, B, a);
            }
            const int t = 32 * ti + r32;
#pragma unroll
            for (int g4 = 0; g4 < 4; ++g4) {
                const int s0 = 32 * si + 8 * g4 + 4 * hi;
                const float a0 = (s0 + 0 <= t) ? a[4 * g4 + 0] : 0.f, a1 = (s0 + 1 <= t) ? a[4 * g4 + 1] : 0.f, a2 = (s0 + 2 <= t) ? a[4 * g4 + 2] : 0.f, a3 = (s0 + 3 <= t) ? a[4 * g4 + 3] : 0.f;
                *(LAS v2u*)(lds + SC_AT + t * TSTR + s0 * 2) = (v2u){pk2(a0, a1), pk2(a2, a3)};
            }
        }
        {
            const LAS float* EL = (const LAS float*)(lds + SC_EL);
#pragma unroll
            for (int j = 0; j < 2; ++j) {
                const int kq = 2 * th + j;
#pragma unroll
                for (int i = 0; i < 16; ++i) S[j][i] *= EL[32 * kq + crow(i, hi)];
#pragma unroll
                for (int kk = 0; kk < 4; ++kk) {
                    const bf16x8 A = *(const LAS bf16x8*)(lds + SC_KT + (32 * kq + r32) * TSTR + (16 * kk + 8 * hi) * 2);
                    const bf16x8 B = *(const LAS bf16x8*)(lds + SC_VT + (32 * vt + r32) * TSTR + (16 * kk + 8 * hi) * 2);
                    S[j] = MFMA32(A, B, S[j]);
                }
            }
            if (has_out) {
#pragma unroll
                for (int kk = 0; kk < 8; ++kk) {
                    const bf16x8 A = *(const LAS bf16x8*)(lds + SC_Q0 + (32 * th + r32) * NSTR + (16 * kk + 8 * hi) * 2);
                    const bf16x8 B = *(const LAS bf16x8*)(lds + SC_ST + (32 * vt + r32) * NSTR + (16 * kk + 8 * hi) * 2);
                    o = MFMA32(A, B, o);
                }
            }
        }
        LDS_WAIT(); __builtin_amdgcn_s_barrier(); asm volatile("" ::: "memory");
        if (has_out) {
#pragma unroll
            for (int kk = 0; kk < 4; ++kk) {
                const bf16x8 A = *(const LAS bf16x8*)(lds + SC_AT + (32 * th + r32) * TSTR + (16 * kk + 8 * hi) * 2);
                const bf16x8 B = *(const LAS bf16x8*)(lds + SC_VT + (32 * vt + r32) * TSTR + (16 * kk + 8 * hi) * 2);
                o = MFMA32(A, B, o);
            }
#pragma unroll
            for (int i = 0; i < 16; ++i) *(LAS unsigned short*)(lds + SC_Q0 + wid * 2560 + crow(i, hi) * 80 + 2 * r32) = f2bf(o[i]);
            LDS_WAIT(); asm volatile("" ::: "memory");
#pragma unroll
            for (int j2 = 0; j2 < 2; ++j2) { const int tl = j2 * 16 + (lane >> 2), pc = lane & 3; const v4u pv = *(const LAS v4u*)(lds + SC_Q0 + wid * 2560 + tl * 80 + 16 * pc);
                const size_t r_ = (size_t)scan_row(c, 32 * th + tl, b, dir); *(v4u*)(OX + r_ * DM + h * 128 + 32 * vt + 8 * pc) = pv; }
        }
          }
    }
#undef SCAN_LOAD
    if (MODE == 0) {
#pragma unroll
        for (int j = 0; j < 2; ++j)
#pragma unroll
            for (int i = 0; i < 16; ++i) UB[((size_t)item * 32 + j * 16 + i) * 512 + tid] = S[j][i];
        if (g == 0) { DB[item * 128 + 2 * kp] = dacc0; DB[item * 128 + 2 * kp + 1] = dacc1; }
    }
    LDS_WAIT(); __builtin_amdgcn_s_barrier(); asm volatile("" ::: "memory");
}
__device__ __forceinline__ void hgrn_combine(int gw, int NGW, int lane, const bf16* OFW, const bf16* OBW, const bf16* HG, const float* onorm, bf16* OG) {
    float wn[16];
#pragma unroll
    for (int e = 0; e < 16; ++e) wn[e] = onorm[lane * 16 + e];
    for (int r0 = gw; r0 < NLAT; r0 += 2 * NGW) {
        const bool hasb = r0 + NGW < NLAT; const int r1 = hasb ? r0 + NGW : r0;
        v4u a[2][2], bq[2][2], gg[2][2];
#pragma unroll
        for (int k = 0; k < 2; ++k) { const size_t off = (size_t)(k ? r1 : r0) * DM + lane * 16;
#pragma unroll
            for (int j = 0; j < 2; ++j) { a[k][j] = *(const v4u*)(OFW + off + 8 * j); bq[k][j] = *(const v4u*)(OBW + off + 8 * j); gg[k][j] = *(const v4u*)(HG + off + 8 * j); } }
#pragma unroll
        for (int k = 0; k < 2; ++k) {
            if (k == 1 && !hasb) break;
            float o[16], gt[16];
#pragma unroll
            for (int j = 0; j < 2; ++j)
#pragma unroll
                for (int e = 0; e < 4; ++e) { o[8 * j + 2 * e] = bf2f((unsigned short)(a[k][j][e] & 0xffffu)) + bf2f((unsigned short)(bq[k][j][e] & 0xffffu)); o[8 * j + 2 * e + 1] = bf2f((unsigned short)(a[k][j][e] >> 16)) + bf2f((unsigned short)(bq[k][j][e] >> 16));
                    gt[8 * j + 2 * e] = bf2f((unsigned short)(gg[k][j][e] & 0xffffu)); gt[8 * j + 2 * e + 1] = bf2f((unsigned short)(gg[k][j][e] >> 16)); }
            float ss = 0.f;
#pragma unroll
            for (int e = 0; e < 16; ++e) ss += o[e] * o[e];
            ss += __shfl_xor(ss, 1); ss += __shfl_xor(ss, 2); ss += __shfl_xor(ss, 4);
            const float rstd = rsqrtf(ss * (1.f / 128.f) + 1e-6f);
            unsigned pk[8];
#pragma unroll
            for (int e = 0; e < 8; ++e) { const float y0 = o[2 * e] * rstd * wn[2 * e] * __builtin_amdgcn_rcpf(1.0f + __expf(-gt[2 * e])), y1 = o[2 * e + 1] * rstd * wn[2 * e + 1] * __builtin_amdgcn_rcpf(1.0f + __expf(-gt[2 * e + 1])); pk[e] = pk2(y0, y1); }
            const size_t off = (size_t)(k ? r1 : r0) * DM + lane * 16;
            *(v4u*)(OG + off) = (v4u){pk[0], pk[1], pk[2], pk[3]}; *(v4u*)(OG + off + 8) = (v4u){pk[4], pk[5], pk[6], pk[7]};
        }
    }
}

#define XB_TMO      128
#define XB_XCNT(j)  (256  + 64 * (j))
#define XB_XSUB(j)  (1280 + 64 * (j))
#define XB_XGEN(j)  (2304 + 64 * (j))
#define XB_TOP      3328
#define XB_TOPGEN   3392
#define XCD_BAR_WORDS 3456
#define XB_SPIN_CAP (1u << 18)

__device__ __forceinline__ unsigned xb_ld(unsigned* p)              { return __hip_atomic_load(p, __ATOMIC_RELAXED, __HIP_MEMORY_SCOPE_AGENT); }
__device__ __forceinline__ unsigned xb_add(unsigned* p, unsigned v) { return __hip_atomic_fetch_add(p, v, __ATOMIC_RELAXED, __HIP_MEMORY_SCOPE_AGENT); }
__device__ __forceinline__ unsigned xb_xcc_id() { return (unsigned)__builtin_amdgcn_s_getreg((3 << 11) | 20) & 0xFu; }
#define XB_SPIN(cond, bar) do { unsigned _sp = 0; while (cond) { __builtin_amdgcn_s_sleep(1); \
    if ((++_sp & 255u) == 0u) { if (xb_ld(&(bar)[XB_TMO])) break; if (_sp > XB_SPIN_CAP) { atomicAdd(&(bar)[XB_TMO], 1u); break; } } } } while (0)

struct XcdBarrier {
    unsigned* bar; unsigned x;
    volatile LAS unsigned* st;
};

__device__ __forceinline__ XcdBarrier xcd_barrier_post(unsigned* bar, volatile LAS unsigned* st) {
    XcdBarrier b; b.bar = bar; b.x = xb_xcc_id(); b.st = st;
    if (threadIdx.x == 0) (void)xb_add(&bar[XB_XCNT(b.x)], 1u);
    return b;
}
__device__ __forceinline__ void xcd_barrier_complete(unsigned* bar, unsigned x, unsigned& nloc, unsigned& nx) {
    const unsigned G = gridDim.x * gridDim.y * gridDim.z;
    unsigned sum, cnt, mine, sp = 0u;
    for (;;) {
        sum = 0u; cnt = 0u; mine = 0u;
#pragma unroll
        for (unsigned j = 0; j < 16; ++j) { const unsigned c = xb_ld(&bar[XB_XCNT(j)]); sum += c; cnt += (c > 0u) ? 1u : 0u; mine = (j == x) ? c : mine; }
        if (sum == G) break;
        __builtin_amdgcn_s_sleep(1);
        if ((++sp & 255u) == 0u) { if (xb_ld(&bar[XB_TMO])) break; if (sp > XB_SPIN_CAP) { atomicAdd(&bar[XB_TMO], 1u); break; } }
    }
    nloc = mine > 0u ? mine : 1u; nx = cnt > 0u ? cnt : 1u;
}

__device__ __forceinline__ void xcd_barrier(const XcdBarrier& b) {
    asm volatile("s_waitcnt vmcnt(0)" ::: "memory");
    __syncthreads();
    if (threadIdx.x == 0) {
        unsigned* bar = b.bar;
        __builtin_amdgcn_s_waitcnt(0);
        unsigned nloc = b.st[0], nx = b.st[1];
        if (nloc == 0u) { xcd_barrier_complete(bar, b.x, nloc, nx); b.st[0] = nloc; b.st[1] = nx; }
        const unsigned old = xb_add(&bar[XB_XSUB(b.x)], 1u);
        const unsigned gen = old / nloc;
        if (old + 1u == (gen + 1u) * nloc) {
            __builtin_amdgcn_fence(__ATOMIC_RELEASE, "agent");
            asm volatile("s_waitcnt vmcnt(0)" ::: "memory");
            const unsigned og = xb_add(&bar[XB_TOP], 1u);
            const unsigned tg = og / nx;
            if (og + 1u == (tg + 1u) * nx) xb_add(&bar[XB_TOPGEN], 1u);
            else XB_SPIN(xb_ld(&bar[XB_TOPGEN]) == tg, bar);
            __builtin_amdgcn_fence(__ATOMIC_ACQUIRE, "agent");
            xb_add(&bar[XB_XGEN(b.x)], 1u);
            asm volatile("s_waitcnt vmcnt(0)" ::: "memory");
        } else {
            XB_SPIN(xb_ld(&bar[XB_XGEN(b.x)]) == gen, bar);
            __builtin_amdgcn_fence(__ATOMIC_ACQUIRE, "agent");
            asm volatile("s_waitcnt vmcnt(0)" ::: "memory");
        }
    }
    __syncthreads();
}

struct Args { const float* in[19]; float* out; unsigned char* ws; };
typedef __attribute__((address_space(4))) Args KArgs;
__device__ __forceinline__ int fresh_v(int t) { asm volatile("" : "+v"(t)); return t; }
__device__ __forceinline__ int fresh_s(int t) { asm volatile("" : "+s"(t)); return t; }
__global__ void __launch_bounds__(NWAVES * 64, 2) mk_fwd(Args args) {
    extern __shared__ __attribute__((aligned(16))) unsigned char lds_raw[];
    LAS unsigned char* lds = (LAS unsigned char*)lds_raw;
    cg::grid_group grid = cg::this_grid();
#define PHASE_IDS() const int tid = fresh_v((int)threadIdx.x), lane = tid & 63, wave = __builtin_amdgcn_readfirstlane(tid >> 6); (void)lane; (void)wave; \
    const int G = fresh_s((int)gridDim.x), bx = fresh_s((int)blockIdx.x); const int vcu = (G % 8 == 0) ? (bx % 8) * (G / 8) + bx / 8 : bx; (void)vcu; \
    const int gw = vcu * NWAVES + wave, NGW = G * NWAVES; (void)gw; (void)NGW; \
    const KArgs* ap = (const KArgs*)__builtin_amdgcn_kernarg_segment_ptr(); asm volatile("" : "+s"(ap)); unsigned char* ws = ap->ws; (void)ws
#define IN(k) (ap->in[k])
#define MOD ((float*)(ws + WS_MOD))
#define ROPEC ((float*)(ws + WS_ROPE))
#define ROPES (ROPEC + 128 * 16)
#define Wqkv_t ((bf16*)(ws + WS_WQKV))
#define Wo_t ((bf16*)(ws + WS_WO))
#define Hin_t ((bf16*)(ws + WS_HIN))
#define Ho_t ((bf16*)(ws + WS_HO))
#define F1A_t ((bf16*)(ws + WS_F1A))
#define F2A_t ((bf16*)(ws + WS_F2A))
#define F1B_t ((bf16*)(ws + WS_F1B))
#define F2B_t ((bf16*)(ws + WS_F2B))
#define HCTX ((bf16*)(ws + WS_HCTX))
#define HB ((bf16*)(ws + WS_HB))
#define OFWP ((bf16*)(ap->out))
#define XN ((bf16*)(ws + WS_XN))
#define QO ((bf16*)(ws + WS_QO))
#define KB ((bf16*)(ws + WS_K))
#define VB ((bf16*)(ws + WS_V))
#define MOD1 (MOD + 5 * 6144)
#define SS0 ((float*)(ws + WS_SS))
#define SS1 (SS0 + MALL)
#define SS2 (SS1 + MALL)
#define SS3 (SS2 + MALL)
#define SHW0 ((float*)(ws + WS_SHW))
#define SHW1 (SHW0 + 5 * 5632)
#define SHW2 (SHW1 + 5 * 5120)
    if (args.ws == nullptr) grid.sync();
    volatile LAS unsigned* bst = (volatile LAS unsigned*)(lds + LDS_BYTES - 16);
    if (threadIdx.x == 0) { bst[0] = 0u; bst[1] = 0u; }
    __syncthreads();
    const XcdBarrier bar = xcd_barrier_post((unsigned*)(args.ws + WS_BAR), bst);
    {
        PHASE_IDS();
        for (int i = (bx * NWAVES * 64) + tid; i < 4 * MALL; i += G * NWAVES * 64) SS0[i] = 0.f;
        LAS float* sl = (LAS float*)(lds + 73728);
        for (int i = tid; i < 5 * 1024; i += NWAVES * 64) { const float v = i < 4096 ? (ap->in[1])[i] : (ap->in[3])[i - 4096]; sl[i] = v / (1.0f + __expf(-v)); }
        __syncthreads();
        for (int it = gw; it < 768; it += NGW) {
            const int l = it / 384, n0 = (it % 384) * 16, cg4 = lane & 3, ks = lane >> 2;
            const float* W = (ap->in[4]) + (size_t)l * 1024 * 6144 + n0 + 4 * cg4;
            f32x4 acc[5];
#pragma unroll
            for (int v = 0; v < 5; ++v) acc[v] = (f32x4){0.f, 0.f, 0.f, 0.f};
#pragma unroll 8
            for (int i = 0; i < 64; ++i) { const int kk = i * 16 + ks; const f32x4 w4 = *(const f32x4*)(W + (size_t)kk * 6144);
#pragma unroll
                for (int v = 0; v < 5; ++v) acc[v] += w4 * sl[v * 1024 + kk]; }
#pragma unroll
            for (int v = 0; v < 5; ++v)
#pragma unroll
                for (int e = 0; e < 4; ++e) { float a = acc[v][e]; a += __shfl_xor(a, 4); a += __shfl_xor(a, 8); a += __shfl_xor(a, 16); a += __shfl_xor(a, 32); acc[v][e] = a; }
            if (ks == 0) { const f32x4 bb = *(const f32x4*)((ap->in[5]) + l * 6144 + n0 + 4 * cg4);
#pragma unroll
                for (int v = 0; v < 5; ++v) *(f32x4*)(MOD + (size_t)(l * 5 + v) * 6144 + n0 + 4 * cg4) = acc[v] + bb; }
        }
        for (int idx = bx * (NWAVES * 64) + tid; idx < 2048; idx += G * NWAVES * 64) {
            const int pos = idx >> 4, f = idx & 15;
            double inv = 1.0; for (int j = 0; j < f; ++j) inv *= 0.56234132519034908;
            const double ang = (double)pos * inv, TWO_PI = 6.283185307179586476925;
            const double kq = __builtin_rint(ang / TWO_PI); const double rr = ang - kq * TWO_PI, r2 = rr * rr;
            double cs = 1.0, sn = rr, tc = 1.0, tsn = rr;
            for (int n = 1; n <= 14; ++n) { tc *= -r2 / (double)((2 * n - 1) * (2 * n)); tsn *= -r2 / (double)((2 * n) * (2 * n + 1)); cs += tc; sn += tsn; }
            ROPEC[idx] = (float)cs; ROPES[idx] = (float)sn;
        }
        LAS float* scr = (LAS float*)(lds + wave * 8448);
        constexpr int I_QKV = 16 * 48, I_O = 16 * 32, I_HIN = 16 * 160, I_HO = 16 * 32, I_F1 = 16 * 176, I_F2 = 44 * 32;
        constexpr int NITEMS = I_QKV + I_O + I_HIN + I_HO + 2 * I_F1 + 2 * I_F2;
        for (int it = gw; it < NITEMS; it += NGW) {
            int r = it;
            if (r < I_QKV) { p0_transpose_item<1>((ap->in[8]), 1024, 1536, Wqkv_t, scr, r, lane); continue; } r -= I_QKV;
            if (r < I_O) { p0_transpose_item<0>((ap->in[11]), 1024, 1024, Wo_t, scr, r, lane); continue; } r -= I_O;
            if (r < I_HIN) { p0_transpose_item<0>((ap->in[12]), 1024, 5120, Hin_t, scr, r, lane); continue; } r -= I_HIN;
            if (r < I_HO) { p0_transpose_item<0>((ap->in[15]), 1024, 1024, Ho_t, scr, r, lane); continue; } r -= I_HO;
            if (r < I_F1) { p0_transpose_item<2>((ap->in[16]), 1024, 5632, F1A_t, scr, r, lane); continue; } r -= I_F1;
            if (r < I_F1) { p0_transpose_item<2>((ap->in[16]) + (size_t)1024 * 5632, 1024, 5632, F1B_t, scr, r, lane); continue; } r -= I_F1;
            if (r < I_F2) { p0_transpose_item<0>((ap->in[17]), 2816, 1024, F2A_t, scr, r, lane); continue; } r -= I_F2;
            p0_transpose_item<0>((ap->in[17]) + (size_t)2816 * 1024, 2816, 1024, F2B_t, scr, r, lane);
        }
    }
    xcd_barrier(bar);
    { PHASE_IDS();
      const bool qcu = (G == 256) && bx < 24;
      if (qcu) {
          const int pm = 128 + bx / 6, pn = bx % 6;
          norm_rows(wave, NWAVES, lane, (ap->in[0]), (ap->in[2]), pm * 256, pm * 256 + 256, (ap->in[6]), MOD, 0, 1, XN);
          asm volatile("s_waitcnt vmcnt(0)" ::: "memory"); __syncthreads();
          if (tid == 0) { __builtin_amdgcn_fence(__ATOMIC_ACQUIRE, "agent"); asm volatile("s_waitcnt vmcnt(0)" ::: "memory"); }
          __syncthreads();
          pg8::Gemm gq{XN, Wqkv_t, MALL, 1536, 1024}; pg8::OneUnit Sq{pm, pn, nullptr};
          pg8::EpiQKV Eq{QO, KB, VB, (ap->in[9]), (ap->in[10]), ROPEC, ROPES, attn_body::C2};
          pg8::gemm_phase<pg8::EpiQKV, pg8::OneUnit, PG8_ALIGN, PG8_SP2>(lds, gq, Sq, Eq);
      } else {
      const int gw1 = (G == 256) ? (bx - 24) * NWAVES + wave : gw, NGW1 = (G == 256) ? 232 * NWAVES : NGW;
      norm_rows(gw1, NGW1, lane, (ap->in[0]), (ap->in[2]), 0, (G == 256) ? NLAT : MALL, (ap->in[6]), MOD, 0, 1, XN);
      for (int site = 0; site < 3; ++site) {
          const bf16* Bt = site == 0 ? F1A_t : site == 1 ? Hin_t : F1B_t; const int N = site == 1 ? 5120 : 5632;
          const float* shv = (site == 0 ? MOD : MOD1) + (site == 1 ? 0 : 3) * 1024; float* dst = site == 0 ? SHW0 : site == 1 ? SHW1 : SHW2;
          for (int n = gw1; n < N; n += NGW1) {
              const v4u w0 = *(const v4u*)(Bt + (size_t)n * 1024 + lane * 16), w1 = *(const v4u*)(Bt + (size_t)n * 1024 + lane * 16 + 8);
              float wf[16];
#pragma unroll
              for (int e = 0; e < 4; ++e) { wf[2 * e] = bf2f((unsigned short)(w0[e] & 0xffffu)); wf[2 * e + 1] = bf2f((unsigned short)(w0[e] >> 16)); wf[8 + 2 * e] = bf2f((unsigned short)(w1[e] & 0xffffu)); wf[8 + 2 * e + 1] = bf2f((unsigned short)(w1[e] >> 16)); }
#pragma unroll
              for (int v = 0; v < 5; ++v) { const float* sp = shv + v * 6144 + lane * 16; float a = 0.f;
#pragma unroll
                  for (int e4 = 0; e4 < 4; ++e4) { const f32x4 s4 = *(const f32x4*)(sp + 4 * e4); a += (wf[4 * e4] * s4[0] + wf[4 * e4 + 1] * s4[1]) + (wf[4 * e4 + 2] * s4[2] + wf[4 * e4 + 3] * s4[3]); }
                  a = wave_sum(a); if (lane == 0) dst[v * N + n] = a; }
          }
      }
      }
    }
    xcd_barrier(bar);
    {
        PHASE_IDS();
        const int Mrows = (G == 256) ? NLAT : MALL;
        pg8::Gemm g{XN, Wqkv_t, Mrows, 1536, 1024}; pg8::StaticOrder S; S.init(Mrows, 1536, G, bx);
        pg8::EpiQKV E{QO, KB, VB, (ap->in[9]), (ap->in[10]), ROPEC, ROPES, attn_body::C2};
        pg8::gemm_phase<pg8::EpiQKV, pg8::StaticOrder, PG8_ALIGN, PG8_SP2>(lds, g, S, E);
    }
    xcd_barrier(bar);
    {
        PHASE_IDS();
        for (int i = 0; i < 8; ++i) {
            const int u = i * 256 + vcu; if (u >= 2048 || G != 256) break;
            const int combo = u >> 7, idx = u & 127, b = combo >> 2, kvh = combo & 3, hq = idx >> 5, qb = idx & 31, h = kvh * 4 + hq;
            const attn_body::bf16* Qu = (const attn_body::bf16*)QO + ((size_t)b * SEQ + qb * 256) * 1024 + h * 64;
            const attn_body::bf16* Kh = (const attn_body::bf16*)KB + (size_t)b * KVROWS * 256 + kvh * 64;
            const attn_body::bf16* Vh = (const attn_body::bf16*)VB + (size_t)b * KVROWS * 256 + kvh * 64;
            attn_body::attn_unit<8>(Qu, Kh, Vh, (attn_body::bf16*)XN + (Qu - (const attn_body::bf16*)QO), 132, (char*)lds_raw);
        }
        if (G != 256) for (int u = bx; u < 2048; u += G) {
            const int combo = u >> 7, idx = u & 127, b = combo >> 2, kvh = combo & 3, hq = idx >> 5, qb = idx & 31, h = kvh * 4 + hq;
            const attn_body::bf16* Qu = (const attn_body::bf16*)QO + ((size_t)b * SEQ + qb * 256) * 1024 + h * 64;
            const attn_body::bf16* Kh = (const attn_body::bf16*)KB + (size_t)b * KVROWS * 256 + kvh * 64;
            const attn_body::bf16* Vh = (const attn_body::bf16*)VB + (size_t)b * KVROWS * 256 + kvh * 64;
            attn_body::attn_unit<8>(Qu, Kh, Vh, (attn_body::bf16*)XN + (Qu - (const attn_body::bf16*)QO), 132, (char*)lds_raw);
        }
        for (int u = bx; u < 64; u += G) {
            const int b = u >> 4, h = u & 15, kvh = h >> 2;
            const attn_body::bf16* Qu = (const attn_body::bf16*)QO + ((size_t)NLAT + b * CTXL) * 1024 + h * 64;
            const attn_body::bf16* Kh = (const attn_body::bf16*)KB + (size_t)b * KVROWS * 256 + kvh * 64;
            const attn_body::bf16* Vh = (const attn_body::bf16*)VB + (size_t)b * KVROWS * 256 + kvh * 64;
            attn_body::attn_unit<8>(Qu, Kh, Vh, (attn_body::bf16*)XN + (Qu - (const attn_body::bf16*)QO), 4, (char*)lds_raw);
        }
    }
    xcd_barrier(bar);
    {
        PHASE_IDS();
        const int Mrows = (G == 256) ? NLAT : MALL;
        pg8::Gemm g{XN, Wo_t, Mrows, 1024, 1024}; pg8::StaticOrder S; S.init(Mrows, 1024, G, bx);
        pg8::EpiResidN<true> E{(ap->in[0]), (ap->in[2]), HB, HCTX, MOD + 2 * 1024, (bf16*)(ws + WS_XN2), SS0, (ap->in[7]), MOD + 4 * 1024, (LAS float*)(lds + 139264)};
        pg8::gemm_phase<pg8::EpiResidN<true>, pg8::StaticOrder, PG8_ALIGN, PG8_SP2>(lds, g, S, E);
    }
    xcd_barrier(bar);
    {
        PHASE_IDS();
        pg8::EpiSwiGLU E{(bf16*)(ws + WS_HID0), SS0, SHW0};
        pg8::Gemm g{(const bf16*)(ws + WS_XN2), F1A_t, MALL, 5632, 1024};
        if (G == 256) {
            unsigned* cntW = (unsigned*)(ws + WS_BAR) + XCD_BAR_WORDS + 64; unsigned* cntU = cntW + 64; unsigned* cntD = cntW + 128;
            if (bx < 240) {
                const int x = bx & 7, idx = bx >> 3; const bool hasW = (x == 0 && idx < 16), hasH = idx < 6;
                if (hasW) {
                    pg8::Gemm gw_{XN, Wo_t, MALL, 1024, 1024}; pg8::OneUnit Sw{128 + (idx >> 2), idx & 3, cntW};
                    pg8::EpiResidN<true> Ew{(ap->in[0]), (ap->in[2]), HB, HCTX, MOD + 2 * 1024, (bf16*)(ws + WS_XN2), SS0, (ap->in[7]), MOD + 4 * 1024, (LAS float*)(lds + 139264)};
                    pg8::gemm_phase<pg8::EpiResidN<true>, pg8::OneUnit, PG8_ALIGN, PG8_SP2>(lds, gw_, Sw, Ew);
                }
                pg8::UpOrder S{bx, hasW ? 1 : 0, hasH ? 11 : 12, cntW, cntU};
                pg8::gemm_phase<pg8::EpiSwiGLU, pg8::UpOrder, PG8_ALIGN, PG8_SP2>(lds, g, S, E);
                if (hasH) {
                    pg8::wave_wait_count(cntD, 16u); __syncthreads();
                    const int hidx = x * 6 + idx;
                    pg8::Gemm gh{XN, Hin_t, MALL, 5120, 1024}; pg8::OneUnit Sh{128 + hidx / 12, 8 + hidx % 12, nullptr};
                    pg8::EpiHgrnIn Eh{ws, (ap->in[13]), SS1, SHW1};
                    pg8::gemm_phase<pg8::EpiHgrnIn, pg8::OneUnit, PG8_ALIGN, PG8_SP2>(lds, gh, Sh, Eh);
                }
            } else {
                const int d = bx - 240;
                { pg8::UpOrderD S{d, 0, 3}; pg8::gemm_phase<pg8::EpiSwiGLU, pg8::UpOrderD, PG8_ALIGN, PG8_SP2>(lds, g, S, E); }
                pg8::wave_wait_count(cntU, 88u); __syncthreads();
                {
                    pg8::Gemm g2{(const bf16*)(ws + WS_HID0), F2A_t, MALL, 1024, FFH}; pg8::OneUnit S2{128 + (d >> 2), d & 3, cntD};
                    pg8::EpiResidN<false> E2{HB, HCTX, HB, HCTX, MOD + 5 * 1024, XN, SS1, (ap->in[6]) + 1024, MOD1 + 1 * 1024, (LAS float*)(lds + 139264)};
                    pg8::gemm_phase<pg8::EpiResidN<false>, pg8::OneUnit, PG8_ALIGN, PG8_SP2>(lds, g2, S2, E2);
                }
                { pg8::UpOrderD S{d, 3, 6}; pg8::gemm_phase<pg8::EpiSwiGLU, pg8::UpOrderD, PG8_ALIGN, PG8_SP2>(lds, g, S, E); }
            }
        } else {
            pg8::StaticOrder S; S.init(MALL, 5632, G, bx);
            pg8::gemm_phase<pg8::EpiSwiGLU, pg8::StaticOrder, PG8_ALIGN, PG8_SP2>(lds, g, S, E);
        }
    }
    xcd_barrier(bar);
    {
        PHASE_IDS();
        const int Mrows = (G == 256) ? NLAT : MALL;
        pg8::Gemm g{(const bf16*)(ws + WS_HID0), F2A_t, Mrows, 1024, FFH}; pg8::StaticOrder S; S.init(Mrows, 1024, G, bx);
        pg8::EpiResidN<false> E{HB, HCTX, HB, HCTX, MOD + 5 * 1024, XN, SS1, (ap->in[6]) + 1024, MOD1 + 1 * 1024, (LAS float*)(lds + 139264)};
        pg8::gemm_phase<pg8::EpiResidN<false>, pg8::StaticOrder, PG8_ALIGN, PG8_SP2>(lds, g, S, E);
    }
    xcd_barrier(bar);
    {
        PHASE_IDS();
        const int Mrows = (G == 256) ? NLAT : MALL;
        pg8::Gemm g{XN, Hin_t, Mrows, 5120, 1024}; pg8::StaticOrder S; S.init(Mrows, 5120, G, bx);
        pg8::EpiHgrnIn E{ws, (ap->in[13]), SS1, SHW1};
        pg8::gemm_phase<pg8::EpiHgrnIn, pg8::StaticOrder, PG8_ALIGN, PG8_SP2>(lds, g, S, E);
    }
    xcd_barrier(bar);
    { PHASE_IDS();
    for (int item = bx; item < 256; item += G)
        hgrn_scan_item<0>(lds, item, (const bf16*)(ws + WS_HQ), (const bf16*)(ws + WS_HV), (const bf16*)(ws + WS_LFW), (const bf16*)(ws + WS_LBW), (const bf16*)(ws + WS_HVC), (const bf16*)(ws + WS_LFWC), (const bf16*)(ws + WS_LBWC), OFWP, (bf16*)(ws + WS_OBW), (float*)(ws + WS_U), (float*)(ws + WS_D)); }
    xcd_barrier(bar);
    { PHASE_IDS();
    for (int item = bx; item < 256; item += G)
        hgrn_scan_item<1>(lds, item, (const bf16*)(ws + WS_HQ), (const bf16*)(ws + WS_HV), (const bf16*)(ws + WS_LFW), (const bf16*)(ws + WS_LBW), (const bf16*)(ws + WS_HVC), (const bf16*)(ws + WS_LFWC), (const bf16*)(ws + WS_LBWC), OFWP, (bf16*)(ws + WS_OBW), (float*)(ws + WS_U), (float*)(ws + WS_D)); }
    xcd_barrier(bar);
    { PHASE_IDS(); hgrn_combine(gw, NGW, lane, (const bf16*)OFWP, (const bf16*)(ws + WS_OBW), (const bf16*)(ws + WS_HG), (ap->in[14]), (bf16*)(ws + WS_OG)); }
    xcd_barrier(bar);
    {
        PHASE_IDS();
        pg8::Gemm g{(const bf16*)(ws + WS_OG), Ho_t, NLAT, 1024, 1024}; pg8::StaticOrder S; S.init(NLAT, 1024, G, bx);
        pg8::EpiResidN<false> E{HB, HCTX, HB, HCTX, MOD1 + 2 * 1024, XN, SS2, (ap->in[7]) + 1024, MOD1 + 4 * 1024, (LAS float*)(lds + 139264)};
        pg8::gemm_phase<pg8::EpiResidN<false>, pg8::StaticOrder, PG8_ALIGN, PG8_SP2>(lds, g, S, E);
    }
    xcd_barrier(bar);
    {
        PHASE_IDS();
        pg8::Gemm g{XN, F1B_t, NLAT, 5632, 1024}; pg8::StaticOrder S; S.init(NLAT, 5632, G, bx);
        pg8::EpiSwiGLU E{(bf16*)(ws + WS_HID1), SS2, SHW2};
        pg8::gemm_phase<pg8::EpiSwiGLU, pg8::StaticOrder, PG8_ALIGN, PG8_SP2>(lds, g, S, E);
    }
    xcd_barrier(bar);
    {
        PHASE_IDS();
        pg8::Gemm g{(const bf16*)(ws + WS_HID1), F2B_t, NLAT, 1024, FFH}; pg8::StaticOrder S; S.init(NLAT, 1024, G, bx);
        if (G == 256) {
            pg8::EpiResidFinal E{HB, (ap->out), MOD1 + 5 * 1024, SS3, (unsigned*)(ws + WS_BAR) + XCD_BAR_WORDS + 256, (ap->in[18]), (LAS float*)(lds + 139264)};
            pg8::gemm_phase<pg8::EpiResidFinal, pg8::StaticOrder, PG8_ALIGN, PG8_SP2>(lds, g, S, E);
        } else {
            pg8::EpiResid E{HB, (ap->out), MOD1 + 5 * 1024};
            pg8::gemm_phase<pg8::EpiResid, pg8::StaticOrder, PG8_ALIGN, PG8_SP2>(lds, g, S, E);
        }
    }
    if (gridDim.x != 256) {
        xcd_barrier(bar);
        { PHASE_IDS(); final_norm_rows(gw, NGW, lane, (ap->out), (ap->in[18])); }
    }
}


extern "C" void kernel_launch(void* const* d_in, const int* in_sizes, int n_in, void* d_out, int out_size, void* d_ws, size_t ws_size, hipStream_t stream) {
    static int grid = 0;
    if (grid == 0) {
        if (n_in != 19 || out_size != NLAT * DM || ws_size < WS_END) { fprintf(stderr, "kernel_launch: unexpected shapes: n_in %d out %d ws %zu\n", n_in, out_size, ws_size); grid = -1; return; }
        int dev = 0, cus = 0, per_cu = 0;
        if (hipGetDevice(&dev) != hipSuccess || hipDeviceGetAttribute(&cus, hipDeviceAttributeMultiprocessorCount, dev) != hipSuccess) { grid = -1; return; }
        if (hipFuncSetAttribute((const void*)mk_fwd, hipFuncAttributeMaxDynamicSharedMemorySize, LDS_BYTES) != hipSuccess) { fprintf(stderr, "kernel_launch: hipFuncSetAttribute failed\n"); grid = -1; return; }
        if (hipOccupancyMaxActiveBlocksPerMultiprocessor(&per_cu, (const void*)mk_fwd, NWAVES * 64, LDS_BYTES) != hipSuccess || per_cu < 1) { fprintf(stderr, "kernel_launch: occupancy query says %d\n", per_cu); per_cu = 1; }
        (void)hipGetLastError();
        grid = cus;
    }
    if (grid < 0) return;
    if (hipMemsetAsync((char*)d_ws + WS_BAR, 0, (XCD_BAR_WORDS + 512) * 4, stream) != hipSuccess) { fprintf(stderr, "kernel_launch: memset of the barrier words failed\n"); return; }
    Args a{};
    for (int i = 0; i < 19; ++i) a.in[i] = (const float*)d_in[i];
    a.out = (float*)d_out; a.ws = (unsigned char*)d_ws;
    void* kargs[] = {&a};
    hipError_t e = hipLaunchCooperativeKernel((const void*)mk_fwd, dim3(grid), dim3(NWAVES * 64), kargs, LDS_BYTES, stream);
    if (e != hipSuccess) fprintf(stderr, "kernel_launch: cooperative launch failed: %s (grid %d)\n", hipGetErrorString(e), grid);
}
```
